# Optimizing an MI355X kernel written in HIP

```python
import jax, jax.numpy as jnp
from jax import lax
import numpy as np

D_MODEL = 2048
BATCH = 4
SEQ = 4096
DEPTH = 4

N_MIXERS = 3
N_POOL_LAYERS = (DEPTH + 2) // 3
N_HGRN_LAYERS = (DEPTH + 1) // 3
N_RET_LAYERS = DEPTH // 3

EPS = 1e-6

POOL_WINDOWS = (2, 4, 8, 16)
POOL_GROUPS = len(POOL_WINDOWS)
POOL_GROUP_DIM = D_MODEL // POOL_GROUPS

HGRN_EXPAND = 128
HGRN_HEADS = D_MODEL // HGRN_EXPAND
HGRN_DK = HGRN_EXPAND
HGRN_DV = D_MODEL // HGRN_HEADS
HGRN_QK = HGRN_HEADS * HGRN_DK
HGRN_V = HGRN_HEADS * HGRN_DV
HGRN_IN = 2 * HGRN_QK + 2 * HGRN_V
HGRN_CHUNK = 16

RET_HEADS = 8
RET_DK = D_MODEL // RET_HEADS
RET_DV = 2 * RET_DK
RET_QK = RET_HEADS * RET_DK
RET_V = RET_HEADS * RET_DV
RET_IN = 2 * RET_QK + 2 * RET_V
RET_CHUNK = 64
ROPE_BASE = 10000.0

FFN_HIDDEN = -(-8 * D_MODEL // (3 * 256)) * 256

kernel_name = "hybrid_pool_hgrn2_retention_adaln"

F32 = jnp.float32


def _rms_norm(x, gain):
    xf = x.astype(F32)
    y = xf * lax.rsqrt(jnp.mean(xf * xf, axis=-1, keepdims=True) + EPS)
    return (y * gain.astype(F32)).astype(x.dtype)


def _modulate(u, shift, scale):
    return u * (1.0 + scale[:, None, :]) + shift[:, None, :]


def _split_heads(t, n_heads):
    b, s, _ = t.shape
    return t.reshape(b, s, n_heads, -1).transpose(0, 2, 1, 3)


def _merge_heads(t):
    b, h, s, d = t.shape
    return t.transpose(0, 2, 1, 3).reshape(b, s, h * d)


def _head_rms_norm(o, gain):
    h, d = o.shape[1], o.shape[3]
    o = o * lax.rsqrt(jnp.mean(o * o, axis=-1, keepdims=True) + EPS)
    return o * gain.astype(F32).reshape(1, h, 1, d)


def _rotary(t, positions):
    half = t.shape[-1] // 2
    inv_freq = ROPE_BASE ** (-jnp.arange(half, dtype=F32) / half)
    ang = positions.astype(F32)[:, None, :, None] * inv_freq
    cos, sin = jnp.cos(ang), jnp.sin(ang)
    t1, t2 = t[..., :half], t[..., half:]
    return jnp.concatenate([t1 * cos - t2 * sin, t1 * sin + t2 * cos], axis=-1)


def _pool_mixer(u, w_group, scale):
    b, s, _ = u.shape
    uf = u.astype(F32)
    count = jnp.arange(1, s + 1, dtype=F32)
    parts = []
    for gi, w in enumerate(POOL_WINDOWS):
        xg = uf[..., gi * POOL_GROUP_DIM:(gi + 1) * POOL_GROUP_DIM]
        cs = jnp.cumsum(xg, axis=1)
        prev = jnp.pad(cs[:, :s - w], ((0, 0), (w, 0), (0, 0)))
        mean = (cs - prev) / jnp.minimum(count, float(w))[None, :, None]
        parts.append(mean - xg)
    p = jnp.stack(parts, axis=2).astype(u.dtype)
    y = jnp.einsum('bsgc,gce->bsge', p, w_group).reshape(b, s, D_MODEL)
    return y * scale


def _gla_chunkwise(q, k, v, log_f):
    b, h, s, dk = q.shape
    dv = v.shape[-1]
    c = HGRN_CHUNK
    n = s // c
    qc = q.reshape(b, h, n, c, dk)
    kc = k.reshape(b, h, n, c, dk)
    vc = v.reshape(b, h, n, c, dv)
    cum = jnp.cumsum(log_f.reshape(b, h, n, c, dk), axis=3)
    cum_last = cum[:, :, :, -1:, :]
    q_dec = qc * jnp.exp(cum)
    k_inv = kc * jnp.exp(-cum)
    k_end = kc * jnp.exp(cum_last - cum)
    decay = jnp.exp(cum_last[:, :, :, 0, :])
    causal = jnp.tril(jnp.ones((c, c), dtype=bool))
    scores = jnp.where(causal, jnp.einsum('bhncd,bhnsd->bhncs', q_dec, k_inv), 0.0)
    o_intra = jnp.einsum('bhncs,bhnsv->bhncv', scores, vc)

    def step(state, xs):
        q_n, k_n, v_n, dec_n = xs
        o_n = jnp.einsum('bhcd,bhdv->bhcv', q_n, state)
        state = dec_n[..., None] * state + jnp.einsum('bhcd,bhcv->bhdv', k_n, v_n)
        return state, o_n

    xs = (jnp.moveaxis(q_dec, 2, 0), jnp.moveaxis(k_end, 2, 0),
          jnp.moveaxis(vc, 2, 0), jnp.moveaxis(decay, 2, 0))
    _, o_inter = lax.scan(step, jnp.zeros((b, h, dk, dv), F32), xs)
    o = o_intra + jnp.moveaxis(o_inter, 0, 2)
    return o.reshape(b, h, s, dv)


def _hgrn2_mixer(u, w_in, lower_bound, norm_g, w_out):
    proj = (u @ w_in).astype(F32)
    q, f_logit, i, g = jnp.split(proj, [HGRN_QK, 2 * HGRN_QK, 2 * HGRN_QK + HGRN_V], axis=-1)
    lb = lower_bound.astype(F32)
    log_f = jnp.log(lb + (1.0 - lb) * jax.nn.sigmoid(f_logit))
    k = (1.0 - lb) * jax.nn.sigmoid(-f_logit)
    o = _gla_chunkwise(_split_heads(q, HGRN_HEADS), _split_heads(k, HGRN_HEADS),
                       _split_heads(i, HGRN_HEADS), _split_heads(log_f, HGRN_HEADS))
    o = _merge_heads(_head_rms_norm(o, norm_g)) * jax.nn.silu(g)
    return o.astype(u.dtype) @ w_out


def _retention_chunkwise(q, k, v):
    b, h, s, dk = q.shape
    dv = v.shape[-1]
    c = RET_CHUNK
    n = s // c
    log_gamma = jnp.log(1.0 - 2.0 ** (-5.0 - jnp.arange(h, dtype=F32)))
    idx = jnp.arange(c, dtype=F32)
    diff = idx[:, None] - idx[None, :]
    dmat = jnp.where(diff >= 0, jnp.exp(log_gamma[:, None, None] * jnp.maximum(diff, 0.0)), 0.0)
    qc = q.reshape(b, h, n, c, dk)
    kc = k.reshape(b, h, n, c, dk)
    vc = v.reshape(b, h, n, c, dv)
    scores = jnp.einsum('bhncd,bhnsd->bhncs', qc, kc) * dmat[None, :, None]
    o_intra = jnp.einsum('bhncs,bhnsv->bhncv', scores, vc)
    q_dec = qc * jnp.exp(log_gamma[:, None] * (idx + 1.0))[None, :, None, :, None]
    k_dec = kc * jnp.exp(log_gamma[:, None] * (c - 1.0 - idx))[None, :, None, :, None]
    chunk_decay = jnp.exp(log_gamma * c)[None, :, None, None]

    def step(state, xs):
        q_n, k_n, v_n = xs
        o_n = jnp.einsum('bhcd,bhdv->bhcv', q_n, state)
        state = chunk_decay * state + jnp.einsum('bhcd,bhcv->bhdv', k_n, v_n)
        return state, o_n

    xs = (jnp.moveaxis(q_dec, 2, 0), jnp.moveaxis(k_dec, 2, 0), jnp.moveaxis(vc, 2, 0))
    _, o_inter = lax.scan(step, jnp.zeros((b, h, dk, dv), F32), xs)
    o = o_intra + jnp.moveaxis(o_inter, 0, 2)
    return o.reshape(b, h, s, dv)


def _retention_mixer(u, positions, w_in, norm_g, w_out):
    proj = (u @ w_in).astype(F32)
    q, k, v, g = jnp.split(proj, [RET_QK, 2 * RET_QK, 2 * RET_QK + RET_V], axis=-1)
    q = _rotary(_split_heads(q, RET_HEADS), positions)
    k = _rotary(_split_heads(k, RET_HEADS), positions) * (RET_DK ** -0.5)
    v = _split_heads(v, RET_HEADS)
    o = _head_rms_norm(_retention_chunkwise(q, k, v), norm_g)
    o = _merge_heads(o) * jax.nn.silu(g)
    return o.astype(u.dtype) @ w_out


def _swiglu(u, w_in, w_out):
    gate, up = jnp.split(u @ w_in, 2, axis=-1)
    return (jax.nn.silu(gate) * up) @ w_out


def setup_inputs(seed: int = 0) -> dict:
    key = jax.random.key(seed)
    ks = jax.random.split(key, 24)
    d = D_MODEL
    nrm = jax.random.normal
    offsets = jax.random.randint(ks[2], (BATCH, 1), 0, 1024, dtype=jnp.int32)
    positions = (offsets + jnp.arange(SEQ, dtype=jnp.int32)[None, :]).astype(jnp.int32)
    return {
        "x": nrm(ks[0], (BATCH, SEQ, d), F32),
        "c": nrm(ks[1], (BATCH, d), F32),
        "positions": positions,
        "w_ada": nrm(ks[3], (DEPTH, d, 6 * d), F32) * (0.5 * d ** -0.5),
        "b_ada": nrm(ks[4], (DEPTH, 6 * d), F32) * 0.02,
        "norm_mix_g": 1.0 + 0.05 * nrm(ks[5], (DEPTH, d), F32),
        "norm_ffn_g": 1.0 + 0.05 * nrm(ks[6], (DEPTH, d), F32),
        "pool_w": nrm(ks[7], (N_POOL_LAYERS, POOL_GROUPS, POOL_GROUP_DIM, POOL_GROUP_DIM), F32) * POOL_GROUP_DIM ** -0.5,
        "pool_scale": 1.0 + 0.05 * nrm(ks[8], (N_POOL_LAYERS, d), F32),
        "hgrn_w_in": nrm(ks[9], (N_HGRN_LAYERS, d, HGRN_IN), F32) * d ** -0.5,
        "hgrn_lb_logits": 0.1 * nrm(ks[10], (DEPTH, HGRN_QK), F32),
        "hgrn_norm_g": 1.0 + 0.05 * nrm(ks[11], (N_HGRN_LAYERS, HGRN_V), F32),
        "hgrn_w_out": nrm(ks[12], (N_HGRN_LAYERS, HGRN_V, d), F32) * HGRN_V ** -0.5,
        "ret_w_in": nrm(ks[13], (N_RET_LAYERS, d, RET_IN), F32) * d ** -0.5,
        "ret_norm_g": 1.0 + 0.05 * nrm(ks[14], (N_RET_LAYERS, RET_V), F32),
        "ret_w_out": nrm(ks[15], (N_RET_LAYERS, RET_V, d), F32) * RET_V ** -0.5,
        "ffn_w_in": nrm(ks[16], (DEPTH, d, 2 * FFN_HIDDEN), F32) * d ** -0.5,
        "ffn_w_out": nrm(ks[17], (DEPTH, FFN_HIDDEN, d), F32) * FFN_HIDDEN ** -0.5,
        "final_norm_g": 1.0 + 0.05 * nrm(ks[18], (d,), F32),
    }


def reference(x, c, positions, w_ada, b_ada, norm_mix_g, norm_ffn_g,
              pool_w, pool_scale,
              hgrn_w_in, hgrn_lb_logits, hgrn_norm_g, hgrn_w_out,
              ret_w_in, ret_norm_g, ret_w_out,
              ffn_w_in, ffn_w_out, final_norm_g):
    ada = jnp.einsum('bd,lde->lbe', jax.nn.silu(c), w_ada) + b_ada[:, None, :]
    ada = ada.astype(x.dtype)
    lb_soft = jax.nn.softmax(hgrn_lb_logits.astype(F32), axis=0)
    lb_all = jnp.cumsum(lb_soft, axis=0) - lb_soft[0:1]
    h = x
    for i in range(DEPTH):
        shift_m, scale_m, gate_m, shift_f, scale_f, gate_f = jnp.split(ada[i], 6, axis=-1)
        u = _modulate(_rms_norm(h, norm_mix_g[i]), shift_m, scale_m)
        kind, j = i % N_MIXERS, i // N_MIXERS
        if kind == 0:
            y = _pool_mixer(u, pool_w[j], pool_scale[j])
        elif kind == 1:
            y = _hgrn2_mixer(u, hgrn_w_in[j], lb_all[i], hgrn_norm_g[j], hgrn_w_out[j])
        else:
            y = _retention_mixer(u, positions, ret_w_in[j], ret_norm_g[j], ret_w_out[j])
        h = h + gate_m[:, None, :] * y.astype(h.dtype)
        u = _modulate(_rms_norm(h, norm_ffn_g[i]), shift_f, scale_f)
        h = h + gate_f[:, None, :] * _swiglu(u, ffn_w_in[i], ffn_w_out[i]).astype(h.dtype)
    return _rms_norm(h, final_norm_g)
```

```cpp
#include <hip/hip_runtime.h>
#include <cstdio>
#include <cstdint>

#ifndef MK_ONE_LAUNCH
#define MK_ONE_LAUNCH 1
#endif
#define REP_S0 1
#define REP_S1 1
#define REP_S2 1
#define REP_S3 1
#define REP_P0 1
#define NAIVE_SCANS 0

constexpr int DM = 2048, NB = 4, SEQ = 4096, DEPTH = 4, M = NB * SEQ;
constexpr int ADA_W = 6 * DM;
constexpr int HG_IN = 8192, HG_H = 16, HG_DK = 128;
constexpr int RT_IN = 12288, RT_H = 8, RT_DK = 256, RT_DV = 512, RT_V = 4096;
constexpr int FF = 5632, FF2 = 2 * FF;
constexpr float EPS = 1e-6f;

namespace pg8 {
#define PG8_LAS __attribute__((address_space(3)))
typedef unsigned short bf16_t;
typedef short bf16x8 __attribute__((ext_vector_type(8)));
typedef float f32x4 __attribute__((ext_vector_type(4)));
typedef unsigned u32x4 __attribute__((ext_vector_type(4)));
constexpr int BM = 256, BK = 64, HALF = 128, HTB = HALF * BK * 2  , STAGE_BYTES = 8 * HTB, NXCD = 8, WGM = 4;

__host__ __device__ __forceinline__ int lds_byte(int r, int c) { const int st = (r >> 4) * 2 + (c >> 5), rr = r & 15, cc = c & 31, ob = rr * 64 + cc * 2; return st * 1024 + (ob ^ (((ob >> 9) & 1) << 5)); }
__host__ __device__ __forceinline__ void stage_rc(int b, int& R, int& C) { const int st = b / 1024, sb = b % 1024, swz = sb ^ (((sb >> 9) & 1) << 5); R = (st >> 1) * 16 + swz / 64; C = (st & 1) * 32 + (swz % 64) / 2; }
__host__ __device__ __forceinline__ int perm32(int rho) { const int n = rho >> 4, i = rho & 15; return 8 * (i >> 2) + 4 * n + (i & 3); }

struct Unit { int pm, pn; };
struct Gemm { const bf16_t* A; const bf16_t* Bt; int M, N, K, lda, ldb, gpn; long a_gs, b_gs; };

struct StaticOrder {
    int nM, nN, nwg, G, c;
    __host__ __device__ void init(int M_, int N_, int G_, int c_) { nM = M_ / BM; nN = N_ / BM; nwg = nM * nN; G = G_; c = c_; }
    __host__ __device__ bool next(int i, Unit& u) const {
        const long L = (long)i * G + c; if (L >= nwg) return false;
        int wgid = (int)L; { const int q = nwg / NXCD, r = nwg % NXCD, xcd = wgid % NXCD, off = wgid / NXCD; wgid = (xcd < r ? xcd * (q + 1) : r * (q + 1) + (xcd - r) * q) + off; }
        const int nig = WGM * nN, gid = wgid / nig, fm = gid * WGM, gsz = (nM - fm) < WGM ? (nM - fm) : WGM;
        u.pm = fm + ((wgid % nig) % gsz); u.pn = (wgid % nig) / gsz; return true;
    }
    __device__ __forceinline__ void a_ready(const Unit&) const {}
    __device__ __forceinline__ void done(const Unit&) const {}
};

__device__ __forceinline__ unsigned cvt_pk_bf16(float lo, float hi) { unsigned r; asm volatile("v_cvt_pk_bf16_f32 %0, %1, %2" : "=v"(r) : "v"(lo), "v"(hi)); return r; }

struct EpiBf16 {
    static constexpr bool PERM = true, AFTER_DRAIN = false;
    bf16_t* O; int ldc;
    __device__ __forceinline__ void operator()(const f32x4 (&acc)[2][2][4][2], const Unit& u, int wr, int wc, int fr, int fq) const {
        const int row0 = u.pm * BM + wr * 64 + fr, col0 = u.pn * BM + wc * 32 + 8 * fq;
#pragma unroll
        for (int ai = 0; ai < 2; ++ai)
#pragma unroll
            for (int m = 0; m < 4; ++m) { bf16_t* rowp = O + (size_t)(row0 + ai * HALF + m * 16) * ldc + col0;
#pragma unroll
                for (int bj = 0; bj < 2; ++bj) { const f32x4 v0 = acc[ai][bj][m][0], v1 = acc[ai][bj][m][1];
                    u32x4 w; w.x = cvt_pk_bf16(v0[0], v0[1]); w.y = cvt_pk_bf16(v0[2], v0[3]); w.z = cvt_pk_bf16(v1[0], v1[1]); w.w = cvt_pk_bf16(v1[2], v1[3]);
                    *(u32x4*)(rowp + bj * HALF) = w; } }
    }
};
__device__ __forceinline__ float scan16_mul(float x) {
#define PG8_DPP_SHR(v, n) __builtin_bit_cast(float, __builtin_amdgcn_update_dpp(0x3f800000, __builtin_bit_cast(int, v), 0x110 + (n), 0xf, 0xf, false))
    x *= PG8_DPP_SHR(x, 1); x *= PG8_DPP_SHR(x, 2); x *= PG8_DPP_SHR(x, 4); x *= PG8_DPP_SHR(x, 8);
#undef PG8_DPP_SHR
    return x;
}
__device__ __forceinline__ float bcast15(float x, int lane) { (void)lane; return __builtin_bit_cast(float, __builtin_amdgcn_update_dpp(0, __builtin_bit_cast(int, x), 0x15F, 0xf, 0xf, false)); }
__device__ __forceinline__ float sigm_f(float x) { return __builtin_amdgcn_rcpf(1.0f + __builtin_amdgcn_exp2f(-1.4426950408889634f * x)); }
struct EpiBf16Rot {
    static constexpr bool PERM = true, AFTER_DRAIN = false;
    bf16_t* O; int ldc; const float* ct; const float* st; int rot_tiles;
    int hg_tiles; const float* lbv; bf16_t* QD; bf16_t* KI; bf16_t* KE; float* DEC; bf16_t* HV;
    __device__ __forceinline__ void operator()(const f32x4 (&acc)[2][2][4][2], const Unit& u, int wr, int wc, int fr, int fq) const {
        const int row0 = u.pm * BM + wr * 64 + fr, col0 = u.pn * BM + wc * 32 + 8 * fq;
        if (u.pn < hg_tiles) {
            const int lane = fq * 16 + fr, cg = u.pn * HALF + wc * 32 + 8 * fq;
            float lb[8];
            { const f32x4 l0 = *(const f32x4*)(lbv + cg), l1 = *(const f32x4*)(lbv + cg + 4);
#pragma unroll
              for (int e = 0; e < 4; ++e) { lb[e] = l0[e]; lb[4 + e] = l1[e]; } }
#pragma unroll
            for (int ai = 0; ai < 2; ++ai)
#pragma unroll
                for (int mp = 0; mp < 2; ++mp) {
                    float qd0[8], ki0[8], ke0[8], qd1[8], ki1[8], ke1[8], tot[8];
#pragma unroll
                    for (int c = 0; c < 8; ++c) {
                        const float z0 = acc[ai][1][2 * mp][c >> 2][c & 3], z1 = acc[ai][1][2 * mp + 1][c >> 2][c & 3];
                        const float q0 = acc[ai][0][2 * mp][c >> 2][c & 3], q1 = acc[ai][0][2 * mp + 1][c >> 2][c & 3];
                        const float s0 = sigm_f(z0), s1 = sigm_f(z1), om = 1.0f - lb[c];
                        const float e0 = scan16_mul(lb[c] + om * s0);
                        const float e1 = scan16_mul(lb[c] + om * s1) * bcast15(e0, lane);
                        const float tt = bcast15(e1, lane);
                        const float k0 = om * (1.0f - s0) * __builtin_amdgcn_rcpf(e0), k1 = om * (1.0f - s1) * __builtin_amdgcn_rcpf(e1);
                        qd0[c] = q0 * e0; ki0[c] = k0; ke0[c] = k0 * tt; qd1[c] = q1 * e1; ki1[c] = k1; ke1[c] = k1 * tt; tot[c] = tt;
                    }
                    const int rr0 = row0 + ai * HALF + 32 * mp;
                    const size_t r0 = ((size_t)((rr0 >> 12) * 16 + u.pn) * 4096 + (rr0 & 4095)) * 128 + (wc * 32 + 8 * fq), r1 = r0 + 16 * 128;
                    u32x4 w;
                    w.x = cvt_pk_bf16(qd0[0], qd0[1]); w.y = cvt_pk_bf16(qd0[2], qd0[3]); w.z = cvt_pk_bf16(qd0[4], qd0[5]); w.w = cvt_pk_bf16(qd0[6], qd0[7]); *(u32x4*)(QD + r0) = w;
                    w.x = cvt_pk_bf16(ki0[0], ki0[1]); w.y = cvt_pk_bf16(ki0[2], ki0[3]); w.z = cvt_pk_bf16(ki0[4], ki0[5]); w.w = cvt_pk_bf16(ki0[6], ki0[7]); *(u32x4*)(KI + r0) = w;
                    w.x = cvt_pk_bf16(ke0[0], ke0[1]); w.y = cvt_pk_bf16(ke0[2], ke0[3]); w.z = cvt_pk_bf16(ke0[4], ke0[5]); w.w = cvt_pk_bf16(ke0[6], ke0[7]); *(u32x4*)(KE + r0) = w;
                    w.x = cvt_pk_bf16(qd1[0], qd1[1]); w.y = cvt_pk_bf16(qd1[2], qd1[3]); w.z = cvt_pk_bf16(qd1[4], qd1[5]); w.w = cvt_pk_bf16(qd1[6], qd1[7]); *(u32x4*)(QD + r1) = w;
                    w.x = cvt_pk_bf16(ki1[0], ki1[1]); w.y = cvt_pk_bf16(ki1[2], ki1[3]); w.z = cvt_pk_bf16(ki1[4], ki1[5]); w.w = cvt_pk_bf16(ki1[6], ki1[7]); *(u32x4*)(KI + r1) = w;
                    w.x = cvt_pk_bf16(ke1[0], ke1[1]); w.y = cvt_pk_bf16(ke1[2], ke1[3]); w.z = cvt_pk_bf16(ke1[4], ke1[5]); w.w = cvt_pk_bf16(ke1[6], ke1[7]); *(u32x4*)(KE + r1) = w;
                    if (fr == 15) { const int crow = u.pm * BM + wr * 64 + ai * HALF + 32 * mp; float* dp = DEC + ((size_t)((crow >> 12) * 16 + u.pn) * 128 + ((crow & 4095) >> 5)) * 128 + (wc * 32 + 8 * fq);
                        *(f32x4*)dp = (f32x4){tot[0], tot[1], tot[2], tot[3]}; *(f32x4*)(dp + 4) = (f32x4){tot[4], tot[5], tot[6], tot[7]}; }
                }
        } else if (u.pn < rot_tiles) {
            const float sc = u.pn >= 8 ? 0.0625f : 1.0f; const int j0 = wc * 32 + 8 * fq;
#pragma unroll
            for (int ai = 0; ai < 2; ++ai)
#pragma unroll
                for (int m = 0; m < 4; ++m) { const int row = row0 + ai * HALF + m * 16; bf16_t* rowp = O + (size_t)row * ldc + col0;
                    const f32x4 c0 = *(const f32x4*)(ct + (size_t)row * 128 + j0), c1 = *(const f32x4*)(ct + (size_t)row * 128 + j0 + 4);
                    const f32x4 s0 = *(const f32x4*)(st + (size_t)row * 128 + j0), s1 = *(const f32x4*)(st + (size_t)row * 128 + j0 + 4);
                    const f32x4 a0 = acc[ai][0][m][0], a1 = acc[ai][0][m][1], b0 = acc[ai][1][m][0], b1 = acc[ai][1][m][1];
                    const f32x4 p0 = (a0 * c0 - b0 * s0) * sc, p1 = (a1 * c1 - b1 * s1) * sc, q0 = (a0 * s0 + b0 * c0) * sc, q1 = (a1 * s1 + b1 * c1) * sc;
                    u32x4 w; w.x = cvt_pk_bf16(p0[0], p0[1]); w.y = cvt_pk_bf16(p0[2], p0[3]); w.z = cvt_pk_bf16(p1[0], p1[1]); w.w = cvt_pk_bf16(p1[2], p1[3]);
                    *(u32x4*)rowp = w;
                    w.x = cvt_pk_bf16(q0[0], q0[1]); w.y = cvt_pk_bf16(q0[2], q0[3]); w.z = cvt_pk_bf16(q1[0], q1[1]); w.w = cvt_pk_bf16(q1[2], q1[3]);
                    *(u32x4*)(rowp + HALF) = w; }
        } else {
            const bool hv = hg_tiles > 0 && u.pn < 24;
#pragma unroll
            for (int ai = 0; ai < 2; ++ai)
#pragma unroll
                for (int m = 0; m < 4; ++m) { const int row = row0 + ai * HALF + m * 16; bf16_t* rowp = O + (size_t)row * ldc + col0;
#pragma unroll
                    for (int bj = 0; bj < 2; ++bj) { const f32x4 v0 = acc[ai][bj][m][0], v1 = acc[ai][bj][m][1];
                        u32x4 w; w.x = cvt_pk_bf16(v0[0], v0[1]); w.y = cvt_pk_bf16(v0[2], v0[3]); w.z = cvt_pk_bf16(v1[0], v1[1]); w.w = cvt_pk_bf16(v1[2], v1[3]);
                        if (hv) *(u32x4*)(HV + ((size_t)((row >> 12) * 16 + 2 * (u.pn - 16) + bj) * 4096 + (row & 4095)) * 128 + wc * 32 + 8 * fq) = w;
                        else *(u32x4*)(rowp + bj * HALF) = w; } }
        }
    }
};
__device__ __forceinline__ float silu_f(float x) { return x * __builtin_amdgcn_rcpf(1.0f + __builtin_amdgcn_exp2f(-1.4426950408889634f * x)); }
struct EpiSwiGLU {
    static constexpr bool PERM = true, AFTER_DRAIN = false;
    bf16_t* O; int ldc;
    __device__ __forceinline__ void operator()(const f32x4 (&acc)[2][2][4][2], const Unit& u, int wr, int wc, int fr, int fq) const {
        const int row0 = u.pm * BM + wr * 64 + fr, col0 = u.pn * HALF + wc * 32 + 8 * fq;
#pragma unroll
        for (int ai = 0; ai < 2; ++ai)
#pragma unroll
            for (int m = 0; m < 4; ++m) { bf16_t* rowp = O + (size_t)(row0 + ai * HALF + m * 16) * ldc + col0;
                const f32x4 g0 = acc[ai][0][m][0], g1 = acc[ai][0][m][1], u0 = acc[ai][1][m][0], u1 = acc[ai][1][m][1];
                f32x4 e0 = g0 * -1.4426950408889634f, e1 = g1 * -1.4426950408889634f;
                const f32x4 p0 = g0 * u0, p1 = g1 * u1;
                __builtin_amdgcn_sched_barrier(0);
#pragma unroll
                for (int i = 0; i < 4; ++i) { e0[i] = __builtin_amdgcn_exp2f(e0[i]); e1[i] = __builtin_amdgcn_exp2f(e1[i]); }
                __builtin_amdgcn_sched_barrier(0);
                e0 = e0 + 1.0f; e1 = e1 + 1.0f;
                __builtin_amdgcn_sched_barrier(0);
#pragma unroll
                for (int i = 0; i < 4; ++i) { e0[i] = __builtin_amdgcn_rcpf(e0[i]); e1[i] = __builtin_amdgcn_rcpf(e1[i]); }
                __builtin_amdgcn_sched_barrier(0);
                const f32x4 o0 = p0 * e0, o1 = p1 * e1;
                u32x4 w; w.x = cvt_pk_bf16(o0[0], o0[1]); w.y = cvt_pk_bf16(o0[2], o0[3]); w.z = cvt_pk_bf16(o1[0], o1[1]); w.w = cvt_pk_bf16(o1[2], o1[3]);
                *(u32x4*)rowp = w; }
    }
};
struct EpiResid {
    static constexpr bool PERM = true, AFTER_DRAIN = false;
    const float* xin; const bf16_t* hin; bf16_t* hout; const float* gate; int gate_bs; const float* cscale;
    __device__ __forceinline__ void operator()(const f32x4 (&acc)[2][2][4][2], const Unit& u, int wr, int wc, int fr, int fq) const {
        const int row0 = u.pm * BM + wr * 64 + fr, col0 = u.pn * BM + wc * 32 + 8 * fq;
        const float* gp = gate + (size_t)(u.pm >> 4) * gate_bs + col0;
        f32x4 gv[2][2];
#pragma unroll
        for (int bj = 0; bj < 2; ++bj)
#pragma unroll
            for (int n = 0; n < 2; ++n) { gv[bj][n] = *(const f32x4*)(gp + bj * HALF + n * 4); if (cscale) gv[bj][n] = gv[bj][n] * *(const f32x4*)(cscale + col0 + bj * HALF + n * 4); }
#pragma unroll
        for (int ai = 0; ai < 2; ++ai)
#pragma unroll
            for (int m = 0; m < 4; ++m) { const size_t ro = (size_t)(row0 + ai * HALF + m * 16) * DM + col0;
#pragma unroll
                for (int bj = 0; bj < 2; ++bj) {
                    f32x4 h0, h1;
                    if (xin) { h0 = *(const f32x4*)(xin + ro + bj * HALF); h1 = *(const f32x4*)(xin + ro + bj * HALF + 4); }
                    else { const u32x4 hb = *(const u32x4*)(hin + ro + bj * HALF);
                        h0 = (f32x4){__builtin_bit_cast(float, hb.x << 16), __builtin_bit_cast(float, hb.x & 0xffff0000u), __builtin_bit_cast(float, hb.y << 16), __builtin_bit_cast(float, hb.y & 0xffff0000u)};
                        h1 = (f32x4){__builtin_bit_cast(float, hb.z << 16), __builtin_bit_cast(float, hb.z & 0xffff0000u), __builtin_bit_cast(float, hb.w << 16), __builtin_bit_cast(float, hb.w & 0xffff0000u)}; }
                    const f32x4 o0 = h0 + gv[bj][0] * acc[ai][bj][m][0], o1 = h1 + gv[bj][1] * acc[ai][bj][m][1];
                    u32x4 w; w.x = cvt_pk_bf16(o0[0], o0[1]); w.y = cvt_pk_bf16(o0[2], o0[3]); w.z = cvt_pk_bf16(o1[0], o1[1]); w.w = cvt_pk_bf16(o1[2], o1[3]);
                    *(u32x4*)(hout + ro + bj * HALF) = w; } }
    }
};

template <class Epi, class Sched, bool ALIGN_EPI = false>
__device__ __forceinline__ void gemm_phase(PG8_LAS unsigned char* lds, const Gemm g, const Sched& S, const Epi& E, const int tid) {
    const int wid = __builtin_amdgcn_readfirstlane(tid >> 6), lane = tid & 63, wr = wid >> 2, wc = wid & 3, fr = lane & 15, fq = lane >> 4;
    const int K = g.K, nt = K / BK, lda = g.lda, ldb = g.ldb;
    unsigned voffA[2], voffB[2];
#pragma unroll
    for (int i = 0; i < 2; ++i) { int R, C; stage_rc(tid * 16 + i * 8192, R, C); const int Rb = Epi::PERM ? ((R & ~31) + perm32(R & 31)) : R;
        voffA[i] = (unsigned)(R * lda + C) * 2u; voffB[i] = (unsigned)(Rb * ldb + C) * 2u; }
    const unsigned kstep = (unsigned)(BK * 2);
    const unsigned hstepA = (unsigned)HALF * lda * 2u, hstepB = (unsigned)HALF * ldb * 2u;
    const __amdgpu_buffer_rsrc_t rsA = __builtin_amdgcn_make_buffer_rsrc((void*)g.A, (short)0, 0x7fffffff, 0x00020000), rsB = __builtin_amdgcn_make_buffer_rsrc((void*)g.Bt, (short)0, 0x7fffffff, 0x00020000);
    const unsigned ldsw = (unsigned)wid * 1024u;
    const int aoff = lds_byte(wr * 64 + fr, fq * 8), boff = lds_byte(wc * 32 + fr, fq * 8);
#define PG8_SA(b, h) (((b) * 2 + (h)) * HTB)
#define PG8_SB(b, h) ((4 + (b) * 2 + (h)) * HTB)
#define PG8_STAGEA(bufoff, soff, voff) do { _Pragma("unroll") for (int _i = 0; _i < 2; ++_i) \
        __builtin_amdgcn_raw_ptr_buffer_load_lds(rsA, (PG8_LAS unsigned*)(lds + (bufoff) + ldsw + _i * 8192), 16, (voff)[_i], (soff), 0, 0); } while (0)
#define PG8_STAGEB(bufoff, soff, voff) do { _Pragma("unroll") for (int _i = 0; _i < 2; ++_i) \
        __builtin_amdgcn_raw_ptr_buffer_load_lds(rsB, (PG8_LAS unsigned*)(lds + (bufoff) + ldsw + _i * 8192), 16, (voff)[_i], (soff), 0, 0); } while (0)
#define PG8_LDA(dst, b, h) do { _Pragma("unroll") for (int m = 0; m < 4; ++m) _Pragma("unroll") for (int k = 0; k < 2; ++k) dst[m][k] = *(const PG8_LAS bf16x8*)(lds + PG8_SA(b, h) + aoff + m * 2048 + k * 1024); } while (0)
#define PG8_LDB(dst, b, h) do { _Pragma("unroll") for (int n = 0; n < 2; ++n) _Pragma("unroll") for (int k = 0; k < 2; ++k) dst[n][k] = *(const PG8_LAS bf16x8*)(lds + PG8_SB(b, h) + boff + n * 2048 + k * 1024); } while (0)
#define PG8_MMA(ai, bj, At, Bt) do { __builtin_amdgcn_s_setprio(1); _Pragma("unroll") for (int m = 0; m < 4; ++m) _Pragma("unroll") for (int n = 0; n < 2; ++n) _Pragma("unroll") for (int k = 0; k < 2; ++k) \
        acc[ai][bj][m][n] = __builtin_amdgcn_mfma_f32_16x16x32_bf16(Bt[n][k], At[m][k], acc[ai][bj][m][n], 0, 0, 0); __builtin_amdgcn_s_setprio(0); } while (0)
#define PG8_WAIT_V(n) asm volatile("s_waitcnt vmcnt(" #n ")" ::: "memory")
#define PG8_WAIT_L(n) asm volatile("s_waitcnt lgkmcnt(" #n ")" ::: "memory")
#define PG8_BAR __builtin_amdgcn_s_barrier()
#define PG8_SCHED __builtin_amdgcn_sched_barrier(0)
#define PG8_ABASE(u) ((unsigned)(((size_t)((u).pn / g.gpn) * (size_t)g.a_gs + (size_t)(u).pm * BM * lda) * 2))
#define PG8_BBASE(u) ((unsigned)(((size_t)((u).pn / g.gpn) * (size_t)g.b_gs + (size_t)((u).pn % g.gpn) * BM * ldb) * 2))
    Unit cur, nxt; int ui = 0;
    if (!S.next(0, cur)) return;
    f32x4 acc[2][2][4][2];
#pragma unroll
    for (int a = 0; a < 2; ++a)
#pragma unroll
        for (int b = 0; b < 2; ++b)
#pragma unroll
            for (int m = 0; m < 4; ++m)
#pragma unroll
                for (int n = 0; n < 2; ++n) acc[a][b][m][n] = (f32x4){0.f, 0.f, 0.f, 0.f};
    bf16x8 At[4][2], B0[2][2], B1[2][2];
    unsigned cA = PG8_ABASE(cur), cB = PG8_BBASE(cur);
    S.a_ready(cur);
    PG8_STAGEB(PG8_SB(0, 0), cB, voffB); PG8_STAGEB(PG8_SB(0, 1), cB + hstepB, voffB); PG8_STAGEA(PG8_SA(0, 0), cA, voffA); PG8_STAGEA(PG8_SA(0, 1), cA + hstepA, voffA);
    PG8_STAGEB(PG8_SB(1, 0), cB + kstep, voffB); PG8_STAGEA(PG8_SA(1, 0), cA + kstep, voffA); PG8_STAGEB(PG8_SB(1, 1), cB + hstepB + kstep, voffB);
    if (wr == 1) PG8_BAR;
    PG8_WAIT_V(8); PG8_BAR;
    PG8_WAIT_V(6); PG8_BAR;
    for (;;) {
        const bool has_next = S.next(ui + 1, nxt);
        const unsigned nA = has_next ? PG8_ABASE(nxt) : cA, nB = has_next ? PG8_BBASE(nxt) : cB;
        for (int t = 0; t < nt; t += 2) {
            const bool last = (t == nt - 2);
            const unsigned a1 = cA + (unsigned)(t + 1) * kstep;
            const unsigned a2 = last ? nA : cA + (unsigned)(t + 2) * kstep, b2 = last ? nB : cB + (unsigned)(t + 2) * kstep;
            const unsigned a3 = a2 + kstep, b3 = b2 + kstep;
            if (last && has_next) S.a_ready(nxt);
            PG8_LDB(B0, 0, 0); PG8_LDB(B1, 0, 1); PG8_SCHED; PG8_LDA(At, 0, 0); PG8_STAGEA(PG8_SA(1, 1), a1 + hstepA, voffA);
            PG8_WAIT_V(8); PG8_WAIT_L(0); PG8_BAR; PG8_MMA(0, 0, At, B0); PG8_MMA(0, 1, At, B1); PG8_BAR; PG8_SCHED;
            PG8_LDA(At, 0, 1); PG8_STAGEB(PG8_SB(0, 0), b2, voffB); PG8_STAGEB(PG8_SB(0, 1), b2 + hstepB, voffB); PG8_STAGEA(PG8_SA(0, 0), a2, voffA);
            PG8_WAIT_V(8); PG8_WAIT_L(0); PG8_BAR; PG8_MMA(1, 0, At, B0); PG8_MMA(1, 1, At, B1); PG8_BAR; PG8_SCHED;
            PG8_LDB(B0, 1, 0); PG8_LDB(B1, 1, 1); PG8_SCHED; PG8_LDA(At, 1, 0); PG8_STAGEA(PG8_SA(0, 1), a2 + hstepA, voffA);
            PG8_WAIT_V(8); PG8_WAIT_L(0); PG8_BAR; PG8_MMA(0, 0, At, B0); PG8_MMA(0, 1, At, B1); PG8_BAR; PG8_SCHED;
            PG8_LDA(At, 1, 1); PG8_STAGEB(PG8_SB(1, 0), b3, voffB); PG8_STAGEB(PG8_SB(1, 1), b3 + hstepB, voffB); PG8_STAGEA(PG8_SA(1, 0), a3, voffA);
            PG8_WAIT_V(8); PG8_WAIT_L(0); PG8_BAR; PG8_MMA(1, 0, At, B0); PG8_MMA(1, 1, At, B1); PG8_BAR; PG8_SCHED;
        }
        if constexpr (ALIGN_EPI) { if (wr == 0) PG8_BAR; }
        E(acc, cur, wr, wc, fr, fq); S.done(cur);
        if (!has_next) break;
#pragma unroll
        for (int a = 0; a < 2; ++a)
#pragma unroll
            for (int b = 0; b < 2; ++b)
#pragma unroll
                for (int m = 0; m < 4; ++m)
#pragma unroll
                    for (int n = 0; n < 2; ++n) acc[a][b][m][n] = (f32x4){0.f, 0.f, 0.f, 0.f};
        cur = nxt; cA = nA; cB = nB; ++ui;
        if constexpr (ALIGN_EPI) { if (wr == 1) PG8_BAR; }
    }
    PG8_WAIT_V(0);
    if constexpr (!ALIGN_EPI) { if (wr == 0) PG8_BAR; }
    PG8_BAR;
#undef PG8_SA
#undef PG8_SB
#undef PG8_STAGEA
#undef PG8_STAGEB
#undef PG8_LDA
#undef PG8_LDB
#undef PG8_MMA
#undef PG8_WAIT_V
#undef PG8_WAIT_L
#undef PG8_BAR
#undef PG8_SCHED
#undef PG8_ABASE
#undef PG8_BBASE
}
}

constexpr size_t MiB = 1u << 20;
constexpr size_t WS_CTL = 0, CTL_ZERO_BYTES = 1 * MiB;
constexpr size_t WS_ADA = 1 * MiB;
constexpr size_t WS_LB = 2 * MiB;
constexpr size_t WS_XRS = 3 * MiB;
constexpr size_t WS_ROT = 4 * MiB;
constexpr size_t WS_POOLW = 20 * MiB;
constexpr size_t WS_HGWIN = 24 * MiB;
constexpr size_t WS_HGWOUT = 56 * MiB;
constexpr size_t WS_RTWIN = 64 * MiB;
constexpr size_t WS_RTWOUT = 112 * MiB;
constexpr size_t WS_FFWIN = 128 * MiB;
constexpr size_t WS_FFWOUT = 304 * MiB;
constexpr size_t WS_U = 392 * MiB;
constexpr size_t WS_P = 456 * MiB;
constexpr size_t WS_PROJ = 584 * MiB;
constexpr size_t WS_O = 968 * MiB;
constexpr size_t WS_H = 1224 * MiB;
constexpr size_t WS_H2 = 1288 * MiB;
constexpr size_t WS_END = 1352 * MiB;
constexpr int CW_TMO = 0, CW_CODE = 1, CW_BAR = 4096;

constexpr int RING_OFF = 0, RING_BYTES = 131072;
constexpr int LDSCTL_OFF = RING_BYTES, MISC_OFF = LDSCTL_OFF + 320;
constexpr int LDS_BYTES = 147456;
constexpr int NWAVES = 8;

#define GAS __attribute__((address_space(1)))
#define LAS __attribute__((address_space(3)))
#define CAS __attribute__((address_space(4)))
typedef unsigned short bf16;
typedef unsigned v4u __attribute__((ext_vector_type(4)));
typedef unsigned v2u __attribute__((ext_vector_type(2)));
typedef float f32x4 __attribute__((ext_vector_type(4)));
typedef GAS unsigned gu32;
#define RLX_AGENT __ATOMIC_RELAXED, __HIP_MEMORY_SCOPE_AGENT
#define LDS_WAIT() asm volatile("s_waitcnt lgkmcnt(0)" ::: "memory")
__device__ __forceinline__ unsigned f2bf(float f) { unsigned u = __builtin_bit_cast(unsigned, f); return (u + 0x7fffu + ((u >> 16) & 1u)) >> 16; }
typedef float pk_f2 __attribute__((ext_vector_type(2)));
typedef __bf16 pk_b2 __attribute__((ext_vector_type(2)));
__device__ __forceinline__ unsigned pk2(float lo, float hi) { const pk_f2 v = {lo, hi}; return __builtin_bit_cast(unsigned, __builtin_convertvector(v, pk_b2)); }
__device__ __forceinline__ float bflo(unsigned w) { return __builtin_bit_cast(float, w << 16); }
__device__ __forceinline__ float bfhi(unsigned w) { return __builtin_bit_cast(float, w & 0xffff0000u); }
__device__ __forceinline__ float bf1(bf16 b) { return __builtin_bit_cast(float, (unsigned)b << 16); }
__device__ __forceinline__ float sigmoid_f(float x) { return __builtin_amdgcn_rcpf(1.0f + __builtin_amdgcn_exp2f(-1.4426950408889634f * x)); }
__device__ __forceinline__ float silu1(float x) { return x * sigmoid_f(x); }

#define XB_TMO      128
#define XB_XCNT(j)  (256  + 64 * (j))
#define XB_XSUB(j)  (1280 + 64 * (j))
#define XB_XGEN(j)  (2304 + 64 * (j))
#define XB_TOP      3328
#define XB_TOPGEN   3392
#define XCD_BAR_WORDS 3456
#define XB_SPIN_CAP (1u << 18)

__device__ __forceinline__ unsigned xb_ld(unsigned* p)              { return __hip_atomic_load(p, __ATOMIC_RELAXED, __HIP_MEMORY_SCOPE_AGENT); }
__device__ __forceinline__ unsigned xb_add(unsigned* p, unsigned v) { return __hip_atomic_fetch_add(p, v, __ATOMIC_RELAXED, __HIP_MEMORY_SCOPE_AGENT); }
__device__ __forceinline__ unsigned xb_xcc_id() { return (unsigned)__builtin_amdgcn_s_getreg((3 << 11) | 20) & 0xFu; }
#define XB_SPIN(cond, bar) do { unsigned _sp = 0; while (cond) { __builtin_amdgcn_s_sleep(1); \
    if ((++_sp & 255u) == 0u) { if (xb_ld(&(bar)[XB_TMO])) break; if (_sp > XB_SPIN_CAP) { atomicAdd(&(bar)[XB_TMO], 1u); break; } } } } while (0)

struct XcdBarrier { unsigned* bar; unsigned x; volatile LAS unsigned* st; };
#define XB_TID() ((int)__builtin_amdgcn_mbcnt_hi(~0u, __builtin_amdgcn_mbcnt_lo(~0u, 0u)) + 64 * xb_wave_id)

__device__ __forceinline__ XcdBarrier xcd_barrier_post(unsigned* bar, volatile LAS unsigned* st, const int xb_wave_id) {
    XcdBarrier b; b.bar = bar; b.x = xb_xcc_id(); b.st = st;
    if (XB_TID() == 0) (void)xb_add(&bar[XB_XCNT(b.x)], 1u);
    return b;
}
__device__ __forceinline__ void xcd_barrier_complete(unsigned* bar, unsigned x, unsigned& nloc, unsigned& nx) {
    const unsigned G = gridDim.x * gridDim.y * gridDim.z;
    unsigned sum, cnt, mine, sp = 0u;
    for (;;) {
        sum = 0u; cnt = 0u; mine = 0u;
#pragma unroll
        for (unsigned j = 0; j < 16; ++j) { const unsigned c = xb_ld(&bar[XB_XCNT(j)]); sum += c; cnt += (c > 0u) ? 1u : 0u; mine = (j == x) ? c : mine; }
        if (sum == G) break;
        __builtin_amdgcn_s_sleep(1);
        if ((++sp & 255u) == 0u) { if (xb_ld(&bar[XB_TMO])) break; if (sp > XB_SPIN_CAP) { atomicAdd(&bar[XB_TMO], 1u); break; } }
    }
    nloc = mine > 0u ? mine : 1u; nx = cnt > 0u ? cnt : 1u;
}
__device__ __forceinline__ void xcd_barrier(const XcdBarrier& b, const int xb_wave_id) {
    asm volatile("s_waitcnt vmcnt(0)" ::: "memory");
    __syncthreads();
    if (XB_TID() == 0) {
        unsigned* bar = b.bar;
        __builtin_amdgcn_s_waitcnt(0);
        unsigned nloc = b.st[0], nx = b.st[1];
        if (nloc == 0u) { xcd_barrier_complete(bar, b.x, nloc, nx); b.st[0] = nloc; b.st[1] = nx; }
        const unsigned old = xb_add(&bar[XB_XSUB(b.x)], 1u);
        const unsigned gen = old / nloc;
        if (old + 1u == (gen + 1u) * nloc) {
            __builtin_amdgcn_fence(__ATOMIC_RELEASE, "agent");
            asm volatile("s_waitcnt vmcnt(0)" ::: "memory");
            const unsigned og = xb_add(&bar[XB_TOP], 1u);
            const unsigned tg = og / nx;
            if (og + 1u == (tg + 1u) * nx) xb_add(&bar[XB_TOPGEN], 1u);
            else XB_SPIN(xb_ld(&bar[XB_TOPGEN]) == tg, bar);
            __builtin_amdgcn_fence(__ATOMIC_ACQUIRE, "agent");
            xb_add(&bar[XB_XGEN(b.x)], 1u);
            asm volatile("s_waitcnt vmcnt(0)" ::: "memory");
        } else {
            XB_SPIN(xb_ld(&bar[XB_XGEN(b.x)]) == gen, bar);
            __builtin_amdgcn_fence(__ATOMIC_ACQUIRE, "agent");
            asm volatile("s_waitcnt vmcnt(0)" ::: "memory");
        }
    }
    __syncthreads();
}

struct Args {
    const float* x; const float* c; const int* pos; const float* w_ada; const float* b_ada; const float* norm_mix_g; const float* norm_ffn_g;
    const float* pool_w; const float* pool_scale; const float* hgrn_w_in; const float* hgrn_lb; const float* hgrn_norm_g; const float* hgrn_w_out;
    const float* ret_w_in; const float* ret_norm_g; const float* ret_w_out; const float* ffn_w_in; const float* ffn_w_out; const float* final_g;
    float* out; unsigned char* ws; int ph_lo, ph_hi;
};

#define WS_DPP(v, ctrl) __builtin_bit_cast(float, __builtin_amdgcn_update_dpp(0, __builtin_bit_cast(int, v), (ctrl), 0xf, 0xf, true))
__device__ __forceinline__ float row16_sum(float v) { v += WS_DPP(v, 0xB1); v += WS_DPP(v, 0x4E); v += WS_DPP(v, 0x141); v += WS_DPP(v, 0x140); return v; }
#define WS_RL(v, l) __builtin_bit_cast(float, __builtin_amdgcn_readlane(__builtin_bit_cast(int, v), (l)))
__device__ __forceinline__ float wave_sum(float v) { v = row16_sum(v); return (WS_RL(v, 0) + WS_RL(v, 16)) + (WS_RL(v, 32) + WS_RL(v, 48)); }
__device__ __forceinline__ float half_sum(float v) {
    v = row16_sum(v); const float lo = WS_RL(v, 0) + WS_RL(v, 16), hi = WS_RL(v, 32) + WS_RL(v, 48);
    return (__builtin_amdgcn_mbcnt_hi(~0u, __builtin_amdgcn_mbcnt_lo(~0u, 0u)) < 32u) ? lo : hi; }

struct TItem { const float* W; bf16* WT; int K, N, mode, item; };
__device__ __forceinline__ void titem_load(const TItem& t, int lane, f32x4 (&wv)[8]) {
    const int nblk = t.N / 32, kb = t.item / nblk, nb = t.item % nblk, k0 = 64 * kb, n0 = 32 * nb;
#pragma unroll
    for (int i = 0; i < 8; ++i) wv[i] = *(const GAS f32x4*)(t.W + (size_t)(k0 + 8 * i + (lane >> 3)) * t.N + n0 + 4 * (lane & 7));
}
__device__ __forceinline__ void titem_finish(const TItem& t, LAS float* scr, int lane, const f32x4 (&wv)[8]) {
    const int nblk = t.N / 32, kb = t.item / nblk, nb = t.item % nblk, k0 = 64 * kb, n0 = 32 * nb;
    int d0 = n0;
    if (t.mode == 1) { const int bj = n0 >= FF ? 1 : 0, j = n0 - bj * FF; d0 = 256 * (j >> 7) + 128 * bj + (j & 127); }
    if (t.mode == 2 && n0 < 4096) { const int bj = n0 >> 11, j = n0 & 2047; d0 = 256 * (j >> 7) + 128 * bj + (j & 127); }
#pragma unroll
    for (int i = 0; i < 8; ++i) { LAS float* d = scr + (8 * i + (lane >> 3)) * 33 + 4 * (lane & 7); d[0] = wv[i].x; d[1] = wv[i].y; d[2] = wv[i].z; d[3] = wv[i].w; }
    LDS_WAIT(); asm volatile("" ::: "memory");
    const int c = lane & 7;
#pragma unroll
    for (int j = 0; j < 4; ++j) { const int n = (lane >> 3) + 8 * j; const LAS float* s = scr + (8 * c) * 33 + n;
        v4u o; o.x = pk2(s[0 * 33], s[1 * 33]); o.y = pk2(s[2 * 33], s[3 * 33]); o.z = pk2(s[4 * 33], s[5 * 33]); o.w = pk2(s[6 * 33], s[7 * 33]);
        if (t.mode == 3) { const int nn = d0 + n, kk = k0 + 8 * c;
            *(GAS v4u*)(t.WT + (size_t)((((nn >> 5) * 32 + (kk >> 4)) * 64) + ((kk >> 3) & 1) * 32 + (nn & 31)) * 8) = o; }
        else *(GAS v4u*)(t.WT + (size_t)(d0 + n) * t.K + k0 + 8 * c) = o; }
    LDS_WAIT(); asm volatile("" ::: "memory");
}
__device__ __forceinline__ void transpose_item(const float* W, int K, int N, bf16* WT, int mode, LAS float* scr, int item, int lane) {
    const TItem t{W, WT, K, N, mode, item}; f32x4 wv[8]; titem_load(t, lane, wv); titem_finish(t, scr, lane, wv);
}
struct WTile { const float* W; bf16* WT; int K, N, mode, idx; };
__device__ __forceinline__ void wtile_load(const WTile& t, int lane, int wave, f32x4 (&wv)[8]) {
    const int nblk = t.N >> 7, k0 = 128 * (t.idx / nblk), n0 = 128 * (t.idx % nblk);
#pragma unroll
    for (int i = 0; i < 8; ++i) wv[i] = *(const GAS f32x4*)(t.W + (size_t)(k0 + 16 * wave + 2 * i + (lane >> 5)) * t.N + n0 + 4 * (lane & 31));
}
__device__ __forceinline__ void wtile_to_lds(LAS unsigned char* T, int lane, int wave, const f32x4 (&wv)[8]) {
#pragma unroll
    for (int i = 0; i < 8; ++i) { const int r = 16 * wave + 2 * i + (lane >> 5); *(LAS f32x4*)(T + r * 512 + (((lane & 31) ^ ((r >> 3) & 7)) << 4)) = wv[i]; }
}
__device__ __forceinline__ void wtile_store(const WTile& t, const LAS unsigned char* T, int lane, int wave) {
    const int nblk = t.N >> 7, k0 = 128 * (t.idx / nblk), n0 = 128 * (t.idx % nblk);
    const int c = (lane & 7) + 8 * (lane >> 5), nl = (lane >> 3) & 3;
#pragma unroll
    for (int p = 0; p < 4; ++p) { const int nloc = 16 * wave + 4 * p + nl, n = n0 + nloc;
        const LAS float* s = (const LAS float*)(T + (8 * c) * 512 + (((nloc >> 2) ^ (lane & 7)) << 4) + (nloc & 3) * 4);
        v4u o; o.x = pk2(s[0 * 128], s[1 * 128]); o.y = pk2(s[2 * 128], s[3 * 128]); o.z = pk2(s[4 * 128], s[5 * 128]); o.w = pk2(s[6 * 128], s[7 * 128]);
        int d = n;
        if (t.mode == 1) { const int nb = n & ~31, bj = nb >= FF ? 1 : 0, j = nb - bj * FF; d = 256 * (j >> 7) + 128 * bj + (j & 127) + (n & 31); }
        if (t.mode == 2 && n < 4096) { const int nb = n & ~31, bj = nb >> 11, j = nb & 2047; d = 256 * (j >> 7) + 128 * bj + (j & 127) + (n & 31); }
        if (t.mode == 3) { const int kk = k0 + 8 * c;
            *(GAS v4u*)(t.WT + (size_t)((((n >> 5) * 32 + (kk >> 4)) * 64) + ((kk >> 3) & 1) * 32 + (n & 31)) * 8) = o; }
        else *(GAS v4u*)(t.WT + (size_t)d * t.K + k0 + 8 * c) = o; }
}
#define WT_BAR() do { asm volatile("s_waitcnt lgkmcnt(0)" ::: "memory"); __builtin_amdgcn_s_barrier(); asm volatile("" ::: "memory"); } while (0)
template <class AP> __device__ __forceinline__ void phase_prologue(const AP a, LAS unsigned char* lds, int tid, int lane, int wave, int vcu, int G) {
    unsigned char* ws = a->ws;
    float* ada = (float*)(ws + WS_ADA);
    LAS float* sc = (LAS float*)lds;
    LAS float* red = (LAS float*)(lds + 32768);
    for (int i = tid; i < NB * DM; i += 512) sc[i] = silu1(a->c[i]);
    __syncthreads();
    for (int it = vcu; it < DEPTH * (ADA_W / 256); it += G) {
        const int l = it / (ADA_W / 256), cb = it % (ADA_W / 256), e0 = cb * 256 + 4 * lane;
        const float* wp = a->w_ada + ((size_t)l * DM + (size_t)wave * 256) * ADA_W + e0;
        f32x4 acc[4];
#pragma unroll
        for (int b = 0; b < 4; ++b) acc[b] = (f32x4){0.f, 0.f, 0.f, 0.f};
#pragma unroll 16
        for (int d = 0; d < 256; ++d) {
            const f32x4 wv = *(const GAS f32x4*)(wp + (size_t)d * ADA_W);
#pragma unroll
            for (int b = 0; b < 4; ++b) { const float s = sc[b * DM + wave * 256 + d]; acc[b] = acc[b] + wv * s; }
        }
#pragma unroll
        for (int b = 0; b < 4; ++b) *(LAS f32x4*)(red + (wave * 4 + b) * 256 + 4 * lane) = acc[b];
        __syncthreads();
        for (int o = tid; o < 4 * 256; o += 512) { const int b = o >> 8, e = o & 255; float s = 0.f;
#pragma unroll
            for (int w = 0; w < 8; ++w) s += red[(w * 4 + b) * 256 + e];
            ada[((size_t)l * NB + b) * ADA_W + cb * 256 + e] = s + a->b_ada[(size_t)l * ADA_W + cb * 256 + e]; }
        __syncthreads();
    }
    const int gw = vcu * NWAVES + wave, NGW = G * NWAVES, gt = gw * 64 + lane, NGT = NGW * 64;
    { float* lb = (float*)(ws + WS_LB);
      for (int col = gt; col < DM; col += NGT) { float z[DEPTH], mx = -1e30f;
#pragma unroll
          for (int j = 0; j < DEPTH; ++j) { z[j] = a->hgrn_lb[j * DM + col]; mx = fmaxf(mx, z[j]); }
          float s = 0.f, e1 = 0.f;
#pragma unroll
          for (int j = 0; j < DEPTH; ++j) { const float e = __expf(z[j] - mx); s += e; if (j == 1) e1 = e; }
          lb[col] = e1 / s; } }
    { float* ct = (float*)(ws + WS_ROT); float* st = ct + (size_t)M * 128;
      for (int i = gt; i < M * 128; i += NGT) { const int m = i >> 7, f = i & 127;
          const float inv = exp2f(-(float)f * (13.287712379549449f / 128.0f));
          const float ang = (float)a->pos[m] * inv;
          const double rev = (double)ang * 0.15915494309189535; const float fr = (float)(rev - floor(rev));
          ct[i] = __builtin_amdgcn_cosf(fr); st[i] = __builtin_amdgcn_sinf(fr); } }
    { constexpr int T_POOL = 8 * 16, T_HGI = (DM / 128) * (HG_IN / 128), T_FFI0 = (DM / 128) * (FF2 / 128), T_FFO0 = (FF / 128) * (DM / 128), NT = T_POOL + T_HGI + T_FFI0 + T_FFO0;
#define EARLY_TDEC(t_, it_) do { int r = (it_); \
        if (r < T_POOL) { const int mt = r / 16; t_ = WTile{a->pool_w + (size_t)mt * 512 * 512, (bf16*)(ws + WS_POOLW) + (size_t)mt * 512 * 512, 512, 512, 3, r % 16}; break; } r -= T_POOL; \
        if (r < T_HGI) { t_ = WTile{a->hgrn_w_in, (bf16*)(ws + WS_HGWIN), DM, HG_IN, 2, r}; break; } r -= T_HGI; \
        if (r < T_FFI0) { t_ = WTile{a->ffn_w_in, (bf16*)(ws + WS_FFWIN), DM, FF2, 1, r}; break; } r -= T_FFI0; \
        t_ = WTile{a->ffn_w_out, (bf16*)(ws + WS_FFWOUT), FF, DM, 0, r}; } while (0)
      const bool balc = (G == 256); const int NGVC = DEPTH * (ADA_W / 256);
      const int lgs = (balc && vcu >= NGVC) ? 2 : 0, NV = balc ? NGVC + (G - NGVC) * 4 : G, vb = balc ? (vcu < NGVC ? vcu : NGVC + (vcu - NGVC) * 4) : vcu;
#define QTILE(q) (vb + ((q) & ((1 << lgs) - 1)) + ((q) >> lgs) * NV)
      __syncthreads();
      if (QTILE(0) < NT) {
          WTile tc, tn; f32x4 wv[8];
          EARLY_TDEC(tc, QTILE(0)); wtile_load(tc, lane, wave, wv);
          for (int q = 0; QTILE(q) < NT; ++q) {
              WT_BAR();
              wtile_to_lds(lds, lane, wave, wv);
              tn = tc; if (QTILE(q + 1) < NT) { EARLY_TDEC(tn, QTILE(q + 1)); wtile_load(tn, lane, wave, wv); }
              WT_BAR();
              wtile_store(tc, lds, lane, wave);
              tc = tn;
          }
          WT_BAR();
      }
#undef QTILE
#undef EARLY_TDEC
    }
    { const int l31 = lane & 31, h5 = lane >> 5;
      const __amdgpu_buffer_rsrc_t rsX = __builtin_amdgcn_make_buffer_rsrc((void*)a->x, (short)0, M * DM * 4, 0x00020000);
      const __amdgpu_buffer_rsrc_t rsC = __builtin_amdgcn_make_buffer_rsrc((void*)(ws + WS_H2), (short)0, M * DM * 2, 0x00020000);
      const bool bal = (G == 256); const int NGV = DEPTH * (ADA_W / 256);
      const int rpa = bal ? (vcu < NGV ? gw : NGV * NWAVES + (vcu - NGV) * NWAVES + wave) : gw, rps = bal ? (vcu < NGV ? M : (G - NGV) * NWAVES) : NGW;
      for (int rp = rpa; rp < M / 2; rp += rps) {
          const int row = 2 * rp + h5; const unsigned vo = (unsigned)row * (DM * 4) + (unsigned)l31 * 32u, vob = (unsigned)row * (DM * 2) + (unsigned)l31 * 16u;
          v4u q0[8], q1[8];
#pragma unroll
          for (int j = 0; j < 8; ++j) { q0[j] = __builtin_amdgcn_raw_buffer_load_b128(rsX, vo, (unsigned)j * 1024u, 0); q1[j] = __builtin_amdgcn_raw_buffer_load_b128(rsX, vo, (unsigned)j * 1024u + 16u, 0); }
          float ss = 0.f;
#pragma unroll
          for (int j = 0; j < 8; ++j) { const f32x4 p = __builtin_bit_cast(f32x4, q0[j]), c = __builtin_bit_cast(f32x4, q1[j]);
              ss += ((p.x * p.x + p.y * p.y) + (p.z * p.z + p.w * p.w)) + ((c.x * c.x + c.y * c.y) + (c.z * c.z + c.w * c.w));
              v4u o; o.x = pk2(p.x, p.y); o.y = pk2(p.z, p.w); o.z = pk2(c.x, c.y); o.w = pk2(c.z, c.w);
              __builtin_amdgcn_raw_buffer_store_b128(o, rsC, vob, (unsigned)j * 512u, 0); }
          ss = half_sum(ss);
          if (l31 == 0) ((float*)(ws + WS_XRS))[row] = 1.0f / sqrtf(ss * (1.0f / DM) + EPS);
      }
    }
}
template <class AP> __device__ __forceinline__ void phase_convert_late(const AP a, LAS unsigned char* lds, int lane, int wave, int gwc, int NGWC) {
    unsigned char* ws = a->ws;
    LAS float* scr = (LAS float*)(lds + wave * 16384);
    constexpr int I_HGO = (DM / 64) * (DM / 32), I_RTI = (DM / 64) * (RT_IN / 32), I_RTO = (RT_V / 64) * (DM / 32), I_FFI1 = (DM / 64) * (FF2 / 32), I_FFO1 = (FF / 64) * (DM / 32);
    constexpr int NITEMS = I_HGO + I_RTI + I_RTO + 3 * I_FFI1 + 3 * I_FFO1;
#define LATE_DECODE(t_, it_) do { int r = (it_); \
        if (r < I_HGO) { t_ = TItem{a->hgrn_w_out, (bf16*)(ws + WS_HGWOUT), DM, DM, 0, r}; break; } r -= I_HGO; \
        if (r < I_RTI) { t_ = TItem{a->ret_w_in, (bf16*)(ws + WS_RTWIN), DM, RT_IN, 0, r}; break; } r -= I_RTI; \
        if (r < I_RTO) { t_ = TItem{a->ret_w_out, (bf16*)(ws + WS_RTWOUT), RT_V, DM, 0, r}; break; } r -= I_RTO; \
        if (r < 3 * I_FFI1) { const int l = 1 + r / I_FFI1; t_ = TItem{a->ffn_w_in + (size_t)l * DM * FF2, (bf16*)(ws + WS_FFWIN) + (size_t)l * FF2 * DM, DM, FF2, 1, r % I_FFI1}; break; } r -= 3 * I_FFI1; \
        { const int l = 1 + r / I_FFO1; t_ = TItem{a->ffn_w_out + (size_t)l * FF * DM, (bf16*)(ws + WS_FFWOUT) + (size_t)l * DM * FF, FF, DM, 0, r % I_FFO1}; } } while (0)
    if (gwc >= NITEMS) return;
    TItem t0, t1, t2; f32x4 w0[8], w1[8], w2[8];
    LATE_DECODE(t0, gwc); titem_load(t0, lane, w0);
    t1 = t0; if (gwc + NGWC < NITEMS) { LATE_DECODE(t1, gwc + NGWC); titem_load(t1, lane, w1); }
    for (int it = gwc; it < NITEMS; it += 3 * NGWC) {
        if (it + 2 * NGWC < NITEMS) { LATE_DECODE(t2, it + 2 * NGWC); titem_load(t2, lane, w2); }
        __builtin_amdgcn_sched_barrier(0);
        titem_finish(t0, scr, lane, w0);
        if (it + NGWC >= NITEMS) break;
        if (it + 3 * NGWC < NITEMS) { LATE_DECODE(t0, it + 3 * NGWC); titem_load(t0, lane, w0); }
        __builtin_amdgcn_sched_barrier(0);
        titem_finish(t1, scr, lane, w1);
        if (it + 2 * NGWC >= NITEMS) break;
        if (it + 4 * NGWC < NITEMS) { LATE_DECODE(t1, it + 4 * NGWC); titem_load(t1, lane, w1); }
        __builtin_amdgcn_sched_barrier(0);
        titem_finish(t2, scr, lane, w2);
    }
#undef LATE_DECODE
}

template <class AP> __device__ __forceinline__ void phase_convert_late_tiles(const AP a, LAS unsigned char* lds, int lane, int wave, int wgc, int NWGC) {
    unsigned char* ws = a->ws;
    constexpr int T_HGO = (DM / 128) * (DM / 128), T_RTI = (DM / 128) * (RT_IN / 128), T_RTO = (RT_V / 128) * (DM / 128), T_FFI = (DM / 128) * (FF2 / 128), T_FFO = (FF / 128) * (DM / 128);
    constexpr int NT = T_HGO + T_RTI + T_RTO + 3 * T_FFI + 3 * T_FFO;
#define LATE_TDEC(t_, it_) do { int r = (it_); \
        if (r < T_HGO) { t_ = WTile{a->hgrn_w_out, (bf16*)(ws + WS_HGWOUT), DM, DM, 0, r}; break; } r -= T_HGO; \
        if (r < T_RTI) { t_ = WTile{a->ret_w_in, (bf16*)(ws + WS_RTWIN), DM, RT_IN, 0, r}; break; } r -= T_RTI; \
        if (r < T_RTO) { t_ = WTile{a->ret_w_out, (bf16*)(ws + WS_RTWOUT), RT_V, DM, 0, r}; break; } r -= T_RTO; \
        if (r < 3 * T_FFI) { const int l = 1 + r / T_FFI; t_ = WTile{a->ffn_w_in + (size_t)l * DM * FF2, (bf16*)(ws + WS_FFWIN) + (size_t)l * FF2 * DM, DM, FF2, 1, r % T_FFI}; break; } r -= 3 * T_FFI; \
        { const int l = 1 + r / T_FFO; t_ = WTile{a->ffn_w_out + (size_t)l * FF * DM, (bf16*)(ws + WS_FFWOUT) + (size_t)l * DM * FF, FF, DM, 0, r % T_FFO}; } } while (0)
    if (wgc >= NT) return;
    WTile tc, tn; f32x4 wv[8];
    LATE_TDEC(tc, wgc); wtile_load(tc, lane, wave, wv);
    for (int it = wgc; it < NT; it += NWGC) {
        WT_BAR();
        wtile_to_lds(lds, lane, wave, wv);
        const bool more = it + NWGC < NT;
        tn = tc; if (more) { LATE_TDEC(tn, it + NWGC); wtile_load(tn, lane, wave, wv); }
        WT_BAR();
        wtile_store(tc, lds, lane, wave);
        tc = tn;
    }
    WT_BAR();
#undef LATE_TDEC
}

__device__ __forceinline__ void phase_normmod(const float* hin, const float* g, const float* shift, const float* scale  , bf16* U, int gw, int NGW, int lane) {
    for (int r0 = gw * 8; r0 < M; r0 += NGW * 8) {
        const int b = r0 >> 12; const float* sh = shift + (size_t)b * ADA_W; const float* scp = scale + (size_t)b * ADA_W;
        f32x4 mul[8], add[8];
#pragma unroll
        for (int j = 0; j < 8; ++j) { const int col = 4 * lane + 256 * j; const f32x4 gv = *(const GAS f32x4*)(g + col), s = *(const GAS f32x4*)(scp + col); mul[j] = gv * (s + 1.0f); add[j] = *(const GAS f32x4*)(sh + col); }
        for (int rr = 0; rr < 8; ++rr) {
            const GAS f32x4* xr = (const GAS f32x4*)(hin + (size_t)(r0 + rr) * DM) + lane;
            f32x4 v[8]; float ss = 0.f;
#pragma unroll
            for (int j = 0; j < 8; ++j) { v[j] = xr[64 * j]; ss += (v[j].x * v[j].x + v[j].y * v[j].y) + (v[j].z * v[j].z + v[j].w * v[j].w); }
            const float rstd = 1.0f / sqrtf(wave_sum(ss) * (1.0f / DM) + EPS);
            GAS v2u* o8 = (GAS v2u*)(U + (size_t)(r0 + rr) * DM) + lane;
#pragma unroll
            for (int j = 0; j < 8; ++j) { const f32x4 y = v[j] * rstd * mul[j] + add[j]; v2u w; w.x = pk2(y.x, y.y); w.y = pk2(y.z, y.w); o8[64 * j] = w; }
        }
    }
}
__device__ __forceinline__ void phase_normmod_bf(const bf16* hin, const float* g, const float* shift, const float* scale  , bf16* U, int gw, int NGW, int lane) {
    for (int r0 = gw * 8; r0 < M; r0 += NGW * 8) {
        const int b = r0 >> 12; const float* sh = shift + (size_t)b * ADA_W; const float* scp = scale + (size_t)b * ADA_W;
        f32x4 mul[8], add[8];
#pragma unroll
        for (int j = 0; j < 8; ++j) { const int col = 8 * lane + 512 * (j >> 1) + 4 * (j & 1); const f32x4 gv = *(const GAS f32x4*)(g + col), s = *(const GAS f32x4*)(scp + col); mul[j] = gv * (s + 1.0f); add[j] = *(const GAS f32x4*)(sh + col); }
        for (int rr = 0; rr < 8; ++rr) {
            const GAS v4u* xr = (const GAS v4u*)(hin + (size_t)(r0 + rr) * DM) + lane;
            f32x4 v[8]; float ss = 0.f;
#pragma unroll
            for (int j = 0; j < 4; ++j) { const v4u q = xr[64 * j]; v[2 * j] = (f32x4){bflo(q.x), bfhi(q.x), bflo(q.y), bfhi(q.y)}; v[2 * j + 1] = (f32x4){bflo(q.z), bfhi(q.z), bflo(q.w), bfhi(q.w)}; }
#pragma unroll
            for (int j = 0; j < 8; ++j) ss += (v[j].x * v[j].x + v[j].y * v[j].y) + (v[j].z * v[j].z + v[j].w * v[j].w);
            const float rstd = 1.0f / sqrtf(wave_sum(ss) * (1.0f / DM) + EPS);
            GAS v4u* o16 = (GAS v4u*)(U + (size_t)(r0 + rr) * DM) + lane;
#pragma unroll
            for (int j = 0; j < 4; ++j) { const f32x4 y0 = v[2 * j] * rstd * mul[2 * j] + add[2 * j], y1 = v[2 * j + 1] * rstd * mul[2 * j + 1] + add[2 * j + 1];
                v4u w; w.x = pk2(y0.x, y0.y); w.y = pk2(y0.z, y0.w); w.z = pk2(y1.x, y1.y); w.w = pk2(y1.z, y1.w); o16[64 * j] = w; }
        }
    }
}
__device__ __forceinline__ void phase_finalnorm_bf(const bf16* hin, const float* g, float* out, int gw, int NGW, int lane) {
    for (int r0 = gw * 8; r0 < M; r0 += NGW * 8) {
        f32x4 mul[8];
#pragma unroll
        for (int j = 0; j < 8; ++j) mul[j] = *(const GAS f32x4*)(g + 8 * lane + 512 * (j >> 1) + 4 * (j & 1));
        for (int rr = 0; rr < 8; ++rr) {
            const GAS v4u* xr = (const GAS v4u*)(hin + (size_t)(r0 + rr) * DM) + lane;
            f32x4 v[8]; float ss = 0.f;
#pragma unroll
            for (int j = 0; j < 4; ++j) { const v4u q = xr[64 * j]; v[2 * j] = (f32x4){bflo(q.x), bfhi(q.x), bflo(q.y), bfhi(q.y)}; v[2 * j + 1] = (f32x4){bflo(q.z), bfhi(q.z), bflo(q.w), bfhi(q.w)}; }
#pragma unroll
            for (int j = 0; j < 8; ++j) ss += (v[j].x * v[j].x + v[j].y * v[j].y) + (v[j].z * v[j].z + v[j].w * v[j].w);
            const float rstd = 1.0f / sqrtf(wave_sum(ss) * (1.0f / DM) + EPS);
            float* orow = out + (size_t)(r0 + rr) * DM + 8 * lane;
#pragma unroll
            for (int j = 0; j < 8; ++j) *(GAS f32x4*)(orow + 512 * (j >> 1) + 4 * (j & 1)) = v[j] * rstd * mul[j];
        }
    }
}
__device__ __forceinline__ void phase_finalnorm(const float* hin, const float* g, float* out, int gw, int NGW, int lane) {
    for (int r0 = gw * 8; r0 < M; r0 += NGW * 8) {
        f32x4 mul[8];
#pragma unroll
        for (int j = 0; j < 8; ++j) mul[j] = *(const GAS f32x4*)(g + 4 * lane + 256 * j);
        for (int rr = 0; rr < 8; ++rr) {
            const GAS f32x4* xr = (const GAS f32x4*)(hin + (size_t)(r0 + rr) * DM) + lane;
            f32x4 v[8]; float ss = 0.f;
#pragma unroll
            for (int j = 0; j < 8; ++j) { v[j] = xr[64 * j]; ss += (v[j].x * v[j].x + v[j].y * v[j].y) + (v[j].z * v[j].z + v[j].w * v[j].w); }
            const float rstd = 1.0f / sqrtf(wave_sum(ss) * (1.0f / DM) + EPS);
            GAS f32x4* o = (GAS f32x4*)(out + (size_t)(r0 + rr) * DM) + lane;
#pragma unroll
            for (int j = 0; j < 8; ++j) o[64 * j] = v[j] * rstd * mul[j];
        }
    }
}
__device__ __forceinline__ void phase_pool(const bf16* U, bf16* Pb, int gw, int NGW, int lane) {
    for (int it = gw; it < (M / 32) * 4; it += NGW) {
        const int gi = it & 3, rw = it >> 2, w = 2 << gi, col = gi * 512 + lane * 8;
        for (int rr = 0; rr < 32; ++rr) {
            const int m = rw * 32 + rr, tpos = m & (SEQ - 1), cnt = (tpos + 1 < w) ? tpos + 1 : w;
            float acc[8];
#pragma unroll
            for (int e = 0; e < 8; ++e) acc[e] = 0.f;
            float cur[8];
            for (int j = 0; j < cnt; ++j) {
                const v4u q = *(const GAS v4u*)(U + (size_t)(m - j) * DM + col);
                const float f0 = bflo(q.x), f1 = bfhi(q.x), f2 = bflo(q.y), f3 = bfhi(q.y), f4 = bflo(q.z), f5 = bfhi(q.z), f6 = bflo(q.w), f7 = bfhi(q.w);
                if (j == 0) { cur[0] = f0; cur[1] = f1; cur[2] = f2; cur[3] = f3; cur[4] = f4; cur[5] = f5; cur[6] = f6; cur[7] = f7; }
                acc[0] += f0; acc[1] += f1; acc[2] += f2; acc[3] += f3; acc[4] += f4; acc[5] += f5; acc[6] += f6; acc[7] += f7;
            }
            const float inv = 1.0f / (float)cnt;
            v4u o; o.x = pk2(acc[0] * inv - cur[0], acc[1] * inv - cur[1]); o.y = pk2(acc[2] * inv - cur[2], acc[3] * inv - cur[3]);
            o.z = pk2(acc[4] * inv - cur[4], acc[5] * inv - cur[5]); o.w = pk2(acc[6] * inv - cur[6], acc[7] * inv - cur[7]);
            *(GAS v4u*)(Pb + (size_t)m * DM + col) = o;
        }
    }
}

__device__ __forceinline__ void phase_hgrn_scan_naive(const bf16* PROJ, const float* lbv, float* O, LAS unsigned char* lds, int tid, int vcu, int G) {
    LAS float* qs = (LAS float*)lds;
    LAS float* fs = qs + 16 * 128;
    LAS float* ks = fs + 16 * 128;
    LAS float* vs = ks + 16 * 128;
    const int v = tid >> 4, dg = tid & 15;
    for (int unit = vcu; unit < NB * HG_H * 4; unit += G) {
        const int b = unit >> 6, h = (unit >> 2) & 15, vsl = unit & 3;
        float S[8];
#pragma unroll
        for (int e = 0; e < 8; ++e) S[e] = 0.f;
        const int lt = tid >> 5, ld4 = (tid & 31) * 4;
        float lbl[4];
#pragma unroll
        for (int e = 0; e < 4; ++e) lbl[e] = lbv[h * 128 + ld4 + e];
        for (int ch = 0; ch < SEQ / 16; ++ch) {
            const size_t m0 = (size_t)b * SEQ + (size_t)ch * 16;
            { const bf16* row = PROJ + (m0 + lt) * HG_IN + h * 128 + ld4;
              const v2u qv = *(const GAS v2u*)row, zv = *(const GAS v2u*)(row + 2048);
              const float qf[4] = {bflo(qv.x), bfhi(qv.x), bflo(qv.y), bfhi(qv.y)}, zf[4] = {bflo(zv.x), bfhi(zv.x), bflo(zv.y), bfhi(zv.y)};
#pragma unroll
              for (int e = 0; e < 4; ++e) { const float sg = sigmoid_f(zf[e]), l = lbl[e]; qs[lt * 128 + ld4 + e] = qf[e]; fs[lt * 128 + ld4 + e] = l + (1.0f - l) * sg; ks[lt * 128 + ld4 + e] = (1.0f - l) * (1.0f - sg); }
              vs[tid] = bf1(PROJ[(m0 + (tid >> 5)) * HG_IN + 4096 + h * 128 + vsl * 32 + (tid & 31)]); }
            __syncthreads();
            for (int tt = 0; tt < 16; ++tt) {
                const float vv = vs[tt * 32 + v]; float acc = 0.f;
#pragma unroll
                for (int e = 0; e < 8; ++e) { const int d = dg * 8 + e; S[e] = fs[tt * 128 + d] * S[e] + ks[tt * 128 + d] * vv; acc += S[e] * qs[tt * 128 + d]; }
                acc += __shfl_xor(acc, 1); acc += __shfl_xor(acc, 2); acc += __shfl_xor(acc, 4); acc += __shfl_xor(acc, 8);
                if (dg == 0) O[(m0 + tt) * DM + h * 128 + vsl * 32 + v] = acc;
            }
            __syncthreads();
        }
    }
}
__device__ __forceinline__ void phase_hgrn_post(const bf16* O, const bf16* PROJ, const float* ng, bf16* Pb, int gw, int NGW, int lane) {
    for (int m = gw; m < M; m += NGW) {
        const GAS v2u* orow = (const GAS v2u*)(O + (size_t)m * DM) + lane;
        const GAS v2u* grow = (const GAS v2u*)(PROJ + (size_t)m * HG_IN + 6144) + lane;
        GAS v2u* prow = (GAS v2u*)(Pb + (size_t)m * DM) + lane;
#pragma unroll
        for (int j = 0; j < 8; ++j) {
            const v2u ob = orow[64 * j]; const f32x4 o = (f32x4){bflo(ob.x), bfhi(ob.x), bflo(ob.y), bfhi(ob.y)}; float ss = (o.x * o.x + o.y * o.y) + (o.z * o.z + o.w * o.w);
            ss = half_sum(ss);
            const float rstd = 1.0f / sqrtf(ss * (1.0f / 128.0f) + EPS);
            const v2u gq = grow[64 * j]; const f32x4 nv = *(const GAS f32x4*)(ng + 4 * lane + 256 * j);
            v2u w; w.x = pk2(o.x * rstd * nv.x * silu1(bflo(gq.x)), o.y * rstd * nv.y * silu1(bfhi(gq.x))); w.y = pk2(o.z * rstd * nv.z * silu1(bflo(gq.y)), o.w * rstd * nv.w * silu1(bfhi(gq.y)));
            prow[64 * j] = w;
        }
    }
}
__device__ __forceinline__ void phase_ret_scan_naive(const bf16* PROJ, const float* rot, float* O, LAS unsigned char* lds, int tid, int vcu, int G) {
    LAS float* qs = (LAS float*)lds;
    LAS float* ks = qs + 16 * 256;
    LAS float* vs = ks + 16 * 256;
    const float* ct = rot; const float* st = rot + (size_t)M * 128;
    const int v = tid >> 3, dg = tid & 7;
    for (int unit = vcu; unit < NB * RT_H * 8; unit += G) {
        const int b = unit >> 6, h = (unit >> 3) & 7, vsl = unit & 7;
        const float gamma = 1.0f - exp2f(-5.0f - (float)h);
        float S[32];
#pragma unroll
        for (int e = 0; e < 32; ++e) S[e] = 0.f;
        const int lt = tid >> 5, li = (tid & 31) * 4;
        for (int ch = 0; ch < SEQ / 16; ++ch) {
            const size_t m0 = (size_t)b * SEQ + (size_t)ch * 16;
            { const size_t m = m0 + lt; const bf16* row = PROJ + m * RT_IN + h * 256 + li;
              const v2u q1 = *(const GAS v2u*)row, q2 = *(const GAS v2u*)(row + 128), k1 = *(const GAS v2u*)(row + 2048), k2 = *(const GAS v2u*)(row + 2048 + 128);
              const f32x4 cv = *(const GAS f32x4*)(ct + m * 128 + li), sv = *(const GAS f32x4*)(st + m * 128 + li);
              const float a1[4] = {bflo(q1.x), bfhi(q1.x), bflo(q1.y), bfhi(q1.y)}, a2[4] = {bflo(q2.x), bfhi(q2.x), bflo(q2.y), bfhi(q2.y)};
              const float b1[4] = {bflo(k1.x), bfhi(k1.x), bflo(k1.y), bfhi(k1.y)}, b2[4] = {bflo(k2.x), bfhi(k2.x), bflo(k2.y), bfhi(k2.y)};
#pragma unroll
              for (int e = 0; e < 4; ++e) { const float cc = cv[e], sn = sv[e];
                  qs[lt * 256 + li + e] = a1[e] * cc - a2[e] * sn; qs[lt * 256 + 128 + li + e] = a1[e] * sn + a2[e] * cc;
                  ks[lt * 256 + li + e] = (b1[e] * cc - b2[e] * sn) * 0.0625f; ks[lt * 256 + 128 + li + e] = (b1[e] * sn + b2[e] * cc) * 0.0625f; }
#pragma unroll
              for (int r = 0; r < 2; ++r) { const int idx = tid + r * 512, tt = idx >> 6, vv = idx & 63; vs[idx] = bf1(PROJ[(m0 + tt) * RT_IN + 4096 + h * 512 + vsl * 64 + vv]); } }
            __syncthreads();
            for (int tt = 0; tt < 16; ++tt) {
                const float vv = vs[tt * 64 + v]; float acc = 0.f;
#pragma unroll
                for (int e = 0; e < 32; ++e) { const int d = dg * 32 + e; S[e] = gamma * S[e] + ks[tt * 256 + d] * vv; acc += S[e] * qs[tt * 256 + d]; }
                acc += __shfl_xor(acc, 1); acc += __shfl_xor(acc, 2); acc += __shfl_xor(acc, 4);
                if (dg == 0) O[(m0 + tt) * RT_V + h * 512 + vsl * 64 + v] = acc;
            }
            __syncthreads();
        }
    }
}
__device__ __forceinline__ void phase_ret_post(const bf16* O, const bf16* PROJ, const float* ng, bf16* Pb, int gw, int NGW, int lane) {
    for (int m = gw; m < M; m += NGW) {
        const GAS v2u* orow = (const GAS v2u*)(O + (size_t)m * RT_V) + lane;
        const GAS v2u* grow = (const GAS v2u*)(PROJ + (size_t)m * RT_IN + 8192) + lane;
        GAS v2u* prow = (GAS v2u*)(Pb + (size_t)m * RT_V) + lane;
#pragma unroll
        for (int hh = 0; hh < 8; ++hh) {
            const v2u ob0 = orow[64 * (2 * hh)], ob1 = orow[64 * (2 * hh + 1)]; const f32x4 o0 = (f32x4){bflo(ob0.x), bfhi(ob0.x), bflo(ob0.y), bfhi(ob0.y)}, o1 = (f32x4){bflo(ob1.x), bfhi(ob1.x), bflo(ob1.y), bfhi(ob1.y)};
            float ss = (o0.x * o0.x + o0.y * o0.y) + (o0.z * o0.z + o0.w * o0.w) + (o1.x * o1.x + o1.y * o1.y) + (o1.z * o1.z + o1.w * o1.w);
            const float rstd = 1.0f / sqrtf(wave_sum(ss) * (1.0f / 512.0f) + EPS);
#pragma unroll
            for (int r = 0; r < 2; ++r) { const int j = 2 * hh + r; const f32x4 o = r ? o1 : o0;
                const v2u gq = grow[64 * j]; const f32x4 nv = *(const GAS f32x4*)(ng + 4 * lane + 256 * j);
                v2u w; w.x = pk2(o.x * rstd * nv.x * silu1(bflo(gq.x)), o.y * rstd * nv.y * silu1(bfhi(gq.x))); w.y = pk2(o.z * rstd * nv.z * silu1(bflo(gq.y)), o.w * rstd * nv.w * silu1(bfhi(gq.y)));
                prow[64 * j] = w; }
        }
    }
}

typedef float f32x16 __attribute__((ext_vector_type(16)));
typedef short s16x4 __attribute__((ext_vector_type(4)));
typedef short s16x8 __attribute__((ext_vector_type(8)));
__device__ __forceinline__ unsigned off_b(unsigned row, unsigned ch) { return 256u * row + 16u * (ch ^ (((row & 3u) << 2) | ((row >> 2) & 3u))); }
__device__ __forceinline__ s16x8 tr_frag_b(LAS unsigned char* img, int lane, int c, int ks) {
    const unsigned h = lane >> 5, blk = (lane >> 4) & 1, q = (lane & 15) >> 2, p = lane & 3;
    const unsigned a0 = off_b(16 * ks + 8 * h + q, 4 * c + 2 * blk + (p >> 1)) + 8 * (p & 1), a1 = off_b(16 * ks + 8 * h + 4 + q, 4 * c + 2 * blk + (p >> 1)) + 8 * (p & 1);
    const s16x4 x = __builtin_amdgcn_ds_read_tr16_b64_v4i16((LAS s16x4*)(img + a0)), y = __builtin_amdgcn_ds_read_tr16_b64_v4i16((LAS s16x4*)(img + a1));
    return (s16x8){x[0], x[1], x[2], x[3], y[0], y[1], y[2], y[3]};
}
__device__ __forceinline__ unsigned trb_base(int lane, int c, int tt) {
    const unsigned h = lane >> 5, blk = (lane >> 4) & 1, q = (lane & 15) >> 2, p = lane & 3;
    return 256u * (8 * h + 4 * tt + q) + 16u * ((4 * c + 2 * blk + (p >> 1)) ^ ((q << 2) | ((2 * h + tt) & 3))) + 8 * (p & 1);
}
__device__ __forceinline__ s16x8 tr_frag_b2(LAS unsigned char* img, unsigned b0, unsigned b1, int ks) {
    const s16x4 x = __builtin_amdgcn_ds_read_tr16_b64_v4i16((LAS s16x4*)(img + b0 + 4096 * ks)), y = __builtin_amdgcn_ds_read_tr16_b64_v4i16((LAS s16x4*)(img + b1 + 4096 * ks));
    return (s16x8){x[0], x[1], x[2], x[3], y[0], y[1], y[2], y[3]};
}
__device__ __forceinline__ s16x8 tr_frag_plain(LAS unsigned char* img, int rs, int lane, int c, int ks) {
    const unsigned h = lane >> 5, blk = (lane >> 4) & 1, q = (lane & 15) >> 2, p = lane & 3;
    const unsigned a0 = (16 * ks + 8 * h + q) * rs + (32 * c + 16 * blk + 4 * p) * 2, a1 = a0 + 4 * rs;
    const s16x4 x = __builtin_amdgcn_ds_read_tr16_b64_v4i16((LAS s16x4*)(img + a0)), y = __builtin_amdgcn_ds_read_tr16_b64_v4i16((LAS s16x4*)(img + a1));
    return (s16x8){x[0], x[1], x[2], x[3], y[0], y[1], y[2], y[3]};
}
__device__ __forceinline__ f32x16 mfma32(s16x8 a, s16x8 b, f32x16 c) { return __builtin_amdgcn_mfma_f32_32x32x16_bf16(a, b, c, 0, 0, 0); }
__device__ __forceinline__ f32x16 zero16() { f32x16 z;
#pragma unroll
    for (int i = 0; i < 16; ++i) z[i] = 0.f; return z; }
__device__ __forceinline__ v4u scale_bf8(v4u q, float f) { v4u o; o.x = pk2(bflo(q.x) * f, bfhi(q.x) * f); o.y = pk2(bflo(q.y) * f, bfhi(q.y) * f); o.z = pk2(bflo(q.z) * f, bfhi(q.z) * f); o.w = pk2(bflo(q.w) * f, bfhi(q.w) * f); return o; }

__device__ __forceinline__ void phase_ret_scan(const bf16* PROJ, bf16* O, LAS unsigned char* lds, int tid, int vcu, int G) {
    constexpr int QN = 0, QRS = 528, KN = 33792, VV = KN + 32768, PI = VV + 16384, PRS = 144, ST = PI + 9216, SRS = 528, LDS_END = ST + 33792;
    static_assert(LDS_END <= RING_BYTES, "retention scan LDS map");
    const int lane = tid & 63, wave = __builtin_amdgcn_readfirstlane(tid >> 6);
    for (int unit = vcu; unit < NB * RT_H * 8; unit += G) {
        const int b = unit >> 6, h = (unit >> 3) & 7, vsl = unit & 7;
        const float lg = __log2f(1.0f - exp2f(-5.0f - (float)h));
        const float g64 = exp2f(64.0f * lg);
        f32x16 S[2][2];
#pragma unroll
        for (int a = 0; a < 2; ++a)
#pragma unroll
            for (int c = 0; c < 2; ++c) S[a][c] = zero16();
        for (int i = tid; i < 33792 / 16; i += 512) *(LAS v4u*)(lds + ST + i * 16) = (v4u){0u, 0u, 0u, 0u};
        v4u pq[4], pk[4], pv;
        const __amdgpu_buffer_rsrc_t rsP = __builtin_amdgcn_make_buffer_rsrc((void*)(PROJ + (size_t)b * SEQ * RT_IN), (short)0, SEQ * RT_IN * 2, 0x00020000);
        const __amdgpu_buffer_rsrc_t rsO = __builtin_amdgcn_make_buffer_rsrc((void*)(O + (size_t)b * SEQ * RT_V), (short)0, SEQ * RT_V * 2, 0x00020000);
        const int vrow = tid >> 3, vch = tid & 7;
        const unsigned voq = (unsigned)((tid >> 5) * RT_IN + (tid & 31) * 8) * 2u, vov = (unsigned)(vrow * RT_IN + vch * 8) * 2u;
        const unsigned soq = (unsigned)(h * 256) * 2u, sok = (unsigned)(2048 + h * 256) * 2u, sov = (unsigned)(4096 + h * 512 + vsl * 64) * 2u;
#define RS_PREFETCH(chn) do { const unsigned cb_ = (unsigned)(chn) * 64u * RT_IN * 2u; _Pragma("unroll") for (int i = 0; i < 4; ++i) { \
            pq[i] = __builtin_amdgcn_raw_buffer_load_b128(rsP, voq, cb_ + (unsigned)i * 16u * RT_IN * 2u + soq, 0); pk[i] = __builtin_amdgcn_raw_buffer_load_b128(rsP, voq, cb_ + (unsigned)i * 16u * RT_IN * 2u + sok, 0); } \
            pv = __builtin_amdgcn_raw_buffer_load_b128(rsP, vov, cb_ + sov, 0); } while (0)
        RS_PREFETCH(0);
        float dec[16];
        { const int a31 = lane & 31, a5 = lane >> 5, w4 = wave & 3, t_i = w4 >> 1, x_i = w4 & 1;
#pragma unroll
          for (int r = 0; r < 16; ++r) {
              if (wave < 4) { const int t = 32 * x_i + a31, s = 32 * t_i + 8 * (r >> 2) + 4 * a5 + (r & 3); dec[r] = (s <= t) ? __builtin_amdgcn_exp2f((float)(t - s) * lg) : 0.f; }
              else { const int t = 32 * t_i + (r & 3) + 8 * (r >> 2) + 4 * a5; dec[r] = __builtin_amdgcn_exp2f((float)(t + 1) * lg); } } }
        unsigned opk[8];
#pragma unroll
        for (int i = 0; i < 8; ++i) opk[i] = 0u;
        for (int ch = 0; ch < SEQ / 64; ++ch) {
#pragma unroll
            for (int i = 0; i < 4; ++i) { const int cid = tid + 512 * i, row = cid >> 5, chq = cid & 31;
                *(LAS v4u*)(lds + QN + row * QRS + chq * 16) = pq[i];
                *(LAS v4u*)(lds + KN + (chq >> 4) * 16384 + off_b(row, chq & 15)) = pk[i]; }
            *(LAS v4u*)(lds + VV + off_b(vrow, vch)) = pv;
            *(LAS v4u*)(lds + VV + off_b(vrow, 8 + vch)) = scale_bf8(pv, __builtin_amdgcn_exp2f((float)(63 - vrow) * lg));
            __syncthreads();
#define RS_STORE_O(chs) do { if (wave >= 4) { const int w4s = wave & 3, tis = w4s >> 1, vis = w4s & 1; const int lnS = lane; \
                const unsigned voo = (unsigned)(4 * (lnS >> 5) * RT_V + h * 512 + vsl * 64 + 32 * vis + (lnS & 31)) * 2u; \
                _Pragma("unroll") for (int r = 0; r < 16; ++r) { const unsigned pr_ = opk[r >> 1]; \
                    __builtin_amdgcn_raw_buffer_store_b16((unsigned short)((r & 1) ? (pr_ >> 16) : (pr_ & 0xffffu)), rsO, voo, (unsigned)((chs) * 64 + 32 * tis + (r & 3) + 8 * (r >> 2)) * RT_V * 2u, 0); } } } while (0)
            if (ch > 0) RS_STORE_O(ch - 1);
            if (ch + 1 < SEQ / 64) RS_PREFETCH(ch + 1);
            f32x16 acc = zero16();
            int lnA = lane; asm volatile("" : "+v"(lnA));
            const int a31 = lnA & 31, a5 = lnA >> 5;
            const int w4 = wave & 3, t_i = w4 >> 1, x_i = w4 & 1;
            s16x8 fa0[4], fb0[4], fa1[4], fb1[4];
            if (wave < 4) {
                const int si = t_i, ti = x_i;
#define RS_LD1A(fa, fb, g4) do { _Pragma("unroll") for (int j = 0; j < 2; ++j) { const int ks = 2 * (g4) + j; \
                    fa[j] = *(const LAS s16x8*)(lds + KN + (ks >> 3) * 16384 + off_b(32 * si + a31, 2 * (ks & 7) + a5)); \
                    fb[j] = *(const LAS s16x8*)(lds + QN + (32 * ti + a31) * QRS + (16 * ks + 8 * a5) * 2); } } while (0)
#define RS_MMA4(fa, fb) do { _Pragma("unroll") for (int j = 0; j < 4; ++j) acc = mfma32(fa[j], fb[j], acc); } while (0)
#define RS_MMA2(fa, fb) do { _Pragma("unroll") for (int j = 0; j < 2; ++j) acc = mfma32(fa[j], fb[j], acc); } while (0)
                RS_LD1A(fa0, fb0, 0); RS_LD1A(fa1, fb1, 1);
#pragma unroll
                for (int g2 = 0; g2 < 3; ++g2) { RS_MMA2(fa0, fb0); RS_LD1A(fa0, fb0, 2 * g2 + 2); RS_MMA2(fa1, fb1); RS_LD1A(fa1, fb1, 2 * g2 + 3); }
                RS_MMA2(fa0, fb0); RS_MMA2(fa1, fb1);
#undef RS_LD1A
                const int t = 32 * ti + a31;
#pragma unroll
                for (int g = 0; g < 4; ++g) { float pvv[4];
#pragma unroll
                    for (int e = 0; e < 4; ++e) pvv[e] = acc[4 * g + e] * dec[4 * g + e];
                    v2u w; w.x = pk2(pvv[0], pvv[1]); w.y = pk2(pvv[2], pvv[3]);
                    *(LAS v2u*)(lds + PI + t * PRS + (32 * si + 8 * g + 4 * a5) * 2) = w; }
            } else {
                const int ti = t_i, vi = x_i;
#define RS_LD1B(fa, fb, g4) do { _Pragma("unroll") for (int j = 0; j < 2; ++j) { const int ks = 2 * (g4) + j; \
                    fa[j] = *(const LAS s16x8*)(lds + QN + (32 * ti + a31) * QRS + (16 * ks + 8 * a5) * 2); \
                    fb[j] = *(const LAS s16x8*)(lds + ST + (32 * vi + a31) * SRS + (16 * ks + 8 * a5) * 2); } } while (0)
                RS_LD1B(fa0, fb0, 0); RS_LD1B(fa1, fb1, 1);
#pragma unroll
                for (int g2 = 0; g2 < 3; ++g2) { RS_MMA2(fa0, fb0); RS_LD1B(fa0, fb0, 2 * g2 + 2); RS_MMA2(fa1, fb1); RS_LD1B(fa1, fb1, 2 * g2 + 3); }
                RS_MMA2(fa0, fb0); RS_MMA2(fa1, fb1);
#undef RS_LD1B
#pragma unroll
                for (int r = 0; r < 16; ++r) acc[r] *= dec[r];
            }
            __syncthreads();
            if (wave < 4) {
                LAS unsigned char* kimg0 = lds + KN + ((2 * wave) >> 2) * 16384; LAS unsigned char* kimg1 = lds + KN + ((2 * wave + 1) >> 2) * 16384;
                const unsigned ka0 = trb_base(lnA, (2 * wave) & 3, 0), ka1 = trb_base(lnA, (2 * wave) & 3, 1), kb0 = trb_base(lnA, (2 * wave + 1) & 3, 0), kb1 = trb_base(lnA, (2 * wave + 1) & 3, 1);
                const unsigned va0 = trb_base(lnA, 2, 0), va1 = trb_base(lnA, 2, 1), vb0 = trb_base(lnA, 3, 0), vb1 = trb_base(lnA, 3, 1);
#define RS_LD2A(g2) do { _Pragma("unroll") for (int j = 0; j < 2; ++j) { const int ks = 2 * (g2) + j; fa0[j] = tr_frag_b2(kimg0, ka0, ka1, ks); fa1[j] = tr_frag_b2(kimg1, kb0, kb1, ks); fb0[j] = tr_frag_b2(lds + VV, va0, va1, ks); fb1[j] = tr_frag_b2(lds + VV, vb0, vb1, ks); } } while (0)
#define RS_MMA2A() do { _Pragma("unroll") for (int j = 0; j < 2; ++j) { S[0][0] = mfma32(fa0[j], fb0[j], S[0][0]); S[0][1] = mfma32(fa0[j], fb1[j], S[0][1]); S[1][0] = mfma32(fa1[j], fb0[j], S[1][0]); S[1][1] = mfma32(fa1[j], fb1[j], S[1][1]); } } while (0)
                RS_LD2A(0);
#pragma unroll
                for (int a = 0; a < 2; ++a)
#pragma unroll
                    for (int c = 0; c < 2; ++c)
#pragma unroll
                        for (int r = 0; r < 16; ++r) S[a][c][r] *= g64;
                RS_MMA2A(); RS_LD2A(1); RS_MMA2A();
#undef RS_LD2A
#undef RS_MMA2A
#pragma unroll
                for (int a = 0; a < 2; ++a)
#pragma unroll
                    for (int c = 0; c < 2; ++c)
#pragma unroll
                        for (int g = 0; g < 4; ++g) { const int d = 32 * (2 * wave + a) + 8 * g + 4 * a5, v = 32 * c + a31;
                            v2u w; w.x = pk2(S[a][c][4 * g], S[a][c][4 * g + 1]); w.y = pk2(S[a][c][4 * g + 2], S[a][c][4 * g + 3]);
                            *(LAS v2u*)(lds + ST + v * SRS + d * 2) = w; }
            } else {
                const int ti = t_i, vi = x_i;
#pragma unroll
                for (int ks = 0; ks < 4; ++ks) { fa0[ks] = *(const LAS s16x8*)(lds + PI + (32 * ti + a31) * PRS + (16 * ks + 8 * a5) * 2); fb0[ks] = tr_frag_b2(lds + VV, trb_base(lnA, vi, 0), trb_base(lnA, vi, 1), ks); }
                RS_MMA4(fa0, fb0);
#pragma unroll
                for (int i = 0; i < 8; ++i) { const float o0_ = acc[2 * i], o1_ = acc[2 * i + 1]; opk[i] = pk2(o0_, o1_); }
            }
#undef RS_MMA4
#undef RS_PREFETCH_DUMMY
#undef RS_MMA2
            __syncthreads();
        }
        RS_STORE_O(SEQ / 64 - 1);
#undef RS_STORE_O
#undef RS_PREFETCH
    }
}

__device__ __forceinline__ void phase_hgrn_pre(const bf16* PROJ, const float* lbv, bf16* QD, bf16* KI, bf16* KE, float* DEC, int gt, int NGT) {
    for (int it = gt; it < (M / 32) * 256; it += NGT) {
        const int chunk = it >> 8, col = (it & 255) * 8; const size_t m0 = (size_t)chunk * 32;
        float lb[8], tot[8], cum[8];
        { const f32x4 l0 = *(const GAS f32x4*)(lbv + col), l1 = *(const GAS f32x4*)(lbv + col + 4);
#pragma unroll
          for (int e = 0; e < 4; ++e) { lb[e] = l0[e]; lb[4 + e] = l1[e]; } }
#pragma unroll
        for (int e = 0; e < 8; ++e) { tot[e] = 1.f; cum[e] = 1.f; }
#pragma unroll 4
        for (int t = 0; t < 32; ++t) { const v4u zz = *(const GAS v4u*)(PROJ + (m0 + t) * HG_IN + 2048 + col);
            const float z[8] = {bflo(zz.x), bfhi(zz.x), bflo(zz.y), bfhi(zz.y), bflo(zz.z), bfhi(zz.z), bflo(zz.w), bfhi(zz.w)};
#pragma unroll
            for (int e = 0; e < 8; ++e) tot[e] *= lb[e] + (1.0f - lb[e]) * sigmoid_f(z[e]); }
#pragma unroll 2
        for (int t = 0; t < 32; ++t) { const size_t m = m0 + t;
            const v4u zz = *(const GAS v4u*)(PROJ + m * HG_IN + 2048 + col), qq = *(const GAS v4u*)(PROJ + m * HG_IN + col);
            const float z[8] = {bflo(zz.x), bfhi(zz.x), bflo(zz.y), bfhi(zz.y), bflo(zz.z), bfhi(zz.z), bflo(zz.w), bfhi(zz.w)};
            const float q[8] = {bflo(qq.x), bfhi(qq.x), bflo(qq.y), bfhi(qq.y), bflo(qq.z), bfhi(qq.z), bflo(qq.w), bfhi(qq.w)};
            float qd[8], ki[8], ke[8];
#pragma unroll
            for (int e = 0; e < 8; ++e) { const float sg = sigmoid_f(z[e]); cum[e] *= lb[e] + (1.0f - lb[e]) * sg; const float kk = (1.0f - lb[e]) * (1.0f - sg);
                qd[e] = q[e] * cum[e]; ki[e] = kk * __builtin_amdgcn_rcpf(cum[e]); ke[e] = ki[e] * tot[e]; }
            v4u o; o.x = pk2(qd[0], qd[1]); o.y = pk2(qd[2], qd[3]); o.z = pk2(qd[4], qd[5]); o.w = pk2(qd[6], qd[7]); *(GAS v4u*)(QD + m * DM + col) = o;
            o.x = pk2(ki[0], ki[1]); o.y = pk2(ki[2], ki[3]); o.z = pk2(ki[4], ki[5]); o.w = pk2(ki[6], ki[7]); *(GAS v4u*)(KI + m * DM + col) = o;
            o.x = pk2(ke[0], ke[1]); o.y = pk2(ke[2], ke[3]); o.z = pk2(ke[4], ke[5]); o.w = pk2(ke[6], ke[7]); *(GAS v4u*)(KE + m * DM + col) = o; }
        f32x4 d0, d1;
#pragma unroll
        for (int e = 0; e < 4; ++e) { d0[e] = tot[e]; d1[e] = tot[4 + e]; }
        *(GAS f32x4*)(DEC + (size_t)chunk * DM + col) = d0; *(GAS f32x4*)(DEC + (size_t)chunk * DM + col + 4) = d1;
    }
}
__device__ __forceinline__ void phase_hgrn_scan(const bf16* HV, const bf16* QD, const bf16* KI, const bf16* KE, const float* DEC, bf16* Ob, LAS unsigned char* lds, int tid, int u0, int ustride) {
    constexpr int RS = 272, PRS = 80, VRS = 128, SET = 30208;
    constexpr int QI = 0, KII = 8704, KEI = 17408, VI = 25600, DCI = 29696, PI = 2 * SET, ST = PI + 2560, LDS_END = ST + 2 * 8704;
    static_assert(LDS_END <= RING_BYTES, "hgrn scan LDS map");
    const int lane = tid & 63, wave = __builtin_amdgcn_readfirstlane(tid >> 6), l31 = lane & 31, h5 = lane >> 5;
    const int vt = (wave >> 1) & 1;
    for (int unit = u0; unit < NB * HG_H * 2; unit += ustride) {
        const int b = unit >> 5, h = (unit >> 1) & 15, vp = unit & 1;
        f32x16 S0 = zero16(), S1 = zero16();
        for (int i = tid; i < 2 * 8704 / 16; i += 512) *(LAS v4u*)(lds + ST + i * 16) = (v4u){0u, 0u, 0u, 0u};
        const int row = tid >> 4, c16 = tid & 15;
        const size_t mb = (size_t)b * SEQ;
        v4u q0, ki0, ke0, x0 = (v4u){0u, 0u, 0u, 0u}, q1, ki1, ke1, x1 = (v4u){0u, 0u, 0u, 0u};
        unsigned opk[8];
#pragma unroll
        for (int i = 0; i < 8; ++i) opk[i] = 0u;
#define HS_CLAMP(c_) ((c_) < SEQ / 32 ? (c_) : SEQ / 32 - 1)
#define HS_LOAD(pq_, pki_, pke_, px_, chn) do { const size_t hb_ = (size_t)(b * 16 + h) * SEQ + (size_t)(chn) * 32; \
            pq_ = *(const GAS v4u*)(QD + (hb_ + row) * 128 + c16 * 8); pki_ = *(const GAS v4u*)(KI + (hb_ + row) * 128 + c16 * 8); pke_ = *(const GAS v4u*)(KE + (hb_ + row) * 128 + c16 * 8); \
            if (tid < 256) px_ = *(const GAS v4u*)(HV + (hb_ + (tid >> 3)) * 128 + vp * 64 + (tid & 7) * 8); \
            else if (tid < 288) px_ = *(const GAS v4u*)(DEC + ((size_t)(b * 16 + h) * (SEQ / 32) + (chn)) * 128 + (tid - 256) * 4); } while (0)
#define HS_WRITE(IB, pq_, pki_, pke_, px_) do { \
            *(LAS v4u*)(lds + (IB) + QI + row * RS + c16 * 16) = pq_; *(LAS v4u*)(lds + (IB) + KII + row * RS + c16 * 16) = pki_; *(LAS v4u*)(lds + (IB) + KEI + off_b(row, c16)) = pke_; \
            if (tid < 256) *(LAS v4u*)(lds + (IB) + VI + (tid >> 3) * VRS + (tid & 7) * 16) = px_; \
            else if (tid < 288) *(LAS v4u*)(lds + (IB) + DCI + (tid - 256) * 16) = px_; } while (0)
#define HS_STORE_O(chs) do { if (wave == 4 || wave == 6) { bf16* op = Ob + (mb + (size_t)(chs) * 32) * DM + h * 128 + vp * 64 + vt * 32 + l31; \
            _Pragma("unroll") for (int r = 0; r < 16; ++r) { const int t = (r & 3) + 8 * (r >> 2) + 4 * h5; const unsigned pr_ = opk[r >> 1]; op[(size_t)t * DM] = (bf16)((r & 1) ? (pr_ >> 16) : (pr_ & 0xffffu)); } } } while (0)
#define HS_CHUNK(IB, NIB, nq_, nki_, nke_, nx_) do { \
            f32x16 acc = zero16(); \
            if (wave == 5) { \
                s16x8 fa[8], fb[8]; \
                _Pragma("unroll") for (int ks = 0; ks < 8; ++ks) { fa[ks] = *(const LAS s16x8*)(lds + (IB) + KII + l31 * RS + (16 * ks + 8 * h5) * 2); fb[ks] = *(const LAS s16x8*)(lds + (IB) + QI + l31 * RS + (16 * ks + 8 * h5) * 2); } \
                _Pragma("unroll") for (int ks = 0; ks < 8; ++ks) acc = mfma32(fa[ks], fb[ks], acc); \
                const int t = l31; \
                _Pragma("unroll") for (int g = 0; g < 4; ++g) { float pvv[4]; \
                    _Pragma("unroll") for (int e = 0; e < 4; ++e) { const int s = 8 * g + 4 * h5 + e; pvv[e] = (s <= t) ? acc[4 * g + e] : 0.f; } \
                    v2u w; w.x = pk2(pvv[0], pvv[1]); w.y = pk2(pvv[2], pvv[3]); \
                    *(LAS v2u*)(lds + PI + t * PRS + (8 * g + 4 * h5) * 2) = w; } \
            } else if (wave == 4 || wave == 6) { \
                s16x8 fa[8], fb[8]; \
                _Pragma("unroll") for (int ks = 0; ks < 8; ++ks) { fa[ks] = *(const LAS s16x8*)(lds + (IB) + QI + l31 * RS + (16 * ks + 8 * h5) * 2); fb[ks] = *(const LAS s16x8*)(lds + ST + vt * 8704 + l31 * RS + (16 * ks + 8 * h5) * 2); } \
                _Pragma("unroll") for (int ks = 0; ks < 8; ++ks) acc = mfma32(fa[ks], fb[ks], acc); \
            } \
            __syncthreads(); \
            if (wave < 4) { \
                _Pragma("unroll") for (int g = 0; g < 4; ++g) { const f32x4 dv = *(const LAS f32x4*)(lds + (IB) + DCI + (32 * wave + 8 * g + 4 * h5) * 4); \
                    _Pragma("unroll") for (int e = 0; e < 4; ++e) { S0[4 * g + e] *= dv[e]; S1[4 * g + e] *= dv[e]; } } \
                _Pragma("unroll") for (int ks = 0; ks < 2; ++ks) { const s16x8 af = tr_frag_b(lds + (IB) + KEI, lane, wave, ks); \
                    const s16x8 b0 = tr_frag_plain(lds + (IB) + VI, VRS, lane, 0, ks), b1 = tr_frag_plain(lds + (IB) + VI, VRS, lane, 1, ks); S0 = mfma32(af, b0, S0); S1 = mfma32(af, b1, S1); } \
                _Pragma("unroll") for (int g = 0; g < 4; ++g) { const int d = 32 * wave + 8 * g + 4 * h5; \
                    v2u w; w.x = pk2(S0[4 * g], S0[4 * g + 1]); w.y = pk2(S0[4 * g + 2], S0[4 * g + 3]); \
                    *(LAS v2u*)(lds + ST + l31 * RS + d * 2) = w; \
                    w.x = pk2(S1[4 * g], S1[4 * g + 1]); w.y = pk2(S1[4 * g + 2], S1[4 * g + 3]); \
                    *(LAS v2u*)(lds + ST + 8704 + l31 * RS + d * 2) = w; } \
            } else if (wave == 4 || wave == 6) { \
                _Pragma("unroll") for (int ks = 0; ks < 2; ++ks) { const s16x8 af = *(const LAS s16x8*)(lds + PI + l31 * PRS + (16 * ks + 8 * h5) * 2); const s16x8 bfr = tr_frag_plain(lds + (IB) + VI, VRS, lane, vt, ks); acc = mfma32(af, bfr, acc); } \
                _Pragma("unroll") for (int i = 0; i < 8; ++i) { const float o0_ = acc[2 * i], o1_ = acc[2 * i + 1]; opk[i] = pk2(o0_, o1_); } \
            } \
            HS_WRITE(NIB, nq_, nki_, nke_, nx_); \
            __syncthreads(); } while (0)
        HS_LOAD(q0, ki0, ke0, x0, 0); HS_LOAD(q1, ki1, ke1, x1, 1);
        HS_WRITE(0, q0, ki0, ke0, x0); HS_LOAD(q0, ki0, ke0, x0, 2);
        __syncthreads();
        for (int ch = 0; ch < SEQ / 32; ch += 2) {
            HS_CHUNK(0, SET, q1, ki1, ke1, x1);     HS_LOAD(q1, ki1, ke1, x1, HS_CLAMP(ch + 3)); HS_STORE_O(ch);
            HS_CHUNK(SET, 0, q0, ki0, ke0, x0);     HS_LOAD(q0, ki0, ke0, x0, HS_CLAMP(ch + 4)); HS_STORE_O(ch + 1);
        }
#undef HS_CLAMP
#undef HS_LOAD
#undef HS_WRITE
#undef HS_STORE_O
#undef HS_CHUNK
    }
}

template <bool XF32>
__device__ __forceinline__ void phase_poolmix(const void* hsrc  , const float* rsrow  , bf16* hout, const float* gnorm, const float* ada_l  ,
                                              const float* pscale, const bf16* Wt  ,
                                              const float* g2, const float* shift2, const float* scale2  , bf16* U2,
                                              LAS unsigned char* lds, int tid, int vcu, int G) {
    constexpr int PA = 0, WB = 65536, RSTD = RING_BYTES, ES = XF32 ? 4 : 2;
    const int lane = tid & 63, wave = __builtin_amdgcn_readfirstlane(tid >> 6), l31 = lane & 31, h5 = lane >> 5;
    LAS float* rstdL = (LAS float*)(lds + RSTD);
    LAS float* rowss = (LAS float*)(lds + RING_BYTES + 4096);
    const __amdgpu_buffer_rsrc_t rsH = __builtin_amdgcn_make_buffer_rsrc((void*)hsrc, (short)0, M * DM * ES, 0x00020000);
    const __amdgpu_buffer_rsrc_t rsO = __builtin_amdgcn_make_buffer_rsrc((void*)hout, (short)0, M * DM * 2, 0x00020000);
    const __amdgpu_buffer_rsrc_t rsW = __builtin_amdgcn_make_buffer_rsrc((void*)Wt, (short)0, 4 * 512 * 512 * 2, 0x00020000);
#define PM_OFFP(row, ch) ((row) * 1024 + 16 * ((ch) ^ ((row) & 15)))
#define PM_OFFW(n, ch) ((n) * 64 + 16 * ((ch) ^ (((n) >> 2) & 3)))
#define PM_LDH(voff, soff) __builtin_amdgcn_raw_buffer_load_b128(rsH, (voff), (soff), 0)
#define PM_UNPK(q_, f_) do { f_[0] = bflo(q_.x); f_[1] = bfhi(q_.x); f_[2] = bflo(q_.y); f_[3] = bfhi(q_.y); f_[4] = bflo(q_.z); f_[5] = bfhi(q_.z); f_[6] = bflo(q_.w); f_[7] = bfhi(q_.w); } while (0)
    for (int unit = vcu; unit < M / 64; unit += G) {
        const int r0 = unit * 64, b = r0 >> 12, tpos0 = r0 & (SEQ - 1), halo = tpos0 < 15 ? tpos0 : 15;
        const float* shp = ada_l + (size_t)b * ADA_W; const float* scp = shp + DM; const float* gtp = shp + 2 * DM;
        if (rsrow) { if (tid < 64 + halo) rstdL[tid + 15 - halo] = rsrow[r0 - halo + tid]; }
        else for (int rp = wave; 2 * rp < 64 + halo; rp += 2 * NWAVES) {
            int rrq[2]; float ssq[2]; v4u qq[2][XF32 ? 16 : 8];
#pragma unroll
            for (int z = 0; z < 2; ++z) { const int rr = 2 * (rp + NWAVES * z) + h5, rrc = rr < 64 + halo ? rr : 63 + halo, row = r0 - halo + rrc; rrq[z] = rr;
                const unsigned vo = (unsigned)row * (DM * ES) + (unsigned)l31 * 16u;
#pragma unroll
                for (int j = 0; j < (XF32 ? 16 : 8); ++j) qq[z][j] = PM_LDH(vo, (unsigned)j * 512u); }
#pragma unroll
            for (int z = 0; z < 2; ++z) { float ss = 0.f;
#pragma unroll
                for (int j = 0; j < (XF32 ? 16 : 8); ++j) { const v4u q = qq[z][j];
                    if constexpr (XF32) { const f32x4 v = __builtin_bit_cast(f32x4, q); ss += (v.x * v.x + v.y * v.y) + (v.z * v.z + v.w * v.w); }
                    else { float f[8]; PM_UNPK(q, f); ss += ((f[0] * f[0] + f[1] * f[1]) + (f[2] * f[2] + f[3] * f[3])) + ((f[4] * f[4] + f[5] * f[5]) + (f[6] * f[6] + f[7] * f[7])); } }
                ssq[z] = ss; }
#pragma unroll
            for (int z = 0; z < 2; ++z) { float ss = ssq[z];
                ss = half_sum(ss);
                const float rstd = 1.0f / sqrtf(ss * (1.0f / DM) + EPS);
                if (l31 == 0 && rrq[z] < 64 + halo) rstdL[rrq[z] + 15 - halo] = rstd; }
        }
        __syncthreads();
#pragma unroll 1
        for (int g = 0; g < 4; ++g) {
            const int w = 2 << g;
            const unsigned wvo = (unsigned)lane * 16u, wso = ((unsigned)g * 16u + 2u * (unsigned)wave) * (32u * 1024u);
            v4u wA[4], wB[4], wC[4];
            v4u hk[8];
#define PM_WLD(dst, kc_) do { _Pragma("unroll") for (int nt = 0; nt < 2; ++nt) _Pragma("unroll") for (int ks = 0; ks < 2; ++ks) \
                dst[nt * 2 + ks] = __builtin_amdgcn_raw_buffer_load_b128(rsW, wvo, wso + (unsigned)(nt * 32 + 2 * (kc_) + ks) * 1024u, 0); } while (0)
            PM_WLD(wA, 0); PM_WLD(wB, 1); PM_WLD(wC, 2);
            { const int oct = tid & 63, col = g * 512 + oct * 8; const unsigned hvo = (unsigned)col * ES;
              float gm[8], sh[8];
              { const f32x4 g0 = *(const GAS f32x4*)(gnorm + col), g1 = *(const GAS f32x4*)(gnorm + col + 4), s0 = *(const GAS f32x4*)(scp + col), s1 = *(const GAS f32x4*)(scp + col + 4);
                const f32x4 a0 = *(const GAS f32x4*)(shp + col), a1 = *(const GAS f32x4*)(shp + col + 4);
#pragma unroll
                for (int e = 0; e < 4; ++e) { gm[e] = g0[e] * (1.0f + s0[e]); gm[4 + e] = g1[e] * (1.0f + s1[e]); sh[e] = a0[e]; sh[4 + e] = a1[e]; } }
              LAS unsigned char* UT = lds + WB;
#pragma unroll
              for (int hf = 0; hf < 2; ++hf) {
                  const int rb = r0 - 15 + 32 * hf;
                  { v4u ha[6], hb2[6]; float rsv[6];
#pragma unroll
                      for (int k = 0; k < 6; ++k) { const int j = wave - 1 + 8 * k, row = rb + j, rowc = (j >= 0 && row >= r0 - halo) ? row : r0;
                          const unsigned so = (unsigned)rowc * (DM * ES);
                          ha[k] = PM_LDH(hvo, so); if constexpr (XF32) hb2[k] = PM_LDH(hvo, so + 16u); rsv[k] = rstdL[rowc - r0 + 15]; }
#pragma unroll
                      for (int k = 0; k < 6; ++k) { const int j = wave - 1 + 8 * k; const float rs_ = rsv[k]; float f[8];
                          if constexpr (XF32) { const f32x4 x0 = __builtin_bit_cast(f32x4, ha[k]), x1 = __builtin_bit_cast(f32x4, hb2[k]); f[0] = x0.x; f[1] = x0.y; f[2] = x0.z; f[3] = x0.w; f[4] = x1.x; f[5] = x1.y; f[6] = x1.z; f[7] = x1.w; }
                          else { PM_UNPK(ha[k], f); if (k >= 2) hk[4 * hf + k - 2] = ha[k]; }
                          v4u uq; uq.x = pk2(f[0] * rs_ * gm[0] + sh[0], f[1] * rs_ * gm[1] + sh[1]); uq.y = pk2(f[2] * rs_ * gm[2] + sh[2], f[3] * rs_ * gm[3] + sh[3]);
                          uq.z = pk2(f[4] * rs_ * gm[4] + sh[4], f[5] * rs_ * gm[5] + sh[5]); uq.w = pk2(f[6] * rs_ * gm[6] + sh[6], f[7] * rs_ * gm[7] + sh[7]);
                          if (j >= 0) *(LAS v4u*)(UT + j * 1024 + oct * 16) = uq; }
                  }
                  __syncthreads();
                  { const int il0 = 4 * wave, sl0 = il0 + 15, tp0 = tpos0 + 32 * hf + il0;
                    float S[8], uc[8];
#pragma unroll
                    for (int e = 0; e < 8; ++e) S[e] = 0.f;
                    { const int cnt = tp0 + 1 < w ? tp0 + 1 : w;
#define PM_WIN(J0, NJ) do { v4u qw[NJ]; \
                          _Pragma("unroll") for (int jj = 0; jj < NJ; ++jj) { const int sj = sl0 - (J0) - jj; qw[jj] = *(const LAS v4u*)(UT + (sj > 0 ? sj : 0) * 1024 + oct * 16); } \
                          _Pragma("unroll") for (int jj = 0; jj < NJ; ++jj) { float f[8]; PM_UNPK(qw[jj], f); const float m_ = (J0) + jj < cnt ? 1.0f : 0.0f; \
                              if ((J0) + jj == 0) { _Pragma("unroll") for (int e = 0; e < 8; ++e) uc[e] = f[e]; } \
                              _Pragma("unroll") for (int e = 0; e < 8; ++e) S[e] += m_ * f[e]; } } while (0)
                      PM_WIN(0, 4);
                      if (w > 4) { PM_WIN(4, 4); if (w > 8) PM_WIN(8, 8); }
#undef PM_WIN
                      const float inv = 1.0f / (float)cnt;
                      v4u o; o.x = pk2(S[0] * inv - uc[0], S[1] * inv - uc[1]); o.y = pk2(S[2] * inv - uc[2], S[3] * inv - uc[3]); o.z = pk2(S[4] * inv - uc[4], S[5] * inv - uc[5]); o.w = pk2(S[6] * inv - uc[6], S[7] * inv - uc[7]);
                      *(LAS v4u*)(lds + PA + PM_OFFP(32 * hf + il0, oct)) = o; }
#pragma unroll
                    for (int r = 1; r < 4; ++r) { const int tpr = tp0 + r, cnt = tpr + 1 < w ? tpr + 1 : w;
                        const v4u qn = *(const LAS v4u*)(UT + (sl0 + r) * 1024 + oct * 16), qo = *(const LAS v4u*)(UT + (sl0 + r - w) * 1024 + oct * 16);
                        float fn[8], fo[8]; PM_UNPK(qn, fn); PM_UNPK(qo, fo); const float m_ = tpr + 1 > w ? 1.0f : 0.0f;
#pragma unroll
                        for (int e = 0; e < 8; ++e) S[e] += fn[e] - m_ * fo[e];
                        const float inv = 1.0f / (float)cnt;
                        v4u o; o.x = pk2(S[0] * inv - fn[0], S[1] * inv - fn[1]); o.y = pk2(S[2] * inv - fn[2], S[3] * inv - fn[3]); o.z = pk2(S[4] * inv - fn[4], S[5] * inv - fn[5]); o.w = pk2(S[6] * inv - fn[6], S[7] * inv - fn[7]);
                        *(LAS v4u*)(lds + PA + PM_OFFP(32 * hf + il0 + r, oct)) = o; }
                  }
                  __syncthreads();
              }
            }
            f32x16 acc[2][2];
#pragma unroll
            for (int a = 0; a < 2; ++a)
#pragma unroll
                for (int c = 0; c < 2; ++c) acc[a][c] = zero16();
#define PM_CHUNK(kc, SET) do { \
                int la_ = lane; asm volatile("" : "+v"(la_)); const int l31_ = la_ & 31, h5_ = la_ >> 5; \
                s16x8 fb[2][2]; \
                _Pragma("unroll") for (int ks = 0; ks < 2; ++ks) _Pragma("unroll") for (int mt = 0; mt < 2; ++mt) fb[mt][ks] = *(const LAS s16x8*)(lds + PA + PM_OFFP(32 * mt + l31_, 4 * (kc) + 2 * ks + h5_)); \
                _Pragma("unroll") for (int ks = 0; ks < 2; ++ks) _Pragma("unroll") for (int nt = 0; nt < 2; ++nt) _Pragma("unroll") for (int mt = 0; mt < 2; ++mt) \
                    acc[nt][mt] = mfma32(__builtin_bit_cast(s16x8, SET[nt * 2 + ks]), fb[mt][ks], acc[nt][mt]); \
                if ((kc) + 3 < 16) PM_WLD(SET, (kc) + 3); } while (0)
            PM_CHUNK(0, wA); PM_CHUNK(1, wB); PM_CHUNK(2, wC); PM_CHUNK(3, wA); PM_CHUNK(4, wB); PM_CHUNK(5, wC); PM_CHUNK(6, wA); PM_CHUNK(7, wB);
            PM_CHUNK(8, wC); PM_CHUNK(9, wA); PM_CHUNK(10, wB); PM_CHUNK(11, wC); PM_CHUNK(12, wA); PM_CHUNK(13, wB); PM_CHUNK(14, wC); PM_CHUNK(15, wA);
#undef PM_CHUNK
#undef PM_WLD
            __syncthreads();
#pragma unroll
            for (int nt = 0; nt < 2; ++nt)
#pragma unroll
                for (int q = 0; q < 4; ++q)
#pragma unroll
                    for (int mt = 0; mt < 2; ++mt) { const int n = 32 * (2 * wave + nt) + 8 * q + 4 * h5, m = 32 * mt + l31;
                        const float y0 = acc[nt][mt][4 * q], y1 = acc[nt][mt][4 * q + 1], y2 = acc[nt][mt][4 * q + 2], y3 = acc[nt][mt][4 * q + 3];
                        v2u o; o.x = pk2(y0, y1); o.y = pk2(y2, y3);
                        *(LAS v2u*)(lds + PA + m * 1040 + n * 2) = o; }
            __syncthreads();
            { const int ch = tid & 63, col = g * 512 + ch * 8; const unsigned hvo = (unsigned)col * ES, ovo = (unsigned)col * 2u;
              const f32x4 gv0 = *(const GAS f32x4*)(gtp + col) * *(const GAS f32x4*)(pscale + col), gv1 = *(const GAS f32x4*)(gtp + col + 4) * *(const GAS f32x4*)(pscale + col + 4);
              if constexpr (XF32) {
#pragma unroll
                  for (int kb = 0; kb < 8; kb += 4) {
                      v4u ha[4], hb2[4];
#pragma unroll
                      for (int k = 0; k < 4; ++k) { const unsigned so = (unsigned)(r0 + wave + 8 * (kb + k)) * (DM * ES); ha[k] = PM_LDH(hvo, so); hb2[k] = PM_LDH(hvo, so + 16u); }
#pragma unroll
                      for (int k = 0; k < 4; ++k) { const int m = wave + 8 * (kb + k); float f[8], y[8];
                          const f32x4 x0 = __builtin_bit_cast(f32x4, ha[k]), x1 = __builtin_bit_cast(f32x4, hb2[k]); f[0] = x0.x; f[1] = x0.y; f[2] = x0.z; f[3] = x0.w; f[4] = x1.x; f[5] = x1.y; f[6] = x1.z; f[7] = x1.w;
                          const v4u yq = *(const LAS v4u*)(lds + PA + m * 1040 + ch * 16); PM_UNPK(yq, y);
                          v4u o; o.x = pk2(f[0] + gv0.x * y[0], f[1] + gv0.y * y[1]); o.y = pk2(f[2] + gv0.z * y[2], f[3] + gv0.w * y[3]); o.z = pk2(f[4] + gv1.x * y[4], f[5] + gv1.y * y[5]); o.w = pk2(f[6] + gv1.z * y[6], f[7] + gv1.w * y[7]);
                          __builtin_amdgcn_raw_buffer_store_b128(o, rsO, ovo, (unsigned)(r0 + m) * (DM * 2u), 0); }
                  }
              } else {
                  (void)hvo;
#pragma unroll
                  for (int kk = 0; kk < 8; ++kk) { const int m = wave + 8 * kk; float f[8], y[8]; PM_UNPK(hk[kk], f);
                      const v4u yq = *(const LAS v4u*)(lds + PA + m * 1040 + ch * 16); PM_UNPK(yq, y);
                      v4u o; o.x = pk2(f[0] + gv0.x * y[0], f[1] + gv0.y * y[1]); o.y = pk2(f[2] + gv0.z * y[2], f[3] + gv0.w * y[3]); o.z = pk2(f[4] + gv1.x * y[4], f[5] + gv1.y * y[5]); o.w = pk2(f[6] + gv1.z * y[6], f[7] + gv1.w * y[7]);
                      __builtin_amdgcn_raw_buffer_store_b128(o, rsO, ovo, (unsigned)(r0 + m) * (DM * 2u), 0);
                      if (U2) { float e[8]; PM_UNPK(o, e);
                          const float s2 = wave_sum(((e[0] * e[0] + e[1] * e[1]) + (e[2] * e[2] + e[3] * e[3])) + ((e[4] * e[4] + e[5] * e[5]) + (e[6] * e[6] + e[7] * e[7])));
                          if (lane == 0) rowss[m] = (g ? rowss[m] : 0.f) + s2; } }
              }
            }
            __syncthreads();
        }
        if (U2) {
            const __amdgpu_buffer_rsrc_t rsU = __builtin_amdgcn_make_buffer_rsrc((void*)U2, (short)0, M * DM * 2, 0x00020000);
            const float* sh2 = shift2 + (size_t)b * ADA_W; const float* sc2 = scale2 + (size_t)b * ADA_W;
            f32x4 mul[8], add[8];
#pragma unroll
            for (int j = 0; j < 8; ++j) { const int col = 8 * lane + 512 * (j >> 1) + 4 * (j & 1); const f32x4 gv = *(const GAS f32x4*)(g2 + col), s = *(const GAS f32x4*)(sc2 + col); mul[j] = gv * (s + 1.0f); add[j] = *(const GAS f32x4*)(sh2 + col); }
#pragma unroll 1
            for (int kb = 0; kb < 8; kb += 2) {
                v4u q[2][4]; float rs2[2];
#pragma unroll
                for (int z = 0; z < 2; ++z) { const int m = wave + 8 * (kb + z); rs2[z] = 1.0f / sqrtf(rowss[m] * (1.0f / DM) + EPS);
#pragma unroll
                    for (int j = 0; j < 4; ++j) q[z][j] = __builtin_amdgcn_raw_buffer_load_b128(rsO, (unsigned)lane * 16u + (unsigned)j * 1024u, (unsigned)(r0 + m) * (DM * 2u), 0); }
#pragma unroll
                for (int z = 0; z < 2; ++z) { const int m = wave + 8 * (kb + z); const float rstd = rs2[z];
#pragma unroll
                    for (int j = 0; j < 4; ++j) { float e[8]; PM_UNPK(q[z][j], e);
                        const f32x4 v0 = {e[0], e[1], e[2], e[3]}, v1 = {e[4], e[5], e[6], e[7]};
                        const f32x4 y0 = v0 * rstd * mul[2 * j] + add[2 * j], y1 = v1 * rstd * mul[2 * j + 1] + add[2 * j + 1];
                        v4u w; w.x = pk2(y0.x, y0.y); w.y = pk2(y0.z, y0.w); w.z = pk2(y1.x, y1.y); w.w = pk2(y1.z, y1.w);
                        __builtin_amdgcn_raw_buffer_store_b128(w, rsU, (unsigned)lane * 16u + (unsigned)j * 1024u, (unsigned)(r0 + m) * (DM * 2u), 0); } }
            }
        }
    }
#undef PM_OFFP
#undef PM_OFFW
#undef PM_LDH
#undef PM_UNPK
}

constexpr int NSUB = 6, PH_FINAL = 1 + NSUB * 2 * DEPTH, PH_END = PH_FINAL + 1;
__host__ __device__ constexpr bool phase_exists(int ph) {
    if (ph == 0 || ph == PH_FINAL) return true;
    const int hl = (ph - 1) / NSUB, s = (ph - 1) % NSUB, layer = hl >> 1;
    if (!(hl & 1) && layer % 3 == 0) return s == 1;
    if ((hl & 1) && layer % 3 == 0 && s == 0) return false;
    if (s == 2) return false;
    if (s == 3 || s == 4) return !(hl & 1) && (layer == 1 || layer == 2);
    return true;
}
__global__ void __launch_bounds__(NWAVES * 64, 2) trunk_fwd(Args a) {
    extern __shared__ __attribute__((aligned(16))) unsigned char lds_raw[];
    LAS unsigned char* lds = (LAS unsigned char*)lds_raw;
    volatile LAS unsigned* MISC = (volatile LAS unsigned*)(lds + MISC_OFF);
    const int G = gridDim.x; const int bx = blockIdx.x; const int vcu = (G % 8 == 0) ? (bx % 8) * (G / 8) + bx / 8 : bx;
    const int NGW = G * NWAVES;
    gu32* ctl = (gu32*)(a.ws + WS_CTL);
    const int wave0 = __builtin_amdgcn_readfirstlane((int)threadIdx.x >> 6);
    for (int u = (int)__builtin_amdgcn_mbcnt_hi(~0u, __builtin_amdgcn_mbcnt_lo(~0u, 0u)) + 64 * wave0; u < (LDS_BYTES - LDSCTL_OFF) / 4; u += NWAVES * 64) ((LAS unsigned*)(lds + LDSCTL_OFF))[u] = 0u;
    __syncthreads();
#define PHASE_IDS() const CAS Args* ap = (const CAS Args*)__builtin_amdgcn_kernarg_segment_ptr(); asm volatile("" : "+s"(ap)); unsigned char* ws = ap->ws; int lane = (int)__builtin_amdgcn_mbcnt_hi(~0u, __builtin_amdgcn_mbcnt_lo(~0u, 0u)); asm volatile("" : "+v"(lane)); const int wave = wave0, tid = wave * 64 + lane, gw = vcu * NWAVES + wave; (void)tid; (void)gw
#if MK_ONE_LAUNCH
    XcdBarrier bar = xcd_barrier_post((unsigned*)(ctl + CW_BAR), MISC + 8, wave0);
#define GRID_BAR() xcd_barrier(bar, wave0)
#else
#define GRID_BAR() do { } while (0)
#endif
    const int lo = a.ph_lo, hi = a.ph_hi;
#define IN(k) (lo <= (k) && (k) < hi)
#define ada ((float*)(ws + WS_ADA))
#define U ((bf16*)(ws + WS_U))
#define Pb ((bf16*)(ws + WS_P))
#define PROJ ((bf16*)(ws + WS_PROJ))
#define O ((bf16*)(ws + WS_O))
#define HQD ((bf16*)(ws + WS_PROJ + 256 * MiB))
#define HKI ((bf16*)(ws + WS_PROJ + 320 * MiB))
#define HKE ((bf16*)(ws + WS_P + 64 * MiB))
#define HDEC ((float*)(ws + WS_O + 128 * MiB))
#define HVV ((bf16*)(ws + WS_O + 136 * MiB))
#define H ((bf16*)(ws + (hl >= 7 ? WS_H2 : WS_H)))
#define HPOOL_OUT ((bf16*)(ws + (hl >= 6 ? WS_H2 : WS_H)))

    if (IN(0)) for (int rep = 0; rep < REP_P0; ++rep) { PHASE_IDS(); phase_prologue(ap, lds, tid, lane, wave, vcu, G); GRID_BAR(); }

    for (int hl = 0; hl < 2 * DEPTH; ++hl) {
        const int layer = hl >> 1, isffn = hl & 1, pb = 1 + NSUB * hl;
        const int kind = layer % 3, jj = layer / 3;
#define ada_l (ada + (size_t)layer * NB * ADA_W)
#define hin_is_x (hl == 0)
        if ((kind != 0) && IN(pb + 0)) for (int rep = 0; rep < REP_S0; ++rep) {
            PHASE_IDS();
            if (hin_is_x) phase_normmod(ap->x, ap->norm_mix_g, ada_l, ada_l + DM, U, gw, NGW, lane);
            else phase_normmod_bf(H, (isffn ? ap->norm_ffn_g : ap->norm_mix_g) + (size_t)layer * DM, ada_l + (isffn ? 3 : 0) * DM, ada_l + (isffn ? 4 : 1) * DM, U, gw, NGW, lane);
            GRID_BAR();
        }
        if (IN(pb + 1)) for (int rep = 0; rep < REP_S1; ++rep) {
            PHASE_IDS();
            if (isffn) {
                pg8::Gemm g{U, (const bf16*)(ws + WS_FFWIN) + (size_t)layer * FF2 * DM, M, FF2, DM, DM, DM, FF2 / 256, 0, 0};
                pg8::StaticOrder S; S.init(M, FF2, G, bx);
                pg8::EpiSwiGLU E{PROJ, FF};
                pg8::gemm_phase<pg8::EpiSwiGLU, pg8::StaticOrder, true>(lds + RING_OFF, g, S, E, tid);
            } else if (kind == 0) {
                phase_poolmix<false>(hin_is_x ? (const void*)(ws + WS_H2) : (const void*)H, hin_is_x ? (const float*)(ws + WS_XRS) : (const float*)nullptr, HPOOL_OUT,
                                     ap->norm_mix_g + (size_t)layer * DM, ada_l, ap->pool_scale + (size_t)jj * DM, (const bf16*)(ws + WS_POOLW) + (size_t)jj * 4 * 512 * 512,
                                     ap->norm_ffn_g + (size_t)layer * DM, ada_l + 3 * DM, ada_l + 4 * DM, U, lds, tid, vcu, G);
            } else {
                const int N = (kind == 1) ? HG_IN : RT_IN;
                pg8::Gemm g{U, (const bf16*)(ws + (kind == 1 ? WS_HGWIN : WS_RTWIN)), M, N, DM, DM, DM, N / 256, 0, 0};
                pg8::StaticOrder S; S.init(M, N, G, bx);
                const float* rot = (const float*)(ws + WS_ROT);
                pg8::EpiBf16Rot E{PROJ, N, rot, rot + (size_t)M * 128, kind == 2 ? 16 : 0, kind == 1 ? 16 : 0, (const float*)(ws + WS_LB), HQD, HKI, HKE, HDEC, HVV};
                pg8::gemm_phase<pg8::EpiBf16Rot, pg8::StaticOrder, true>(lds + RING_OFF, g, S, E, tid);
            }
            GRID_BAR();
        }
        if (0) for (int rep = 0; rep < REP_S2; ++rep) {
            PHASE_IDS();
            phase_hgrn_pre(PROJ, (const float*)(ws + WS_LB), HQD, HKI, HKE, HDEC, gw * 64 + lane, NGW * 64);
            GRID_BAR();
        }
        if (!isffn && kind != 0 && IN(pb + 3)) for (int rep = 0; rep < REP_S2; ++rep) {
            PHASE_IDS();
#if NAIVE_SCANS
            if (kind == 1) phase_hgrn_scan_naive(PROJ, (const float*)(ws + WS_LB), O, lds, tid, vcu, G);
            else phase_ret_scan_naive(PROJ, (const float*)(ws + WS_ROT), O, lds, tid, vcu, G);
#else
            if (kind == 1) { if ((vcu & 1) && G >= 2) phase_convert_late_tiles(ap, lds, lane, wave, vcu >> 1, G >> 1);
                             else phase_hgrn_scan(HVV, HQD, HKI, HKE, HDEC, O, lds, tid, G >= 2 ? (vcu >> 1) : vcu, G >= 2 ? ((G + 1) >> 1) : 1); }
            else phase_ret_scan(PROJ, O, lds, tid, vcu, G);
#endif
            GRID_BAR();
        }
        if (!isffn && kind != 0 && IN(pb + 4)) for (int rep = 0; rep < REP_S3; ++rep) {
            PHASE_IDS();
            if (kind == 1) phase_hgrn_post(O, PROJ, ap->hgrn_norm_g, Pb, gw, NGW, lane);
            else phase_ret_post(O, PROJ, ap->ret_norm_g, Pb, gw, NGW, lane);
            GRID_BAR();
        }
        if ((isffn || kind != 0) && IN(pb + 5)) {
            PHASE_IDS();
            pg8::Gemm g;
            const float* cs = nullptr;
            if (isffn) g = pg8::Gemm{PROJ, (const bf16*)(ws + WS_FFWOUT) + (size_t)layer * DM * FF, M, DM, FF, FF, FF, DM / 256, 0, 0};
            else if (kind == 0) { g = pg8::Gemm{Pb, (const bf16*)(ws + WS_POOLW) + (size_t)jj * 4 * 512 * 512, M, DM, 512, DM, 512, 2, 512, 512 * 512}; cs = ap->pool_scale + (size_t)jj * DM; }
            else if (kind == 1) g = pg8::Gemm{Pb, (const bf16*)(ws + WS_HGWOUT), M, DM, DM, DM, DM, DM / 256, 0, 0};
            else g = pg8::Gemm{Pb, (const bf16*)(ws + WS_RTWOUT), M, DM, RT_V, RT_V, RT_V, DM / 256, 0, 0};
            pg8::StaticOrder S; S.init(M, DM, G, bx);
            pg8::EpiResid E{hin_is_x ? ap->x : (const float*)nullptr, H, H, ada_l + (isffn ? 5 : 2) * DM, ADA_W, cs};
            pg8::gemm_phase<pg8::EpiResid, pg8::StaticOrder, true>(lds + RING_OFF, g, S, E, tid);
            GRID_BAR();
        }
    }
    if (IN(PH_FINAL)) { PHASE_IDS(); phase_finalnorm_bf((const bf16*)(ws + WS_H2), ap->final_g, ap->out, gw, NGW, lane); }
#undef IN
#undef ada
#undef U
#undef Pb
#undef PROJ
#undef O
#undef HQD
#undef HKI
#undef HKE
#undef HDEC
#undef HVV
#undef H
#undef HPOOL_OUT
#undef ada_l
#undef hin_is_x
}

extern "C" void kernel_launch(void* const* d_in, const int* in_sizes, int n_in, void* d_out, int out_size, void* d_ws, size_t ws_size, hipStream_t stream) {
    static int grid = 0;
    if (grid == 0) {
        if (n_in != 19 || in_sizes[0] != M * DM || out_size != M * DM || ws_size < WS_END) { fprintf(stderr, "kernel_launch: unexpected shapes (n_in %d, in0 %d, out %d, ws %zu < %zu); nothing launched\n", n_in, n_in > 0 ? in_sizes[0] : -1, out_size, ws_size, (size_t)WS_END); grid = -1; return; }
        int dev = 0, cus = 0, per_cu = 0;
        if (hipGetDevice(&dev) != hipSuccess || hipDeviceGetAttribute(&cus, hipDeviceAttributeMultiprocessorCount, dev) != hipSuccess) { grid = -1; return; }
        if (hipFuncSetAttribute((const void*)trunk_fwd, hipFuncAttributeMaxDynamicSharedMemorySize, LDS_BYTES) != hipSuccess) { fprintf(stderr, "kernel_launch: hipFuncSetAttribute failed\n"); grid = -1; return; }
        if (hipOccupancyMaxActiveBlocksPerMultiprocessor(&per_cu, (const void*)trunk_fwd, NWAVES * 64, LDS_BYTES) != hipSuccess || per_cu < 1)
            fprintf(stderr, "kernel_launch: note: occupancy query reports %d workgroups per CU\n", per_cu);
        (void)hipGetLastError();
        grid = cus;
    }
    if (grid < 0) return;
    if (hipMemsetAsync((char*)d_ws + WS_CTL, 0, CTL_ZERO_BYTES, stream) != hipSuccess) { fprintf(stderr, "kernel_launch: memset failed\n"); return; }
    Args a{};
    a.x = (const float*)d_in[0]; a.c = (const float*)d_in[1]; a.pos = (const int*)d_in[2]; a.w_ada = (const float*)d_in[3]; a.b_ada = (const float*)d_in[4];
    a.norm_mix_g = (const float*)d_in[5]; a.norm_ffn_g = (const float*)d_in[6]; a.pool_w = (const float*)d_in[7]; a.pool_scale = (const float*)d_in[8];
    a.hgrn_w_in = (const float*)d_in[9]; a.hgrn_lb = (const float*)d_in[10]; a.hgrn_norm_g = (const float*)d_in[11]; a.hgrn_w_out = (const float*)d_in[12];
    a.ret_w_in = (const float*)d_in[13]; a.ret_norm_g = (const float*)d_in[14]; a.ret_w_out = (const float*)d_in[15]; a.ffn_w_in = (const float*)d_in[16];
    a.ffn_w_out = (const float*)d_in[17]; a.final_g = (const float*)d_in[18];
    a.out = (float*)d_out; a.ws = (unsigned char*)d_ws;
#if MK_ONE_LAUNCH
    a.ph_lo = 0; a.ph_hi = PH_END;
    hipLaunchKernelGGL(trunk_fwd, dim3(grid), dim3(NWAVES * 64), LDS_BYTES, stream, a);
    { const hipError_t le = hipPeekAtLastError(); if (le != hipSuccess) fprintf(stderr, "kernel_launch: launch failed: %s\n", hipGetErrorName(le)); }
#else
    for (int ph = 0; ph < PH_END; ++ph) {
        if (!phase_exists(ph)) continue;
        a.ph_lo = ph; a.ph_hi = ph + 1;
        hipLaunchKernelGGL(trunk_fwd, dim3(grid), dim3(NWAVES * 64), LDS_BYTES, stream, a);
        const hipError_t le = hipPeekAtLastError();
        if (le != hipSuccess) { fprintf(stderr, "kernel_launch: launch %d failed: %s\n", ph, hipGetErrorName(le)); break; }
    }
#endif
}
```

```cpp
#include <hip/hip_runtime.h>
#include <cstdio>
#include <cstdint>

#ifndef MK_ONE_LAUNCH
#define MK_ONE_LAUNCH 1
#endif
#define REP_S0 1
#define REP_S1 1
#define REP_S2 1
#define REP_S3 1
#define REP_P0 1
#define NAIVE_SCANS 0

constexpr int DM = 2048, NB = 4, SEQ = 4096, DEPTH = 4, M = NB * SEQ;
constexpr int ADA_W = 6 * DM;
constexpr int HG_IN = 8192, HG_H = 16, HG_DK = 128;
constexpr int RT_IN = 12288, RT_H = 8, RT_DK = 256, RT_DV = 512, RT_V = 4096;
constexpr int FF = 5632, FF2 = 2 * FF;
constexpr float EPS = 1e-6f;

namespace pg8 {
#define PG8_LAS __attribute__((address_space(3)))
typedef unsigned short bf16_t;
typedef short bf16x8 __attribute__((ext_vector_type(8)));
typedef float f32x4 __attribute__((ext_vector_type(4)));
typedef unsigned u32x4 __attribute__((ext_vector_type(4)));
constexpr int BM = 256, BK = 64, HALF = 128, HTB = HALF * BK * 2  , STAGE_BYTES = 8 * HTB, NXCD = 8, WGM = 4;

__host__ __device__ __forceinline__ int lds_byte(int r, int c) { const int st = (r >> 4) * 2 + (c >> 5), rr = r & 15, cc = c & 31, ob = rr * 64 + cc * 2; return st * 1024 + (ob ^ (((ob >> 9) & 1) << 5)); }
__host__ __device__ __forceinline__ void stage_rc(int b, int& R, int& C) { const int st = b / 1024, sb = b % 1024, swz = sb ^ (((sb >> 9) & 1) << 5); R = (st >> 1) * 16 + swz / 64; C = (st & 1) * 32 + (swz % 64) / 2; }
__host__ __device__ __forceinline__ int perm32(int rho) { const int n = rho >> 4, i = rho & 15; return 8 * (i >> 2) + 4 * n + (i & 3); }

struct Unit { int pm, pn; };
struct Gemm { const bf16_t* A; const bf16_t* Bt; int M, N, K, lda, ldb, gpn; long a_gs, b_gs; };

struct StaticOrder {
    int nM, nN, nwg, G, c;
    __host__ __device__ void init(int M_, int N_, int G_, int c_) { nM = M_ / BM; nN = N_ / BM; nwg = nM * nN; G = G_; c = c_; }
    __host__ __device__ bool next(int i, Unit& u) const {
        const long L = (long)i * G + c; if (L >= nwg) return false;
        int wgid = (int)L; { const int q = nwg / NXCD, r = nwg % NXCD, xcd = wgid % NXCD, off = wgid / NXCD; wgid = (xcd < r ? xcd * (q + 1) : r * (q + 1) + (xcd - r) * q) + off; }
        const int nig = WGM * nN, gid = wgid / nig, fm = gid * WGM, gsz = (nM - fm) < WGM ? (nM - fm) : WGM;
        u.pm = fm + ((wgid % nig) % gsz); u.pn = (wgid % nig) / gsz; return true;
    }
    __device__ __forceinline__ void a_ready(const Unit&) const {}
    __device__ __forceinline__ void done(const Unit&) const {}
};

__device__ __forceinline__ unsigned cvt_pk_bf16(float lo, float hi) { unsigned r; asm volatile("v_cvt_pk_bf16_f32 %0, %1, %2" : "=v"(r) : "v"(lo), "v"(hi)); return r; }

struct EpiBf16 {
    static constexpr bool PERM = true, AFTER_DRAIN = false;
    bf16_t* O; int ldc;
    __device__ __forceinline__ void operator()(const f32x4 (&acc)[2][2][4][2], const Unit& u, int wr, int wc, int fr, int fq) const {
        const int row0 = u.pm * BM + wr * 64 + fr, col0 = u.pn * BM + wc * 32 + 8 * fq;
#pragma unroll
        for (int ai = 0; ai < 2; ++ai)
#pragma unroll
            for (int m = 0; m < 4; ++m) { bf16_t* rowp = O + (size_t)(row0 + ai * HALF + m * 16) * ldc + col0;
#pragma unroll
                for (int bj = 0; bj < 2; ++bj) { const f32x4 v0 = acc[ai][bj][m][0], v1 = acc[ai][bj][m][1];
                    u32x4 w; w.x = cvt_pk_bf16(v0[0], v0[1]); w.y = cvt_pk_bf16(v0[2], v0[3]); w.z = cvt_pk_bf16(v1[0], v1[1]); w.w = cvt_pk_bf16(v1[2], v1[3]);
                    *(u32x4*)(rowp + bj * HALF) = w; } }
    }
};
__device__ __forceinline__ float scan16_mul(float x) {
#define PG8_DPP_SHR(v, n) __builtin_bit_cast(float, __builtin_amdgcn_update_dpp(0x3f800000, __builtin_bit_cast(int, v), 0x110 + (n), 0xf, 0xf, false))
    x *= PG8_DPP_SHR(x, 1); x *= PG8_DPP_SHR(x, 2); x *= PG8_DPP_SHR(x, 4); x *= PG8_DPP_SHR(x, 8);
#undef PG8_DPP_SHR
    return x;
}
__device__ __forceinline__ float bcast15(float x, int lane) { (void)lane; return __builtin_bit_cast(float, __builtin_amdgcn_update_dpp(0, __builtin_bit_cast(int, x), 0x15F, 0xf, 0xf, false)); }
__device__ __forceinline__ float sigm_f(float x) { return __builtin_amdgcn_rcpf(1.0f + __builtin_amdgcn_exp2f(-1.4426950408889634f * x)); }
struct EpiBf16Rot {
    static constexpr bool PERM = true, AFTER_DRAIN = false;
    bf16_t* O; int ldc; const float* ct; const float* st; int rot_tiles;
    int hg_tiles; const float* lbv; bf16_t* QD; bf16_t* KI; bf16_t* KE; float* DEC; bf16_t* HV;
    __device__ __forceinline__ void operator()(const f32x4 (&acc)[2][2][4][2], const Unit& u, int wr, int wc, int fr, int fq) const {
        const int row0 = u.pm * BM + wr * 64 + fr, col0 = u.pn * BM + wc * 32 + 8 * fq;
        if (u.pn < hg_tiles) {
            const int lane = fq * 16 + fr, cg = u.pn * HALF + wc * 32 + 8 * fq;
            float lb[8];
            { const f32x4 l0 = *(const f32x4*)(lbv + cg), l1 = *(const f32x4*)(lbv + cg + 4);
#pragma unroll
              for (int e = 0; e < 4; ++e) { lb[e] = l0[e]; lb[4 + e] = l1[e]; } }
#pragma unroll
            for (int ai = 0; ai < 2; ++ai)
#pragma unroll
                for (int mp = 0; mp < 2; ++mp) {
                    float qd0[8], ki0[8], ke0[8], qd1[8], ki1[8], ke1[8], tot[8];
#pragma unroll
                    for (int c = 0; c < 8; ++c) {
                        const float z0 = acc[ai][1][2 * mp][c >> 2][c & 3], z1 = acc[ai][1][2 * mp + 1][c >> 2][c & 3];
                        const float q0 = acc[ai][0][2 * mp][c >> 2][c & 3], q1 = acc[ai][0][2 * mp + 1][c >> 2][c & 3];
                        const float s0 = sigm_f(z0), s1 = sigm_f(z1), om = 1.0f - lb[c];
                        const float e0 = scan16_mul(lb[c] + om * s0);
                        const float e1 = scan16_mul(lb[c] + om * s1) * bcast15(e0, lane);
                        const float tt = bcast15(e1, lane);
                        const float k0 = om * (1.0f - s0) * __builtin_amdgcn_rcpf(e0), k1 = om * (1.0f - s1) * __builtin_amdgcn_rcpf(e1);
                        qd0[c] = q0 * e0; ki0[c] = k0; ke0[c] = k0 * tt; qd1[c] = q1 * e1; ki1[c] = k1; ke1[c] = k1 * tt; tot[c] = tt;
                    }
                    const int rr0 = row0 + ai * HALF + 32 * mp;
                    const size_t r0 = ((size_t)((rr0 >> 12) * 16 + u.pn) * 4096 + (rr0 & 4095)) * 128 + (wc * 32 + 8 * fq), r1 = r0 + 16 * 128;
                    u32x4 w;
                    w.x = cvt_pk_bf16(qd0[0], qd0[1]); w.y = cvt_pk_bf16(qd0[2], qd0[3]); w.z = cvt_pk_bf16(qd0[4], qd0[5]); w.w = cvt_pk_bf16(qd0[6], qd0[7]); *(u32x4*)(QD + r0) = w;
                    w.x = cvt_pk_bf16(ki0[0], ki0[1]); w.y = cvt_pk_bf16(ki0[2], ki0[3]); w.z = cvt_pk_bf16(ki0[4], ki0[5]); w.w = cvt_pk_bf16(ki0[6], ki0[7]); *(u32x4*)(KI + r0) = w;
                    w.x = cvt_pk_bf16(ke0[0], ke0[1]); w.y = cvt_pk_bf16(ke0[2], ke0[3]); w.z = cvt_pk_bf16(ke0[4], ke0[5]); w.w = cvt_pk_bf16(ke0[6], ke0[7]); *(u32x4*)(KE + r0) = w;
                    w.x = cvt_pk_bf16(qd1[0], qd1[1]); w.y = cvt_pk_bf16(qd1[2], qd1[3]); w.z = cvt_pk_bf16(qd1[4], qd1[5]); w.w = cvt_pk_bf16(qd1[6], qd1[7]); *(u32x4*)(QD + r1) = w;
                    w.x = cvt_pk_bf16(ki1[0], ki1[1]); w.y = cvt_pk_bf16(ki1[2], ki1[3]); w.z = cvt_pk_bf16(ki1[4], ki1[5]); w.w = cvt_pk_bf16(ki1[6], ki1[7]); *(u32x4*)(KI + r1) = w;
                    w.x = cvt_pk_bf16(ke1[0], ke1[1]); w.y = cvt_pk_bf16(ke1[2], ke1[3]); w.z = cvt_pk_bf16(ke1[4], ke1[5]); w.w = cvt_pk_bf16(ke1[6], ke1[7]); *(u32x4*)(KE + r1) = w;
                    if (fr == 15) { const int crow = u.pm * BM + wr * 64 + ai * HALF + 32 * mp; float* dp = DEC + ((size_t)((crow >> 12) * 16 + u.pn) * 128 + ((crow & 4095) >> 5)) * 128 + (wc * 32 + 8 * fq);
                        *(f32x4*)dp = (f32x4){tot[0], tot[1], tot[2], tot[3]}; *(f32x4*)(dp + 4) = (f32x4){tot[4], tot[5], tot[6], tot[7]}; }
                }
        } else if (u.pn < rot_tiles) {
            const float sc = u.pn >= 8 ? 0.0625f : 1.0f; const int j0 = wc * 32 + 8 * fq;
#pragma unroll
            for (int ai = 0; ai < 2; ++ai)
#pragma unroll
                for (int m = 0; m < 4; ++m) { const int row = row0 + ai * HALF + m * 16; bf16_t* rowp = O + (size_t)row * ldc + col0;
                    const f32x4 c0 = *(const f32x4*)(ct + (size_t)row * 128 + j0), c1 = *(const f32x4*)(ct + (size_t)row * 128 + j0 + 4);
                    const f32x4 s0 = *(const f32x4*)(st + (size_t)row * 128 + j0), s1 = *(const f32x4*)(st + (size_t)row * 128 + j0 + 4);
                    const f32x4 a0 = acc[ai][0][m][0], a1 = acc[ai][0][m][1], b0 = acc[ai][1][m][0], b1 = acc[ai][1][m][1];
                    const f32x4 p0 = (a0 * c0 - b0 * s0) * sc, p1 = (a1 * c1 - b1 * s1) * sc, q0 = (a0 * s0 + b0 * c0) * sc, q1 = (a1 * s1 + b1 * c1) * sc;
                    u32x4 w; w.x = cvt_pk_bf16(p0[0], p0[1]); w.y = cvt_pk_bf16(p0[2], p0[3]); w.z = cvt_pk_bf16(p1[0], p1[1]); w.w = cvt_pk_bf16(p1[2], p1[3]);
                    *(u32x4*)rowp = w;
                    w.x = cvt_pk_bf16(q0[0], q0[1]); w.y = cvt_pk_bf16(q0[2], q0[3]); w.z = cvt_pk_bf16(q1[0], q1[1]); w.w = cvt_pk_bf16(q1[2], q1[3]);
                    *(u32x4*)(rowp + HALF) = w; }
        } else {
            const bool hv = hg_tiles > 0 && u.pn < 24;
#pragma unroll
            for (int ai = 0; ai < 2; ++ai)
#pragma unroll
                for (int m = 0; m < 4; ++m) { const int row = row0 + ai * HALF + m * 16; bf16_t* rowp = O + (size_t)row * ldc + col0;
#pragma unroll
                    for (int bj = 0; bj < 2; ++bj) { const f32x4 v0 = acc[ai][bj][m][0], v1 = acc[ai][bj][m][1];
                        u32x4 w; w.x = cvt_pk_bf16(v0[0], v0[1]); w.y = cvt_pk_bf16(v0[2], v0[3]); w.z = cvt_pk_bf16(v1[0], v1[1]); w.w = cvt_pk_bf16(v1[2], v1[3]);
                        if (hv) *(u32x4*)(HV + ((size_t)((row >> 12) * 16 + 2 * (u.pn - 16) + bj) * 4096 + (row & 4095)) * 128 + wc * 32 + 8 * fq) = w;
                        else *(u32x4*)(rowp + bj * HALF) = w; } }
        }
    }
};
__device__ __forceinline__ float silu_f(float x) { return x * __builtin_amdgcn_rcpf(1.0f + __builtin_amdgcn_exp2f(-1.4426950408889634f * x)); }
struct EpiSwiGLU {
    static constexpr bool PERM = true, AFTER_DRAIN = false;
    bf16_t* O; int ldc;
    __device__ __forceinline__ void operator()(const f32x4 (&acc)[2][2][4][2], const Unit& u, int wr, int wc, int fr, int fq) const {
        const int row0 = u.pm * BM + wr * 64 + fr, col0 = u.pn * HALF + wc * 32 + 8 * fq;
#pragma unroll
        for (int ai = 0; ai < 2; ++ai)
#pragma unroll
            for (int m = 0; m < 4; ++m) { bf16_t* rowp = O + (size_t)(row0 + ai * HALF + m * 16) * ldc + col0;
                const f32x4 g0 = acc[ai][0][m][0], g1 = acc[ai][0][m][1], u0 = acc[ai][1][m][0], u1 = acc[ai][1][m][1];
                f32x4 e0 = g0 * -1.4426950408889634f, e1 = g1 * -1.4426950408889634f;
                const f32x4 p0 = g0 * u0, p1 = g1 * u1;
                __builtin_amdgcn_sched_barrier(0);
#pragma unroll
                for (int i = 0; i < 4; ++i) { e0[i] = __builtin_amdgcn_exp2f(e0[i]); e1[i] = __builtin_amdgcn_exp2f(e1[i]); }
                __builtin_amdgcn_sched_barrier(0);
                e0 = e0 + 1.0f; e1 = e1 + 1.0f;
                __builtin_amdgcn_sched_barrier(0);
#pragma unroll
                for (int i = 0; i < 4; ++i) { e0[i] = __builtin_amdgcn_rcpf(e0[i]); e1[i] = __builtin_amdgcn_rcpf(e1[i]); }
                __builtin_amdgcn_sched_barrier(0);
                const f32x4 o0 = p0 * e0, o1 = p1 * e1;
                u32x4 w; w.x = cvt_pk_bf16(o0[0], o0[1]); w.y = cvt_pk_bf16(o0[2], o0[3]); w.z = cvt_pk_bf16(o1[0], o1[1]); w.w = cvt_pk_bf16(o1[2], o1[3]);
                *(u32x4*)rowp = w; }
    }
};
struct EpiResid {
    static constexpr bool PERM = true, AFTER_DRAIN = false;
    const float* xin; const bf16_t* hin; bf16_t* hout; const float* gate; int gate_bs; const float* cscale;
    __device__ __forceinline__ void operator()(const f32x4 (&acc)[2][2][4][2], const Unit& u, int wr, int wc, int fr, int fq) const {
        const int row0 = u.pm * BM + wr * 64 + fr, col0 = u.pn * BM + wc * 32 + 8 * fq;
        const float* gp = gate + (size_t)(u.pm >> 4) * gate_bs + col0;
        f32x4 gv[2][2];
#pragma unroll
        for (int bj = 0; bj < 2; ++bj)
#pragma unroll
            for (int n = 0; n < 2; ++n) { gv[bj][n] = *(const f32x4*)(gp + bj * HALF + n * 4); if (cscale) gv[bj][n] = gv[bj][n] * *(const f32x4*)(cscale + col0 + bj * HALF + n * 4); }
#pragma unroll
        for (int ai = 0; ai < 2; ++ai)
#pragma unroll
            for (int m = 0; m < 4; ++m) { const size_t ro = (size_t)(row0 + ai * HALF + m * 16) * DM + col0;
#pragma unroll
                for (int bj = 0; bj < 2; ++bj) {
                    f32x4 h0, h1;
                    if (xin) { h0 = *(const f32x4*)(xin + ro + bj * HALF); h1 = *(const f32x4*)(xin + ro + bj * HALF + 4); }
                    else { const u32x4 hb = *(const u32x4*)(hin + ro + bj * HALF);
                        h0 = (f32x4){__builtin_bit_cast(float, hb.x << 16), __builtin_bit_cast(float, hb.x & 0xffff0000u), __builtin_bit_cast(float, hb.y << 16), __builtin_bit_cast(float, hb.y & 0xffff0000u)};
                        h1 = (f32x4){__builtin_bit_cast(float, hb.z << 16), __builtin_bit_cast(float, hb.z & 0xffff0000u), __builtin_bit_cast(float, hb.w << 16), __builtin_bit_cast(float, hb.w & 0xffff0000u)}; }
                    const f32x4 o0 = h0 + gv[bj][0] * acc[ai][bj][m][0], o1 = h1 + gv[bj][1] * acc[ai][bj][m][1];
                    u32x4 w; w.x = cvt_pk_bf16(o0[0], o0[1]); w.y = cvt_pk_bf16(o0[2], o0[3]); w.z = cvt_pk_bf16(o1[0], o1[1]); w.w = cvt_pk_bf16(o1[2], o1[3]);
                    *(u32x4*)(hout + ro + bj * HALF) = w; } }
    }
};

template <class Epi, class Sched, bool ALIGN_EPI = false>
__device__ __forceinline__ void gemm_phase(PG8_LAS unsigned char* lds, const Gemm g, const Sched& S, const Epi& E, const int tid) {
    const int wid = __builtin_amdgcn_readfirstlane(tid >> 6), lane = tid & 63, wr = wid >> 2, wc = wid & 3, fr = lane & 15, fq = lane >> 4;
    const int K = g.K, nt = K / BK, lda = g.lda, ldb = g.ldb;
    unsigned voffA[2], voffB[2];
#pragma unroll
    for (int i = 0; i < 2; ++i) { int R, C; stage_rc(tid * 16 + i * 8192, R, C); const int Rb = Epi::PERM ? ((R & ~31) + perm32(R & 31)) : R;
        voffA[i] = (unsigned)(R * lda + C) * 2u; voffB[i] = (unsigned)(Rb * ldb + C) * 2u; }
    const unsigned kstep = (unsigned)(BK * 2);
    const unsigned hstepA = (unsigned)HALF * lda * 2u, hstepB = (unsigned)HALF * ldb * 2u;
    const __amdgpu_buffer_rsrc_t rsA = __builtin_amdgcn_make_buffer_rsrc((void*)g.A, (short)0, 0x7fffffff, 0x00020000), rsB = __builtin_amdgcn_make_buffer_rsrc((void*)g.Bt, (short)0, 0x7fffffff, 0x00020000);
    const unsigned ldsw = (unsigned)wid * 1024u;
    const int aoff = lds_byte(wr * 64 + fr, fq * 8), boff = lds_byte(wc * 32 + fr, fq * 8);
#define PG8_SA(b, h) (((b) * 2 + (h)) * HTB)
#define PG8_SB(b, h) ((4 + (b) * 2 + (h)) * HTB)
#define PG8_STAGEA(bufoff, soff, voff) do { _Pragma("unroll") for (int _i = 0; _i < 2; ++_i) \
        __builtin_amdgcn_raw_ptr_buffer_load_lds(rsA, (PG8_LAS unsigned*)(lds + (bufoff) + ldsw + _i * 8192), 16, (voff)[_i], (soff), 0, 0); } while (0)
#define PG8_STAGEB(bufoff, soff, voff) do { _Pragma("unroll") for (int _i = 0; _i < 2; ++_i) \
        __builtin_amdgcn_raw_ptr_buffer_load_lds(rsB, (PG8_LAS unsigned*)(lds + (bufoff) + ldsw + _i * 8192), 16, (voff)[_i], (soff), 0, 0); } while (0)
#define PG8_LDA(dst, b, h) do { _Pragma("unroll") for (int m = 0; m < 4; ++m) _Pragma("unroll") for (int k = 0; k < 2; ++k) dst[m][k] = *(const PG8_LAS bf16x8*)(lds + PG8_SA(b, h) + aoff + m * 2048 + k * 1024); } while (0)
#define PG8_LDB(dst, b, h) do { _Pragma("unroll") for (int n = 0; n < 2; ++n) _Pragma("unroll") for (int k = 0; k < 2; ++k) dst[n][k] = *(const PG8_LAS bf16x8*)(lds + PG8_SB(b, h) + boff + n * 2048 + k * 1024); } while (0)
#define PG8_MMA(ai, bj, At, Bt) do { __builtin_amdgcn_s_setprio(1); _Pragma("unroll") for (int m = 0; m < 4; ++m) _Pragma("unroll") for (int n = 0; n < 2; ++n) _Pragma("unroll") for (int k = 0; k < 2; ++k) \
        acc[ai][bj][m][n] = __builtin_amdgcn_mfma_f32_16x16x32_bf16(Bt[n][k], At[m][k], acc[ai][bj][m][n], 0, 0, 0); __builtin_amdgcn_s_setprio(0); } while (0)
#define PG8_WAIT_V(n) asm volatile("s_waitcnt vmcnt(" #n ")" ::: "memory")
#define PG8_WAIT_L(n) asm volatile("s_waitcnt lgkmcnt(" #n ")" ::: "memory")
#define PG8_BAR __builtin_amdgcn_s_barrier()
#define PG8_SCHED __builtin_amdgcn_sched_barrier(0)
#define PG8_ABASE(u) ((unsigned)(((size_t)((u).pn / g.gpn) * (size_t)g.a_gs + (size_t)(u).pm * BM * lda) * 2))
#define PG8_BBASE(u) ((unsigned)(((size_t)((u).pn / g.gpn) * (size_t)g.b_gs + (size_t)((u).pn % g.gpn) * BM * ldb) * 2))
    Unit cur, nxt; int ui = 0;
    if (!S.next(0, cur)) return;
    f32x4 acc[2][2][4][2];
#pragma unroll
    for (int a = 0; a < 2; ++a)
#pragma unroll
        for (int b = 0; b < 2; ++b)
#pragma unroll
            for (int m = 0; m < 4; ++m)
#pragma unroll
                for (int n = 0; n < 2; ++n) acc[a][b][m][n] = (f32x4){0.f, 0.f, 0.f, 0.f};
    bf16x8 At[4][2], B0[2][2], B1[2][2];
    unsigned cA = PG8_ABASE(cur), cB = PG8_BBASE(cur);
    S.a_ready(cur);
    PG8_STAGEB(PG8_SB(0, 0), cB, voffB); PG8_STAGEB(PG8_SB(0, 1), cB + hstepB, voffB); PG8_STAGEA(PG8_SA(0, 0), cA, voffA); PG8_STAGEA(PG8_SA(0, 1), cA + hstepA, voffA);
    PG8_STAGEB(PG8_SB(1, 0), cB + kstep, voffB); PG8_STAGEA(PG8_SA(1, 0), cA + kstep, voffA); PG8_STAGEB(PG8_SB(1, 1), cB + hstepB + kstep, voffB);
    if (wr == 1) PG8_BAR;
    PG8_WAIT_V(8); PG8_BAR;
    PG8_WAIT_V(6); PG8_BAR;
    for (;;) {
        const bool has_next = S.next(ui + 1, nxt);
        const unsigned nA = has_next ? PG8_ABASE(nxt) : cA, nB = has_next ? PG8_BBASE(nxt) : cB;
        for (int t = 0; t < nt; t += 2) {
            const bool last = (t == nt - 2);
            const unsigned a1 = cA + (unsigned)(t + 1) * kstep;
            const unsigned a2 = last ? nA : cA + (unsigned)(t + 2) * kstep, b2 = last ? nB : cB + (unsigned)(t + 2) * kstep;
            const unsigned a3 = a2 + kstep, b3 = b2 + kstep;
            if (last && has_next) S.a_ready(nxt);
            PG8_LDB(B0, 0, 0); PG8_LDB(B1, 0, 1); PG8_SCHED; PG8_LDA(At, 0, 0); PG8_STAGEA(PG8_SA(1, 1), a1 + hstepA, voffA);
            PG8_WAIT_V(8); PG8_WAIT_L(0); PG8_BAR; PG8_MMA(0, 0, At, B0); PG8_MMA(0, 1, At, B1); PG8_BAR; PG8_SCHED;
            PG8_LDA(At, 0, 1); PG8_STAGEB(PG8_SB(0, 0), b2, voffB); PG8_STAGEB(PG8_SB(0, 1), b2 + hstepB, voffB); PG8_STAGEA(PG8_SA(0, 0), a2, voffA);
            PG8_WAIT_V(8); PG8_WAIT_L(0); PG8_BAR; PG8_MMA(1, 0, At, B0); PG8_MMA(1, 1, At, B1); PG8_BAR; PG8_SCHED;
            PG8_LDB(B0, 1, 0); PG8_LDB(B1, 1, 1); PG8_SCHED; PG8_LDA(At, 1, 0); PG8_STAGEA(PG8_SA(0, 1), a2 + hstepA, voffA);
            PG8_WAIT_V(8); PG8_WAIT_L(0); PG8_BAR; PG8_MMA(0, 0, At, B0); PG8_MMA(0, 1, At, B1); PG8_BAR; PG8_SCHED;
            PG8_LDA(At, 1, 1); PG8_STAGEB(PG8_SB(1, 0), b3, voffB); PG8_STAGEB(PG8_SB(1, 1), b3 + hstepB, voffB); PG8_STAGEA(PG8_SA(1, 0), a3, voffA);
            PG8_WAIT_V(8); PG8_WAIT_L(0); PG8_BAR; PG8_MMA(1, 0, At, B0); PG8_MMA(1, 1, At, B1); PG8_BAR; PG8_SCHED;
        }
        if constexpr (ALIGN_EPI) { if (wr == 0) PG8_BAR; }
        E(acc, cur, wr, wc, fr, fq); S.done(cur);
        if (!has_next) break;
#pragma unroll
        for (int a = 0; a < 2; ++a)
#pragma unroll
            for (int b = 0; b < 2; ++b)
#pragma unroll
                for (int m = 0; m < 4; ++m)
#pragma unroll
                    for (int n = 0; n < 2; ++n) acc[a][b][m][n] = (f32x4){0.f, 0.f, 0.f, 0.f};
        cur = nxt; cA = nA; cB = nB; ++ui;
        if constexpr (ALIGN_EPI) { if (wr == 1) PG8_BAR; }
    }
    PG8_WAIT_V(0);
    if constexpr (!ALIGN_EPI) { if (wr == 0) PG8_BAR; }
    PG8_BAR;
#undef PG8_SA
#undef PG8_SB
#undef PG8_STAGEA
#undef PG8_STAGEB
#undef PG8_LDA
#undef PG8_LDB
#undef PG8_MMA
#undef PG8_WAIT_V
#undef PG8_WAIT_L
#undef PG8_BAR
#undef PG8_SCHED
#undef PG8_ABASE
#undef PG8_BBASE
}
}

constexpr size_t MiB = 1u << 20;
constexpr size_t WS_CTL = 0, CTL_ZERO_BYTES = 1 * MiB;
constexpr size_t WS_ADA = 1 * MiB;
constexpr size_t WS_LB = 2 * MiB;
constexpr size_t WS_XRS = 3 * MiB;
constexpr size_t WS_ROT = 4 * MiB;
constexpr size_t WS_POOLW = 20 * MiB;
constexpr size_t WS_HGWIN = 24 * MiB;
constexpr size_t WS_HGWOUT = 56 * MiB;
constexpr size_t WS_RTWIN = 64 * MiB;
constexpr size_t WS_RTWOUT = 112 * MiB;
constexpr size_t WS_FFWIN = 128 * MiB;
constexpr size_t WS_FFWOUT = 304 * MiB;
constexpr size_t WS_U = 392 * MiB;
constexpr size_t WS_P = 456 * MiB;
constexpr size_t WS_PROJ = 584 * MiB;
constexpr size_t WS_O = 968 * MiB;
constexpr size_t WS_H = 1224 * MiB;
constexpr size_t WS_H2 = 1288 * MiB;
constexpr size_t WS_END = 1352 * MiB;
constexpr int CW_TMO = 0, CW_CODE = 1, CW_BAR = 4096;

constexpr int RING_OFF = 0, RING_BYTES = 131072;
constexpr int LDSCTL_OFF = RING_BYTES, MISC_OFF = LDSCTL_OFF + 320;
constexpr int LDS_BYTES = 147456;
constexpr int NWAVES = 8;

#define GAS __attribute__((address_space(1)))
#define LAS __attribute__((address_space(3)))
#define CAS __attribute__((address_space(4)))
typedef unsigned short bf16;
typedef unsigned v4u __attribute__((ext_vector_type(4)));
typedef unsigned v2u __attribute__((ext_vector_type(2)));
typedef float f32x4 __attribute__((ext_vector_type(4)));
typedef GAS unsigned gu32;
#define RLX_AGENT __ATOMIC_RELAXED, __HIP_MEMORY_SCOPE_AGENT
#define LDS_WAIT() asm volatile("s_waitcnt lgkmcnt(0)" ::: "memory")
__device__ __forceinline__ unsigned f2bf(float f) { unsigned u = __builtin_bit_cast(unsigned, f); return (u + 0x7fffu + ((u >> 16) & 1u)) >> 16; }
typedef float pk_f2 __attribute__((ext_vector_type(2)));
typedef __bf16 pk_b2 __attribute__((ext_vector_type(2)));
__device__ __forceinline__ unsigned pk2(float lo, float hi) { const pk_f2 v = {lo, hi}; return __builtin_bit_cast(unsigned, __builtin_convertvector(v, pk_b2)); }
__device__ __forceinline__ float bflo(unsigned w) { return __builtin_bit_cast(float, w << 16); }
__device__ __forceinline__ float bfhi(unsigned w) { return __builtin_bit_cast(float, w & 0xffff0000u); }
__device__ __forceinline__ float bf1(bf16 b) { return __builtin_bit_cast(float, (unsigned)b << 16); }
__device__ __forceinline__ float sigmoid_f(float x) { return __builtin_amdgcn_rcpf(1.0f + __builtin_amdgcn_exp2f(-1.4426950408889634f * x)); }
__device__ __forceinline__ float silu1(float x) { return x * sigmoid_f(x); }

#define XB_TMO      128
#define XB_XCNT(j)  (256  + 64 * (j))
#define XB_XSUB(j)  (1280 + 64 * (j))
#define XB_XGEN(j)  (2304 + 64 * (j))
#define XB_TOP      3328
#define XB_TOPGEN   3392
#define XCD_BAR_WORDS 3456
#define XB_SPIN_CAP (1u << 18)

__device__ __forceinline__ unsigned xb_ld(unsigned* p)              { return __hip_atomic_load(p, __ATOMIC_RELAXED, __HIP_MEMORY_SCOPE_AGENT); }
__device__ __forceinline__ unsigned xb_add(unsigned* p, unsigned v) { return __hip_atomic_fetch_add(p, v, __ATOMIC_RELAXED, __HIP_MEMORY_SCOPE_AGENT); }
__device__ __forceinline__ unsigned xb_xcc_id() { return (unsigned)__builtin_amdgcn_s_getreg((3 << 11) | 20) & 0xFu; }
#define XB_SPIN(cond, bar) do { unsigned _sp = 0; while (cond) { __builtin_amdgcn_s_sleep(1); \
    if ((++_sp & 255u) == 0u) { if (xb_ld(&(bar)[XB_TMO])) break; if (_sp > XB_SPIN_CAP) { atomicAdd(&(bar)[XB_TMO], 1u); break; } } } } while (0)

struct XcdBarrier { unsigned* bar; unsigned x; volatile LAS unsigned* st; };
#define XB_TID() ((int)__builtin_amdgcn_mbcnt_hi(~0u, __builtin_amdgcn_mbcnt_lo(~0u, 0u)) + 64 * xb_wave_id)

__device__ __forceinline__ XcdBarrier xcd_barrier_post(unsigned* bar, volatile LAS unsigned* st, const int xb_wave_id) {
    XcdBarrier b; b.bar = bar; b.x = xb_xcc_id(); b.st = st;
    if (XB_TID() == 0) (void)xb_add(&bar[XB_XCNT(b.x)], 1u);
    return b;
}
__device__ __forceinline__ void xcd_barrier_complete(unsigned* bar, unsigned x, unsigned& nloc, unsigned& nx) {
    const unsigned G = gridDim.x * gridDim.y * gridDim.z;
    unsigned sum, cnt, mine, sp = 0u;
    for (;;) {
        sum = 0u; cnt = 0u; mine = 0u;
#pragma unroll
        for (unsigned j = 0; j < 16; ++j) { const unsigned c = xb_ld(&bar[XB_XCNT(j)]); sum += c; cnt += (c > 0u) ? 1u : 0u; mine = (j == x) ? c : mine; }
        if (sum == G) break;
        __builtin_amdgcn_s_sleep(1);
        if ((++sp & 255u) == 0u) { if (xb_ld(&bar[XB_TMO])) break; if (sp > XB_SPIN_CAP) { atomicAdd(&bar[XB_TMO], 1u); break; } }
    }
    nloc = mine > 0u ? mine : 1u; nx = cnt > 0u ? cnt : 1u;
}
__device__ __forceinline__ void xcd_barrier(const XcdBarrier& b, const int xb_wave_id) {
    asm volatile("s_waitcnt vmcnt(0)" ::: "memory");
    __syncthreads();
    if (XB_TID() == 0) {
        unsigned* bar = b.bar;
        __builtin_amdgcn_s_waitcnt(0);
        unsigned nloc = b.st[0], nx = b.st[1];
        if (nloc == 0u) { xcd_barrier_complete(bar, b.x, nloc, nx); b.st[0] = nloc; b.st[1] = nx; }
        const unsigned old = xb_add(&bar[XB_XSUB(b.x)], 1u);
        const unsigned gen = old / nloc;
        if (old + 1u == (gen + 1u) * nloc) {
            __builtin_amdgcn_fence(__ATOMIC_RELEASE, "agent");
            asm volatile("s_waitcnt vmcnt(0)" ::: "memory");
            const unsigned og = xb_add(&bar[XB_TOP], 1u);
            const unsigned tg = og / nx;
            if (og + 1u == (tg + 1u) * nx) xb_add(&bar[XB_TOPGEN], 1u);
            else XB_SPIN(xb_ld(&bar[XB_TOPGEN]) == tg, bar);
            __builtin_amdgcn_fence(__ATOMIC_ACQUIRE, "agent");
            xb_add(&bar[XB_XGEN(b.x)], 1u);
            asm volatile("s_waitcnt vmcnt(0)" ::: "memory");
        } else {
            XB_SPIN(xb_ld(&bar[XB_XGEN(b.x)]) == gen, bar);
            __builtin_amdgcn_fence(__ATOMIC_ACQUIRE, "agent");
            asm volatile("s_waitcnt vmcnt(0)" ::: "memory");
        }
    }
    __syncthreads();
}

struct Args {
    const float* x; const float* c; const int* pos; const float* w_ada; const float* b_ada; const float* norm_mix_g; const float* norm_ffn_g;
    const float* pool_w; const float* pool_scale; const float* hgrn_w_in; const float* hgrn_lb; const float* hgrn_norm_g; const float* hgrn_w_out;
    const float* ret_w_in; const float* ret_norm_g; const float* ret_w_out; const float* ffn_w_in; const float* ffn_w_out; const float* final_g;
    float* out; unsigned char* ws; int ph_lo, ph_hi;
};

#define WS_DPP(v, ctrl) __builtin_bit_cast(float, __builtin_amdgcn_update_dpp(0, __builtin_bit_cast(int, v), (ctrl), 0xf, 0xf, true))
__device__ __forceinline__ float row16_sum(float v) { v += WS_DPP(v, 0xB1); v += WS_DPP(v, 0x4E); v += WS_DPP(v, 0x141); v += WS_DPP(v, 0x140); return v; }
#define WS_RL(v, l) __builtin_bit_cast(float, __builtin_amdgcn_readlane(__builtin_bit_cast(int, v), (l)))
__device__ __forceinline__ float wave_sum(float v) { v = row16_sum(v); return (WS_RL(v, 0) + WS_RL(v, 16)) + (WS_RL(v, 32) + WS_RL(v, 48)); }
__device__ __forceinline__ float half_sum(float v) {
    v = row16_sum(v); const float lo = WS_RL(v, 0) + WS_RL(v, 16), hi = WS_RL(v, 32) + WS_RL(v, 48);
    return (__builtin_amdgcn_mbcnt_hi(~0u, __builtin_amdgcn_mbcnt_lo(~0u, 0u)) < 32u) ? lo : hi; }

struct TItem { const float* W; bf16* WT; int K, N, mode, item; };
__device__ __forceinline__ void titem_load(const TItem& t, int lane, f32x4 (&wv)[8]) {
    const int nblk = t.N / 32, kb = t.item / nblk, nb = t.item % nblk, k0 = 64 * kb, n0 = 32 * nb;
#pragma unroll
    for (int i = 0; i < 8; ++i) wv[i] = *(const GAS f32x4*)(t.W + (size_t)(k0 + 8 * i + (lane >> 3)) * t.N + n0 + 4 * (lane & 7));
}
__device__ __forceinline__ void titem_finish(const TItem& t, LAS float* scr, int lane, const f32x4 (&wv)[8]) {
    const int nblk = t.N / 32, kb = t.item / nblk, nb = t.item % nblk, k0 = 64 * kb, n0 = 32 * nb;
    int d0 = n0;
    if (t.mode == 1) { const int bj = n0 >= FF ? 1 : 0, j = n0 - bj * FF; d0 = 256 * (j >> 7) + 128 * bj + (j & 127); }
    if (t.mode == 2 && n0 < 4096) { const int bj = n0 >> 11, j = n0 & 2047; d0 = 256 * (j >> 7) + 128 * bj + (j & 127); }
#pragma unroll
    for (int i = 0; i < 8; ++i) { LAS float* d = scr + (8 * i + (lane >> 3)) * 33 + 4 * (lane & 7); d[0] = wv[i].x; d[1] = wv[i].y; d[2] = wv[i].z; d[3] = wv[i].w; }
    LDS_WAIT(); asm volatile("" ::: "memory");
    const int c = lane & 7;
#pragma unroll
    for (int j = 0; j < 4; ++j) { const int n = (lane >> 3) + 8 * j; const LAS float* s = scr + (8 * c) * 33 + n;
        v4u o; o.x = pk2(s[0 * 33], s[1 * 33]); o.y = pk2(s[2 * 33], s[3 * 33]); o.z = pk2(s[4 * 33], s[5 * 33]); o.w = pk2(s[6 * 33], s[7 * 33]);
        if (t.mode == 3) { const int nn = d0 + n, kk = k0 + 8 * c;
            *(GAS v4u*)(t.WT + (size_t)((((nn >> 5) * 32 + (kk >> 4)) * 64) + ((kk >> 3) & 1) * 32 + (nn & 31)) * 8) = o; }
        else *(GAS v4u*)(t.WT + (size_t)(d0 + n) * t.K + k0 + 8 * c) = o; }
    LDS_WAIT(); asm volatile("" ::: "memory");
}
__device__ __forceinline__ void transpose_item(const float* W, int K, int N, bf16* WT, int mode, LAS float* scr, int item, int lane) {
    const TItem t{W, WT, K, N, mode, item}; f32x4 wv[8]; titem_load(t, lane, wv); titem_finish(t, scr, lane, wv);
}
struct WTile { const float* W; bf16* WT; int K, N, mode, idx; };
__device__ __forceinline__ void wtile_load(const WTile& t, int lane, int wave, f32x4 (&wv)[8]) {
    const int nblk = t.N >> 7, k0 = 128 * (t.idx / nblk), n0 = 128 * (t.idx % nblk);
#pragma unroll
    for (int i = 0; i < 8; ++i) wv[i] = *(const GAS f32x4*)(t.W + (size_t)(k0 + 16 * wave + 2 * i + (lane >> 5)) * t.N + n0 + 4 * (lane & 31));
}
__device__ __forceinline__ void wtile_to_lds(LAS unsigned char* T, int lane, int wave, const f32x4 (&wv)[8]) {
#pragma unroll
    for (int i = 0; i < 8; ++i) { const int r = 16 * wave + 2 * i + (lane >> 5); *(LAS f32x4*)(T + r * 512 + (((lane & 31) ^ ((r >> 3) & 7)) << 4)) = wv[i]; }
}
__device__ __forceinline__ void wtile_store(const WTile& t, const LAS unsigned char* T, int lane, int wave) {
    const int nblk = t.N >> 7, k0 = 128 * (t.idx / nblk), n0 = 128 * (t.idx % nblk);
    const int c = (lane & 7) + 8 * (lane >> 5), nl = (lane >> 3) & 3;
#pragma unroll
    for (int p = 0; p < 4; ++p) { const int nloc = 16 * wave + 4 * p + nl, n = n0 + nloc;
        const LAS float* s = (const LAS float*)(T + (8 * c) * 512 + (((nloc >> 2) ^ (lane & 7)) << 4) + (nloc & 3) * 4);
        v4u o; o.x = pk2(s[0 * 128], s[1 * 128]); o.y = pk2(s[2 * 128], s[3 * 128]); o.z = pk2(s[4 * 128], s[5 * 128]); o.w = pk2(s[6 * 128], s[7 * 128]);
        int d = n;
        if (t.mode == 1) { const int nb = n & ~31, bj = nb >= FF ? 1 : 0, j = nb - bj * FF; d = 256 * (j >> 7) + 128 * bj + (j & 127) + (n & 31); }
        if (t.mode == 2 && n < 4096) { const int nb = n & ~31, bj = nb >> 11, j = nb & 2047; d = 256 * (j >> 7) + 128 * bj + (j & 127) + (n & 31); }
        if (t.mode == 3) { const int kk = k0 + 8 * c;
            *(GAS v4u*)(t.WT + (size_t)((((n >> 5) * 32 + (kk >> 4)) * 64) + ((kk >> 3) & 1) * 32 + (n & 31)) * 8) = o; }
        else *(GAS v4u*)(t.WT + (size_t)d * t.K + k0 + 8 * c) = o; }
}
#define WT_BAR() do { asm volatile("s_waitcnt lgkmcnt(0)" ::: "memory"); __builtin_amdgcn_s_barrier(); asm volatile("" ::: "memory"); } while (0)
template <class AP> __device__ __forceinline__ void phase_prologue(const AP a, LAS unsigned char* lds, int tid, int lane, int wave, int vcu, int G) {
    unsigned char* ws = a->ws;
    float* ada = (float*)(ws + WS_ADA);
    LAS float* sc = (LAS float*)lds;
    LAS float* red = (LAS float*)(lds + 32768);
    for (int i = tid; i < NB * DM; i += 512) sc[i] = silu1(a->c[i]);
    __syncthreads();
    for (int it = vcu; it < DEPTH * (ADA_W / 256); it += G) {
        const int l = it / (ADA_W / 256), cb = it % (ADA_W / 256), e0 = cb * 256 + 4 * lane;
        const float* wp = a->w_ada + ((size_t)l * DM + (size_t)wave * 256) * ADA_W + e0;
        f32x4 acc[4];
#pragma unroll
        for (int b = 0; b < 4; ++b) acc[b] = (f32x4){0.f, 0.f, 0.f, 0.f};
#pragma unroll 16
        for (int d = 0; d < 256; ++d) {
            const f32x4 wv = *(const GAS f32x4*)(wp + (size_t)d * ADA_W);
#pragma unroll
            for (int b = 0; b < 4; ++b) { const float s = sc[b * DM + wave * 256 + d]; acc[b] = acc[b] + wv * s; }
        }
#pragma unroll
        for (int b = 0; b < 4; ++b) *(LAS f32x4*)(red + (wave * 4 + b) * 256 + 4 * lane) = acc[b];
        __syncthreads();
        for (int o = tid; o < 4 * 256; o += 512) { const int b = o >> 8, e = o & 255; float s = 0.f;
#pragma unroll
            for (int w = 0; w < 8; ++w) s += red[(w * 4 + b) * 256 + e];
            ada[((size_t)l * NB + b) * ADA_W + cb * 256 + e] = s + a->b_ada[(size_t)l * ADA_W + cb * 256 + e]; }
        __syncthreads();
    }
    const int gw = vcu * NWAVES + wave, NGW = G * NWAVES, gt = gw * 64 + lane, NGT = NGW * 64;
    { float* lb = (float*)(ws + WS_LB);
      for (int col = gt; col < DM; col += NGT) { float z[DEPTH], mx = -1e30f;
#pragma unroll
          for (int j = 0; j < DEPTH; ++j) { z[j] = a->hgrn_lb[j * DM + col]; mx = fmaxf(mx, z[j]); }
          float s = 0.f, e1 = 0.f;
#pragma unroll
          for (int j = 0; j < DEPTH; ++j) { const float e = __expf(z[j] - mx); s += e; if (j == 1) e1 = e; }
          lb[col] = e1 / s; } }
    { float* ct = (float*)(ws + WS_ROT); float* st = ct + (size_t)M * 128;
      for (int i = gt; i < M * 128; i += NGT) { const int m = i >> 7, f = i & 127;
          const float inv = exp2f(-(float)f * (13.287712379549449f / 128.0f));
          const float ang = (float)a->pos[m] * inv;
          const double rev = (double)ang * 0.15915494309189535; const float fr = (float)(rev - floor(rev));
          ct[i] = __builtin_amdgcn_cosf(fr); st[i] = __builtin_amdgcn_sinf(fr); } }
    { constexpr int T_POOL = 8 * 16, T_HGI = (DM / 128) * (HG_IN / 128), T_FFI0 = (DM / 128) * (FF2 / 128), T_FFO0 = (FF / 128) * (DM / 128), NT = T_POOL + T_HGI + T_FFI0 + T_FFO0;
#define EARLY_TDEC(t_, it_) do { int r = (it_); \
        if (r < T_POOL) { const int mt = r / 16; t_ = WTile{a->pool_w + (size_t)mt * 512 * 512, (bf16*)(ws + WS_POOLW) + (size_t)mt * 512 * 512, 512, 512, 3, r % 16}; break; } r -= T_POOL; \
        if (r < T_HGI) { t_ = WTile{a->hgrn_w_in, (bf16*)(ws + WS_HGWIN), DM, HG_IN, 2, r}; break; } r -= T_HGI; \
        if (r < T_FFI0) { t_ = WTile{a->ffn_w_in, (bf16*)(ws + WS_FFWIN), DM, FF2, 1, r}; break; } r -= T_FFI0; \
        t_ = WTile{a->ffn_w_out, (bf16*)(ws + WS_FFWOUT), FF, DM, 0, r}; } while (0)
      const bool balc = (G == 256); const int NGVC = DEPTH * (ADA_W / 256);
      const int lgs = (balc && vcu >= NGVC) ? 2 : 0, NV = balc ? NGVC + (G - NGVC) * 4 : G, vb = balc ? (vcu < NGVC ? vcu : NGVC + (vcu - NGVC) * 4) : vcu;
#define QTILE(q) (vb + ((q) & ((1 << lgs) - 1)) + ((q) >> lgs) * NV)
      __syncthreads();
      if (QTILE(0) < NT) {
          WTile ta, tb, tn; f32x4 wa[8], wb[8];
          EARLY_TDEC(ta, QTILE(0)); wtile_load(ta, lane, wave, wa);
          tb = ta; if (QTILE(1) < NT) { EARLY_TDEC(tb, QTILE(1)); wtile_load(tb, lane, wave, wb); }
          for (int q = 0; QTILE(q) < NT; q += 2) {
              WT_BAR();
              wtile_to_lds(lds, lane, wave, wa);
              tn = ta; if (QTILE(q + 2) < NT) { EARLY_TDEC(tn, QTILE(q + 2)); wtile_load(tn, lane, wave, wa); }
              WT_BAR();
              wtile_store(ta, lds, lane, wave);
              ta = tn;
              if (QTILE(q + 1) >= NT) break;
              WT_BAR();
              wtile_to_lds(lds, lane, wave, wb);
              tn = tb; if (QTILE(q + 3) < NT) { EARLY_TDEC(tn, QTILE(q + 3)); wtile_load(tn, lane, wave, wb); }
              WT_BAR();
              wtile_store(tb, lds, lane, wave);
              tb = tn;
          }
          WT_BAR();
      }
#undef QTILE
#undef EARLY_TDEC
    }
    { const int l31 = lane & 31, h5 = lane >> 5;
      const __amdgpu_buffer_rsrc_t rsX = __builtin_amdgcn_make_buffer_rsrc((void*)a->x, (short)0, M * DM * 4, 0x00020000);
      const __amdgpu_buffer_rsrc_t rsC = __builtin_amdgcn_make_buffer_rsrc((void*)(ws + WS_H2), (short)0, M * DM * 2, 0x00020000);
      const bool bal = (G == 256); const int NGV = DEPTH * (ADA_W / 256);
      const int rpa = bal ? (vcu < NGV ? gw : NGV * NWAVES + (vcu - NGV) * NWAVES + wave) : gw, rps = bal ? (vcu < NGV ? M : (G - NGV) * NWAVES) : NGW;
      for (int rp = rpa; rp < M / 2; rp += rps) {
          const int row = 2 * rp + h5; const unsigned vo = (unsigned)row * (DM * 4) + (unsigned)l31 * 32u, vob = (unsigned)row * (DM * 2) + (unsigned)l31 * 16u;
          v4u q0[8], q1[8];
#pragma unroll
          for (int j = 0; j < 8; ++j) { q0[j] = __builtin_amdgcn_raw_buffer_load_b128(rsX, vo, (unsigned)j * 1024u, 0); q1[j] = __builtin_amdgcn_raw_buffer_load_b128(rsX, vo, (unsigned)j * 1024u + 16u, 0); }
          float ss = 0.f;
#pragma unroll
          for (int j = 0; j < 8; ++j) { const f32x4 p = __builtin_bit_cast(f32x4, q0[j]), c = __builtin_bit_cast(f32x4, q1[j]);
              ss += ((p.x * p.x + p.y * p.y) + (p.z * p.z + p.w * p.w)) + ((c.x * c.x + c.y * c.y) + (c.z * c.z + c.w * c.w));
              v4u o; o.x = pk2(p.x, p.y); o.y = pk2(p.z, p.w); o.z = pk2(c.x, c.y); o.w = pk2(c.z, c.w);
              __builtin_amdgcn_raw_buffer_store_b128(o, rsC, vob, (unsigned)j * 512u, 0); }
          ss = half_sum(ss);
          if (l31 == 0) ((float*)(ws + WS_XRS))[row] = 1.0f / sqrtf(ss * (1.0f / DM) + EPS);
      }
    }
}
template <class AP> __device__ __forceinline__ void phase_convert_late(const AP a, LAS unsigned char* lds, int lane, int wave, int gwc, int NGWC) {
    unsigned char* ws = a->ws;
    LAS float* scr = (LAS float*)(lds + wave * 16384);
    constexpr int I_HGO = (DM / 64) * (DM / 32), I_RTI = (DM / 64) * (RT_IN / 32), I_RTO = (RT_V / 64) * (DM / 32), I_FFI1 = (DM / 64) * (FF2 / 32), I_FFO1 = (FF / 64) * (DM / 32);
    constexpr int NITEMS = I_HGO + I_RTI + I_RTO + 3 * I_FFI1 + 3 * I_FFO1;
#define LATE_DECODE(t_, it_) do { int r = (it_); \
        if (r < I_HGO) { t_ = TItem{a->hgrn_w_out, (bf16*)(ws + WS_HGWOUT), DM, DM, 0, r}; break; } r -= I_HGO; \
        if (r < I_RTI) { t_ = TItem{a->ret_w_in, (bf16*)(ws + WS_RTWIN), DM, RT_IN, 0, r}; break; } r -= I_RTI; \
        if (r < I_RTO) { t_ = TItem{a->ret_w_out, (bf16*)(ws + WS_RTWOUT), RT_V, DM, 0, r}; break; } r -= I_RTO; \
        if (r < 3 * I_FFI1) { const int l = 1 + r / I_FFI1; t_ = TItem{a->ffn_w_in + (size_t)l * DM * FF2, (bf16*)(ws + WS_FFWIN) + (size_t)l * FF2 * DM, DM, FF2, 1, r % I_FFI1}; break; } r -= 3 * I_FFI1; \
        { const int l = 1 + r / I_FFO1; t_ = TItem{a->ffn_w_out + (size_t)l * FF * DM, (bf16*)(ws + WS_FFWOUT) + (size_t)l * DM * FF, FF, DM, 0, r % I_FFO1}; } } while (0)
    if (gwc >= NITEMS) return;
    TItem t0, t1, t2; f32x4 w0[8], w1[8], w2[8];
    LATE_DECODE(t0, gwc); titem_load(t0, lane, w0);
    t1 = t0; if (gwc + NGWC < NITEMS) { LATE_DECODE(t1, gwc + NGWC); titem_load(t1, lane, w1); }
    for (int it = gwc; it < NITEMS; it += 3 * NGWC) {
        if (it + 2 * NGWC < NITEMS) { LATE_DECODE(t2, it + 2 * NGWC); titem_load(t2, lane, w2); }
        __builtin_amdgcn_sched_barrier(0);
        titem_finish(t0, scr, lane, w0);
        if (it + NGWC >= NITEMS) break;
        if (it + 3 * NGWC < NITEMS) { LATE_DECODE(t0, it + 3 * NGWC); titem_load(t0, lane, w0); }
        __builtin_amdgcn_sched_barrier(0);
        titem_finish(t1, scr, lane, w1);
        if (it + 2 * NGWC >= NITEMS) break;
        if (it + 4 * NGWC < NITEMS) { LATE_DECODE(t1, it + 4 * NGWC); titem_load(t1, lane, w1); }
        __builtin_amdgcn_sched_barrier(0);
        titem_finish(t2, scr, lane, w2);
    }
#undef LATE_DECODE
}

template <class AP> __device__ __forceinline__ void phase_convert_late_tiles(const AP a, LAS unsigned char* lds, int lane, int wave, int wgc, int NWGC) {
    unsigned char* ws = a->ws;
    constexpr int T_HGO = (DM / 128) * (DM / 128), T_RTI = (DM / 128) * (RT_IN / 128), T_RTO = (RT_V / 128) * (DM / 128), T_FFI = (DM / 128) * (FF2 / 128), T_FFO = (FF / 128) * (DM / 128);
    constexpr int NT = T_HGO + T_RTI + T_RTO + 3 * T_FFI + 3 * T_FFO;
#define LATE_TDEC(t_, it_) do { int r = (it_); \
        if (r < T_HGO) { t_ = WTile{a->hgrn_w_out, (bf16*)(ws + WS_HGWOUT), DM, DM, 0, r}; break; } r -= T_HGO; \
        if (r < T_RTI) { t_ = WTile{a->ret_w_in, (bf16*)(ws + WS_RTWIN), DM, RT_IN, 0, r}; break; } r -= T_RTI; \
        if (r < T_RTO) { t_ = WTile{a->ret_w_out, (bf16*)(ws + WS_RTWOUT), RT_V, DM, 0, r}; break; } r -= T_RTO; \
        if (r < 3 * T_FFI) { const int l = 1 + r / T_FFI; t_ = WTile{a->ffn_w_in + (size_t)l * DM * FF2, (bf16*)(ws + WS_FFWIN) + (size_t)l * FF2 * DM, DM, FF2, 1, r % T_FFI}; break; } r -= 3 * T_FFI; \
        { const int l = 1 + r / T_FFO; t_ = WTile{a->ffn_w_out + (size_t)l * FF * DM, (bf16*)(ws + WS_FFWOUT) + (size_t)l * DM * FF, FF, DM, 0, r % T_FFO}; } } while (0)
    if (wgc >= NT) return;
    WTile tc, tn; f32x4 wv[8];
    LATE_TDEC(tc, wgc); wtile_load(tc, lane, wave, wv);
    for (int it = wgc; it < NT; it += NWGC) {
        WT_BAR();
        wtile_to_lds(lds, lane, wave, wv);
        const bool more = it + NWGC < NT;
        tn = tc; if (more) { LATE_TDEC(tn, it + NWGC); wtile_load(tn, lane, wave, wv); }
        WT_BAR();
        wtile_store(tc, lds, lane, wave);
        tc = tn;
    }
    WT_BAR();
#undef LATE_TDEC
}

__device__ __forceinline__ void phase_normmod(const float* hin, const float* g, const float* shift, const float* scale  , bf16* U, int gw, int NGW, int lane) {
    for (int r0 = gw * 8; r0 < M; r0 += NGW * 8) {
        const int b = r0 >> 12; const float* sh = shift + (size_t)b * ADA_W; const float* scp = scale + (size_t)b * ADA_W;
        f32x4 mul[8], add[8];
#pragma unroll
        for (int j = 0; j < 8; ++j) { const int col = 4 * lane + 256 * j; const f32x4 gv = *(const GAS f32x4*)(g + col), s = *(const GAS f32x4*)(scp + col); mul[j] = gv * (s + 1.0f); add[j] = *(const GAS f32x4*)(sh + col); }
        for (int rr = 0; rr < 8; ++rr) {
            const GAS f32x4* xr = (const GAS f32x4*)(hin + (size_t)(r0 + rr) * DM) + lane;
            f32x4 v[8]; float ss = 0.f;
#pragma unroll
            for (int j = 0; j < 8; ++j) { v[j] = xr[64 * j]; ss += (v[j].x * v[j].x + v[j].y * v[j].y) + (v[j].z * v[j].z + v[j].w * v[j].w); }
            const float rstd = 1.0f / sqrtf(wave_sum(ss) * (1.0f / DM) + EPS);
            GAS v2u* o8 = (GAS v2u*)(U + (size_t)(r0 + rr) * DM) + lane;
#pragma unroll
            for (int j = 0; j < 8; ++j) { const f32x4 y = v[j] * rstd * mul[j] + add[j]; v2u w; w.x = pk2(y.x, y.y); w.y = pk2(y.z, y.w); o8[64 * j] = w; }
        }
    }
}
__device__ __forceinline__ void phase_normmod_bf(const bf16* hin, const float* g, const float* shift, const float* scale  , bf16* U, int gw, int NGW, int lane) {
    for (int r0 = gw * 8; r0 < M; r0 += NGW * 8) {
        const int b = r0 >> 12; const float* sh = shift + (size_t)b * ADA_W; const float* scp = scale + (size_t)b * ADA_W;
        f32x4 mul[8], add[8];
#pragma unroll
        for (int j = 0; j < 8; ++j) { const int col = 8 * lane + 512 * (j >> 1) + 4 * (j & 1); const f32x4 gv = *(const GAS f32x4*)(g + col), s = *(const GAS f32x4*)(scp + col); mul[j] = gv * (s + 1.0f); add[j] = *(const GAS f32x4*)(sh + col); }
        for (int rr = 0; rr < 8; ++rr) {
            const GAS v4u* xr = (const GAS v4u*)(hin + (size_t)(r0 + rr) * DM) + lane;
            f32x4 v[8]; float ss = 0.f;
#pragma unroll
            for (int j = 0; j < 4; ++j) { const v4u q = xr[64 * j]; v[2 * j] = (f32x4){bflo(q.x), bfhi(q.x), bflo(q.y), bfhi(q.y)}; v[2 * j + 1] = (f32x4){bflo(q.z), bfhi(q.z), bflo(q.w), bfhi(q.w)}; }
#pragma unroll
            for (int j = 0; j < 8; ++j) ss += (v[j].x * v[j].x + v[j].y * v[j].y) + (v[j].z * v[j].z + v[j].w * v[j].w);
            const float rstd = 1.0f / sqrtf(wave_sum(ss) * (1.0f / DM) + EPS);
            GAS v4u* o16 = (GAS v4u*)(U + (size_t)(r0 + rr) * DM) + lane;
#pragma unroll
            for (int j = 0; j < 4; ++j) { const f32x4 y0 = v[2 * j] * rstd * mul[2 * j] + add[2 * j], y1 = v[2 * j + 1] * rstd * mul[2 * j + 1] + add[2 * j + 1];
                v4u w; w.x = pk2(y0.x, y0.y); w.y = pk2(y0.z, y0.w); w.z = pk2(y1.x, y1.y); w.w = pk2(y1.z, y1.w); o16[64 * j] = w; }
        }
    }
}
__device__ __forceinline__ void phase_finalnorm_bf(const bf16* hin, const float* g, float* out, int gw, int NGW, int lane) {
    for (int r0 = gw * 8; r0 < M; r0 += NGW * 8) {
        f32x4 mul[8];
#pragma unroll
        for (int j = 0; j < 8; ++j) mul[j] = *(const GAS f32x4*)(g + 8 * lane + 512 * (j >> 1) + 4 * (j & 1));
        for (int rr = 0; rr < 8; ++rr) {
            const GAS v4u* xr = (const GAS v4u*)(hin + (size_t)(r0 + rr) * DM) + lane;
            f32x4 v[8]; float ss = 0.f;
#pragma unroll
            for (int j = 0; j < 4; ++j) { const v4u q = xr[64 * j]; v[2 * j] = (f32x4){bflo(q.x), bfhi(q.x), bflo(q.y), bfhi(q.y)}; v[2 * j + 1] = (f32x4){bflo(q.z), bfhi(q.z), bflo(q.w), bfhi(q.w)}; }
#pragma unroll
            for (int j = 0; j < 8; ++j) ss += (v[j].x * v[j].x + v[j].y * v[j].y) + (v[j].z * v[j].z + v[j].w * v[j].w);
            const float rstd = 1.0f / sqrtf(wave_sum(ss) * (1.0f / DM) + EPS);
            float* orow = out + (size_t)(r0 + rr) * DM + 8 * lane;
#pragma unroll
            for (int j = 0; j < 8; ++j) *(GAS f32x4*)(orow + 512 * (j >> 1) + 4 * (j & 1)) = v[j] * rstd * mul[j];
        }
    }
}
__device__ __forceinline__ void phase_finalnorm(const float* hin, const float* g, float* out, int gw, int NGW, int lane) {
    for (int r0 = gw * 8; r0 < M; r0 += NGW * 8) {
        f32x4 mul[8];
#pragma unroll
        for (int j = 0; j < 8; ++j) mul[j] = *(const GAS f32x4*)(g + 4 * lane + 256 * j);
        for (int rr = 0; rr < 8; ++rr) {
            const GAS f32x4* xr = (const GAS f32x4*)(hin + (size_t)(r0 + rr) * DM) + lane;
            f32x4 v[8]; float ss = 0.f;
#pragma unroll
            for (int j = 0; j < 8; ++j) { v[j] = xr[64 * j]; ss += (v[j].x * v[j].x + v[j].y * v[j].y) + (v[j].z * v[j].z + v[j].w * v[j].w); }
            const float rstd = 1.0f / sqrtf(wave_sum(ss) * (1.0f / DM) + EPS);
            GAS f32x4* o = (GAS f32x4*)(out + (size_t)(r0 + rr) * DM) + lane;
#pragma unroll
            for (int j = 0; j < 8; ++j) o[64 * j] = v[j] * rstd * mul[j];
        }
    }
}
__device__ __forceinline__ void phase_pool(const bf16* U, bf16* Pb, int gw, int NGW, int lane) {
    for (int it = gw; it < (M / 32) * 4; it += NGW) {
        const int gi = it & 3, rw = it >> 2, w = 2 << gi, col = gi * 512 + lane * 8;
        for (int rr = 0; rr < 32; ++rr) {
            const int m = rw * 32 + rr, tpos = m & (SEQ - 1), cnt = (tpos + 1 < w) ? tpos + 1 : w;
            float acc[8];
#pragma unroll
            for (int e = 0; e < 8; ++e) acc[e] = 0.f;
            float cur[8];
            for (int j = 0; j < cnt; ++j) {
                const v4u q = *(const GAS v4u*)(U + (size_t)(m - j) * DM + col);
                const float f0 = bflo(q.x), f1 = bfhi(q.x), f2 = bflo(q.y), f3 = bfhi(q.y), f4 = bflo(q.z), f5 = bfhi(q.z), f6 = bflo(q.w), f7 = bfhi(q.w);
                if (j == 0) { cur[0] = f0; cur[1] = f1; cur[2] = f2; cur[3] = f3; cur[4] = f4; cur[5] = f5; cur[6] = f6; cur[7] = f7; }
                acc[0] += f0; acc[1] += f1; acc[2] += f2; acc[3] += f3; acc[4] += f4; acc[5] += f5; acc[6] += f6; acc[7] += f7;
            }
            const float inv = 1.0f / (float)cnt;
            v4u o; o.x = pk2(acc[0] * inv - cur[0], acc[1] * inv - cur[1]); o.y = pk2(acc[2] * inv - cur[2], acc[3] * inv - cur[3]);
            o.z = pk2(acc[4] * inv - cur[4], acc[5] * inv - cur[5]); o.w = pk2(acc[6] * inv - cur[6], acc[7] * inv - cur[7]);
            *(GAS v4u*)(Pb + (size_t)m * DM + col) = o;
        }
    }
}

__device__ __forceinline__ void phase_hgrn_scan_naive(const bf16* PROJ, const float* lbv, float* O, LAS unsigned char* lds, int tid, int vcu, int G) {
    LAS float* qs = (LAS float*)lds;
    LAS float* fs = qs + 16 * 128;
    LAS float* ks = fs + 16 * 128;
    LAS float* vs = ks + 16 * 128;
    const int v = tid >> 4, dg = tid & 15;
    for (int unit = vcu; unit < NB * HG_H * 4; unit += G) {
        const int b = unit >> 6, h = (unit >> 2) & 15, vsl = unit & 3;
        float S[8];
#pragma unroll
        for (int e = 0; e < 8; ++e) S[e] = 0.f;
        const int lt = tid >> 5, ld4 = (tid & 31) * 4;
        float lbl[4];
#pragma unroll
        for (int e = 0; e < 4; ++e) lbl[e] = lbv[h * 128 + ld4 + e];
        for (int ch = 0; ch < SEQ / 16; ++ch) {
            const size_t m0 = (size_t)b * SEQ + (size_t)ch * 16;
            { const bf16* row = PROJ + (m0 + lt) * HG_IN + h * 128 + ld4;
              const v2u qv = *(const GAS v2u*)row, zv = *(const GAS v2u*)(row + 2048);
              const float qf[4] = {bflo(qv.x), bfhi(qv.x), bflo(qv.y), bfhi(qv.y)}, zf[4] = {bflo(zv.x), bfhi(zv.x), bflo(zv.y), bfhi(zv.y)};
#pragma unroll
              for (int e = 0; e < 4; ++e) { const float sg = sigmoid_f(zf[e]), l = lbl[e]; qs[lt * 128 + ld4 + e] = qf[e]; fs[lt * 128 + ld4 + e] = l + (1.0f - l) * sg; ks[lt * 128 + ld4 + e] = (1.0f - l) * (1.0f - sg); }
              vs[tid] = bf1(PROJ[(m0 + (tid >> 5)) * HG_IN + 4096 + h * 128 + vsl * 32 + (tid & 31)]); }
            __syncthreads();
            for (int tt = 0; tt < 16; ++tt) {
                const float vv = vs[tt * 32 + v]; float acc = 0.f;
#pragma unroll
                for (int e = 0; e < 8; ++e) { const int d = dg * 8 + e; S[e] = fs[tt * 128 + d] * S[e] + ks[tt * 128 + d] * vv; acc += S[e] * qs[tt * 128 + d]; }
                acc += __shfl_xor(acc, 1); acc += __shfl_xor(acc, 2); acc += __shfl_xor(acc, 4); acc += __shfl_xor(acc, 8);
                if (dg == 0) O[(m0 + tt) * DM + h * 128 + vsl * 32 + v] = acc;
            }
            __syncthreads();
        }
    }
}
__device__ __forceinline__ void phase_hgrn_post(const bf16* O, const bf16* PROJ, const float* ng, bf16* Pb, int gw, int NGW, int lane) {
    for (int m = gw; m < M; m += NGW) {
        const GAS v2u* orow = (const GAS v2u*)(O + (size_t)m * DM) + lane;
        const GAS v2u* grow = (const GAS v2u*)(PROJ + (size_t)m * HG_IN + 6144) + lane;
        GAS v2u* prow = (GAS v2u*)(Pb + (size_t)m * DM) + lane;
#pragma unroll
        for (int j = 0; j < 8; ++j) {
            const v2u ob = orow[64 * j]; const f32x4 o = (f32x4){bflo(ob.x), bfhi(ob.x), bflo(ob.y), bfhi(ob.y)}; float ss = (o.x * o.x + o.y * o.y) + (o.z * o.z + o.w * o.w);
            ss = half_sum(ss);
            const float rstd = 1.0f / sqrtf(ss * (1.0f / 128.0f) + EPS);
            const v2u gq = grow[64 * j]; const f32x4 nv = *(const GAS f32x4*)(ng + 4 * lane + 256 * j);
            v2u w; w.x = pk2(o.x * rstd * nv.x * silu1(bflo(gq.x)), o.y * rstd * nv.y * silu1(bfhi(gq.x))); w.y = pk2(o.z * rstd * nv.z * silu1(bflo(gq.y)), o.w * rstd * nv.w * silu1(bfhi(gq.y)));
            prow[64 * j] = w;
        }
    }
}
__device__ __forceinline__ void phase_ret_scan_naive(const bf16* PROJ, const float* rot, float* O, LAS unsigned char* lds, int tid, int vcu, int G) {
    LAS float* qs = (LAS float*)lds;
    LAS float* ks = qs + 16 * 256;
    LAS float* vs = ks + 16 * 256;
    const float* ct = rot; const float* st = rot + (size_t)M * 128;
    const int v = tid >> 3, dg = tid & 7;
    for (int unit = vcu; unit < NB * RT_H * 8; unit += G) {
        const int b = unit >> 6, h = (unit >> 3) & 7, vsl = unit & 7;
        const float gamma = 1.0f - exp2f(-5.0f - (float)h);
        float S[32];
#pragma unroll
        for (int e = 0; e < 32; ++e) S[e] = 0.f;
        const int lt = tid >> 5, li = (tid & 31) * 4;
        for (int ch = 0; ch < SEQ / 16; ++ch) {
            const size_t m0 = (size_t)b * SEQ + (size_t)ch * 16;
            { const size_t m = m0 + lt; const bf16* row = PROJ + m * RT_IN + h * 256 + li;
              const v2u q1 = *(const GAS v2u*)row, q2 = *(const GAS v2u*)(row + 128), k1 = *(const GAS v2u*)(row + 2048), k2 = *(const GAS v2u*)(row + 2048 + 128);
              const f32x4 cv = *(const GAS f32x4*)(ct + m * 128 + li), sv = *(const GAS f32x4*)(st + m * 128 + li);
              const float a1[4] = {bflo(q1.x), bfhi(q1.x), bflo(q1.y), bfhi(q1.y)}, a2[4] = {bflo(q2.x), bfhi(q2.x), bflo(q2.y), bfhi(q2.y)};
              const float b1[4] = {bflo(k1.x), bfhi(k1.x), bflo(k1.y), bfhi(k1.y)}, b2[4] = {bflo(k2.x), bfhi(k2.x), bflo(k2.y), bfhi(k2.y)};
#pragma unroll
              for (int e = 0; e < 4; ++e) { const float cc = cv[e], sn = sv[e];
                  qs[lt * 256 + li + e] = a1[e] * cc - a2[e] * sn; qs[lt * 256 + 128 + li + e] = a1[e] * sn + a2[e] * cc;
                  ks[lt * 256 + li + e] = (b1[e] * cc - b2[e] * sn) * 0.0625f; ks[lt * 256 + 128 + li + e] = (b1[e] * sn + b2[e] * cc) * 0.0625f; }
#pragma unroll
              for (int r = 0; r < 2; ++r) { const int idx = tid + r * 512, tt = idx >> 6, vv = idx & 63; vs[idx] = bf1(PROJ[(m0 + tt) * RT_IN + 4096 + h * 512 + vsl * 64 + vv]); } }
            __syncthreads();
            for (int tt = 0; tt < 16; ++tt) {
                const float vv = vs[tt * 64 + v]; float acc = 0.f;
#pragma unroll
                for (int e = 0; e < 32; ++e) { const int d = dg * 32 + e; S[e] = gamma * S[e] + ks[tt * 256 + d] * vv; acc += S[e] * qs[tt * 256 + d]; }
                acc += __shfl_xor(acc, 1); acc += __shfl_xor(acc, 2); acc += __shfl_xor(acc, 4);
                if (dg == 0) O[(m0 + tt) * RT_V + h * 512 + vsl * 64 + v] = acc;
            }
            __syncthreads();
        }
    }
}
__device__ __forceinline__ void phase_ret_post(const bf16* O, const bf16* PROJ, const float* ng, bf16* Pb, int gw, int NGW, int lane) {
    for (int m = gw; m < M; m += NGW) {
        const GAS v2u* orow = (const GAS v2u*)(O + (size_t)m * RT_V) + lane;
        const GAS v2u* grow = (const GAS v2u*)(PROJ + (size_t)m * RT_IN + 8192) + lane;
        GAS v2u* prow = (GAS v2u*)(Pb + (size_t)m * RT_V) + lane;
#pragma unroll
        for (int hh = 0; hh < 8; ++hh) {
            const v2u ob0 = orow[64 * (2 * hh)], ob1 = orow[64 * (2 * hh + 1)]; const f32x4 o0 = (f32x4){bflo(ob0.x), bfhi(ob0.x), bflo(ob0.y), bfhi(ob0.y)}, o1 = (f32x4){bflo(ob1.x), bfhi(ob1.x), bflo(ob1.y), bfhi(ob1.y)};
            float ss = (o0.x * o0.x + o0.y * o0.y) + (o0.z * o0.z + o0.w * o0.w) + (o1.x * o1.x + o1.y * o1.y) + (o1.z * o1.z + o1.w * o1.w);
            const float rstd = 1.0f / sqrtf(wave_sum(ss) * (1.0f / 512.0f) + EPS);
#pragma unroll
            for (int r = 0; r < 2; ++r) { const int j = 2 * hh + r; const f32x4 o = r ? o1 : o0;
                const v2u gq = grow[64 * j]; const f32x4 nv = *(const GAS f32x4*)(ng + 4 * lane + 256 * j);
                v2u w; w.x = pk2(o.x * rstd * nv.x * silu1(bflo(gq.x)), o.y * rstd * nv.y * silu1(bfhi(gq.x))); w.y = pk2(o.z * rstd * nv.z * silu1(bflo(gq.y)), o.w * rstd * nv.w * silu1(bfhi(gq.y)));
                prow[64 * j] = w; }
        }
    }
}

typedef float f32x16 __attribute__((ext_vector_type(16)));
typedef short s16x4 __attribute__((ext_vector_type(4)));
typedef short s16x8 __attribute__((ext_vector_type(8)));
__device__ __forceinline__ unsigned off_b(unsigned row, unsigned ch) { return 256u * row + 16u * (ch ^ (((row & 3u) << 2) | ((row >> 2) & 3u))); }
__device__ __forceinline__ s16x8 tr_frag_b(LAS unsigned char* img, int lane, int c, int ks) {
    const unsigned h = lane >> 5, blk = (lane >> 4) & 1, q = (lane & 15) >> 2, p = lane & 3;
    const unsigned a0 = off_b(16 * ks + 8 * h + q, 4 * c + 2 * blk + (p >> 1)) + 8 * (p & 1), a1 = off_b(16 * ks + 8 * h + 4 + q, 4 * c + 2 * blk + (p >> 1)) + 8 * (p & 1);
    const s16x4 x = __builtin_amdgcn_ds_read_tr16_b64_v4i16((LAS s16x4*)(img + a0)), y = __builtin_amdgcn_ds_read_tr16_b64_v4i16((LAS s16x4*)(img + a1));
    return (s16x8){x[0], x[1], x[2], x[3], y[0], y[1], y[2], y[3]};
}
__device__ __forceinline__ unsigned trb_base(int lane, int c, int tt) {
    const unsigned h = lane >> 5, blk = (lane >> 4) & 1, q = (lane & 15) >> 2, p = lane & 3;
    return 256u * (8 * h + 4 * tt + q) + 16u * ((4 * c + 2 * blk + (p >> 1)) ^ ((q << 2) | ((2 * h + tt) & 3))) + 8 * (p & 1);
}
__device__ __forceinline__ s16x8 tr_frag_b2(LAS unsigned char* img, unsigned b0, unsigned b1, int ks) {
    const s16x4 x = __builtin_amdgcn_ds_read_tr16_b64_v4i16((LAS s16x4*)(img + b0 + 4096 * ks)), y = __builtin_amdgcn_ds_read_tr16_b64_v4i16((LAS s16x4*)(img + b1 + 4096 * ks));
    return (s16x8){x[0], x[1], x[2], x[3], y[0], y[1], y[2], y[3]};
}
__device__ __forceinline__ s16x8 tr_frag_plain(LAS unsigned char* img, int rs, int lane, int c, int ks) {
    const unsigned h = lane >> 5, blk = (lane >> 4) & 1, q = (lane & 15) >> 2, p = lane & 3;
    const unsigned a0 = (16 * ks + 8 * h + q) * rs + (32 * c + 16 * blk + 4 * p) * 2, a1 = a0 + 4 * rs;
    const s16x4 x = __builtin_amdgcn_ds_read_tr16_b64_v4i16((LAS s16x4*)(img + a0)), y = __builtin_amdgcn_ds_read_tr16_b64_v4i16((LAS s16x4*)(img + a1));
    return (s16x8){x[0], x[1], x[2], x[3], y[0], y[1], y[2], y[3]};
}
__device__ __forceinline__ f32x16 mfma32(s16x8 a, s16x8 b, f32x16 c) { return __builtin_amdgcn_mfma_f32_32x32x16_bf16(a, b, c, 0, 0, 0); }
__device__ __forceinline__ f32x16 zero16() { f32x16 z;
#pragma unroll
    for (int i = 0; i < 16; ++i) z[i] = 0.f; return z; }
__device__ __forceinline__ v4u scale_bf8(v4u q, float f) { v4u o; o.x = pk2(bflo(q.x) * f, bfhi(q.x) * f); o.y = pk2(bflo(q.y) * f, bfhi(q.y) * f); o.z = pk2(bflo(q.z) * f, bfhi(q.z) * f); o.w = pk2(bflo(q.w) * f, bfhi(q.w) * f); return o; }

__device__ __forceinline__ void phase_ret_scan(const bf16* PROJ, bf16* O, LAS unsigned char* lds, int tid, int vcu, int G) {
    constexpr int QN = 0, QRS = 528, KN = 33792, VV = KN + 32768, PI = VV + 16384, PRS = 144, ST = PI + 9216, SRS = 528, LDS_END = ST + 33792;
    static_assert(LDS_END <= RING_BYTES, "retention scan LDS map");
    const int lane = tid & 63, wave = __builtin_amdgcn_readfirstlane(tid >> 6);
    for (int unit = vcu; unit < NB * RT_H * 8; unit += G) {
        const int b = unit >> 6, h = (unit >> 3) & 7, vsl = unit & 7;
        const float lg = __log2f(1.0f - exp2f(-5.0f - (float)h));
        const float g64 = exp2f(64.0f * lg);
        f32x16 S[2][2];
#pragma unroll
        for (int a = 0; a < 2; ++a)
#pragma unroll
            for (int c = 0; c < 2; ++c) S[a][c] = zero16();
        for (int i = tid; i < 33792 / 16; i += 512) *(LAS v4u*)(lds + ST + i * 16) = (v4u){0u, 0u, 0u, 0u};
        v4u pq[4], pk[4], pv;
        const __amdgpu_buffer_rsrc_t rsP = __builtin_amdgcn_make_buffer_rsrc((void*)(PROJ + (size_t)b * SEQ * RT_IN), (short)0, SEQ * RT_IN * 2, 0x00020000);
        const __amdgpu_buffer_rsrc_t rsO = __builtin_amdgcn_make_buffer_rsrc((void*)(O + (size_t)b * SEQ * RT_V), (short)0, SEQ * RT_V * 2, 0x00020000);
        const int vrow = tid >> 3, vch = tid & 7;
        const unsigned voq = (unsigned)((tid >> 5) * RT_IN + (tid & 31) * 8) * 2u, vov = (unsigned)(vrow * RT_IN + vch * 8) * 2u;
        const unsigned soq = (unsigned)(h * 256) * 2u, sok = (unsigned)(2048 + h * 256) * 2u, sov = (unsigned)(4096 + h * 512 + vsl * 64) * 2u;
#define RS_PREFETCH(chn) do { const unsigned cb_ = (unsigned)(chn) * 64u * RT_IN * 2u; _Pragma("unroll") for (int i = 0; i < 4; ++i) { \
            pq[i] = __builtin_amdgcn_raw_buffer_load_b128(rsP, voq, cb_ + (unsigned)i * 16u * RT_IN * 2u + soq, 0); pk[i] = __builtin_amdgcn_raw_buffer_load_b128(rsP, voq, cb_ + (unsigned)i * 16u * RT_IN * 2u + sok, 0); } \
            pv = __builtin_amdgcn_raw_buffer_load_b128(rsP, vov, cb_ + sov, 0); } while (0)
        RS_PREFETCH(0);
        float dec[16];
        { const int a31 = lane & 31, a5 = lane >> 5, w4 = wave & 3, t_i = w4 >> 1, x_i = w4 & 1;
#pragma unroll
          for (int r = 0; r < 16; ++r) {
              if (wave < 4) { const int t = 32 * x_i + a31, s = 32 * t_i + 8 * (r >> 2) + 4 * a5 + (r & 3); dec[r] = (s <= t) ? __builtin_amdgcn_exp2f((float)(t - s) * lg) : 0.f; }
              else { const int t = 32 * t_i + (r & 3) + 8 * (r >> 2) + 4 * a5; dec[r] = __builtin_amdgcn_exp2f((float)(t + 1) * lg); } } }
        unsigned opk[8];
#pragma unroll
        for (int i = 0; i < 8; ++i) opk[i] = 0u;
        for (int ch = 0; ch < SEQ / 64; ++ch) {
#pragma unroll
            for (int i = 0; i < 4; ++i) { const int cid = tid + 512 * i, row = cid >> 5, chq = cid & 31;
                *(LAS v4u*)(lds + QN + row * QRS + chq * 16) = pq[i];
                *(LAS v4u*)(lds + KN + (chq >> 4) * 16384 + off_b(row, chq & 15)) = pk[i]; }
            *(LAS v4u*)(lds + VV + off_b(vrow, vch)) = pv;
            *(LAS v4u*)(lds + VV + off_b(vrow, 8 + vch)) = scale_bf8(pv, __builtin_amdgcn_exp2f((float)(63 - vrow) * lg));
            __syncthreads();
#define RS_STORE_O(chs) do { if (wave >= 4) { const int w4s = wave & 3, tis = w4s >> 1, vis = w4s & 1; const int lnS = lane; \
                const unsigned voo = (unsigned)(4 * (lnS >> 5) * RT_V + h * 512 + vsl * 64 + 32 * vis + (lnS & 31)) * 2u; \
                _Pragma("unroll") for (int r = 0; r < 16; ++r) { const unsigned pr_ = opk[r >> 1]; \
                    __builtin_amdgcn_raw_buffer_store_b16((unsigned short)((r & 1) ? (pr_ >> 16) : (pr_ & 0xffffu)), rsO, voo, (unsigned)((chs) * 64 + 32 * tis + (r & 3) + 8 * (r >> 2)) * RT_V * 2u, 0); } } } while (0)
            if (ch > 0) RS_STORE_O(ch - 1);
            if (ch + 1 < SEQ / 64) RS_PREFETCH(ch + 1);
            f32x16 acc = zero16();
            int lnA = lane; asm volatile("" : "+v"(lnA));
            const int a31 = lnA & 31, a5 = lnA >> 5;
            const int w4 = wave & 3, t_i = w4 >> 1, x_i = w4 & 1;
            s16x8 fa0[4], fb0[4], fa1[4], fb1[4];
            if (wave < 4) {
                const int si = t_i, ti = x_i;
#define RS_LD1A(fa, fb, g4) do { _Pragma("unroll") for (int j = 0; j < 2; ++j) { const int ks = 2 * (g4) + j; \
                    fa[j] = *(const LAS s16x8*)(lds + KN + (ks >> 3) * 16384 + off_b(32 * si + a31, 2 * (ks & 7) + a5)); \
                    fb[j] = *(const LAS s16x8*)(lds + QN + (32 * ti + a31) * QRS + (16 * ks + 8 * a5) * 2); } } while (0)
#define RS_MMA4(fa, fb) do { _Pragma("unroll") for (int j = 0; j < 4; ++j) acc = mfma32(fa[j], fb[j], acc); } while (0)
#define RS_MMA2(fa, fb) do { _Pragma("unroll") for (int j = 0; j < 2; ++j) acc = mfma32(fa[j], fb[j], acc); } while (0)
                RS_LD1A(fa0, fb0, 0); RS_LD1A(fa1, fb1, 1);
#pragma unroll
                for (int g2 = 0; g2 < 3; ++g2) { RS_MMA2(fa0, fb0); RS_LD1A(fa0, fb0, 2 * g2 + 2); RS_MMA2(fa1, fb1); RS_LD1A(fa1, fb1, 2 * g2 + 3); }
                RS_MMA2(fa0, fb0); RS_MMA2(fa1, fb1);
#undef RS_LD1A
                const int t = 32 * ti + a31;
#pragma unroll
                for (int g = 0; g < 4; ++g) { float pvv[4];
#pragma unroll
                    for (int e = 0; e < 4; ++e) pvv[e] = acc[4 * g + e] * dec[4 * g + e];
                    v2u w; w.x = pk2(pvv[0], pvv[1]); w.y = pk2(pvv[2], pvv[3]);
                    *(LAS v2u*)(lds + PI + t * PRS + (32 * si + 8 * g + 4 * a5) * 2) = w; }
            } else {
                const int ti = t_i, vi = x_i;
#define RS_LD1B(fa, fb, g4) do { _Pragma("unroll") for (int j = 0; j < 2; ++j) { const int ks = 2 * (g4) + j; \
                    fa[j] = *(const LAS s16x8*)(lds + QN + (32 * ti + a31) * QRS + (16 * ks + 8 * a5) * 2); \
                    fb[j] = *(const LAS s16x8*)(lds + ST + (32 * vi + a31) * SRS + (16 * ks + 8 * a5) * 2); } } while (0)
                RS_LD1B(fa0, fb0, 0); RS_LD1B(fa1, fb1, 1);
#pragma unroll
                for (int g2 = 0; g2 < 3; ++g2) { RS_MMA2(fa0, fb0); RS_LD1B(fa0, fb0, 2 * g2 + 2); RS_MMA2(fa1, fb1); RS_LD1B(fa1, fb1, 2 * g2 + 3); }
                RS_MMA2(fa0, fb0); RS_MMA2(fa1, fb1);
#undef RS_LD1B
#pragma unroll
                for (int r = 0; r < 16; ++r) acc[r] *= dec[r];
            }
            __syncthreads();
            if (wave < 4) {
                LAS unsigned char* kimg0 = lds + KN + ((2 * wave) >> 2) * 16384; LAS unsigned char* kimg1 = lds + KN + ((2 * wave + 1) >> 2) * 16384;
                const unsigned ka0 = trb_base(lnA, (2 * wave) & 3, 0), ka1 = trb_base(lnA, (2 * wave) & 3, 1), kb0 = trb_base(lnA, (2 * wave + 1) & 3, 0), kb1 = trb_base(lnA, (2 * wave + 1) & 3, 1);
                const unsigned va0 = trb_base(lnA, 2, 0), va1 = trb_base(lnA, 2, 1), vb0 = trb_base(lnA, 3, 0), vb1 = trb_base(lnA, 3, 1);
#define RS_LD2A(g2) do { _Pragma("unroll") for (int j = 0; j < 2; ++j) { const int ks = 2 * (g2) + j; fa0[j] = tr_frag_b2(kimg0, ka0, ka1, ks); fa1[j] = tr_frag_b2(kimg1, kb0, kb1, ks); fb0[j] = tr_frag_b2(lds + VV, va0, va1, ks); fb1[j] = tr_frag_b2(lds + VV, vb0, vb1, ks); } } while (0)
#define RS_MMA2A() do { _Pragma("unroll") for (int j = 0; j < 2; ++j) { S[0][0] = mfma32(fa0[j], fb0[j], S[0][0]); S[0][1] = mfma32(fa0[j], fb1[j], S[0][1]); S[1][0] = mfma32(fa1[j], fb0[j], S[1][0]); S[1][1] = mfma32(fa1[j], fb1[j], S[1][1]); } } while (0)
                RS_LD2A(0);
#pragma unroll
                for (int a = 0; a < 2; ++a)
#pragma unroll
                    for (int c = 0; c < 2; ++c)
#pragma unroll
                        for (int r = 0; r < 16; ++r) S[a][c][r] *= g64;
                RS_MMA2A(); RS_LD2A(1); RS_MMA2A();
#undef RS_LD2A
#undef RS_MMA2A
#pragma unroll
                for (int a = 0; a < 2; ++a)
#pragma unroll
                    for (int c = 0; c < 2; ++c)
#pragma unroll
                        for (int g = 0; g < 4; ++g) { const int d = 32 * (2 * wave + a) + 8 * g + 4 * a5, v = 32 * c + a31;
                            v2u w; w.x = pk2(S[a][c][4 * g], S[a][c][4 * g + 1]); w.y = pk2(S[a][c][4 * g + 2], S[a][c][4 * g + 3]);
                            *(LAS v2u*)(lds + ST + v * SRS + d * 2) = w; }
            } else {
                const int ti = t_i, vi = x_i;
#pragma unroll
                for (int ks = 0; ks < 4; ++ks) { fa0[ks] = *(const LAS s16x8*)(lds + PI + (32 * ti + a31) * PRS + (16 * ks + 8 * a5) * 2); fb0[ks] = tr_frag_b2(lds + VV, trb_base(lnA, vi, 0), trb_base(lnA, vi, 1), ks); }
                RS_MMA4(fa0, fb0);
#pragma unroll
                for (int i = 0; i < 8; ++i) { const float o0_ = acc[2 * i], o1_ = acc[2 * i + 1]; opk[i] = pk2(o0_, o1_); }
            }
#undef RS_MMA4
#undef RS_PREFETCH_DUMMY
#undef RS_MMA2
            __syncthreads();
        }
        RS_STORE_O(SEQ / 64 - 1);
#undef RS_STORE_O
#undef RS_PREFETCH
    }
}

__device__ __forceinline__ void phase_hgrn_pre(const bf16* PROJ, const float* lbv, bf16* QD, bf16* KI, bf16* KE, float* DEC, int gt, int NGT) {
    for (int it = gt; it < (M / 32) * 256; it += NGT) {
        const int chunk = it >> 8, col = (it & 255) * 8; const size_t m0 = (size_t)chunk * 32;
        float lb[8], tot[8], cum[8];
        { const f32x4 l0 = *(const GAS f32x4*)(lbv + col), l1 = *(const GAS f32x4*)(lbv + col + 4);
#pragma unroll
          for (int e = 0; e < 4; ++e) { lb[e] = l0[e]; lb[4 + e] = l1[e]; } }
#pragma unroll
        for (int e = 0; e < 8; ++e) { tot[e] = 1.f; cum[e] = 1.f; }
#pragma unroll 4
        for (int t = 0; t < 32; ++t) { const v4u zz = *(const GAS v4u*)(PROJ + (m0 + t) * HG_IN + 2048 + col);
            const float z[8] = {bflo(zz.x), bfhi(zz.x), bflo(zz.y), bfhi(zz.y), bflo(zz.z), bfhi(zz.z), bflo(zz.w), bfhi(zz.w)};
#pragma unroll
            for (int e = 0; e < 8; ++e) tot[e] *= lb[e] + (1.0f - lb[e]) * sigmoid_f(z[e]); }
#pragma unroll 2
        for (int t = 0; t < 32; ++t) { const size_t m = m0 + t;
            const v4u zz = *(const GAS v4u*)(PROJ + m * HG_IN + 2048 + col), qq = *(const GAS v4u*)(PROJ + m * HG_IN + col);
            const float z[8] = {bflo(zz.x), bfhi(zz.x), bflo(zz.y), bfhi(zz.y), bflo(zz.z), bfhi(zz.z), bflo(zz.w), bfhi(zz.w)};
            const float q[8] = {bflo(qq.x), bfhi(qq.x), bflo(qq.y), bfhi(qq.y), bflo(qq.z), bfhi(qq.z), bflo(qq.w), bfhi(qq.w)};
            float qd[8], ki[8], ke[8];
#pragma unroll
            for (int e = 0; e < 8; ++e) { const float sg = sigmoid_f(z[e]); cum[e] *= lb[e] + (1.0f - lb[e]) * sg; const float kk = (1.0f - lb[e]) * (1.0f - sg);
                qd[e] = q[e] * cum[e]; ki[e] = kk * __builtin_amdgcn_rcpf(cum[e]); ke[e] = ki[e] * tot[e]; }
            v4u o; o.x = pk2(qd[0], qd[1]); o.y = pk2(qd[2], qd[3]); o.z = pk2(qd[4], qd[5]); o.w = pk2(qd[6], qd[7]); *(GAS v4u*)(QD + m * DM + col) = o;
            o.x = pk2(ki[0], ki[1]); o.y = pk2(ki[2], ki[3]); o.z = pk2(ki[4], ki[5]); o.w = pk2(ki[6], ki[7]); *(GAS v4u*)(KI + m * DM + col) = o;
            o.x = pk2(ke[0], ke[1]); o.y = pk2(ke[2], ke[3]); o.z = pk2(ke[4], ke[5]); o.w = pk2(ke[6], ke[7]); *(GAS v4u*)(KE + m * DM + col) = o; }
        f32x4 d0, d1;
#pragma unroll
        for (int e = 0; e < 4; ++e) { d0[e] = tot[e]; d1[e] = tot[4 + e]; }
        *(GAS f32x4*)(DEC + (size_t)chunk * DM + col) = d0; *(GAS f32x4*)(DEC + (size_t)chunk * DM + col + 4) = d1;
    }
}
__device__ __forceinline__ void phase_hgrn_scan(const bf16* HV, const bf16* QD, const bf16* KI, const bf16* KE, const float* DEC, bf16* Ob, LAS unsigned char* lds, int tid, int u0, int ustride) {
    constexpr int RS = 272, PRS = 80, VRS = 128, SET = 30208;
    constexpr int QI = 0, KII = 8704, KEI = 17408, VI = 25600, DCI = 29696, PI = 2 * SET, ST = PI + 2560, LDS_END = ST + 2 * 8704;
    static_assert(LDS_END <= RING_BYTES, "hgrn scan LDS map");
    const int lane = tid & 63, wave = __builtin_amdgcn_readfirstlane(tid >> 6), l31 = lane & 31, h5 = lane >> 5;
    const int vt = (wave >> 1) & 1;
    for (int unit = u0; unit < NB * HG_H * 2; unit += ustride) {
        const int b = unit >> 5, h = (unit >> 1) & 15, vp = unit & 1;
        f32x16 S0 = zero16(), S1 = zero16();
        for (int i = tid; i < 2 * 8704 / 16; i += 512) *(LAS v4u*)(lds + ST + i * 16) = (v4u){0u, 0u, 0u, 0u};
        const int row = tid >> 4, c16 = tid & 15;
        const size_t mb = (size_t)b * SEQ;
        v4u q0, ki0, ke0, x0 = (v4u){0u, 0u, 0u, 0u}, q1, ki1, ke1, x1 = (v4u){0u, 0u, 0u, 0u};
        unsigned opk[8];
#pragma unroll
        for (int i = 0; i < 8; ++i) opk[i] = 0u;
#define HS_CLAMP(c_) ((c_) < SEQ / 32 ? (c_) : SEQ / 32 - 1)
#define HS_LOAD(pq_, pki_, pke_, px_, chn) do { const size_t hb_ = (size_t)(b * 16 + h) * SEQ + (size_t)(chn) * 32; \
            pq_ = *(const GAS v4u*)(QD + (hb_ + row) * 128 + c16 * 8); pki_ = *(const GAS v4u*)(KI + (hb_ + row) * 128 + c16 * 8); pke_ = *(const GAS v4u*)(KE + (hb_ + row) * 128 + c16 * 8); \
            if (tid < 256) px_ = *(const GAS v4u*)(HV + (hb_ + (tid >> 3)) * 128 + vp * 64 + (tid & 7) * 8); \
            else if (tid < 288) px_ = *(const GAS v4u*)(DEC + ((size_t)(b * 16 + h) * (SEQ / 32) + (chn)) * 128 + (tid - 256) * 4); } while (0)
#define HS_WRITE(IB, pq_, pki_, pke_, px_) do { \
            *(LAS v4u*)(lds + (IB) + QI + row * RS + c16 * 16) = pq_; *(LAS v4u*)(lds + (IB) + KII + row * RS + c16 * 16) = pki_; *(LAS v4u*)(lds + (IB) + KEI + off_b(row, c16)) = pke_; \
            if (tid < 256) *(LAS v4u*)(lds + (IB) + VI + (tid >> 3) * VRS + (tid & 7) * 16) = px_; \
            else if (tid < 288) *(LAS v4u*)(lds + (IB) + DCI + (tid - 256) * 16) = px_; } while (0)
#define HS_STORE_O(chs) do { if (wave == 4 || wave == 6) { bf16* op = Ob + (mb + (size_t)(chs) * 32) * DM + h * 128 + vp * 64 + vt * 32 + l31; \
            _Pragma("unroll") for (int r = 0; r < 16; ++r) { const int t = (r & 3) + 8 * (r >> 2) + 4 * h5; const unsigned pr_ = opk[r >> 1]; op[(size_t)t * DM] = (bf16)((r & 1) ? (pr_ >> 16) : (pr_ & 0xffffu)); } } } while (0)
#define HS_CHUNK(IB, NIB, nq_, nki_, nke_, nx_) do { \
            f32x16 acc = zero16(); \
            if (wave == 5) { \
                s16x8 fa[8], fb[8]; \
                _Pragma("unroll") for (int ks = 0; ks < 8; ++ks) { fa[ks] = *(const LAS s16x8*)(lds + (IB) + KII + l31 * RS + (16 * ks + 8 * h5) * 2); fb[ks] = *(const LAS s16x8*)(lds + (IB) + QI + l31 * RS + (16 * ks + 8 * h5) * 2); } \
                _Pragma("unroll") for (int ks = 0; ks < 8; ++ks) acc = mfma32(fa[ks], fb[ks], acc); \
                const int t = l31; \
                _Pragma("unroll") for (int g = 0; g < 4; ++g) { float pvv[4]; \
                    _Pragma("unroll") for (int e = 0; e < 4; ++e) { const int s = 8 * g + 4 * h5 + e; pvv[e] = (s <= t) ? acc[4 * g + e] : 0.f; } \
                    v2u w; w.x = pk2(pvv[0], pvv[1]); w.y = pk2(pvv[2], pvv[3]); \
                    *(LAS v2u*)(lds + PI + t * PRS + (8 * g + 4 * h5) * 2) = w; } \
            } else if (wave == 4 || wave == 6) { \
                s16x8 fa[8], fb[8]; \
                _Pragma("unroll") for (int ks = 0; ks < 8; ++ks) { fa[ks] = *(const LAS s16x8*)(lds + (IB) + QI + l31 * RS + (16 * ks + 8 * h5) * 2); fb[ks] = *(const LAS s16x8*)(lds + ST + vt * 8704 + l31 * RS + (16 * ks + 8 * h5) * 2); } \
                _Pragma("unroll") for (int ks = 0; ks < 8; ++ks) acc = mfma32(fa[ks], fb[ks], acc); \
            } \
            __syncthreads(); \
            if (wave < 4) { \
                _Pragma("unroll") for (int g = 0; g < 4; ++g) { const f32x4 dv = *(const LAS f32x4*)(lds + (IB) + DCI + (32 * wave + 8 * g + 4 * h5) * 4); \
                    _Pragma("unroll") for (int e = 0; e < 4; ++e) { S0[4 * g + e] *= dv[e]; S1[4 * g + e] *= dv[e]; } } \
                _Pragma("unroll") for (int ks = 0; ks < 2; ++ks) { const s16x8 af = tr_frag_b(lds + (IB) + KEI, lane, wave, ks); \
                    const s16x8 b0 = tr_frag_plain(lds + (IB) + VI, VRS, lane, 0, ks), b1 = tr_frag_plain(lds + (IB) + VI, VRS, lane, 1, ks); S0 = mfma32(af, b0, S0); S1 = mfma32(af, b1, S1); } \
                _Pragma("unroll") for (int g = 0; g < 4; ++g) { const int d = 32 * wave + 8 * g + 4 * h5; \
                    v2u w; w.x = pk2(S0[4 * g], S0[4 * g + 1]); w.y = pk2(S0[4 * g + 2], S0[4 * g + 3]); \
                    *(LAS v2u*)(lds + ST + l31 * RS + d * 2) = w; \
                    w.x = pk2(S1[4 * g], S1[4 * g + 1]); w.y = pk2(S1[4 * g + 2], S1[4 * g + 3]); \
                    *(LAS v2u*)(lds + ST + 8704 + l31 * RS + d * 2) = w; } \
            } else if (wave == 4 || wave == 6) { \
                _Pragma("unroll") for (int ks = 0; ks < 2; ++ks) { const s16x8 af = *(const LAS s16x8*)(lds + PI + l31 * PRS + (16 * ks + 8 * h5) * 2); const s16x8 bfr = tr_frag_plain(lds + (IB) + VI, VRS, lane, vt, ks); acc = mfma32(af, bfr, acc); } \
                _Pragma("unroll") for (int i = 0; i < 8; ++i) { const float o0_ = acc[2 * i], o1_ = acc[2 * i + 1]; opk[i] = pk2(o0_, o1_); } \
            } \
            HS_WRITE(NIB, nq_, nki_, nke_, nx_); \
            __syncthreads(); } while (0)
        HS_LOAD(q0, ki0, ke0, x0, 0); HS_LOAD(q1, ki1, ke1, x1, 1);
        HS_WRITE(0, q0, ki0, ke0, x0); HS_LOAD(q0, ki0, ke0, x0, 2);
        __syncthreads();
        for (int ch = 0; ch < SEQ / 32; ch += 2) {
            HS_CHUNK(0, SET, q1, ki1, ke1, x1);     HS_LOAD(q1, ki1, ke1, x1, HS_CLAMP(ch + 3)); HS_STORE_O(ch);
            HS_CHUNK(SET, 0, q0, ki0, ke0, x0);     HS_LOAD(q0, ki0, ke0, x0, HS_CLAMP(ch + 4)); HS_STORE_O(ch + 1);
        }
#undef HS_CLAMP
#undef HS_LOAD
#undef HS_WRITE
#undef HS_STORE_O
#undef HS_CHUNK
    }
}

template <bool XF32>
__device__ __forceinline__ void phase_poolmix(const void* hsrc  , const float* rsrow  , bf16* hout, const float* gnorm, const float* ada_l  ,
                                              const float* pscale, const bf16* Wt  ,
                                              const float* g2, const float* shift2, const float* scale2  , bf16* U2,
                                              LAS unsigned char* lds, int tid, int vcu, int G) {
    constexpr int PA = 0, WB = 65536, RSTD = RING_BYTES, ES = XF32 ? 4 : 2;
    const int lane = tid & 63, wave = __builtin_amdgcn_readfirstlane(tid >> 6), l31 = lane & 31, h5 = lane >> 5;
    LAS float* rstdL = (LAS float*)(lds + RSTD);
    LAS float* rowss = (LAS float*)(lds + RING_BYTES + 4096);
    const __amdgpu_buffer_rsrc_t rsH = __builtin_amdgcn_make_buffer_rsrc((void*)hsrc, (short)0, M * DM * ES, 0x00020000);
    const __amdgpu_buffer_rsrc_t rsO = __builtin_amdgcn_make_buffer_rsrc((void*)hout, (short)0, M * DM * 2, 0x00020000);
    const __amdgpu_buffer_rsrc_t rsW = __builtin_amdgcn_make_buffer_rsrc((void*)Wt, (short)0, 4 * 512 * 512 * 2, 0x00020000);
#define PM_OFFP(row, ch) ((row) * 1024 + 16 * ((ch) ^ ((row) & 15)))
#define PM_OFFW(n, ch) ((n) * 64 + 16 * ((ch) ^ (((n) >> 2) & 3)))
#define PM_LDH(voff, soff) __builtin_amdgcn_raw_buffer_load_b128(rsH, (voff), (soff), 0)
#define PM_UNPK(q_, f_) do { f_[0] = bflo(q_.x); f_[1] = bfhi(q_.x); f_[2] = bflo(q_.y); f_[3] = bfhi(q_.y); f_[4] = bflo(q_.z); f_[5] = bfhi(q_.z); f_[6] = bflo(q_.w); f_[7] = bfhi(q_.w); } while (0)
    for (int unit = vcu; unit < M / 64; unit += G) {
        const int r0 = unit * 64, b = r0 >> 12, tpos0 = r0 & (SEQ - 1), halo = tpos0 < 15 ? tpos0 : 15;
        const float* shp = ada_l + (size_t)b * ADA_W; const float* scp = shp + DM; const float* gtp = shp + 2 * DM;
        if (rsrow) { if (tid < 64 + halo) rstdL[tid + 15 - halo] = rsrow[r0 - halo + tid]; }
        else for (int rp = wave; 2 * rp < 64 + halo; rp += 2 * NWAVES) {
            int rrq[2]; float ssq[2]; v4u qq[2][XF32 ? 16 : 8];
#pragma unroll
            for (int z = 0; z < 2; ++z) { const int rr = 2 * (rp + NWAVES * z) + h5, rrc = rr < 64 + halo ? rr : 63 + halo, row = r0 - halo + rrc; rrq[z] = rr;
                const unsigned vo = (unsigned)row * (DM * ES) + (unsigned)l31 * 16u;
#pragma unroll
                for (int j = 0; j < (XF32 ? 16 : 8); ++j) qq[z][j] = PM_LDH(vo, (unsigned)j * 512u); }
#pragma unroll
            for (int z = 0; z < 2; ++z) { float ss = 0.f;
#pragma unroll
                for (int j = 0; j < (XF32 ? 16 : 8); ++j) { const v4u q = qq[z][j];
                    if constexpr (XF32) { const f32x4 v = __builtin_bit_cast(f32x4, q); ss += (v.x * v.x + v.y * v.y) + (v.z * v.z + v.w * v.w); }
                    else { float f[8]; PM_UNPK(q, f); ss += ((f[0] * f[0] + f[1] * f[1]) + (f[2] * f[2] + f[3] * f[3])) + ((f[4] * f[4] + f[5] * f[5]) + (f[6] * f[6] + f[7] * f[7])); } }
                ssq[z] = ss; }
#pragma unroll
            for (int z = 0; z < 2; ++z) { float ss = ssq[z];
                ss = half_sum(ss);
                const float rstd = 1.0f / sqrtf(ss * (1.0f / DM) + EPS);
                if (l31 == 0 && rrq[z] < 64 + halo) rstdL[rrq[z] + 15 - halo] = rstd; }
        }
        __syncthreads();
#pragma unroll 1
        for (int g = 0; g < 4; ++g) {
            const int w = 2 << g;
            const unsigned wvo = (unsigned)lane * 16u, wso = ((unsigned)g * 16u + 2u * (unsigned)wave) * (32u * 1024u);
            v4u wA[4], wB[4], wC[4];
            v4u hk[8];
#define PM_WLD(dst, kc_) do { _Pragma("unroll") for (int nt = 0; nt < 2; ++nt) _Pragma("unroll") for (int ks = 0; ks < 2; ++ks) \
                dst[nt * 2 + ks] = __builtin_amdgcn_raw_buffer_load_b128(rsW, wvo, wso + (unsigned)(nt * 32 + 2 * (kc_) + ks) * 1024u, 0); } while (0)
            PM_WLD(wA, 0); PM_WLD(wB, 1); PM_WLD(wC, 2);
            { const int oct = tid & 63, col = g * 512 + oct * 8; const unsigned hvo = (unsigned)col * ES;
              float gm[8], sh[8];
              { const f32x4 g0 = *(const GAS f32x4*)(gnorm + col), g1 = *(const GAS f32x4*)(gnorm + col + 4), s0 = *(const GAS f32x4*)(scp + col), s1 = *(const GAS f32x4*)(scp + col + 4);
                const f32x4 a0 = *(const GAS f32x4*)(shp + col), a1 = *(const GAS f32x4*)(shp + col + 4);
#pragma unroll
                for (int e = 0; e < 4; ++e) { gm[e] = g0[e] * (1.0f + s0[e]); gm[4 + e] = g1[e] * (1.0f + s1[e]); sh[e] = a0[e]; sh[4 + e] = a1[e]; } }
              LAS unsigned char* UT = lds + WB;
#pragma unroll
              for (int hf = 0; hf < 2; ++hf) {
                  const int rb = r0 - 15 + 32 * hf;
                  { v4u ha[6], hb2[6]; float rsv[6];
#pragma unroll
                      for (int k = 0; k < 6; ++k) { const int j = wave - 1 + 8 * k, row = rb + j, rowc = (j >= 0 && row >= r0 - halo) ? row : r0;
                          const unsigned so = (unsigned)rowc * (DM * ES);
                          ha[k] = PM_LDH(hvo, so); if constexpr (XF32) hb2[k] = PM_LDH(hvo, so + 16u); rsv[k] = rstdL[rowc - r0 + 15]; }
#pragma unroll
                      for (int k = 0; k < 6; ++k) { const int j = wave - 1 + 8 * k; const float rs_ = rsv[k]; float f[8];
                          if constexpr (XF32) { const f32x4 x0 = __builtin_bit_cast(f32x4, ha[k]), x1 = __builtin_bit_cast(f32x4, hb2[k]); f[0] = x0.x; f[1] = x0.y; f[2] = x0.z; f[3] = x0.w; f[4] = x1.x; f[5] = x1.y; f[6] = x1.z; f[7] = x1.w; }
                          else { PM_UNPK(ha[k], f); if (k >= 2) hk[4 * hf + k - 2] = ha[k]; }
                          v4u uq; uq.x = pk2(f[0] * rs_ * gm[0] + sh[0], f[1] * rs_ * gm[1] + sh[1]); uq.y = pk2(f[2] * rs_ * gm[2] + sh[2], f[3] * rs_ * gm[3] + sh[3]);
                          uq.z = pk2(f[4] * rs_ * gm[4] + sh[4], f[5] * rs_ * gm[5] + sh[5]); uq.w = pk2(f[6] * rs_ * gm[6] + sh[6], f[7] * rs_ * gm[7] + sh[7]);
                          if (j >= 0) *(LAS v4u*)(UT + j * 1024 + oct * 16) = uq; }
                  }
                  __syncthreads();
                  { const int il0 = 4 * wave, sl0 = il0 + 15, tp0 = tpos0 + 32 * hf + il0;
                    float S[8], uc[8];
#pragma unroll
                    for (int e = 0; e < 8; ++e) S[e] = 0.f;
                    { const int cnt = tp0 + 1 < w ? tp0 + 1 : w;
#define PM_WIN(J0, NJ) do { v4u qw[NJ]; \
                          _Pragma("unroll") for (int jj = 0; jj < NJ; ++jj) { const int sj = sl0 - (J0) - jj; qw[jj] = *(const LAS v4u*)(UT + (sj > 0 ? sj : 0) * 1024 + oct * 16); } \
                          _Pragma("unroll") for (int jj = 0; jj < NJ; ++jj) { float f[8]; PM_UNPK(qw[jj], f); const float m_ = (J0) + jj < cnt ? 1.0f : 0.0f; \
                              if ((J0) + jj == 0) { _Pragma("unroll") for (int e = 0; e < 8; ++e) uc[e] = f[e]; } \
                              _Pragma("unroll") for (int e = 0; e < 8; ++e) S[e] += m_ * f[e]; } } while (0)
                      PM_WIN(0, 4);
                      if (w > 4) { PM_WIN(4, 4); if (w > 8) PM_WIN(8, 8); }
#undef PM_WIN
                      const float inv = 1.0f / (float)cnt;
                      v4u o; o.x = pk2(S[0] * inv - uc[0], S[1] * inv - uc[1]); o.y = pk2(S[2] * inv - uc[2], S[3] * inv - uc[3]); o.z = pk2(S[4] * inv - uc[4], S[5] * inv - uc[5]); o.w = pk2(S[6] * inv - uc[6], S[7] * inv - uc[7]);
                      *(LAS v4u*)(lds + PA + PM_OFFP(32 * hf + il0, oct)) = o; }
#pragma unroll
                    for (int r = 1; r < 4; ++r) { const int tpr = tp0 + r, cnt = tpr + 1 < w ? tpr + 1 : w;
                        const v4u qn = *(const LAS v4u*)(UT + (sl0 + r) * 1024 + oct * 16), qo = *(const LAS v4u*)(UT + (sl0 + r - w) * 1024 + oct * 16);
                        float fn[8], fo[8]; PM_UNPK(qn, fn); PM_UNPK(qo, fo); const float m_ = tpr + 1 > w ? 1.0f : 0.0f;
#pragma unroll
                        for (int e = 0; e < 8; ++e) S[e] += fn[e] - m_ * fo[e];
                        const float inv = 1.0f / (float)cnt;
                        v4u o; o.x = pk2(S[0] * inv - fn[0], S[1] * inv - fn[1]); o.y = pk2(S[2] * inv - fn[2], S[3] * inv - fn[3]); o.z = pk2(S[4] * inv - fn[4], S[5] * inv - fn[5]); o.w = pk2(S[6] * inv - fn[6], S[7] * inv - fn[7]);
                        *(LAS v4u*)(lds + PA + PM_OFFP(32 * hf + il0 + r, oct)) = o; }
                  }
                  __syncthreads();
              }
            }
            f32x16 acc[2][2];
#pragma unroll
            for (int a = 0; a < 2; ++a)
#pragma unroll
                for (int c = 0; c < 2; ++c) acc[a][c] = zero16();
#define PM_CHUNK(kc, SET) do { \
                int la_ = lane; asm volatile("" : "+v"(la_)); const int l31_ = la_ & 31, h5_ = la_ >> 5; \
                s16x8 fb[2][2]; \
                _Pragma("unroll") for (int ks = 0; ks < 2; ++ks) _Pragma("unroll") for (int mt = 0; mt < 2; ++mt) fb[mt][ks] = *(const LAS s16x8*)(lds + PA + PM_OFFP(32 * mt + l31_, 4 * (kc) + 2 * ks + h5_)); \
                _Pragma("unroll") for (int ks = 0; ks < 2; ++ks) _Pragma("unroll") for (int nt = 0; nt < 2; ++nt) _Pragma("unroll") for (int mt = 0; mt < 2; ++mt) \
                    acc[nt][mt] = mfma32(__builtin_bit_cast(s16x8, SET[nt * 2 + ks]), fb[mt][ks], acc[nt][mt]); \
                if ((kc) + 3 < 16) PM_WLD(SET, (kc) + 3); } while (0)
            PM_CHUNK(0, wA); PM_CHUNK(1, wB); PM_CHUNK(2, wC); PM_CHUNK(3, wA); PM_CHUNK(4, wB); PM_CHUNK(5, wC); PM_CHUNK(6, wA); PM_CHUNK(7, wB);
            PM_CHUNK(8, wC); PM_CHUNK(9, wA); PM_CHUNK(10, wB); PM_CHUNK(11, wC); PM_CHUNK(12, wA); PM_CHUNK(13, wB); PM_CHUNK(14, wC); PM_CHUNK(15, wA);
#undef PM_CHUNK
#undef PM_WLD
            __syncthreads();
#pragma unroll
            for (int nt = 0; nt < 2; ++nt)
#pragma unroll
                for (int q = 0; q < 4; ++q)
#pragma unroll
                    for (int mt = 0; mt < 2; ++mt) { const int n = 32 * (2 * wave + nt) + 8 * q + 4 * h5, m = 32 * mt + l31;
                        const float y0 = acc[nt][mt][4 * q], y1 = acc[nt][mt][4 * q + 1], y2 = acc[nt][mt][4 * q + 2], y3 = acc[nt][mt][4 * q + 3];
                        v2u o; o.x = pk2(y0, y1); o.y = pk2(y2, y3);
                        *(LAS v2u*)(lds + PA + m * 1040 + n * 2) = o; }
            __syncthreads();
            { const int ch = tid & 63, col = g * 512 + ch * 8; const unsigned hvo = (unsigned)col * ES, ovo = (unsigned)col * 2u;
              const f32x4 gv0 = *(const GAS f32x4*)(gtp + col) * *(const GAS f32x4*)(pscale + col), gv1 = *(const GAS f32x4*)(gtp + col + 4) * *(const GAS f32x4*)(pscale + col + 4);
              if constexpr (XF32) {
#pragma unroll
                  for (int kb = 0; kb < 8; kb += 4) {
                      v4u ha[4], hb2[4];
#pragma unroll
                      for (int k = 0; k < 4; ++k) { const unsigned so = (unsigned)(r0 + wave + 8 * (kb + k)) * (DM * ES); ha[k] = PM_LDH(hvo, so); hb2[k] = PM_LDH(hvo, so + 16u); }
#pragma unroll
                      for (int k = 0; k < 4; ++k) { const int m = wave + 8 * (kb + k); float f[8], y[8];
                          const f32x4 x0 = __builtin_bit_cast(f32x4, ha[k]), x1 = __builtin_bit_cast(f32x4, hb2[k]); f[0] = x0.x; f[1] = x0.y; f[2] = x0.z; f[3] = x0.w; f[4] = x1.x; f[5] = x1.y; f[6] = x1.z; f[7] = x1.w;
                          const v4u yq = *(const LAS v4u*)(lds + PA + m * 1040 + ch * 16); PM_UNPK(yq, y);
                          v4u o; o.x = pk2(f[0] + gv0.x * y[0], f[1] + gv0.y * y[1]); o.y = pk2(f[2] + gv0.z * y[2], f[3] + gv0.w * y[3]); o.z = pk2(f[4] + gv1.x * y[4], f[5] + gv1.y * y[5]); o.w = pk2(f[6] + gv1.z * y[6], f[7] + gv1.w * y[7]);
                          __builtin_amdgcn_raw_buffer_store_b128(o, rsO, ovo, (unsigned)(r0 + m) * (DM * 2u), 0); }
                  }
              } else {
                  (void)hvo;
#pragma unroll
                  for (int kk = 0; kk < 8; ++kk) { const int m = wave + 8 * kk; float f[8], y[8]; PM_UNPK(hk[kk], f);
                      const v4u yq = *(const LAS v4u*)(lds + PA + m * 1040 + ch * 16); PM_UNPK(yq, y);
                      v4u o; o.x = pk2(f[0] + gv0.x * y[0], f[1] + gv0.y * y[1]); o.y = pk2(f[2] + gv0.z * y[2], f[3] + gv0.w * y[3]); o.z = pk2(f[4] + gv1.x * y[4], f[5] + gv1.y * y[5]); o.w = pk2(f[6] + gv1.z * y[6], f[7] + gv1.w * y[7]);
                      __builtin_amdgcn_raw_buffer_store_b128(o, rsO, ovo, (unsigned)(r0 + m) * (DM * 2u), 0);
                      if (U2) { float e[8]; PM_UNPK(o, e);
                          const float s2 = wave_sum(((e[0] * e[0] + e[1] * e[1]) + (e[2] * e[2] + e[3] * e[3])) + ((e[4] * e[4] + e[5] * e[5]) + (e[6] * e[6] + e[7] * e[7])));
                          if (lane == 0) rowss[m] = (g ? rowss[m] : 0.f) + s2; } }
              }
            }
            __syncthreads();
        }
        if (U2) {
            const __amdgpu_buffer_rsrc_t rsU = __builtin_amdgcn_make_buffer_rsrc((void*)U2, (short)0, M * DM * 2, 0x00020000);
            const float* sh2 = shift2 + (size_t)b * ADA_W; const float* sc2 = scale2 + (size_t)b * ADA_W;
            f32x4 mul[8], add[8];
#pragma unroll
            for (int j = 0; j < 8; ++j) { const int col = 8 * lane + 512 * (j >> 1) + 4 * (j & 1); const f32x4 gv = *(const GAS f32x4*)(g2 + col), s = *(const GAS f32x4*)(sc2 + col); mul[j] = gv * (s + 1.0f); add[j] = *(const GAS f32x4*)(sh2 + col); }
#pragma unroll 1
            for (int kb = 0; kb < 8; kb += 2) {
                v4u q[2][4]; float rs2[2];
#pragma unroll
                for (int z = 0; z < 2; ++z) { const int m = wave + 8 * (kb + z); rs2[z] = 1.0f / sqrtf(rowss[m] * (1.0f / DM) + EPS);
#pragma unroll
                    for (int j = 0; j < 4; ++j) q[z][j] = __builtin_amdgcn_raw_buffer_load_b128(rsO, (unsigned)lane * 16u + (unsigned)j * 1024u, (unsigned)(r0 + m) * (DM * 2u), 0); }
#pragma unroll
                for (int z = 0; z < 2; ++z) { const int m = wave + 8 * (kb + z); const float rstd = rs2[z];
#pragma unroll
                    for (int j = 0; j < 4; ++j) { float e[8]; PM_UNPK(q[z][j], e);
                        const f32x4 v0 = {e[0], e[1], e[2], e[3]}, v1 = {e[4], e[5], e[6], e[7]};
                        const f32x4 y0 = v0 * rstd * mul[2 * j] + add[2 * j], y1 = v1 * rstd * mul[2 * j + 1] + add[2 * j + 1];
                        v4u w; w.x = pk2(y0.x, y0.y); w.y = pk2(y0.z, y0.w); w.z = pk2(y1.x, y1.y); w.w = pk2(y1.z, y1.w);
                        __builtin_amdgcn_raw_buffer_store_b128(w, rsU, (unsigned)lane * 16u + (unsigned)j * 1024u, (unsigned)(r0 + m) * (DM * 2u), 0); } }
            }
        }
    }
#undef PM_OFFP
#undef PM_OFFW
#undef PM_LDH
#undef PM_UNPK
}

constexpr int NSUB = 6, PH_FINAL = 1 + NSUB * 2 * DEPTH, PH_END = PH_FINAL + 1;
__host__ __device__ constexpr bool phase_exists(int ph) {
    if (ph == 0 || ph == PH_FINAL) return true;
    const int hl = (ph - 1) / NSUB, s = (ph - 1) % NSUB, layer = hl >> 1;
    if (!(hl & 1) && layer % 3 == 0) return s == 1;
    if ((hl & 1) && layer % 3 == 0 && s == 0) return false;
    if (s == 2) return false;
    if (s == 3 || s == 4) return !(hl & 1) && (layer == 1 || layer == 2);
    return true;
}
__global__ void __launch_bounds__(NWAVES * 64, 2) trunk_fwd(Args a) {
    extern __shared__ __attribute__((aligned(16))) unsigned char lds_raw[];
    LAS unsigned char* lds = (LAS unsigned char*)lds_raw;
    volatile LAS unsigned* MISC = (volatile LAS unsigned*)(lds + MISC_OFF);
    const int G = gridDim.x; const int bx = blockIdx.x; const int vcu = (G % 8 == 0) ? (bx % 8) * (G / 8) + bx / 8 : bx;
    const int NGW = G * NWAVES;
    gu32* ctl = (gu32*)(a.ws + WS_CTL);
    const int wave0 = __builtin_amdgcn_readfirstlane((int)threadIdx.x >> 6);
    for (int u = (int)__builtin_amdgcn_mbcnt_hi(~0u, __builtin_amdgcn_mbcnt_lo(~0u, 0u)) + 64 * wave0; u < (LDS_BYTES - LDSCTL_OFF) / 4; u += NWAVES * 64) ((LAS unsigned*)(lds + LDSCTL_OFF))[u] = 0u;
    __syncthreads();
#define PHASE_IDS() const CAS Args* ap = (const CAS Args*)__builtin_amdgcn_kernarg_segment_ptr(); asm volatile("" : "+s"(ap)); unsigned char* ws = ap->ws; int lane = (int)__builtin_amdgcn_mbcnt_hi(~0u, __builtin_amdgcn_mbcnt_lo(~0u, 0u)); asm volatile("" : "+v"(lane)); const int wave = wave0, tid = wave * 64 + lane, gw = vcu * NWAVES + wave; (void)tid; (void)gw
#if MK_ONE_LAUNCH
    XcdBarrier bar = xcd_barrier_post((unsigned*)(ctl + CW_BAR), MISC + 8, wave0);
#define GRID_BAR() xcd_barrier(bar, wave0)
#else
#define GRID_BAR() do { } while (0)
#endif
    const int lo = a.ph_lo, hi = a.ph_hi;
#define IN(k) (lo <= (k) && (k) < hi)
#define ada ((float*)(ws + WS_ADA))
#define U ((bf16*)(ws + WS_U))
#define Pb ((bf16*)(ws + WS_P))
#define PROJ ((bf16*)(ws + WS_PROJ))
#define O ((bf16*)(ws + WS_O))
#define HQD ((bf16*)(ws + WS_PROJ + 256 * MiB))
#define HKI ((bf16*)(ws + WS_PROJ + 320 * MiB))
#define HKE ((bf16*)(ws + WS_P + 64 * MiB))
#define HDEC ((float*)(ws + WS_O + 128 * MiB))
#define HVV ((bf16*)(ws + WS_O + 136 * MiB))
#define H ((bf16*)(ws + (hl >= 7 ? WS_H2 : WS_H)))
#define HPOOL_OUT ((bf16*)(ws + (hl >= 6 ? WS_H2 : WS_H)))

    if (IN(0)) for (int rep = 0; rep < REP_P0; ++rep) { PHASE_IDS(); phase_prologue(ap, lds, tid, lane, wave, vcu, G); GRID_BAR(); }

    for (int hl = 0; hl < 2 * DEPTH; ++hl) {
        const int layer = hl >> 1, isffn = hl & 1, pb = 1 + NSUB * hl;
        const int kind = layer % 3, jj = layer / 3;
#define ada_l (ada + (size_t)layer * NB * ADA_W)
#define hin_is_x (hl == 0)
        if ((kind != 0) && IN(pb + 0)) for (int rep = 0; rep < REP_S0; ++rep) {
            PHASE_IDS();
            if (hin_is_x) phase_normmod(ap->x, ap->norm_mix_g, ada_l, ada_l + DM, U, gw, NGW, lane);
            else phase_normmod_bf(H, (isffn ? ap->norm_ffn_g : ap->norm_mix_g) + (size_t)layer * DM, ada_l + (isffn ? 3 : 0) * DM, ada_l + (isffn ? 4 : 1) * DM, U, gw, NGW, lane);
            GRID_BAR();
        }
        if (IN(pb + 1)) for (int rep = 0; rep < REP_S1; ++rep) {
            PHASE_IDS();
            if (isffn) {
                pg8::Gemm g{U, (const bf16*)(ws + WS_FFWIN) + (size_t)layer * FF2 * DM, M, FF2, DM, DM, DM, FF2 / 256, 0, 0};
                pg8::StaticOrder S; S.init(M, FF2, G, bx);
                pg8::EpiSwiGLU E{PROJ, FF};
                pg8::gemm_phase<pg8::EpiSwiGLU, pg8::StaticOrder, true>(lds + RING_OFF, g, S, E, tid);
            } else if (kind == 0) {
                phase_poolmix<false>(hin_is_x ? (const void*)(ws + WS_H2) : (const void*)H, hin_is_x ? (const float*)(ws + WS_XRS) : (const float*)nullptr, HPOOL_OUT,
                                     ap->norm_mix_g + (size_t)layer * DM, ada_l, ap->pool_scale + (size_t)jj * DM, (const bf16*)(ws + WS_POOLW) + (size_t)jj * 4 * 512 * 512,
                                     ap->norm_ffn_g + (size_t)layer * DM, ada_l + 3 * DM, ada_l + 4 * DM, U, lds, tid, vcu, G);
            } else {
                const int N = (kind == 1) ? HG_IN : RT_IN;
                pg8::Gemm g{U, (const bf16*)(ws + (kind == 1 ? WS_HGWIN : WS_RTWIN)), M, N, DM, DM, DM, N / 256, 0, 0};
                pg8::StaticOrder S; S.init(M, N, G, bx);
                const float* rot = (const float*)(ws + WS_ROT);
                pg8::EpiBf16Rot E{PROJ, N, rot, rot + (size_t)M * 128, kind == 2 ? 16 : 0, kind == 1 ? 16 : 0, (const float*)(ws + WS_LB), HQD, HKI, HKE, HDEC, HVV};
                pg8::gemm_phase<pg8::EpiBf16Rot, pg8::StaticOrder, true>(lds + RING_OFF, g, S, E, tid);
            }
            GRID_BAR();
        }
        if (0) for (int rep = 0; rep < REP_S2; ++rep) {
            PHASE_IDS();
            phase_hgrn_pre(PROJ, (const float*)(ws + WS_LB), HQD, HKI, HKE, HDEC, gw * 64 + lane, NGW * 64);
            GRID_BAR();
        }
        if (!isffn && kind != 0 && IN(pb + 3)) for (int rep = 0; rep < REP_S2; ++rep) {
            PHASE_IDS();
#if NAIVE_SCANS
            if (kind == 1) phase_hgrn_scan_naive(PROJ, (const float*)(ws + WS_LB), O, lds, tid, vcu, G);
            else phase_ret_scan_naive(PROJ, (const float*)(ws + WS_ROT), O, lds, tid, vcu, G);
#else
            if (kind == 1) { if ((vcu & 1) && G >= 2) phase_convert_late_tiles(ap, lds, lane, wave, vcu >> 1, G >> 1);
                             else phase_hgrn_scan(HVV, HQD, HKI, HKE, HDEC, O, lds, tid, G >= 2 ? (vcu >> 1) : vcu, G >= 2 ? ((G + 1) >> 1) : 1); }
            else phase_ret_scan(PROJ, O, lds, tid, vcu, G);
#endif
            GRID_BAR();
        }
        if (!isffn && kind != 0 && IN(pb + 4)) for (int rep = 0; rep < REP_S3; ++rep) {
            PHASE_IDS();
            if (kind == 1) phase_hgrn_post(O, PROJ, ap->hgrn_norm_g, Pb, gw, NGW, lane);
            else phase_ret_post(O, PROJ, ap->ret_norm_g, Pb, gw, NGW, lane);
            GRID_BAR();
        }
        if ((isffn || kind != 0) && IN(pb + 5)) {
            PHASE_IDS();
            pg8::Gemm g;
            const float* cs = nullptr;
            if (isffn) g = pg8::Gemm{PROJ, (const bf16*)(ws + WS_FFWOUT) + (size_t)layer * DM * FF, M, DM, FF, FF, FF, DM / 256, 0, 0};
            else if (kind == 0) { g = pg8::Gemm{Pb, (const bf16*)(ws + WS_POOLW) + (size_t)jj * 4 * 512 * 512, M, DM, 512, DM, 512, 2, 512, 512 * 512}; cs = ap->pool_scale + (size_t)jj * DM; }
            else if (kind == 1) g = pg8::Gemm{Pb, (const bf16*)(ws + WS_HGWOUT), M, DM, DM, DM, DM, DM / 256, 0, 0};
            else g = pg8::Gemm{Pb, (const bf16*)(ws + WS_RTWOUT), M, DM, RT_V, RT_V, RT_V, DM / 256, 0, 0};
            pg8::StaticOrder S; S.init(M, DM, G, bx);
            pg8::EpiResid E{hin_is_x ? ap->x : (const float*)nullptr, H, H, ada_l + (isffn ? 5 : 2) * DM, ADA_W, cs};
            pg8::gemm_phase<pg8::EpiResid, pg8::StaticOrder, true>(lds + RING_OFF, g, S, E, tid);
            GRID_BAR();
        }
    }
    if (IN(PH_FINAL)) { PHASE_IDS(); phase_finalnorm_bf((const bf16*)(ws + WS_H2), ap->final_g, ap->out, gw, NGW, lane); }
#undef IN
#undef ada
#undef U
#undef Pb
#undef PROJ
#undef O
#undef HQD
#undef HKI
#undef HKE
#undef HDEC
#undef HVV
#undef H
#undef HPOOL_OUT
#undef ada_l
#undef hin_is_x
}

extern "C" void kernel_launch(void* const* d_in, const int* in_sizes, int n_in, void* d_out, int out_size, void* d_ws, size_t ws_size, hipStream_t stream) {
    static int grid = 0;
    if (grid == 0) {
        if (n_in != 19 || in_sizes[0] != M * DM || out_size != M * DM || ws_size < WS_END) { fprintf(stderr, "kernel_launch: unexpected shapes (n_in %d, in0 %d, out %d, ws %zu < %zu); nothing launched\n", n_in, n_in > 0 ? in_sizes[0] : -1, out_size, ws_size, (size_t)WS_END); grid = -1; return; }
        int dev = 0, cus = 0, per_cu = 0;
        if (hipGetDevice(&dev) != hipSuccess || hipDeviceGetAttribute(&cus, hipDeviceAttributeMultiprocessorCount, dev) != hipSuccess) { grid = -1; return; }
        if (hipFuncSetAttribute((const void*)trunk_fwd, hipFuncAttributeMaxDynamicSharedMemorySize, LDS_BYTES) != hipSuccess) { fprintf(stderr, "kernel_launch: hipFuncSetAttribute failed\n"); grid = -1; return; }
        if (hipOccupancyMaxActiveBlocksPerMultiprocessor(&per_cu, (const void*)trunk_fwd, NWAVES * 64, LDS_BYTES) != hipSuccess || per_cu < 1)
            fprintf(stderr, "kernel_launch: note: occupancy query reports %d workgroups per CU\n", per_cu);
        (void)hipGetLastError();
        grid = cus;
    }
    if (grid < 0) return;
    if (hipMemsetAsync((char*)d_ws + WS_CTL, 0, CTL_ZERO_BYTES, stream) != hipSuccess) { fprintf(stderr, "kernel_launch: memset failed\n"); return; }
    Args a{};
    a.x = (const float*)d_in[0]; a.c = (const float*)d_in[1]; a.pos = (const int*)d_in[2]; a.w_ada = (const float*)d_in[3]; a.b_ada = (const float*)d_in[4];
    a.norm_mix_g = (const float*)d_in[5]; a.norm_ffn_g = (const float*)d_in[6]; a.pool_w = (const float*)d_in[7]; a.pool_scale = (const float*)d_in[8];
    a.hgrn_w_in = (const float*)d_in[9]; a.hgrn_lb = (const float*)d_in[10]; a.hgrn_norm_g = (const float*)d_in[11]; a.hgrn_w_out = (const float*)d_in[12];
    a.ret_w_in = (const float*)d_in[13]; a.ret_norm_g = (const float*)d_in[14]; a.ret_w_out = (const float*)d_in[15]; a.ffn_w_in = (const float*)d_in[16];
    a.ffn_w_out = (const float*)d_in[17]; a.final_g = (const float*)d_in[18];
    a.out = (float*)d_out; a.ws = (unsigned char*)d_ws;
#if MK_ONE_LAUNCH
    a.ph_lo = 0; a.ph_hi = PH_END;
    hipLaunchKernelGGL(trunk_fwd, dim3(grid), dim3(NWAVES * 64), LDS_BYTES, stream, a);
    { const hipError_t le = hipPeekAtLastError(); if (le != hipSuccess) fprintf(stderr, "kernel_launch: launch failed: %s\n", hipGetErrorName(le)); }
#else
    for (int ph = 0; ph < PH_END; ++ph) {
        if (!phase_exists(ph)) continue;
        a.ph_lo = ph; a.ph_hi = ph + 1;
        hipLaunchKernelGGL(trunk_fwd, dim3(grid), dim3(NWAVES * 64), LDS_BYTES, stream, a);
        const hipError_t le = hipPeekAtLastError();
        if (le != hipSuccess) { fprintf(stderr, "kernel_launch: launch %d failed: %s\n", ph, hipGetErrorName(le)); break; }
    }
#endif
}
```

```cpp
#include <hip/hip_runtime.h>
#include <cstdio>
#include <cstdint>

#ifndef MK_ONE_LAUNCH
#define MK_ONE_LAUNCH 1
#endif
#define REP_S0 1
#define REP_S1 1
#define REP_S2 1
#define REP_S3 1
#define REP_P0 1
#define NAIVE_SCANS 0

constexpr int DM = 2048, NB = 4, SEQ = 4096, DEPTH = 4, M = NB * SEQ;
constexpr int ADA_W = 6 * DM;
constexpr int HG_IN = 8192, HG_H = 16, HG_DK = 128;
constexpr int RT_IN = 12288, RT_H = 8, RT_DK = 256, RT_DV = 512, RT_V = 4096;
constexpr int FF = 5632, FF2 = 2 * FF;
constexpr float EPS = 1e-6f;

namespace pg8 {
#define PG8_LAS __attribute__((address_space(3)))
typedef unsigned short bf16_t;
typedef short bf16x8 __attribute__((ext_vector_type(8)));
typedef float f32x4 __attribute__((ext_vector_type(4)));
typedef unsigned u32x4 __attribute__((ext_vector_type(4)));
constexpr int BM = 256, BK = 64, HALF = 128, HTB = HALF * BK * 2  , STAGE_BYTES = 8 * HTB, NXCD = 8, WGM = 4;

__host__ __device__ __forceinline__ int lds_byte(int r, int c) { const int st = (r >> 4) * 2 + (c >> 5), rr = r & 15, cc = c & 31, ob = rr * 64 + cc * 2; return st * 1024 + (ob ^ (((ob >> 9) & 1) << 5)); }
__host__ __device__ __forceinline__ void stage_rc(int b, int& R, int& C) { const int st = b / 1024, sb = b % 1024, swz = sb ^ (((sb >> 9) & 1) << 5); R = (st >> 1) * 16 + swz / 64; C = (st & 1) * 32 + (swz % 64) / 2; }
__host__ __device__ __forceinline__ int perm32(int rho) { const int n = rho >> 4, i = rho & 15; return 8 * (i >> 2) + 4 * n + (i & 3); }

struct Unit { int pm, pn; };
struct Gemm { const bf16_t* A; const bf16_t* Bt; int M, N, K, lda, ldb, gpn; long a_gs, b_gs; };

struct StaticOrder {
    int nM, nN, nwg, G, c;
    __host__ __device__ void init(int M_, int N_, int G_, int c_) { nM = M_ / BM; nN = N_ / BM; nwg = nM * nN; G = G_; c = c_; }
    __host__ __device__ bool next(int i, Unit& u) const {
        const long L = (long)i * G + c; if (L >= nwg) return false;
        int wgid = (int)L; { const int q = nwg / NXCD, r = nwg % NXCD, xcd = wgid % NXCD, off = wgid / NXCD; wgid = (xcd < r ? xcd * (q + 1) : r * (q + 1) + (xcd - r) * q) + off; }
        const int nig = WGM * nN, gid = wgid / nig, fm = gid * WGM, gsz = (nM - fm) < WGM ? (nM - fm) : WGM;
        u.pm = fm + ((wgid % nig) % gsz); u.pn = (wgid % nig) / gsz; return true;
    }
    __device__ __forceinline__ void a_ready(const Unit&) const {}
    __device__ __forceinline__ void done(const Unit&) const {}
};

__device__ __forceinline__ unsigned cvt_pk_bf16(float lo, float hi) { unsigned r; asm volatile("v_cvt_pk_bf16_f32 %0, %1, %2" : "=v"(r) : "v"(lo), "v"(hi)); return r; }

struct EpiBf16 {
    static constexpr bool PERM = true, AFTER_DRAIN = false;
    bf16_t* O; int ldc;
    __device__ __forceinline__ void operator()(const f32x4 (&acc)[2][2][4][2], const Unit& u, int wr, int wc, int fr, int fq) const {
        const int row0 = u.pm * BM + wr * 64 + fr, col0 = u.pn * BM + wc * 32 + 8 * fq;
#pragma unroll
        for (int ai = 0; ai < 2; ++ai)
#pragma unroll
            for (int m = 0; m < 4; ++m) { bf16_t* rowp = O + (size_t)(row0 + ai * HALF + m * 16) * ldc + col0;
#pragma unroll
                for (int bj = 0; bj < 2; ++bj) { const f32x4 v0 = acc[ai][bj][m][0], v1 = acc[ai][bj][m][1];
                    u32x4 w; w.x = cvt_pk_bf16(v0[0], v0[1]); w.y = cvt_pk_bf16(v0[2], v0[3]); w.z = cvt_pk_bf16(v1[0], v1[1]); w.w = cvt_pk_bf16(v1[2], v1[3]);
                    *(u32x4*)(rowp + bj * HALF) = w; } }
    }
};
__device__ __forceinline__ float scan16_mul(float x) {
#define PG8_DPP_SHR(v, n) __builtin_bit_cast(float, __builtin_amdgcn_update_dpp(0x3f800000, __builtin_bit_cast(int, v), 0x110 + (n), 0xf, 0xf, false))
    x *= PG8_DPP_SHR(x, 1); x *= PG8_DPP_SHR(x, 2); x *= PG8_DPP_SHR(x, 4); x *= PG8_DPP_SHR(x, 8);
#undef PG8_DPP_SHR
    return x;
}
__device__ __forceinline__ float bcast15(float x, int lane) { (void)lane; return __builtin_bit_cast(float, __builtin_amdgcn_update_dpp(0, __builtin_bit_cast(int, x), 0x15F, 0xf, 0xf, false)); }
__device__ __forceinline__ float sigm_f(float x) { return __builtin_amdgcn_rcpf(1.0f + __builtin_amdgcn_exp2f(-1.4426950408889634f * x)); }
struct EpiBf16Rot {
    static constexpr bool PERM = true, AFTER_DRAIN = false;
    bf16_t* O; int ldc; const float* ct; const float* st; int rot_tiles;
    int hg_tiles; const float* lbv; bf16_t* QD; bf16_t* KI; bf16_t* KE; float* DEC; bf16_t* HV;
    __device__ __forceinline__ void operator()(const f32x4 (&acc)[2][2][4][2], const Unit& u, int wr, int wc, int fr, int fq) const {
        const int row0 = u.pm * BM + wr * 64 + fr, col0 = u.pn * BM + wc * 32 + 8 * fq;
        if (u.pn < hg_tiles) {
            const int lane = fq * 16 + fr, cg = u.pn * HALF + wc * 32 + 8 * fq;
            float lb[8];
            { const f32x4 l0 = *(const f32x4*)(lbv + cg), l1 = *(const f32x4*)(lbv + cg + 4);
#pragma unroll
              for (int e = 0; e < 4; ++e) { lb[e] = l0[e]; lb[4 + e] = l1[e]; } }
#pragma unroll
            for (int ai = 0; ai < 2; ++ai)
#pragma unroll
                for (int mp = 0; mp < 2; ++mp) {
                    float qd0[8], ki0[8], ke0[8], qd1[8], ki1[8], ke1[8], tot[8];
#pragma unroll
                    for (int c = 0; c < 8; ++c) {
                        const float z0 = acc[ai][1][2 * mp][c >> 2][c & 3], z1 = acc[ai][1][2 * mp + 1][c >> 2][c & 3];
                        const float q0 = acc[ai][0][2 * mp][c >> 2][c & 3], q1 = acc[ai][0][2 * mp + 1][c >> 2][c & 3];
                        const float s0 = sigm_f(z0), s1 = sigm_f(z1), om = 1.0f - lb[c];
                        const float e0 = scan16_mul(lb[c] + om * s0);
                        const float e1 = scan16_mul(lb[c] + om * s1) * bcast15(e0, lane);
                        const float tt = bcast15(e1, lane);
                        const float k0 = om * (1.0f - s0) * __builtin_amdgcn_rcpf(e0), k1 = om * (1.0f - s1) * __builtin_amdgcn_rcpf(e1);
                        qd0[c] = q0 * e0; ki0[c] = k0; ke0[c] = k0 * tt; qd1[c] = q1 * e1; ki1[c] = k1; ke1[c] = k1 * tt; tot[c] = tt;
                    }
                    const int rr0 = row0 + ai * HALF + 32 * mp;
                    const size_t r0 = ((size_t)((rr0 >> 12) * 16 + u.pn) * 4096 + (rr0 & 4095)) * 128 + (wc * 32 + 8 * fq), r1 = r0 + 16 * 128;
                    u32x4 w;
                    w.x = cvt_pk_bf16(qd0[0], qd0[1]); w.y = cvt_pk_bf16(qd0[2], qd0[3]); w.z = cvt_pk_bf16(qd0[4], qd0[5]); w.w = cvt_pk_bf16(qd0[6], qd0[7]); *(u32x4*)(QD + r0) = w;
                    w.x = cvt_pk_bf16(ki0[0], ki0[1]); w.y = cvt_pk_bf16(ki0[2], ki0[3]); w.z = cvt_pk_bf16(ki0[4], ki0[5]); w.w = cvt_pk_bf16(ki0[6], ki0[7]); *(u32x4*)(KI + r0) = w;
                    w.x = cvt_pk_bf16(ke0[0], ke0[1]); w.y = cvt_pk_bf16(ke0[2], ke0[3]); w.z = cvt_pk_bf16(ke0[4], ke0[5]); w.w = cvt_pk_bf16(ke0[6], ke0[7]); *(u32x4*)(KE + r0) = w;
                    w.x = cvt_pk_bf16(qd1[0], qd1[1]); w.y = cvt_pk_bf16(qd1[2], qd1[3]); w.z = cvt_pk_bf16(qd1[4], qd1[5]); w.w = cvt_pk_bf16(qd1[6], qd1[7]); *(u32x4*)(QD + r1) = w;
                    w.x = cvt_pk_bf16(ki1[0], ki1[1]); w.y = cvt_pk_bf16(ki1[2], ki1[3]); w.z = cvt_pk_bf16(ki1[4], ki1[5]); w.w = cvt_pk_bf16(ki1[6], ki1[7]); *(u32x4*)(KI + r1) = w;
                    w.x = cvt_pk_bf16(ke1[0], ke1[1]); w.y = cvt_pk_bf16(ke1[2], ke1[3]); w.z = cvt_pk_bf16(ke1[4], ke1[5]); w.w = cvt_pk_bf16(ke1[6], ke1[7]); *(u32x4*)(KE + r1) = w;
                    if (fr == 15) { const int crow = u.pm * BM + wr * 64 + ai * HALF + 32 * mp; float* dp = DEC + ((size_t)((crow >> 12) * 16 + u.pn) * 128 + ((crow & 4095) >> 5)) * 128 + (wc * 32 + 8 * fq);
                        *(f32x4*)dp = (f32x4){tot[0], tot[1], tot[2], tot[3]}; *(f32x4*)(dp + 4) = (f32x4){tot[4], tot[5], tot[6], tot[7]}; }
                }
        } else if (u.pn < rot_tiles) {
            const float sc = u.pn >= 8 ? 0.0625f : 1.0f; const int j0 = wc * 32 + 8 * fq;
#pragma unroll
            for (int ai = 0; ai < 2; ++ai)
#pragma unroll
                for (int m = 0; m < 4; ++m) { const int row = row0 + ai * HALF + m * 16; bf16_t* rowp = O + (size_t)row * ldc + col0;
                    const f32x4 c0 = *(const f32x4*)(ct + (size_t)row * 128 + j0), c1 = *(const f32x4*)(ct + (size_t)row * 128 + j0 + 4);
                    const f32x4 s0 = *(const f32x4*)(st + (size_t)row * 128 + j0), s1 = *(const f32x4*)(st + (size_t)row * 128 + j0 + 4);
                    const f32x4 a0 = acc[ai][0][m][0], a1 = acc[ai][0][m][1], b0 = acc[ai][1][m][0], b1 = acc[ai][1][m][1];
                    const f32x4 p0 = (a0 * c0 - b0 * s0) * sc, p1 = (a1 * c1 - b1 * s1) * sc, q0 = (a0 * s0 + b0 * c0) * sc, q1 = (a1 * s1 + b1 * c1) * sc;
                    u32x4 w; w.x = cvt_pk_bf16(p0[0], p0[1]); w.y = cvt_pk_bf16(p0[2], p0[3]); w.z = cvt_pk_bf16(p1[0], p1[1]); w.w = cvt_pk_bf16(p1[2], p1[3]);
                    *(u32x4*)rowp = w;
                    w.x = cvt_pk_bf16(q0[0], q0[1]); w.y = cvt_pk_bf16(q0[2], q0[3]); w.z = cvt_pk_bf16(q1[0], q1[1]); w.w = cvt_pk_bf16(q1[2], q1[3]);
                    *(u32x4*)(rowp + HALF) = w; }
        } else {
            const bool hv = hg_tiles > 0 && u.pn < 24;
#pragma unroll
            for (int ai = 0; ai < 2; ++ai)
#pragma unroll
                for (int m = 0; m < 4; ++m) { const int row = row0 + ai * HALF + m * 16; bf16_t* rowp = O + (size_t)row * ldc + col0;
#pragma unroll
                    for (int bj = 0; bj < 2; ++bj) { const f32x4 v0 = acc[ai][bj][m][0], v1 = acc[ai][bj][m][1];
                        u32x4 w; w.x = cvt_pk_bf16(v0[0], v0[1]); w.y = cvt_pk_bf16(v0[2], v0[3]); w.z = cvt_pk_bf16(v1[0], v1[1]); w.w = cvt_pk_bf16(v1[2], v1[3]);
                        if (hv) *(u32x4*)(HV + ((size_t)((row >> 12) * 16 + 2 * (u.pn - 16) + bj) * 4096 + (row & 4095)) * 128 + wc * 32 + 8 * fq) = w;
                        else *(u32x4*)(rowp + bj * HALF) = w; } }
        }
    }
};
__device__ __forceinline__ float silu_f(float x) { return x * __builtin_amdgcn_rcpf(1.0f + __builtin_amdgcn_exp2f(-1.4426950408889634f * x)); }
struct EpiSwiGLU {
    static constexpr bool PERM = true, AFTER_DRAIN = false;
    bf16_t* O; int ldc;
    __device__ __forceinline__ void operator()(const f32x4 (&acc)[2][2][4][2], const Unit& u, int wr, int wc, int fr, int fq) const {
        const int row0 = u.pm * BM + wr * 64 + fr, col0 = u.pn * HALF + wc * 32 + 8 * fq;
#pragma unroll
        for (int ai = 0; ai < 2; ++ai)
#pragma unroll
            for (int m = 0; m < 4; ++m) { bf16_t* rowp = O + (size_t)(row0 + ai * HALF + m * 16) * ldc + col0;
                const f32x4 g0 = acc[ai][0][m][0], g1 = acc[ai][0][m][1], u0 = acc[ai][1][m][0], u1 = acc[ai][1][m][1];
                f32x4 e0 = g0 * -1.4426950408889634f, e1 = g1 * -1.4426950408889634f;
                const f32x4 p0 = g0 * u0, p1 = g1 * u1;
                __builtin_amdgcn_sched_barrier(0);
#pragma unroll
                for (int i = 0; i < 4; ++i) { e0[i] = __builtin_amdgcn_exp2f(e0[i]); e1[i] = __builtin_amdgcn_exp2f(e1[i]); }
                __builtin_amdgcn_sched_barrier(0);
                e0 = e0 + 1.0f; e1 = e1 + 1.0f;
                __builtin_amdgcn_sched_barrier(0);
#pragma unroll
                for (int i = 0; i < 4; ++i) { e0[i] = __builtin_amdgcn_rcpf(e0[i]); e1[i] = __builtin_amdgcn_rcpf(e1[i]); }
                __builtin_amdgcn_sched_barrier(0);
                const f32x4 o0 = p0 * e0, o1 = p1 * e1;
                u32x4 w; w.x = cvt_pk_bf16(o0[0], o0[1]); w.y = cvt_pk_bf16(o0[2], o0[3]); w.z = cvt_pk_bf16(o1[0], o1[1]); w.w = cvt_pk_bf16(o1[2], o1[3]);
                *(u32x4*)rowp = w; }
    }
};
struct EpiResid {
    static constexpr bool PERM = true, AFTER_DRAIN = false;
    const float* xin; const bf16_t* hin; bf16_t* hout; const float* gate; int gate_bs; const float* cscale;
    __device__ __forceinline__ void operator()(const f32x4 (&acc)[2][2][4][2], const Unit& u, int wr, int wc, int fr, int fq) const {
        const int row0 = u.pm * BM + wr * 64 + fr, col0 = u.pn * BM + wc * 32 + 8 * fq;
        const float* gp = gate + (size_t)(u.pm >> 4) * gate_bs + col0;
        f32x4 gv[2][2];
#pragma unroll
        for (int bj = 0; bj < 2; ++bj)
#pragma unroll
            for (int n = 0; n < 2; ++n) { gv[bj][n] = *(const f32x4*)(gp + bj * HALF + n * 4); if (cscale) gv[bj][n] = gv[bj][n] * *(const f32x4*)(cscale + col0 + bj * HALF + n * 4); }
#pragma unroll
        for (int ai = 0; ai < 2; ++ai)
#pragma unroll
            for (int m = 0; m < 4; ++m) { const size_t ro = (size_t)(row0 + ai * HALF + m * 16) * DM + col0;
#pragma unroll
                for (int bj = 0; bj < 2; ++bj) {
                    f32x4 h0, h1;
                    if (xin) { h0 = *(const f32x4*)(xin + ro + bj * HALF); h1 = *(const f32x4*)(xin + ro + bj * HALF + 4); }
                    else { const u32x4 hb = *(const u32x4*)(hin + ro + bj * HALF);
                        h0 = (f32x4){__builtin_bit_cast(float, hb.x << 16), __builtin_bit_cast(float, hb.x & 0xffff0000u), __builtin_bit_cast(float, hb.y << 16), __builtin_bit_cast(float, hb.y & 0xffff0000u)};
                        h1 = (f32x4){__builtin_bit_cast(float, hb.z << 16), __builtin_bit_cast(float, hb.z & 0xffff0000u), __builtin_bit_cast(float, hb.w << 16), __builtin_bit_cast(float, hb.w & 0xffff0000u)}; }
                    const f32x4 o0 = h0 + gv[bj][0] * acc[ai][bj][m][0], o1 = h1 + gv[bj][1] * acc[ai][bj][m][1];
                    u32x4 w; w.x = cvt_pk_bf16(o0[0], o0[1]); w.y = cvt_pk_bf16(o0[2], o0[3]); w.z = cvt_pk_bf16(o1[0], o1[1]); w.w = cvt_pk_bf16(o1[2], o1[3]);
                    *(u32x4*)(hout + ro + bj * HALF) = w; } }
    }
};

template <class Epi, class Sched, bool ALIGN_EPI = false>
__device__ __forceinline__ void gemm_phase(PG8_LAS unsigned char* lds, const Gemm g, const Sched& S, const Epi& E, const int tid) {
    const int wid = __builtin_amdgcn_readfirstlane(tid >> 6), lane = tid & 63, wr = wid >> 2, wc = wid & 3, fr = lane & 15, fq = lane >> 4;
    const int K = g.K, nt = K / BK, lda = g.lda, ldb = g.ldb;
    unsigned voffA[2], voffB[2];
#pragma unroll
    for (int i = 0; i < 2; ++i) { int R, C; stage_rc(tid * 16 + i * 8192, R, C); const int Rb = Epi::PERM ? ((R & ~31) + perm32(R & 31)) : R;
        voffA[i] = (unsigned)(R * lda + C) * 2u; voffB[i] = (unsigned)(Rb * ldb + C) * 2u; }
    const unsigned kstep = (unsigned)(BK * 2);
    const unsigned hstepA = (unsigned)HALF * lda * 2u, hstepB = (unsigned)HALF * ldb * 2u;
    const __amdgpu_buffer_rsrc_t rsA = __builtin_amdgcn_make_buffer_rsrc((void*)g.A, (short)0, 0x7fffffff, 0x00020000), rsB = __builtin_amdgcn_make_buffer_rsrc((void*)g.Bt, (short)0, 0x7fffffff, 0x00020000);
    const unsigned ldsw = (unsigned)wid * 1024u;
    const int aoff = lds_byte(wr * 64 + fr, fq * 8), boff = lds_byte(wc * 32 + fr, fq * 8);
#define PG8_SA(b, h) (((b) * 2 + (h)) * HTB)
#define PG8_SB(b, h) ((4 + (b) * 2 + (h)) * HTB)
#define PG8_STAGEA(bufoff, soff, voff) do { _Pragma("unroll") for (int _i = 0; _i < 2; ++_i) \
        __builtin_amdgcn_raw_ptr_buffer_load_lds(rsA, (PG8_LAS unsigned*)(lds + (bufoff) + ldsw + _i * 8192), 16, (voff)[_i], (soff), 0, 0); } while (0)
#define PG8_STAGEB(bufoff, soff, voff) do { _Pragma("unroll") for (int _i = 0; _i < 2; ++_i) \
        __builtin_amdgcn_raw_ptr_buffer_load_lds(rsB, (PG8_LAS unsigned*)(lds + (bufoff) + ldsw + _i * 8192), 16, (voff)[_i], (soff), 0, 0); } while (0)
#define PG8_LDA(dst, b, h) do { _Pragma("unroll") for (int m = 0; m < 4; ++m) _Pragma("unroll") for (int k = 0; k < 2; ++k) dst[m][k] = *(const PG8_LAS bf16x8*)(lds + PG8_SA(b, h) + aoff + m * 2048 + k * 1024); } while (0)
#define PG8_LDB(dst, b, h) do { _Pragma("unroll") for (int n = 0; n < 2; ++n) _Pragma("unroll") for (int k = 0; k < 2; ++k) dst[n][k] = *(const PG8_LAS bf16x8*)(lds + PG8_SB(b, h) + boff + n * 2048 + k * 1024); } while (0)
#define PG8_MMA(ai, bj, At, Bt) do { __builtin_amdgcn_s_setprio(1); _Pragma("unroll") for (int m = 0; m < 4; ++m) _Pragma("unroll") for (int n = 0; n < 2; ++n) _Pragma("unroll") for (int k = 0; k < 2; ++k) \
        acc[ai][bj][m][n] = __builtin_amdgcn_mfma_f32_16x16x32_bf16(Bt[n][k], At[m][k], acc[ai][bj][m][n], 0, 0, 0); __builtin_amdgcn_s_setprio(0); } while (0)
#define PG8_WAIT_V(n) asm volatile("s_waitcnt vmcnt(" #n ")" ::: "memory")
#define PG8_WAIT_L(n) asm volatile("s_waitcnt lgkmcnt(" #n ")" ::: "memory")
#define PG8_BAR __builtin_amdgcn_s_barrier()
#define PG8_SCHED __builtin_amdgcn_sched_barrier(0)
#define PG8_ABASE(u) ((unsigned)(((size_t)((u).pn / g.gpn) * (size_t)g.a_gs + (size_t)(u).pm * BM * lda) * 2))
#define PG8_BBASE(u) ((unsigned)(((size_t)((u).pn / g.gpn) * (size_t)g.b_gs + (size_t)((u).pn % g.gpn) * BM * ldb) * 2))
    Unit cur, nxt; int ui = 0;
    if (!S.next(0, cur)) return;
    f32x4 acc[2][2][4][2];
#pragma unroll
    for (int a = 0; a < 2; ++a)
#pragma unroll
        for (int b = 0; b < 2; ++b)
#pragma unroll
            for (int m = 0; m < 4; ++m)
#pragma unroll
                for (int n = 0; n < 2; ++n) acc[a][b][m][n] = (f32x4){0.f, 0.f, 0.f, 0.f};
    bf16x8 At[4][2], B0[2][2], B1[2][2];
    unsigned cA = PG8_ABASE(cur), cB = PG8_BBASE(cur);
    S.a_ready(cur);
    PG8_STAGEB(PG8_SB(0, 0), cB, voffB); PG8_STAGEB(PG8_SB(0, 1), cB + hstepB, voffB); PG8_STAGEA(PG8_SA(0, 0), cA, voffA); PG8_STAGEA(PG8_SA(0, 1), cA + hstepA, voffA);
    PG8_STAGEB(PG8_SB(1, 0), cB + kstep, voffB); PG8_STAGEA(PG8_SA(1, 0), cA + kstep, voffA); PG8_STAGEB(PG8_SB(1, 1), cB + hstepB + kstep, voffB);
    if (wr == 1) PG8_BAR;
    PG8_WAIT_V(8); PG8_BAR;
    PG8_WAIT_V(6); PG8_BAR;
    for (;;) {
        const bool has_next = S.next(ui + 1, nxt);
        const unsigned nA = has_next ? PG8_ABASE(nxt) : cA, nB = has_next ? PG8_BBASE(nxt) : cB;
        for (int t = 0; t < nt; t += 2) {
            const bool last = (t == nt - 2);
            const unsigned a1 = cA + (unsigned)(t + 1) * kstep;
            const unsigned a2 = last ? nA : cA + (unsigned)(t + 2) * kstep, b2 = last ? nB : cB + (unsigned)(t + 2) * kstep;
            const unsigned a3 = a2 + kstep, b3 = b2 + kstep;
            if (last && has_next) S.a_ready(nxt);
            PG8_LDB(B0, 0, 0); PG8_LDB(B1, 0, 1); PG8_SCHED; PG8_LDA(At, 0, 0); PG8_STAGEA(PG8_SA(1, 1), a1 + hstepA, voffA);
            PG8_WAIT_V(8); PG8_WAIT_L(0); PG8_BAR; PG8_MMA(0, 0, At, B0); PG8_MMA(0, 1, At, B1); PG8_BAR; PG8_SCHED;
            PG8_LDA(At, 0, 1); PG8_STAGEB(PG8_SB(0, 0), b2, voffB); PG8_STAGEB(PG8_SB(0, 1), b2 + hstepB, voffB); PG8_STAGEA(PG8_SA(0, 0), a2, voffA);
            PG8_WAIT_V(8); PG8_WAIT_L(0); PG8_BAR; PG8_MMA(1, 0, At, B0); PG8_MMA(1, 1, At, B1); PG8_BAR; PG8_SCHED;
            PG8_LDB(B0, 1, 0); PG8_LDB(B1, 1, 1); PG8_SCHED; PG8_LDA(At, 1, 0); PG8_STAGEA(PG8_SA(0, 1), a2 + hstepA, voffA);
            PG8_WAIT_V(8); PG8_WAIT_L(0); PG8_BAR; PG8_MMA(0, 0, At, B0); PG8_MMA(0, 1, At, B1); PG8_BAR; PG8_SCHED;
            PG8_LDA(At, 1, 1); PG8_STAGEB(PG8_SB(1, 0), b3, voffB); PG8_STAGEB(PG8_SB(1, 1), b3 + hstepB, voffB); PG8_STAGEA(PG8_SA(1, 0), a3, voffA);
            PG8_WAIT_V(8); PG8_WAIT_L(0); PG8_BAR; PG8_MMA(1, 0, At, B0); PG8_MMA(1, 1, At, B1); PG8_BAR; PG8_SCHED;
        }
        if constexpr (ALIGN_EPI) { if (wr == 0) PG8_BAR; }
        E(acc, cur, wr, wc, fr, fq); S.done(cur);
        if (!has_next) break;
#pragma unroll
        for (int a = 0; a < 2; ++a)
#pragma unroll
            for (int b = 0; b < 2; ++b)
#pragma unroll
                for (int m = 0; m < 4; ++m)
#pragma unroll
                    for (int n = 0; n < 2; ++n) acc[a][b][m][n] = (f32x4){0.f, 0.f, 0.f, 0.f};
        cur = nxt; cA = nA; cB = nB; ++ui;
        if constexpr (ALIGN_EPI) { if (wr == 1) PG8_BAR; }
    }
    PG8_WAIT_V(0);
    if constexpr (!ALIGN_EPI) { if (wr == 0) PG8_BAR; }
    PG8_BAR;
#undef PG8_SA
#undef PG8_SB
#undef PG8_STAGEA
#undef PG8_STAGEB
#undef PG8_LDA
#undef PG8_LDB
#undef PG8_MMA
#undef PG8_WAIT_V
#undef PG8_WAIT_L
#undef PG8_BAR
#undef PG8_SCHED
#undef PG8_ABASE
#undef PG8_BBASE
}
}

constexpr size_t MiB = 1u << 20;
constexpr size_t WS_CTL = 0, CTL_ZERO_BYTES = 1 * MiB;
constexpr size_t WS_ADA = 1 * MiB;
constexpr size_t WS_LB = 2 * MiB;
constexpr size_t WS_XRS = 3 * MiB;
constexpr size_t WS_ROT = 4 * MiB;
constexpr size_t WS_POOLW = 20 * MiB;
constexpr size_t WS_HGWIN = 24 * MiB;
constexpr size_t WS_HGWOUT = 56 * MiB;
constexpr size_t WS_RTWIN = 64 * MiB;
constexpr size_t WS_RTWOUT = 112 * MiB;
constexpr size_t WS_FFWIN = 128 * MiB;
constexpr size_t WS_FFWOUT = 304 * MiB;
constexpr size_t WS_U = 392 * MiB;
constexpr size_t WS_P = 456 * MiB;
constexpr size_t WS_PROJ = 584 * MiB;
constexpr size_t WS_O = 968 * MiB;
constexpr size_t WS_H = 1224 * MiB;
constexpr size_t WS_H2 = 1288 * MiB;
constexpr size_t WS_END = 1352 * MiB;
constexpr int CW_TMO = 0, CW_CODE = 1, CW_BAR = 4096;

constexpr int RING_OFF = 0, RING_BYTES = 131072;
constexpr int LDSCTL_OFF = RING_BYTES, MISC_OFF = LDSCTL_OFF + 320;
constexpr int LDS_BYTES = 147456;
constexpr int NWAVES = 8;

#define GAS __attribute__((address_space(1)))
#define LAS __attribute__((address_space(3)))
#define CAS __attribute__((address_space(4)))
typedef unsigned short bf16;
typedef unsigned v4u __attribute__((ext_vector_type(4)));
typedef unsigned v2u __attribute__((ext_vector_type(2)));
typedef float f32x4 __attribute__((ext_vector_type(4)));
typedef GAS unsigned gu32;
#define RLX_AGENT __ATOMIC_RELAXED, __HIP_MEMORY_SCOPE_AGENT
#define LDS_WAIT() asm volatile("s_waitcnt lgkmcnt(0)" ::: "memory")
__device__ __forceinline__ unsigned f2bf(float f) { unsigned u = __builtin_bit_cast(unsigned, f); return (u + 0x7fffu + ((u >> 16) & 1u)) >> 16; }
typedef float pk_f2 __attribute__((ext_vector_type(2)));
typedef __bf16 pk_b2 __attribute__((ext_vector_type(2)));
__device__ __forceinline__ unsigned pk2(float lo, float hi) { const pk_f2 v = {lo, hi}; return __builtin_bit_cast(unsigned, __builtin_convertvector(v, pk_b2)); }
__device__ __forceinline__ float bflo(unsigned w) { return __builtin_bit_cast(float, w << 16); }
__device__ __forceinline__ float bfhi(unsigned w) { return __builtin_bit_cast(float, w & 0xffff0000u); }
__device__ __forceinline__ float bf1(bf16 b) { return __builtin_bit_cast(float, (unsigned)b << 16); }
__device__ __forceinline__ float sigmoid_f(float x) { return __builtin_amdgcn_rcpf(1.0f + __builtin_amdgcn_exp2f(-1.4426950408889634f * x)); }
__device__ __forceinline__ float silu1(float x) { return x * sigmoid_f(x); }

#define XB_TMO      128
#define XB_XCNT(j)  (256  + 64 * (j))
#define XB_XSUB(j)  (1280 + 64 * (j))
#define XB_XGEN(j)  (2304 + 64 * (j))
#define XB_TOP      3328
#define XB_TOPGEN   3392
#define XCD_BAR_WORDS 3456
#define XB_SPIN_CAP (1u << 18)

__device__ __forceinline__ unsigned xb_ld(unsigned* p)              { return __hip_atomic_load(p, __ATOMIC_RELAXED, __HIP_MEMORY_SCOPE_AGENT); }
__device__ __forceinline__ unsigned xb_add(unsigned* p, unsigned v) { return __hip_atomic_fetch_add(p, v, __ATOMIC_RELAXED, __HIP_MEMORY_SCOPE_AGENT); }
__device__ __forceinline__ unsigned xb_xcc_id() { return (unsigned)__builtin_amdgcn_s_getreg((3 << 11) | 20) & 0xFu; }
#define XB_SPIN(cond, bar) do { unsigned _sp = 0; while (cond) { __builtin_amdgcn_s_sleep(1); \
    if ((++_sp & 255u) == 0u) { if (xb_ld(&(bar)[XB_TMO])) break; if (_sp > XB_SPIN_CAP) { atomicAdd(&(bar)[XB_TMO], 1u); break; } } } } while (0)

struct XcdBarrier { unsigned* bar; unsigned x; volatile LAS unsigned* st; };
#define XB_TID() ((int)__builtin_amdgcn_mbcnt_hi(~0u, __builtin_amdgcn_mbcnt_lo(~0u, 0u)) + 64 * xb_wave_id)

__device__ __forceinline__ XcdBarrier xcd_barrier_post(unsigned* bar, volatile LAS unsigned* st, const int xb_wave_id) {
    XcdBarrier b; b.bar = bar; b.x = xb_xcc_id(); b.st = st;
    if (XB_TID() == 0) (void)xb_add(&bar[XB_XCNT(b.x)], 1u);
    return b;
}
__device__ __forceinline__ void xcd_barrier_complete(unsigned* bar, unsigned x, unsigned& nloc, unsigned& nx) {
    const unsigned G = gridDim.x * gridDim.y * gridDim.z;
    unsigned sum, cnt, mine, sp = 0u;
    for (;;) {
        sum = 0u; cnt = 0u; mine = 0u;
#pragma unroll
        for (unsigned j = 0; j < 16; ++j) { const unsigned c = xb_ld(&bar[XB_XCNT(j)]); sum += c; cnt += (c > 0u) ? 1u : 0u; mine = (j == x) ? c : mine; }
        if (sum == G) break;
        __builtin_amdgcn_s_sleep(1);
        if ((++sp & 255u) == 0u) { if (xb_ld(&bar[XB_TMO])) break; if (sp > XB_SPIN_CAP) { atomicAdd(&bar[XB_TMO], 1u); break; } }
    }
    nloc = mine > 0u ? mine : 1u; nx = cnt > 0u ? cnt : 1u;
}
__device__ __forceinline__ void xcd_barrier(const XcdBarrier& b, const int xb_wave_id) {
    asm volatile("s_waitcnt vmcnt(0)" ::: "memory");
    __syncthreads();
    if (XB_TID() == 0) {
        unsigned* bar = b.bar;
        __builtin_amdgcn_s_waitcnt(0);
        unsigned nloc = b.st[0], nx = b.st[1];
        if (nloc == 0u) { xcd_barrier_complete(bar, b.x, nloc, nx); b.st[0] = nloc; b.st[1] = nx; }
        const unsigned old = xb_add(&bar[XB_XSUB(b.x)], 1u);
        const unsigned gen = old / nloc;
        if (old + 1u == (gen + 1u) * nloc) {
            __builtin_amdgcn_fence(__ATOMIC_RELEASE, "agent");
            asm volatile("s_waitcnt vmcnt(0)" ::: "memory");
            const unsigned og = xb_add(&bar[XB_TOP], 1u);
            const unsigned tg = og / nx;
            if (og + 1u == (tg + 1u) * nx) xb_add(&bar[XB_TOPGEN], 1u);
            else XB_SPIN(xb_ld(&bar[XB_TOPGEN]) == tg, bar);
            __builtin_amdgcn_fence(__ATOMIC_ACQUIRE, "agent");
            xb_add(&bar[XB_XGEN(b.x)], 1u);
            asm volatile("s_waitcnt vmcnt(0)" ::: "memory");
        } else {
            XB_SPIN(xb_ld(&bar[XB_XGEN(b.x)]) == gen, bar);
            __builtin_amdgcn_fence(__ATOMIC_ACQUIRE, "agent");
            asm volatile("s_waitcnt vmcnt(0)" ::: "memory");
        }
    }
    __syncthreads();
}

struct Args {
    const float* x; const float* c; const int* pos; const float* w_ada; const float* b_ada; const float* norm_mix_g; const float* norm_ffn_g;
    const float* pool_w; const float* pool_scale; const float* hgrn_w_in; const float* hgrn_lb; const float* hgrn_norm_g; const float* hgrn_w_out;
    const float* ret_w_in; const float* ret_norm_g; const float* ret_w_out; const float* ffn_w_in; const float* ffn_w_out; const float* final_g;
    float* out; unsigned char* ws; int ph_lo, ph_hi;
};

#define WS_DPP(v, ctrl) __builtin_bit_cast(float, __builtin_amdgcn_update_dpp(0, __builtin_bit_cast(int, v), (ctrl), 0xf, 0xf, true))
__device__ __forceinline__ float row16_sum(float v) { v += WS_DPP(v, 0xB1); v += WS_DPP(v, 0x4E); v += WS_DPP(v, 0x141); v += WS_DPP(v, 0x140); return v; }
#define WS_RL(v, l) __builtin_bit_cast(float, __builtin_amdgcn_readlane(__builtin_bit_cast(int, v), (l)))
__device__ __forceinline__ float wave_sum(float v) { v = row16_sum(v); return (WS_RL(v, 0) + WS_RL(v, 16)) + (WS_RL(v, 32) + WS_RL(v, 48)); }
__device__ __forceinline__ float half_sum(float v) {
    v = row16_sum(v); const float lo = WS_RL(v, 0) + WS_RL(v, 16), hi = WS_RL(v, 32) + WS_RL(v, 48);
    return (__builtin_amdgcn_mbcnt_hi(~0u, __builtin_amdgcn_mbcnt_lo(~0u, 0u)) < 32u) ? lo : hi; }

struct TItem { const float* W; bf16* WT; int K, N, mode, item; };
__device__ __forceinline__ void titem_load(const TItem& t, int lane, f32x4 (&wv)[8]) {
    const int nblk = t.N / 32, kb = t.item / nblk, nb = t.item % nblk, k0 = 64 * kb, n0 = 32 * nb;
#pragma unroll
    for (int i = 0; i < 8; ++i) wv[i] = *(const GAS f32x4*)(t.W + (size_t)(k0 + 8 * i + (lane >> 3)) * t.N + n0 + 4 * (lane & 7));
}
__device__ __forceinline__ void titem_finish(const TItem& t, LAS float* scr, int lane, const f32x4 (&wv)[8]) {
    const int nblk = t.N / 32, kb = t.item / nblk, nb = t.item % nblk, k0 = 64 * kb, n0 = 32 * nb;
    int d0 = n0;
    if (t.mode == 1) { const int bj = n0 >= FF ? 1 : 0, j = n0 - bj * FF; d0 = 256 * (j >> 7) + 128 * bj + (j & 127); }
    if (t.mode == 2 && n0 < 4096) { const int bj = n0 >> 11, j = n0 & 2047; d0 = 256 * (j >> 7) + 128 * bj + (j & 127); }
#pragma unroll
    for (int i = 0; i < 8; ++i) { LAS float* d = scr + (8 * i + (lane >> 3)) * 33 + 4 * (lane & 7); d[0] = wv[i].x; d[1] = wv[i].y; d[2] = wv[i].z; d[3] = wv[i].w; }
    LDS_WAIT(); asm volatile("" ::: "memory");
    const int c = lane & 7;
#pragma unroll
    for (int j = 0; j < 4; ++j) { const int n = (lane >> 3) + 8 * j; const LAS float* s = scr + (8 * c) * 33 + n;
        v4u o; o.x = pk2(s[0 * 33], s[1 * 33]); o.y = pk2(s[2 * 33], s[3 * 33]); o.z = pk2(s[4 * 33], s[5 * 33]); o.w = pk2(s[6 * 33], s[7 * 33]);
        if (t.mode == 3) { const int nn = d0 + n, kk = k0 + 8 * c;
            *(GAS v4u*)(t.WT + (size_t)((((nn >> 5) * 32 + (kk >> 4)) * 64) + ((kk >> 3) & 1) * 32 + (nn & 31)) * 8) = o; }
        else *(GAS v4u*)(t.WT + (size_t)(d0 + n) * t.K + k0 + 8 * c) = o; }
    LDS_WAIT(); asm volatile("" ::: "memory");
}
__device__ __forceinline__ void transpose_item(const float* W, int K, int N, bf16* WT, int mode, LAS float* scr, int item, int lane) {
    const TItem t{W, WT, K, N, mode, item}; f32x4 wv[8]; titem_load(t, lane, wv); titem_finish(t, scr, lane, wv);
}
template <class AP> __device__ __forceinline__ void phase_prologue(const AP a, LAS unsigned char* lds, int tid, int lane, int wave, int vcu, int G) {
    unsigned char* ws = a->ws;
    float* ada = (float*)(ws + WS_ADA);
    LAS float* sc = (LAS float*)lds;
    LAS float* red = (LAS float*)(lds + 32768);
    for (int i = tid; i < NB * DM; i += 512) sc[i] = silu1(a->c[i]);
    __syncthreads();
    for (int it = vcu; it < DEPTH * (ADA_W / 256); it += G) {
        const int l = it / (ADA_W / 256), cb = it % (ADA_W / 256), e0 = cb * 256 + 4 * lane;
        const float* wp = a->w_ada + ((size_t)l * DM + (size_t)wave * 256) * ADA_W + e0;
        f32x4 acc[4];
#pragma unroll
        for (int b = 0; b < 4; ++b) acc[b] = (f32x4){0.f, 0.f, 0.f, 0.f};
#pragma unroll 16
        for (int d = 0; d < 256; ++d) {
            const f32x4 wv = *(const GAS f32x4*)(wp + (size_t)d * ADA_W);
#pragma unroll
            for (int b = 0; b < 4; ++b) { const float s = sc[b * DM + wave * 256 + d]; acc[b] = acc[b] + wv * s; }
        }
#pragma unroll
        for (int b = 0; b < 4; ++b) *(LAS f32x4*)(red + (wave * 4 + b) * 256 + 4 * lane) = acc[b];
        __syncthreads();
        for (int o = tid; o < 4 * 256; o += 512) { const int b = o >> 8, e = o & 255; float s = 0.f;
#pragma unroll
            for (int w = 0; w < 8; ++w) s += red[(w * 4 + b) * 256 + e];
            ada[((size_t)l * NB + b) * ADA_W + cb * 256 + e] = s + a->b_ada[(size_t)l * ADA_W + cb * 256 + e]; }
        __syncthreads();
    }
    const int gw = vcu * NWAVES + wave, NGW = G * NWAVES, gt = gw * 64 + lane, NGT = NGW * 64;
    { float* lb = (float*)(ws + WS_LB);
      for (int col = gt; col < DM; col += NGT) { float z[DEPTH], mx = -1e30f;
#pragma unroll
          for (int j = 0; j < DEPTH; ++j) { z[j] = a->hgrn_lb[j * DM + col]; mx = fmaxf(mx, z[j]); }
          float s = 0.f, e1 = 0.f;
#pragma unroll
          for (int j = 0; j < DEPTH; ++j) { const float e = __expf(z[j] - mx); s += e; if (j == 1) e1 = e; }
          lb[col] = e1 / s; } }
    { float* ct = (float*)(ws + WS_ROT); float* st = ct + (size_t)M * 128;
      for (int i = gt; i < M * 128; i += NGT) { const int m = i >> 7, f = i & 127;
          const float inv = exp2f(-(float)f * (13.287712379549449f / 128.0f));
          const float ang = (float)a->pos[m] * inv;
          const double rev = (double)ang * 0.15915494309189535; const float fr = (float)(rev - floor(rev));
          ct[i] = __builtin_amdgcn_cosf(fr); st[i] = __builtin_amdgcn_sinf(fr); } }
    LAS float* scr = (LAS float*)(lds + wave * 16384);
    constexpr int I_POOL = 8 * (512 / 64) * (512 / 32), I_HGI = (DM / 64) * (HG_IN / 32), I_FFI1 = (DM / 64) * (FF2 / 32), I_FFO1 = (FF / 64) * (DM / 32);
    constexpr int NITEMS = I_POOL + I_HGI + I_FFI1 + I_FFO1;
#define EARLY_DECODE(t_, it_) do { int r = (it_); \
        if (r < I_POOL) { const int mt = r / 128; t_ = TItem{a->pool_w + (size_t)mt * 512 * 512, (bf16*)(ws + WS_POOLW) + (size_t)mt * 512 * 512, 512, 512, 3, r % 128}; break; } r -= I_POOL; \
        if (r < I_HGI) { t_ = TItem{a->hgrn_w_in, (bf16*)(ws + WS_HGWIN), DM, HG_IN, 2, r}; break; } r -= I_HGI; \
        if (r < I_FFI1) { t_ = TItem{a->ffn_w_in, (bf16*)(ws + WS_FFWIN), DM, FF2, 1, r}; break; } r -= I_FFI1; \
        t_ = TItem{a->ffn_w_out, (bf16*)(ws + WS_FFWOUT), FF, DM, 0, r}; } while (0)
    { const bool balc = (G == 256); const int NGVC = DEPTH * (ADA_W / 256);
      const int lgs = (balc && vcu >= NGVC) ? 2 : 0, NGWV = balc ? NGVC * NWAVES + (G - NGVC) * NWAVES * 4 : NGW;
      const int vb = balc ? (vcu < NGVC ? gw : NGVC * NWAVES + ((vcu - NGVC) * NWAVES + wave) * 4) : gw;
#define QITEM(q) (vb + ((q) & ((1 << lgs) - 1)) + ((q) >> lgs) * NGWV)
      if (QITEM(0) < NITEMS) {
        TItem t0, t1, t2; f32x4 w0[8], w1[8], w2[8];
        EARLY_DECODE(t0, QITEM(0)); titem_load(t0, lane, w0);
        t1 = t0; if (QITEM(1) < NITEMS) { EARLY_DECODE(t1, QITEM(1)); titem_load(t1, lane, w1); }
        for (int q = 0; QITEM(q) < NITEMS; q += 3) {
            if (QITEM(q + 2) < NITEMS) { EARLY_DECODE(t2, QITEM(q + 2)); titem_load(t2, lane, w2); }
            __builtin_amdgcn_sched_barrier(0);
            titem_finish(t0, scr, lane, w0);
            if (QITEM(q + 1) >= NITEMS) break;
            if (QITEM(q + 3) < NITEMS) { EARLY_DECODE(t0, QITEM(q + 3)); titem_load(t0, lane, w0); }
            __builtin_amdgcn_sched_barrier(0);
            titem_finish(t1, scr, lane, w1);
            if (QITEM(q + 2) >= NITEMS) break;
            if (QITEM(q + 4) < NITEMS) { EARLY_DECODE(t1, QITEM(q + 4)); titem_load(t1, lane, w1); }
            __builtin_amdgcn_sched_barrier(0);
            titem_finish(t2, scr, lane, w2);
        }
      }
#undef QITEM
    }
#undef EARLY_DECODE
    { const int l31 = lane & 31, h5 = lane >> 5;
      const __amdgpu_buffer_rsrc_t rsX = __builtin_amdgcn_make_buffer_rsrc((void*)a->x, (short)0, M * DM * 4, 0x00020000);
      const __amdgpu_buffer_rsrc_t rsC = __builtin_amdgcn_make_buffer_rsrc((void*)(ws + WS_H2), (short)0, M * DM * 2, 0x00020000);
      const bool bal = (G == 256); const int NGV = DEPTH * (ADA_W / 256);
      const int rpa = bal ? (vcu < NGV ? gw : NGV * NWAVES + (vcu - NGV) * NWAVES + wave) : gw, rps = bal ? (vcu < NGV ? M : (G - NGV) * NWAVES) : NGW;
      for (int rp = rpa; rp < M / 2; rp += rps) {
          const int row = 2 * rp + h5; const unsigned vo = (unsigned)row * (DM * 4) + (unsigned)l31 * 32u, vob = (unsigned)row * (DM * 2) + (unsigned)l31 * 16u;
          v4u q0[8], q1[8];
#pragma unroll
          for (int j = 0; j < 8; ++j) { q0[j] = __builtin_amdgcn_raw_buffer_load_b128(rsX, vo, (unsigned)j * 1024u, 0); q1[j] = __builtin_amdgcn_raw_buffer_load_b128(rsX, vo, (unsigned)j * 1024u + 16u, 0); }
          float ss = 0.f;
#pragma unroll
          for (int j = 0; j < 8; ++j) { const f32x4 p = __builtin_bit_cast(f32x4, q0[j]), c = __builtin_bit_cast(f32x4, q1[j]);
              ss += ((p.x * p.x + p.y * p.y) + (p.z * p.z + p.w * p.w)) + ((c.x * c.x + c.y * c.y) + (c.z * c.z + c.w * c.w));
              v4u o; o.x = pk2(p.x, p.y); o.y = pk2(p.z, p.w); o.z = pk2(c.x, c.y); o.w = pk2(c.z, c.w);
              __builtin_amdgcn_raw_buffer_store_b128(o, rsC, vob, (unsigned)j * 512u, 0); }
          ss = half_sum(ss);
          if (l31 == 0) ((float*)(ws + WS_XRS))[row] = 1.0f / sqrtf(ss * (1.0f / DM) + EPS);
      }
    }
}
template <class AP> __device__ __forceinline__ void phase_convert_late(const AP a, LAS unsigned char* lds, int lane, int wave, int gwc, int NGWC) {
    unsigned char* ws = a->ws;
    LAS float* scr = (LAS float*)(lds + wave * 16384);
    constexpr int I_HGO = (DM / 64) * (DM / 32), I_RTI = (DM / 64) * (RT_IN / 32), I_RTO = (RT_V / 64) * (DM / 32), I_FFI1 = (DM / 64) * (FF2 / 32), I_FFO1 = (FF / 64) * (DM / 32);
    constexpr int NITEMS = I_HGO + I_RTI + I_RTO + 3 * I_FFI1 + 3 * I_FFO1;
#define LATE_DECODE(t_, it_) do { int r = (it_); \
        if (r < I_HGO) { t_ = TItem{a->hgrn_w_out, (bf16*)(ws + WS_HGWOUT), DM, DM, 0, r}; break; } r -= I_HGO; \
        if (r < I_RTI) { t_ = TItem{a->ret_w_in, (bf16*)(ws + WS_RTWIN), DM, RT_IN, 0, r}; break; } r -= I_RTI; \
        if (r < I_RTO) { t_ = TItem{a->ret_w_out, (bf16*)(ws + WS_RTWOUT), RT_V, DM, 0, r}; break; } r -= I_RTO; \
        if (r < 3 * I_FFI1) { const int l = 1 + r / I_FFI1; t_ = TItem{a->ffn_w_in + (size_t)l * DM * FF2, (bf16*)(ws + WS_FFWIN) + (size_t)l * FF2 * DM, DM, FF2, 1, r % I_FFI1}; break; } r -= 3 * I_FFI1; \
        { const int l = 1 + r / I_FFO1; t_ = TItem{a->ffn_w_out + (size_t)l * FF * DM, (bf16*)(ws + WS_FFWOUT) + (size_t)l * DM * FF, FF, DM, 0, r % I_FFO1}; } } while (0)
    if (gwc >= NITEMS) return;
    TItem t0, t1, t2; f32x4 w0[8], w1[8], w2[8];
    LATE_DECODE(t0, gwc); titem_load(t0, lane, w0);
    t1 = t0; if (gwc + NGWC < NITEMS) { LATE_DECODE(t1, gwc + NGWC); titem_load(t1, lane, w1); }
    for (int it = gwc; it < NITEMS; it += 3 * NGWC) {
        if (it + 2 * NGWC < NITEMS) { LATE_DECODE(t2, it + 2 * NGWC); titem_load(t2, lane, w2); }
        __builtin_amdgcn_sched_barrier(0);
        titem_finish(t0, scr, lane, w0);
        if (it + NGWC >= NITEMS) break;
        if (it + 3 * NGWC < NITEMS) { LATE_DECODE(t0, it + 3 * NGWC); titem_load(t0, lane, w0); }
        __builtin_amdgcn_sched_barrier(0);
        titem_finish(t1, scr, lane, w1);
        if (it + 2 * NGWC >= NITEMS) break;
        if (it + 4 * NGWC < NITEMS) { LATE_DECODE(t1, it + 4 * NGWC); titem_load(t1, lane, w1); }
        __builtin_amdgcn_sched_barrier(0);
        titem_finish(t2, scr, lane, w2);
    }
#undef LATE_DECODE
}

struct WTile { const float* W; bf16* WT; int K, N, mode, idx; };
__device__ __forceinline__ void wtile_load(const WTile& t, int lane, int wave, f32x4 (&wv)[8]) {
    const int nblk = t.N >> 7, k0 = 128 * (t.idx / nblk), n0 = 128 * (t.idx % nblk);
#pragma unroll
    for (int i = 0; i < 8; ++i) wv[i] = *(const GAS f32x4*)(t.W + (size_t)(k0 + 16 * wave + 2 * i + (lane >> 5)) * t.N + n0 + 4 * (lane & 31));
}
__device__ __forceinline__ void wtile_to_lds(LAS unsigned char* T, int lane, int wave, const f32x4 (&wv)[8]) {
#pragma unroll
    for (int i = 0; i < 8; ++i) { const int r = 16 * wave + 2 * i + (lane >> 5); *(LAS f32x4*)(T + r * 512 + (((lane & 31) ^ ((r >> 3) & 7)) << 4)) = wv[i]; }
}
__device__ __forceinline__ void wtile_store(const WTile& t, const LAS unsigned char* T, int lane, int wave) {
    const int nblk = t.N >> 7, k0 = 128 * (t.idx / nblk), n0 = 128 * (t.idx % nblk);
    const int c = (lane & 7) + 8 * (lane >> 5), nl = (lane >> 3) & 3;
#pragma unroll
    for (int p = 0; p < 4; ++p) { const int nloc = 16 * wave + 4 * p + nl, n = n0 + nloc;
        const LAS float* s = (const LAS float*)(T + (8 * c) * 512 + (((nloc >> 2) ^ (lane & 7)) << 4) + (nloc & 3) * 4);
        v4u o; o.x = pk2(s[0 * 128], s[1 * 128]); o.y = pk2(s[2 * 128], s[3 * 128]); o.z = pk2(s[4 * 128], s[5 * 128]); o.w = pk2(s[6 * 128], s[7 * 128]);
        int d = n;
        if (t.mode == 1) { const int nb = n & ~31, bj = nb >= FF ? 1 : 0, j = nb - bj * FF; d = 256 * (j >> 7) + 128 * bj + (j & 127) + (n & 31); }
        *(GAS v4u*)(t.WT + (size_t)d * t.K + k0 + 8 * c) = o; }
}
#define WT_BAR() do { asm volatile("s_waitcnt lgkmcnt(0)" ::: "memory"); __builtin_amdgcn_s_barrier(); asm volatile("" ::: "memory"); } while (0)
template <class AP> __device__ __forceinline__ void phase_convert_late_tiles(const AP a, LAS unsigned char* lds, int lane, int wave, int wgc, int NWGC) {
    unsigned char* ws = a->ws;
    constexpr int T_HGO = (DM / 128) * (DM / 128), T_RTI = (DM / 128) * (RT_IN / 128), T_RTO = (RT_V / 128) * (DM / 128), T_FFI = (DM / 128) * (FF2 / 128), T_FFO = (FF / 128) * (DM / 128);
    constexpr int NT = T_HGO + T_RTI + T_RTO + 3 * T_FFI + 3 * T_FFO;
#define LATE_TDEC(t_, it_) do { int r = (it_); \
        if (r < T_HGO) { t_ = WTile{a->hgrn_w_out, (bf16*)(ws + WS_HGWOUT), DM, DM, 0, r}; break; } r -= T_HGO; \
        if (r < T_RTI) { t_ = WTile{a->ret_w_in, (bf16*)(ws + WS_RTWIN), DM, RT_IN, 0, r}; break; } r -= T_RTI; \
        if (r < T_RTO) { t_ = WTile{a->ret_w_out, (bf16*)(ws + WS_RTWOUT), RT_V, DM, 0, r}; break; } r -= T_RTO; \
        if (r < 3 * T_FFI) { const int l = 1 + r / T_FFI; t_ = WTile{a->ffn_w_in + (size_t)l * DM * FF2, (bf16*)(ws + WS_FFWIN) + (size_t)l * FF2 * DM, DM, FF2, 1, r % T_FFI}; break; } r -= 3 * T_FFI; \
        { const int l = 1 + r / T_FFO; t_ = WTile{a->ffn_w_out + (size_t)l * FF * DM, (bf16*)(ws + WS_FFWOUT) + (size_t)l * DM * FF, FF, DM, 0, r % T_FFO}; } } while (0)
    if (wgc >= NT) return;
    WTile tc, tn; f32x4 wv[8];
    LATE_TDEC(tc, wgc); wtile_load(tc, lane, wave, wv);
    for (int it = wgc; it < NT; it += NWGC) {
        WT_BAR();
        wtile_to_lds(lds, lane, wave, wv);
        const bool more = it + NWGC < NT;
        tn = tc; if (more) { LATE_TDEC(tn, it + NWGC); wtile_load(tn, lane, wave, wv); }
        WT_BAR();
        wtile_store(tc, lds, lane, wave);
        tc = tn;
    }
    WT_BAR();
#undef LATE_TDEC
}

__device__ __forceinline__ void phase_normmod(const float* hin, const float* g, const float* shift, const float* scale  , bf16* U, int gw, int NGW, int lane) {
    for (int r0 = gw * 8; r0 < M; r0 += NGW * 8) {
        const int b = r0 >> 12; const float* sh = shift + (size_t)b * ADA_W; const float* scp = scale + (size_t)b * ADA_W;
        f32x4 mul[8], add[8];
#pragma unroll
        for (int j = 0; j < 8; ++j) { const int col = 4 * lane + 256 * j; const f32x4 gv = *(const GAS f32x4*)(g + col), s = *(const GAS f32x4*)(scp + col); mul[j] = gv * (s + 1.0f); add[j] = *(const GAS f32x4*)(sh + col); }
        for (int rr = 0; rr < 8; ++rr) {
            const GAS f32x4* xr = (const GAS f32x4*)(hin + (size_t)(r0 + rr) * DM) + lane;
            f32x4 v[8]; float ss = 0.f;
#pragma unroll
            for (int j = 0; j < 8; ++j) { v[j] = xr[64 * j]; ss += (v[j].x * v[j].x + v[j].y * v[j].y) + (v[j].z * v[j].z + v[j].w * v[j].w); }
            const float rstd = 1.0f / sqrtf(wave_sum(ss) * (1.0f / DM) + EPS);
            GAS v2u* o8 = (GAS v2u*)(U + (size_t)(r0 + rr) * DM) + lane;
#pragma unroll
            for (int j = 0; j < 8; ++j) { const f32x4 y = v[j] * rstd * mul[j] + add[j]; v2u w; w.x = pk2(y.x, y.y); w.y = pk2(y.z, y.w); o8[64 * j] = w; }
        }
    }
}
__device__ __forceinline__ void phase_normmod_bf(const bf16* hin, const float* g, const float* shift, const float* scale  , bf16* U, int gw, int NGW, int lane) {
    for (int r0 = gw * 8; r0 < M; r0 += NGW * 8) {
        const int b = r0 >> 12; const float* sh = shift + (size_t)b * ADA_W; const float* scp = scale + (size_t)b * ADA_W;
        f32x4 mul[8], add[8];
#pragma unroll
        for (int j = 0; j < 8; ++j) { const int col = 8 * lane + 512 * (j >> 1) + 4 * (j & 1); const f32x4 gv = *(const GAS f32x4*)(g + col), s = *(const GAS f32x4*)(scp + col); mul[j] = gv * (s + 1.0f); add[j] = *(const GAS f32x4*)(sh + col); }
        for (int rr = 0; rr < 8; ++rr) {
            const GAS v4u* xr = (const GAS v4u*)(hin + (size_t)(r0 + rr) * DM) + lane;
            f32x4 v[8]; float ss = 0.f;
#pragma unroll
            for (int j = 0; j < 4; ++j) { const v4u q = xr[64 * j]; v[2 * j] = (f32x4){bflo(q.x), bfhi(q.x), bflo(q.y), bfhi(q.y)}; v[2 * j + 1] = (f32x4){bflo(q.z), bfhi(q.z), bflo(q.w), bfhi(q.w)}; }
#pragma unroll
            for (int j = 0; j < 8; ++j) ss += (v[j].x * v[j].x + v[j].y * v[j].y) + (v[j].z * v[j].z + v[j].w * v[j].w);
            const float rstd = 1.0f / sqrtf(wave_sum(ss) * (1.0f / DM) + EPS);
            GAS v4u* o16 = (GAS v4u*)(U + (size_t)(r0 + rr) * DM) + lane;
#pragma unroll
            for (int j = 0; j < 4; ++j) { const f32x4 y0 = v[2 * j] * rstd * mul[2 * j] + add[2 * j], y1 = v[2 * j + 1] * rstd * mul[2 * j + 1] + add[2 * j + 1];
                v4u w; w.x = pk2(y0.x, y0.y); w.y = pk2(y0.z, y0.w); w.z = pk2(y1.x, y1.y); w.w = pk2(y1.z, y1.w); o16[64 * j] = w; }
        }
    }
}
__device__ __forceinline__ void phase_finalnorm_bf(const bf16* hin, const float* g, float* out, int gw, int NGW, int lane) {
    for (int r0 = gw * 8; r0 < M; r0 += NGW * 8) {
        f32x4 mul[8];
#pragma unroll
        for (int j = 0; j < 8; ++j) mul[j] = *(const GAS f32x4*)(g + 8 * lane + 512 * (j >> 1) + 4 * (j & 1));
        for (int rr = 0; rr < 8; ++rr) {
            const GAS v4u* xr = (const GAS v4u*)(hin + (size_t)(r0 + rr) * DM) + lane;
            f32x4 v[8]; float ss = 0.f;
#pragma unroll
            for (int j = 0; j < 4; ++j) { const v4u q = xr[64 * j]; v[2 * j] = (f32x4){bflo(q.x), bfhi(q.x), bflo(q.y), bfhi(q.y)}; v[2 * j + 1] = (f32x4){bflo(q.z), bfhi(q.z), bflo(q.w), bfhi(q.w)}; }
#pragma unroll
            for (int j = 0; j < 8; ++j) ss += (v[j].x * v[j].x + v[j].y * v[j].y) + (v[j].z * v[j].z + v[j].w * v[j].w);
            const float rstd = 1.0f / sqrtf(wave_sum(ss) * (1.0f / DM) + EPS);
            float* orow = out + (size_t)(r0 + rr) * DM + 8 * lane;
#pragma unroll
            for (int j = 0; j < 8; ++j) *(GAS f32x4*)(orow + 512 * (j >> 1) + 4 * (j & 1)) = v[j] * rstd * mul[j];
        }
    }
}
__device__ __forceinline__ void phase_finalnorm(const float* hin, const float* g, float* out, int gw, int NGW, int lane) {
    for (int r0 = gw * 8; r0 < M; r0 += NGW * 8) {
        f32x4 mul[8];
#pragma unroll
        for (int j = 0; j < 8; ++j) mul[j] = *(const GAS f32x4*)(g + 4 * lane + 256 * j);
        for (int rr = 0; rr < 8; ++rr) {
            const GAS f32x4* xr = (const GAS f32x4*)(hin + (size_t)(r0 + rr) * DM) + lane;
            f32x4 v[8]; float ss = 0.f;
#pragma unroll
            for (int j = 0; j < 8; ++j) { v[j] = xr[64 * j]; ss += (v[j].x * v[j].x + v[j].y * v[j].y) + (v[j].z * v[j].z + v[j].w * v[j].w); }
            const float rstd = 1.0f / sqrtf(wave_sum(ss) * (1.0f / DM) + EPS);
            GAS f32x4* o = (GAS f32x4*)(out + (size_t)(r0 + rr) * DM) + lane;
#pragma unroll
            for (int j = 0; j < 8; ++j) o[64 * j] = v[j] * rstd * mul[j];
        }
    }
}
__device__ __forceinline__ void phase_pool(const bf16* U, bf16* Pb, int gw, int NGW, int lane) {
    for (int it = gw; it < (M / 32) * 4; it += NGW) {
        const int gi = it & 3, rw = it >> 2, w = 2 << gi, col = gi * 512 + lane * 8;
        for (int rr = 0; rr < 32; ++rr) {
            const int m = rw * 32 + rr, tpos = m & (SEQ - 1), cnt = (tpos + 1 < w) ? tpos + 1 : w;
            float acc[8];
#pragma unroll
            for (int e = 0; e < 8; ++e) acc[e] = 0.f;
            float cur[8];
            for (int j = 0; j < cnt; ++j) {
                const v4u q = *(const GAS v4u*)(U + (size_t)(m - j) * DM + col);
                const float f0 = bflo(q.x), f1 = bfhi(q.x), f2 = bflo(q.y), f3 = bfhi(q.y), f4 = bflo(q.z), f5 = bfhi(q.z), f6 = bflo(q.w), f7 = bfhi(q.w);
                if (j == 0) { cur[0] = f0; cur[1] = f1; cur[2] = f2; cur[3] = f3; cur[4] = f4; cur[5] = f5; cur[6] = f6; cur[7] = f7; }
                acc[0] += f0; acc[1] += f1; acc[2] += f2; acc[3] += f3; acc[4] += f4; acc[5] += f5; acc[6] += f6; acc[7] += f7;
            }
            const float inv = 1.0f / (float)cnt;
            v4u o; o.x = pk2(acc[0] * inv - cur[0], acc[1] * inv - cur[1]); o.y = pk2(acc[2] * inv - cur[2], acc[3] * inv - cur[3]);
            o.z = pk2(acc[4] * inv - cur[4], acc[5] * inv - cur[5]); o.w = pk2(acc[6] * inv - cur[6], acc[7] * inv - cur[7]);
            *(GAS v4u*)(Pb + (size_t)m * DM + col) = o;
        }
    }
}

__device__ __forceinline__ void phase_hgrn_scan_naive(const bf16* PROJ, const float* lbv, float* O, LAS unsigned char* lds, int tid, int vcu, int G) {
    LAS float* qs = (LAS float*)lds;
    LAS float* fs = qs + 16 * 128;
    LAS float* ks = fs + 16 * 128;
    LAS float* vs = ks + 16 * 128;
    const int v = tid >> 4, dg = tid & 15;
    for (int unit = vcu; unit < NB * HG_H * 4; unit += G) {
        const int b = unit >> 6, h = (unit >> 2) & 15, vsl = unit & 3;
        float S[8];
#pragma unroll
        for (int e = 0; e < 8; ++e) S[e] = 0.f;
        const int lt = tid >> 5, ld4 = (tid & 31) * 4;
        float lbl[4];
#pragma unroll
        for (int e = 0; e < 4; ++e) lbl[e] = lbv[h * 128 + ld4 + e];
        for (int ch = 0; ch < SEQ / 16; ++ch) {
            const size_t m0 = (size_t)b * SEQ + (size_t)ch * 16;
            { const bf16* row = PROJ + (m0 + lt) * HG_IN + h * 128 + ld4;
              const v2u qv = *(const GAS v2u*)row, zv = *(const GAS v2u*)(row + 2048);
              const float qf[4] = {bflo(qv.x), bfhi(qv.x), bflo(qv.y), bfhi(qv.y)}, zf[4] = {bflo(zv.x), bfhi(zv.x), bflo(zv.y), bfhi(zv.y)};
#pragma unroll
              for (int e = 0; e < 4; ++e) { const float sg = sigmoid_f(zf[e]), l = lbl[e]; qs[lt * 128 + ld4 + e] = qf[e]; fs[lt * 128 + ld4 + e] = l + (1.0f - l) * sg; ks[lt * 128 + ld4 + e] = (1.0f - l) * (1.0f - sg); }
              vs[tid] = bf1(PROJ[(m0 + (tid >> 5)) * HG_IN + 4096 + h * 128 + vsl * 32 + (tid & 31)]); }
            __syncthreads();
            for (int tt = 0; tt < 16; ++tt) {
                const float vv = vs[tt * 32 + v]; float acc = 0.f;
#pragma unroll
                for (int e = 0; e < 8; ++e) { const int d = dg * 8 + e; S[e] = fs[tt * 128 + d] * S[e] + ks[tt * 128 + d] * vv; acc += S[e] * qs[tt * 128 + d]; }
                acc += __shfl_xor(acc, 1); acc += __shfl_xor(acc, 2); acc += __shfl_xor(acc, 4); acc += __shfl_xor(acc, 8);
                if (dg == 0) O[(m0 + tt) * DM + h * 128 + vsl * 32 + v] = acc;
            }
            __syncthreads();
        }
    }
}
__device__ __forceinline__ void phase_hgrn_post(const bf16* O, const bf16* PROJ, const float* ng, bf16* Pb, int gw, int NGW, int lane) {
    f32x4 nv[4][2];
#pragma unroll
    for (int j = 0; j < 4; ++j) { nv[j][0] = *(const GAS f32x4*)(ng + 512 * j + 8 * lane); nv[j][1] = *(const GAS f32x4*)(ng + 512 * j + 8 * lane + 4); }
    for (int m = gw; m < M; m += NGW) {
        const GAS v4u* orow = (const GAS v4u*)(O + (size_t)m * DM) + lane;
        const GAS v4u* grow = (const GAS v4u*)(PROJ + (size_t)m * HG_IN + 6144) + lane;
        GAS v4u* prow = (GAS v4u*)(Pb + (size_t)m * DM) + lane;
        v4u ob[4], gq[4];
#pragma unroll
        for (int j = 0; j < 4; ++j) { ob[j] = orow[64 * j]; gq[j] = grow[64 * j]; }
#pragma unroll
        for (int j = 0; j < 4; ++j) {
            const f32x4 o0 = (f32x4){bflo(ob[j].x), bfhi(ob[j].x), bflo(ob[j].y), bfhi(ob[j].y)}, o1 = (f32x4){bflo(ob[j].z), bfhi(ob[j].z), bflo(ob[j].w), bfhi(ob[j].w)};
            float ss = ((o0.x * o0.x + o0.y * o0.y) + (o0.z * o0.z + o0.w * o0.w)) + ((o1.x * o1.x + o1.y * o1.y) + (o1.z * o1.z + o1.w * o1.w));
            ss = row16_sum(ss);
            const float rstd = 1.0f / sqrtf(ss * (1.0f / 128.0f) + EPS);
            const v4u g = gq[j];
            v4u w; w.x = pk2(o0.x * rstd * nv[j][0].x * silu1(bflo(g.x)), o0.y * rstd * nv[j][0].y * silu1(bfhi(g.x))); w.y = pk2(o0.z * rstd * nv[j][0].z * silu1(bflo(g.y)), o0.w * rstd * nv[j][0].w * silu1(bfhi(g.y)));
            w.z = pk2(o1.x * rstd * nv[j][1].x * silu1(bflo(g.z)), o1.y * rstd * nv[j][1].y * silu1(bfhi(g.z))); w.w = pk2(o1.z * rstd * nv[j][1].z * silu1(bflo(g.w)), o1.w * rstd * nv[j][1].w * silu1(bfhi(g.w)));
            prow[64 * j] = w;
        }
    }
}
__device__ __forceinline__ void phase_ret_scan_naive(const bf16* PROJ, const float* rot, float* O, LAS unsigned char* lds, int tid, int vcu, int G) {
    LAS float* qs = (LAS float*)lds;
    LAS float* ks = qs + 16 * 256;
    LAS float* vs = ks + 16 * 256;
    const float* ct = rot; const float* st = rot + (size_t)M * 128;
    const int v = tid >> 3, dg = tid & 7;
    for (int unit = vcu; unit < NB * RT_H * 8; unit += G) {
        const int b = unit >> 6, h = (unit >> 3) & 7, vsl = unit & 7;
        const float gamma = 1.0f - exp2f(-5.0f - (float)h);
        float S[32];
#pragma unroll
        for (int e = 0; e < 32; ++e) S[e] = 0.f;
        const int lt = tid >> 5, li = (tid & 31) * 4;
        for (int ch = 0; ch < SEQ / 16; ++ch) {
            const size_t m0 = (size_t)b * SEQ + (size_t)ch * 16;
            { const size_t m = m0 + lt; const bf16* row = PROJ + m * RT_IN + h * 256 + li;
              const v2u q1 = *(const GAS v2u*)row, q2 = *(const GAS v2u*)(row + 128), k1 = *(const GAS v2u*)(row + 2048), k2 = *(const GAS v2u*)(row + 2048 + 128);
              const f32x4 cv = *(const GAS f32x4*)(ct + m * 128 + li), sv = *(const GAS f32x4*)(st + m * 128 + li);
              const float a1[4] = {bflo(q1.x), bfhi(q1.x), bflo(q1.y), bfhi(q1.y)}, a2[4] = {bflo(q2.x), bfhi(q2.x), bflo(q2.y), bfhi(q2.y)};
              const float b1[4] = {bflo(k1.x), bfhi(k1.x), bflo(k1.y), bfhi(k1.y)}, b2[4] = {bflo(k2.x), bfhi(k2.x), bflo(k2.y), bfhi(k2.y)};
#pragma unroll
              for (int e = 0; e < 4; ++e) { const float cc = cv[e], sn = sv[e];
                  qs[lt * 256 + li + e] = a1[e] * cc - a2[e] * sn; qs[lt * 256 + 128 + li + e] = a1[e] * sn + a2[e] * cc;
                  ks[lt * 256 + li + e] = (b1[e] * cc - b2[e] * sn) * 0.0625f; ks[lt * 256 + 128 + li + e] = (b1[e] * sn + b2[e] * cc) * 0.0625f; }
#pragma unroll
              for (int r = 0; r < 2; ++r) { const int idx = tid + r * 512, tt = idx >> 6, vv = idx & 63; vs[idx] = bf1(PROJ[(m0 + tt) * RT_IN + 4096 + h * 512 + vsl * 64 + vv]); } }
            __syncthreads();
            for (int tt = 0; tt < 16; ++tt) {
                const float vv = vs[tt * 64 + v]; float acc = 0.f;
#pragma unroll
                for (int e = 0; e < 32; ++e) { const int d = dg * 32 + e; S[e] = gamma * S[e] + ks[tt * 256 + d] * vv; acc += S[e] * qs[tt * 256 + d]; }
                acc += __shfl_xor(acc, 1); acc += __shfl_xor(acc, 2); acc += __shfl_xor(acc, 4);
                if (dg == 0) O[(m0 + tt) * RT_V + h * 512 + vsl * 64 + v] = acc;
            }
            __syncthreads();
        }
    }
}
__device__ __forceinline__ void phase_ret_post(const bf16* O, const bf16* PROJ, const float* ng, bf16* Pb, int gw, int NGW, int lane) {
    f32x4 nv[8][2];
#pragma unroll
    for (int hh = 0; hh < 8; ++hh) { nv[hh][0] = *(const GAS f32x4*)(ng + 512 * hh + 8 * lane); nv[hh][1] = *(const GAS f32x4*)(ng + 512 * hh + 8 * lane + 4); }
    for (int m = gw; m < M; m += NGW) {
        const GAS v4u* orow = (const GAS v4u*)(O + (size_t)m * RT_V) + lane;
        const GAS v4u* grow = (const GAS v4u*)(PROJ + (size_t)m * RT_IN + 8192) + lane;
        GAS v4u* prow = (GAS v4u*)(Pb + (size_t)m * RT_V) + lane;
        v4u ob[8], gq[8];
#pragma unroll
        for (int hh = 0; hh < 8; ++hh) { ob[hh] = orow[64 * hh]; gq[hh] = grow[64 * hh]; }
#pragma unroll
        for (int hh = 0; hh < 8; ++hh) {
            const f32x4 o0 = (f32x4){bflo(ob[hh].x), bfhi(ob[hh].x), bflo(ob[hh].y), bfhi(ob[hh].y)}, o1 = (f32x4){bflo(ob[hh].z), bfhi(ob[hh].z), bflo(ob[hh].w), bfhi(ob[hh].w)};
            const float ss = ((o0.x * o0.x + o0.y * o0.y) + (o0.z * o0.z + o0.w * o0.w)) + ((o1.x * o1.x + o1.y * o1.y) + (o1.z * o1.z + o1.w * o1.w));
            const float rstd = 1.0f / sqrtf(wave_sum(ss) * (1.0f / 512.0f) + EPS);
            const v4u g = gq[hh];
            v4u w; w.x = pk2(o0.x * rstd * nv[hh][0].x * silu1(bflo(g.x)), o0.y * rstd * nv[hh][0].y * silu1(bfhi(g.x))); w.y = pk2(o0.z * rstd * nv[hh][0].z * silu1(bflo(g.y)), o0.w * rstd * nv[hh][0].w * silu1(bfhi(g.y)));
            w.z = pk2(o1.x * rstd * nv[hh][1].x * silu1(bflo(g.z)), o1.y * rstd * nv[hh][1].y * silu1(bfhi(g.z))); w.w = pk2(o1.z * rstd * nv[hh][1].z * silu1(bflo(g.w)), o1.w * rstd * nv[hh][1].w * silu1(bfhi(g.w)));
            prow[64 * hh] = w;
        }
    }
}

typedef float f32x16 __attribute__((ext_vector_type(16)));
typedef short s16x4 __attribute__((ext_vector_type(4)));
typedef short s16x8 __attribute__((ext_vector_type(8)));
__device__ __forceinline__ unsigned off_b(unsigned row, unsigned ch) { return 256u * row + 16u * (ch ^ (((row & 3u) << 2) | ((row >> 2) & 3u))); }
__device__ __forceinline__ s16x8 tr_frag_b(LAS unsigned char* img, int lane, int c, int ks) {
    const unsigned h = lane >> 5, blk = (lane >> 4) & 1, q = (lane & 15) >> 2, p = lane & 3;
    const unsigned a0 = off_b(16 * ks + 8 * h + q, 4 * c + 2 * blk + (p >> 1)) + 8 * (p & 1), a1 = off_b(16 * ks + 8 * h + 4 + q, 4 * c + 2 * blk + (p >> 1)) + 8 * (p & 1);
    const s16x4 x = __builtin_amdgcn_ds_read_tr16_b64_v4i16((LAS s16x4*)(img + a0)), y = __builtin_amdgcn_ds_read_tr16_b64_v4i16((LAS s16x4*)(img + a1));
    return (s16x8){x[0], x[1], x[2], x[3], y[0], y[1], y[2], y[3]};
}
__device__ __forceinline__ unsigned trb_base(int lane, int c, int tt) {
    const unsigned h = lane >> 5, blk = (lane >> 4) & 1, q = (lane & 15) >> 2, p = lane & 3;
    return 256u * (8 * h + 4 * tt + q) + 16u * ((4 * c + 2 * blk + (p >> 1)) ^ ((q << 2) | ((2 * h + tt) & 3))) + 8 * (p & 1);
}
__device__ __forceinline__ s16x8 tr_frag_b2(LAS unsigned char* img, unsigned b0, unsigned b1, int ks) {
    const s16x4 x = __builtin_amdgcn_ds_read_tr16_b64_v4i16((LAS s16x4*)(img + b0 + 4096 * ks)), y = __builtin_amdgcn_ds_read_tr16_b64_v4i16((LAS s16x4*)(img + b1 + 4096 * ks));
    return (s16x8){x[0], x[1], x[2], x[3], y[0], y[1], y[2], y[3]};
}
__device__ __forceinline__ s16x8 tr_frag_plain(LAS unsigned char* img, int rs, int lane, int c, int ks) {
    const unsigned h = lane >> 5, blk = (lane >> 4) & 1, q = (lane & 15) >> 2, p = lane & 3;
    const unsigned a0 = (16 * ks + 8 * h + q) * rs + (32 * c + 16 * blk + 4 * p) * 2, a1 = a0 + 4 * rs;
    const s16x4 x = __builtin_amdgcn_ds_read_tr16_b64_v4i16((LAS s16x4*)(img + a0)), y = __builtin_amdgcn_ds_read_tr16_b64_v4i16((LAS s16x4*)(img + a1));
    return (s16x8){x[0], x[1], x[2], x[3], y[0], y[1], y[2], y[3]};
}
__device__ __forceinline__ f32x16 mfma32(s16x8 a, s16x8 b, f32x16 c) { return __builtin_amdgcn_mfma_f32_32x32x16_bf16(a, b, c, 0, 0, 0); }
__device__ __forceinline__ f32x16 zero16() { f32x16 z;
#pragma unroll
    for (int i = 0; i < 16; ++i) z[i] = 0.f; return z; }
__device__ __forceinline__ v4u scale_bf8(v4u q, float f) { v4u o; o.x = pk2(bflo(q.x) * f, bfhi(q.x) * f); o.y = pk2(bflo(q.y) * f, bfhi(q.y) * f); o.z = pk2(bflo(q.z) * f, bfhi(q.z) * f); o.w = pk2(bflo(q.w) * f, bfhi(q.w) * f); return o; }

__device__ __forceinline__ void phase_ret_scan(const bf16* PROJ, bf16* O, LAS unsigned char* lds, int tid, int vcu, int G) {
    constexpr int QN = 0, QRS = 528, KN = 33792, VV = KN + 32768, PI = VV + 16384, PRS = 144, ST = PI + 9216, SRS = 528, LDS_END = ST + 33792;
    static_assert(LDS_END <= RING_BYTES, "retention scan LDS map");
    const int lane = tid & 63, wave = __builtin_amdgcn_readfirstlane(tid >> 6);
    for (int unit = vcu; unit < NB * RT_H * 8; unit += G) {
        const int b = unit >> 6, h = (unit >> 3) & 7, vsl = unit & 7;
        const float lg = __log2f(1.0f - exp2f(-5.0f - (float)h));
        const float g64 = exp2f(64.0f * lg);
        f32x16 S[2][2];
#pragma unroll
        for (int a = 0; a < 2; ++a)
#pragma unroll
            for (int c = 0; c < 2; ++c) S[a][c] = zero16();
        for (int i = tid; i < 33792 / 16; i += 512) *(LAS v4u*)(lds + ST + i * 16) = (v4u){0u, 0u, 0u, 0u};
        v4u pq[4], pk[4], pv;
        const __amdgpu_buffer_rsrc_t rsP = __builtin_amdgcn_make_buffer_rsrc((void*)(PROJ + (size_t)b * SEQ * RT_IN), (short)0, SEQ * RT_IN * 2, 0x00020000);
        const __amdgpu_buffer_rsrc_t rsO = __builtin_amdgcn_make_buffer_rsrc((void*)(O + (size_t)b * SEQ * RT_V), (short)0, SEQ * RT_V * 2, 0x00020000);
        const int vrow = tid >> 3, vch = tid & 7;
        const unsigned voq = (unsigned)((tid >> 5) * RT_IN + (tid & 31) * 8) * 2u, vov = (unsigned)(vrow * RT_IN + vch * 8) * 2u;
        const unsigned soq = (unsigned)(h * 256) * 2u, sok = (unsigned)(2048 + h * 256) * 2u, sov = (unsigned)(4096 + h * 512 + vsl * 64) * 2u;
#define RS_PREFETCH(chn) do { const unsigned cb_ = (unsigned)(chn) * 64u * RT_IN * 2u; _Pragma("unroll") for (int i = 0; i < 4; ++i) { \
            pq[i] = __builtin_amdgcn_raw_buffer_load_b128(rsP, voq, cb_ + (unsigned)i * 16u * RT_IN * 2u + soq, 0); pk[i] = __builtin_amdgcn_raw_buffer_load_b128(rsP, voq, cb_ + (unsigned)i * 16u * RT_IN * 2u + sok, 0); } \
            pv = __builtin_amdgcn_raw_buffer_load_b128(rsP, vov, cb_ + sov, 0); } while (0)
        RS_PREFETCH(0);
        float dec[16];
        { const int a31 = lane & 31, a5 = lane >> 5, w4 = wave & 3, t_i = w4 >> 1, x_i = w4 & 1;
#pragma unroll
          for (int r = 0; r < 16; ++r) {
              if (wave < 4) { const int t = 32 * x_i + a31, s = 32 * t_i + 8 * (r >> 2) + 4 * a5 + (r & 3); dec[r] = (s <= t) ? __builtin_amdgcn_exp2f((float)(t - s) * lg) : 0.f; }
              else { const int t = 32 * t_i + (r & 3) + 8 * (r >> 2) + 4 * a5; dec[r] = __builtin_amdgcn_exp2f((float)(t + 1) * lg); } } }
        unsigned opk[8];
#pragma unroll
        for (int i = 0; i < 8; ++i) opk[i] = 0u;
        for (int ch = 0; ch < SEQ / 64; ++ch) {
#pragma unroll
            for (int i = 0; i < 4; ++i) { const int cid = tid + 512 * i, row = cid >> 5, chq = cid & 31;
                *(LAS v4u*)(lds + QN + row * QRS + chq * 16) = pq[i];
                *(LAS v4u*)(lds + KN + (chq >> 4) * 16384 + off_b(row, chq & 15)) = pk[i]; }
            *(LAS v4u*)(lds + VV + off_b(vrow, vch)) = pv;
            *(LAS v4u*)(lds + VV + off_b(vrow, 8 + vch)) = scale_bf8(pv, __builtin_amdgcn_exp2f((float)(63 - vrow) * lg));
            __syncthreads();
#define RS_STORE_O(chs) do { if (wave >= 4) { const int w4s = wave & 3, tis = w4s >> 1, vis = w4s & 1; const int lnS = lane; \
                const unsigned voo = (unsigned)(4 * (lnS >> 5) * RT_V + h * 512 + vsl * 64 + 32 * vis + (lnS & 31)) * 2u; \
                _Pragma("unroll") for (int r = 0; r < 16; ++r) { const unsigned pr_ = opk[r >> 1]; \
                    __builtin_amdgcn_raw_buffer_store_b16((unsigned short)((r & 1) ? (pr_ >> 16) : (pr_ & 0xffffu)), rsO, voo, (unsigned)((chs) * 64 + 32 * tis + (r & 3) + 8 * (r >> 2)) * RT_V * 2u, 0); } } } while (0)
            if (ch > 0) RS_STORE_O(ch - 1);
            if (ch + 1 < SEQ / 64) RS_PREFETCH(ch + 1);
            f32x16 acc = zero16();
            int lnA = lane; asm volatile("" : "+v"(lnA));
            const int a31 = lnA & 31, a5 = lnA >> 5;
            const int w4 = wave & 3, t_i = w4 >> 1, x_i = w4 & 1;
            s16x8 fa0[4], fb0[4], fa1[4], fb1[4];
            if (wave < 4) {
                const int si = t_i, ti = x_i;
#define RS_LD1A(fa, fb, g4) do { _Pragma("unroll") for (int j = 0; j < 2; ++j) { const int ks = 2 * (g4) + j; \
                    fa[j] = *(const LAS s16x8*)(lds + KN + (ks >> 3) * 16384 + off_b(32 * si + a31, 2 * (ks & 7) + a5)); \
                    fb[j] = *(const LAS s16x8*)(lds + QN + (32 * ti + a31) * QRS + (16 * ks + 8 * a5) * 2); } } while (0)
#define RS_MMA4(fa, fb) do { _Pragma("unroll") for (int j = 0; j < 4; ++j) acc = mfma32(fa[j], fb[j], acc); } while (0)
#define RS_MMA2(fa, fb) do { _Pragma("unroll") for (int j = 0; j < 2; ++j) acc = mfma32(fa[j], fb[j], acc); } while (0)
                RS_LD1A(fa0, fb0, 0); RS_LD1A(fa1, fb1, 1);
#pragma unroll
                for (int g2 = 0; g2 < 3; ++g2) { RS_MMA2(fa0, fb0); RS_LD1A(fa0, fb0, 2 * g2 + 2); RS_MMA2(fa1, fb1); RS_LD1A(fa1, fb1, 2 * g2 + 3); }
                RS_MMA2(fa0, fb0); RS_MMA2(fa1, fb1);
#undef RS_LD1A
                const int t = 32 * ti + a31;
#pragma unroll
                for (int g = 0; g < 4; ++g) { float pvv[4];
#pragma unroll
                    for (int e = 0; e < 4; ++e) pvv[e] = acc[4 * g + e] * dec[4 * g + e];
                    v2u w; w.x = pk2(pvv[0], pvv[1]); w.y = pk2(pvv[2], pvv[3]);
                    *(LAS v2u*)(lds + PI + t * PRS + (32 * si + 8 * g + 4 * a5) * 2) = w; }
            } else {
                const int ti = t_i, vi = x_i;
#define RS_LD1B(fa, fb, g4) do { _Pragma("unroll") for (int j = 0; j < 2; ++j) { const int ks = 2 * (g4) + j; \
                    fa[j] = *(const LAS s16x8*)(lds + QN + (32 * ti + a31) * QRS + (16 * ks + 8 * a5) * 2); \
                    fb[j] = *(const LAS s16x8*)(lds + ST + (32 * vi + a31) * SRS + (16 * ks + 8 * a5) * 2); } } while (0)
                RS_LD1B(fa0, fb0, 0); RS_LD1B(fa1, fb1, 1);
#pragma unroll
                for (int g2 = 0; g2 < 3; ++g2) { RS_MMA2(fa0, fb0); RS_LD1B(fa0, fb0, 2 * g2 + 2); RS_MMA2(fa1, fb1); RS_LD1B(fa1, fb1, 2 * g2 + 3); }
                RS_MMA2(fa0, fb0); RS_MMA2(fa1, fb1);
#undef RS_LD1B
#pragma unroll
                for (int r = 0; r < 16; ++r) acc[r] *= dec[r];
            }
            __syncthreads();
            if (wave < 4) {
                LAS unsigned char* kimg0 = lds + KN + ((2 * wave) >> 2) * 16384; LAS unsigned char* kimg1 = lds + KN + ((2 * wave + 1) >> 2) * 16384;
                const unsigned ka0 = trb_base(lnA, (2 * wave) & 3, 0), ka1 = trb_base(lnA, (2 * wave) & 3, 1), kb0 = trb_base(lnA, (2 * wave + 1) & 3, 0), kb1 = trb_base(lnA, (2 * wave + 1) & 3, 1);
                const unsigned va0 = trb_base(lnA, 2, 0), va1 = trb_base(lnA, 2, 1), vb0 = trb_base(lnA, 3, 0), vb1 = trb_base(lnA, 3, 1);
#define RS_LD2A(g2) do { _Pragma("unroll") for (int j = 0; j < 2; ++j) { const int ks = 2 * (g2) + j; fa0[j] = tr_frag_b2(kimg0, ka0, ka1, ks); fa1[j] = tr_frag_b2(kimg1, kb0, kb1, ks); fb0[j] = tr_frag_b2(lds + VV, va0, va1, ks); fb1[j] = tr_frag_b2(lds + VV, vb0, vb1, ks); } } while (0)
#define RS_MMA2A() do { _Pragma("unroll") for (int j = 0; j < 2; ++j) { S[0][0] = mfma32(fa0[j], fb0[j], S[0][0]); S[0][1] = mfma32(fa0[j], fb1[j], S[0][1]); S[1][0] = mfma32(fa1[j], fb0[j], S[1][0]); S[1][1] = mfma32(fa1[j], fb1[j], S[1][1]); } } while (0)
                RS_LD2A(0);
#pragma unroll
                for (int a = 0; a < 2; ++a)
#pragma unroll
                    for (int c = 0; c < 2; ++c)
#pragma unroll
                        for (int r = 0; r < 16; ++r) S[a][c][r] *= g64;
                RS_MMA2A(); RS_LD2A(1); RS_MMA2A();
#undef RS_LD2A
#undef RS_MMA2A
#pragma unroll
                for (int a = 0; a < 2; ++a)
#pragma unroll
                    for (int c = 0; c < 2; ++c)
#pragma unroll
                        for (int g = 0; g < 4; ++g) { const int d = 32 * (2 * wave + a) + 8 * g + 4 * a5, v = 32 * c + a31;
                            v2u w; w.x = pk2(S[a][c][4 * g], S[a][c][4 * g + 1]); w.y = pk2(S[a][c][4 * g + 2], S[a][c][4 * g + 3]);
                            *(LAS v2u*)(lds + ST + v * SRS + d * 2) = w; }
            } else {
                const int ti = t_i, vi = x_i;
#pragma unroll
                for (int ks = 0; ks < 4; ++ks) { fa0[ks] = *(const LAS s16x8*)(lds + PI + (32 * ti + a31) * PRS + (16 * ks + 8 * a5) * 2); fb0[ks] = tr_frag_b2(lds + VV, trb_base(lnA, vi, 0), trb_base(lnA, vi, 1), ks); }
                RS_MMA4(fa0, fb0);
#pragma unroll
                for (int i = 0; i < 8; ++i) { const float o0_ = acc[2 * i], o1_ = acc[2 * i + 1]; opk[i] = pk2(o0_, o1_); }
            }
#undef RS_MMA4
#undef RS_PREFETCH_DUMMY
#undef RS_MMA2
            __syncthreads();
        }
        RS_STORE_O(SEQ / 64 - 1);
#undef RS_STORE_O
#undef RS_PREFETCH
    }
}

__device__ __forceinline__ void phase_hgrn_pre(const bf16* PROJ, const float* lbv, bf16* QD, bf16* KI, bf16* KE, float* DEC, int gt, int NGT) {
    for (int it = gt; it < (M / 32) * 256; it += NGT) {
        const int chunk = it >> 8, col = (it & 255) * 8; const size_t m0 = (size_t)chunk * 32;
        float lb[8], tot[8], cum[8];
        { const f32x4 l0 = *(const GAS f32x4*)(lbv + col), l1 = *(const GAS f32x4*)(lbv + col + 4);
#pragma unroll
          for (int e = 0; e < 4; ++e) { lb[e] = l0[e]; lb[4 + e] = l1[e]; } }
#pragma unroll
        for (int e = 0; e < 8; ++e) { tot[e] = 1.f; cum[e] = 1.f; }
#pragma unroll 4
        for (int t = 0; t < 32; ++t) { const v4u zz = *(const GAS v4u*)(PROJ + (m0 + t) * HG_IN + 2048 + col);
            const float z[8] = {bflo(zz.x), bfhi(zz.x), bflo(zz.y), bfhi(zz.y), bflo(zz.z), bfhi(zz.z), bflo(zz.w), bfhi(zz.w)};
#pragma unroll
            for (int e = 0; e < 8; ++e) tot[e] *= lb[e] + (1.0f - lb[e]) * sigmoid_f(z[e]); }
#pragma unroll 2
        for (int t = 0; t < 32; ++t) { const size_t m = m0 + t;
            const v4u zz = *(const GAS v4u*)(PROJ + m * HG_IN + 2048 + col), qq = *(const GAS v4u*)(PROJ + m * HG_IN + col);
            const float z[8] = {bflo(zz.x), bfhi(zz.x), bflo(zz.y), bfhi(zz.y), bflo(zz.z), bfhi(zz.z), bflo(zz.w), bfhi(zz.w)};
            const float q[8] = {bflo(qq.x), bfhi(qq.x), bflo(qq.y), bfhi(qq.y), bflo(qq.z), bfhi(qq.z), bflo(qq.w), bfhi(qq.w)};
            float qd[8], ki[8], ke[8];
#pragma unroll
            for (int e = 0; e < 8; ++e) { const float sg = sigmoid_f(z[e]); cum[e] *= lb[e] + (1.0f - lb[e]) * sg; const float kk = (1.0f - lb[e]) * (1.0f - sg);
                qd[e] = q[e] * cum[e]; ki[e] = kk * __builtin_amdgcn_rcpf(cum[e]); ke[e] = ki[e] * tot[e]; }
            v4u o; o.x = pk2(qd[0], qd[1]); o.y = pk2(qd[2], qd[3]); o.z = pk2(qd[4], qd[5]); o.w = pk2(qd[6], qd[7]); *(GAS v4u*)(QD + m * DM + col) = o;
            o.x = pk2(ki[0], ki[1]); o.y = pk2(ki[2], ki[3]); o.z = pk2(ki[4], ki[5]); o.w = pk2(ki[6], ki[7]); *(GAS v4u*)(KI + m * DM + col) = o;
            o.x = pk2(ke[0], ke[1]); o.y = pk2(ke[2], ke[3]); o.z = pk2(ke[4], ke[5]); o.w = pk2(ke[6], ke[7]); *(GAS v4u*)(KE + m * DM + col) = o; }
        f32x4 d0, d1;
#pragma unroll
        for (int e = 0; e < 4; ++e) { d0[e] = tot[e]; d1[e] = tot[4 + e]; }
        *(GAS f32x4*)(DEC + (size_t)chunk * DM + col) = d0; *(GAS f32x4*)(DEC + (size_t)chunk * DM + col + 4) = d1;
    }
}
__device__ __forceinline__ void phase_hgrn_scan(const bf16* HV, const bf16* QD, const bf16* KI, const bf16* KE, const float* DEC, bf16* Ob, LAS unsigned char* lds, int tid, int u0, int ustride) {
    constexpr int RS = 272, PRS = 80, VRS = 128, SET = 30208;
    constexpr int QI = 0, KII = 8704, KEI = 17408, VI = 25600, DCI = 29696, PI = 2 * SET, ST = PI + 2560, LDS_END = ST + 2 * 8704;
    static_assert(LDS_END <= RING_BYTES, "hgrn scan LDS map");
    const int lane = tid & 63, wave = __builtin_amdgcn_readfirstlane(tid >> 6), l31 = lane & 31, h5 = lane >> 5;
    const int vt = (wave >> 1) & 1;
    for (int unit = u0; unit < NB * HG_H * 2; unit += ustride) {
        const int b = unit >> 5, h = (unit >> 1) & 15, vp = unit & 1;
        f32x16 S0 = zero16(), S1 = zero16();
        for (int i = tid; i < 2 * 8704 / 16; i += 512) *(LAS v4u*)(lds + ST + i * 16) = (v4u){0u, 0u, 0u, 0u};
        const int row = tid >> 4, c16 = tid & 15;
        const size_t mb = (size_t)b * SEQ;
        v4u q0, ki0, ke0, x0 = (v4u){0u, 0u, 0u, 0u}, q1, ki1, ke1, x1 = (v4u){0u, 0u, 0u, 0u};
        unsigned opk[8];
#pragma unroll
        for (int i = 0; i < 8; ++i) opk[i] = 0u;
#define HS_CLAMP(c_) ((c_) < SEQ / 32 ? (c_) : SEQ / 32 - 1)
#define HS_LOAD(pq_, pki_, pke_, px_, chn) do { const size_t hb_ = (size_t)(b * 16 + h) * SEQ + (size_t)(chn) * 32; \
            pq_ = *(const GAS v4u*)(QD + (hb_ + row) * 128 + c16 * 8); pki_ = *(const GAS v4u*)(KI + (hb_ + row) * 128 + c16 * 8); pke_ = *(const GAS v4u*)(KE + (hb_ + row) * 128 + c16 * 8); \
            if (tid < 256) px_ = *(const GAS v4u*)(HV + (hb_ + (tid >> 3)) * 128 + vp * 64 + (tid & 7) * 8); \
            else if (tid < 288) px_ = *(const GAS v4u*)(DEC + ((size_t)(b * 16 + h) * (SEQ / 32) + (chn)) * 128 + (tid - 256) * 4); } while (0)
#define HS_WRITE(IB, pq_, pki_, pke_, px_) do { \
            *(LAS v4u*)(lds + (IB) + QI + row * RS + c16 * 16) = pq_; *(LAS v4u*)(lds + (IB) + KII + row * RS + c16 * 16) = pki_; *(LAS v4u*)(lds + (IB) + KEI + off_b(row, c16)) = pke_; \
            if (tid < 256) *(LAS v4u*)(lds + (IB) + VI + (tid >> 3) * VRS + (tid & 7) * 16) = px_; \
            else if (tid < 288) *(LAS v4u*)(lds + (IB) + DCI + (tid - 256) * 16) = px_; } while (0)
#define HS_STORE_O(chs) do { if (wave == 4 || wave == 6) { bf16* op = Ob + (mb + (size_t)(chs) * 32) * DM + h * 128 + vp * 64 + vt * 32 + l31; \
            _Pragma("unroll") for (int r = 0; r < 16; ++r) { const int t = (r & 3) + 8 * (r >> 2) + 4 * h5; const unsigned pr_ = opk[r >> 1]; op[(size_t)t * DM] = (bf16)((r & 1) ? (pr_ >> 16) : (pr_ & 0xffffu)); } } } while (0)
#define HS_CHUNK(IB, NIB, nq_, nki_, nke_, nx_) do { \
            f32x16 acc = zero16(); \
            if (wave == 5) { \
                s16x8 fa[8], fb[8]; \
                _Pragma("unroll") for (int ks = 0; ks < 8; ++ks) { fa[ks] = *(const LAS s16x8*)(lds + (IB) + KII + l31 * RS + (16 * ks + 8 * h5) * 2); fb[ks] = *(const LAS s16x8*)(lds + (IB) + QI + l31 * RS + (16 * ks + 8 * h5) * 2); } \
                _Pragma("unroll") for (int ks = 0; ks < 8; ++ks) acc = mfma32(fa[ks], fb[ks], acc); \
                const int t = l31; \
                _Pragma("unroll") for (int g = 0; g < 4; ++g) { float pvv[4]; \
                    _Pragma("unroll") for (int e = 0; e < 4; ++e) { const int s = 8 * g + 4 * h5 + e; pvv[e] = (s <= t) ? acc[4 * g + e] : 0.f; } \
                    v2u w; w.x = pk2(pvv[0], pvv[1]); w.y = pk2(pvv[2], pvv[3]); \
                    *(LAS v2u*)(lds + PI + t * PRS + (8 * g + 4 * h5) * 2) = w; } \
            } else if (wave == 4 || wave == 6) { \
                s16x8 fa[8], fb[8]; \
                _Pragma("unroll") for (int ks = 0; ks < 8; ++ks) { fa[ks] = *(const LAS s16x8*)(lds + (IB) + QI + l31 * RS + (16 * ks + 8 * h5) * 2); fb[ks] = *(const LAS s16x8*)(lds + ST + vt * 8704 + l31 * RS + (16 * ks + 8 * h5) * 2); } \
                _Pragma("unroll") for (int ks = 0; ks < 8; ++ks) acc = mfma32(fa[ks], fb[ks], acc); \
            } \
            __syncthreads(); \
            if (wave < 4) { \
                _Pragma("unroll") for (int g = 0; g < 4; ++g) { const f32x4 dv = *(const LAS f32x4*)(lds + (IB) + DCI + (32 * wave + 8 * g + 4 * h5) * 4); \
                    _Pragma("unroll") for (int e = 0; e < 4; ++e) { S0[4 * g + e] *= dv[e]; S1[4 * g + e] *= dv[e]; } } \
                _Pragma("unroll") for (int ks = 0; ks < 2; ++ks) { const s16x8 af = tr_frag_b(lds + (IB) + KEI, lane, wave, ks); \
                    const s16x8 b0 = tr_frag_plain(lds + (IB) + VI, VRS, lane, 0, ks), b1 = tr_frag_plain(lds + (IB) + VI, VRS, lane, 1, ks); S0 = mfma32(af, b0, S0); S1 = mfma32(af, b1, S1); } \
                _Pragma("unroll") for (int g = 0; g < 4; ++g) { const int d = 32 * wave + 8 * g + 4 * h5; \
                    v2u w; w.x = pk2(S0[4 * g], S0[4 * g + 1]); w.y = pk2(S0[4 * g + 2], S0[4 * g + 3]); \
                    *(LAS v2u*)(lds + ST + l31 * RS + d * 2) = w; \
                    w.x = pk2(S1[4 * g], S1[4 * g + 1]); w.y = pk2(S1[4 * g + 2], S1[4 * g + 3]); \
                    *(LAS v2u*)(lds + ST + 8704 + l31 * RS + d * 2) = w; } \
            } else if (wave == 4 || wave == 6) { \
                _Pragma("unroll") for (int ks = 0; ks < 2; ++ks) { const s16x8 af = *(const LAS s16x8*)(lds + PI + l31 * PRS + (16 * ks + 8 * h5) * 2); const s16x8 bfr = tr_frag_plain(lds + (IB) + VI, VRS, lane, vt, ks); acc = mfma32(af, bfr, acc); } \
                _Pragma("unroll") for (int i = 0; i < 8; ++i) { const float o0_ = acc[2 * i], o1_ = acc[2 * i + 1]; opk[i] = pk2(o0_, o1_); } \
            } \
            HS_WRITE(NIB, nq_, nki_, nke_, nx_); \
            __syncthreads(); } while (0)
        HS_LOAD(q0, ki0, ke0, x0, 0); HS_LOAD(q1, ki1, ke1, x1, 1);
        HS_WRITE(0, q0, ki0, ke0, x0); HS_LOAD(q0, ki0, ke0, x0, 2);
        __syncthreads();
        for (int ch = 0; ch < SEQ / 32; ch += 2) {
            HS_CHUNK(0, SET, q1, ki1, ke1, x1);     HS_LOAD(q1, ki1, ke1, x1, HS_CLAMP(ch + 3)); HS_STORE_O(ch);
            HS_CHUNK(SET, 0, q0, ki0, ke0, x0);     HS_LOAD(q0, ki0, ke0, x0, HS_CLAMP(ch + 4)); HS_STORE_O(ch + 1);
        }
#undef HS_CLAMP
#undef HS_LOAD
#undef HS_WRITE
#undef HS_STORE_O
#undef HS_CHUNK
    }
}

template <bool XF32>
__device__ __forceinline__ void phase_poolmix(const void* hsrc  , const float* rsrow  , bf16* hout, const float* gnorm, const float* ada_l  ,
                                              const float* pscale, const bf16* Wt  ,
                                              const float* g2, const float* shift2, const float* scale2  , bf16* U2,
                                              LAS unsigned char* lds, int tid, int vcu, int G) {
    constexpr int PA = 0, WB = 65536, RSTD = RING_BYTES, ES = XF32 ? 4 : 2;
    const int lane = tid & 63, wave = __builtin_amdgcn_readfirstlane(tid >> 6), l31 = lane & 31, h5 = lane >> 5;
    LAS float* rstdL = (LAS float*)(lds + RSTD);
    LAS float* rowss = (LAS float*)(lds + RING_BYTES + 4096);
    const __amdgpu_buffer_rsrc_t rsH = __builtin_amdgcn_make_buffer_rsrc((void*)hsrc, (short)0, M * DM * ES, 0x00020000);
    const __amdgpu_buffer_rsrc_t rsO = __builtin_amdgcn_make_buffer_rsrc((void*)hout, (short)0, M * DM * 2, 0x00020000);
    const __amdgpu_buffer_rsrc_t rsW = __builtin_amdgcn_make_buffer_rsrc((void*)Wt, (short)0, 4 * 512 * 512 * 2, 0x00020000);
#define PM_OFFP(row, ch) ((row) * 1024 + 16 * ((ch) ^ ((row) & 15)))
#define PM_OFFW(n, ch) ((n) * 64 + 16 * ((ch) ^ (((n) >> 2) & 3)))
#define PM_LDH(voff, soff) __builtin_amdgcn_raw_buffer_load_b128(rsH, (voff), (soff), 0)
#define PM_UNPK(q_, f_) do { f_[0] = bflo(q_.x); f_[1] = bfhi(q_.x); f_[2] = bflo(q_.y); f_[3] = bfhi(q_.y); f_[4] = bflo(q_.z); f_[5] = bfhi(q_.z); f_[6] = bflo(q_.w); f_[7] = bfhi(q_.w); } while (0)
    for (int unit = vcu; unit < M / 64; unit += G) {
        const int r0 = unit * 64, b = r0 >> 12, tpos0 = r0 & (SEQ - 1), halo = tpos0 < 15 ? tpos0 : 15;
        const float* shp = ada_l + (size_t)b * ADA_W; const float* scp = shp + DM; const float* gtp = shp + 2 * DM;
        if (rsrow) { if (tid < 64 + halo) rstdL[tid + 15 - halo] = rsrow[r0 - halo + tid]; }
        else for (int rp = wave; 2 * rp < 64 + halo; rp += 2 * NWAVES) {
            int rrq[2]; float ssq[2]; v4u qq[2][XF32 ? 16 : 8];
#pragma unroll
            for (int z = 0; z < 2; ++z) { const int rr = 2 * (rp + NWAVES * z) + h5, rrc = rr < 64 + halo ? rr : 63 + halo, row = r0 - halo + rrc; rrq[z] = rr;
                const unsigned vo = (unsigned)row * (DM * ES) + (unsigned)l31 * 16u;
#pragma unroll
                for (int j = 0; j < (XF32 ? 16 : 8); ++j) qq[z][j] = PM_LDH(vo, (unsigned)j * 512u); }
#pragma unroll
            for (int z = 0; z < 2; ++z) { float ss = 0.f;
#pragma unroll
                for (int j = 0; j < (XF32 ? 16 : 8); ++j) { const v4u q = qq[z][j];
                    if constexpr (XF32) { const f32x4 v = __builtin_bit_cast(f32x4, q); ss += (v.x * v.x + v.y * v.y) + (v.z * v.z + v.w * v.w); }
                    else { float f[8]; PM_UNPK(q, f); ss += ((f[0] * f[0] + f[1] * f[1]) + (f[2] * f[2] + f[3] * f[3])) + ((f[4] * f[4] + f[5] * f[5]) + (f[6] * f[6] + f[7] * f[7])); } }
                ssq[z] = ss; }
#pragma unroll
            for (int z = 0; z < 2; ++z) { float ss = ssq[z];
                ss = half_sum(ss);
                const float rstd = 1.0f / sqrtf(ss * (1.0f / DM) + EPS);
                if (l31 == 0 && rrq[z] < 64 + halo) rstdL[rrq[z] + 15 - halo] = rstd; }
        }
        __syncthreads();
#pragma unroll 1
        for (int g = 0; g < 4; ++g) {
            const int w = 2 << g;
            const unsigned wvo = (unsigned)lane * 16u, wso = ((unsigned)g * 16u + 2u * (unsigned)wave) * (32u * 1024u);
            v4u wA[4], wB[4], wC[4];
            v4u hk[8];
#define PM_WLD(dst, kc_) do { _Pragma("unroll") for (int nt = 0; nt < 2; ++nt) _Pragma("unroll") for (int ks = 0; ks < 2; ++ks) \
                dst[nt * 2 + ks] = __builtin_amdgcn_raw_buffer_load_b128(rsW, wvo, wso + (unsigned)(nt * 32 + 2 * (kc_) + ks) * 1024u, 0); } while (0)
            PM_WLD(wA, 0); PM_WLD(wB, 1); PM_WLD(wC, 2);
            { const int oct = tid & 63, col = g * 512 + oct * 8; const unsigned hvo = (unsigned)col * ES;
              float gm[8], sh[8];
              { const f32x4 g0 = *(const GAS f32x4*)(gnorm + col), g1 = *(const GAS f32x4*)(gnorm + col + 4), s0 = *(const GAS f32x4*)(scp + col), s1 = *(const GAS f32x4*)(scp + col + 4);
                const f32x4 a0 = *(const GAS f32x4*)(shp + col), a1 = *(const GAS f32x4*)(shp + col + 4);
#pragma unroll
                for (int e = 0; e < 4; ++e) { gm[e] = g0[e] * (1.0f + s0[e]); gm[4 + e] = g1[e] * (1.0f + s1[e]); sh[e] = a0[e]; sh[4 + e] = a1[e]; } }
              LAS unsigned char* UT = lds + WB;
#pragma unroll
              for (int hf = 0; hf < 2; ++hf) {
                  const int rb = r0 - 15 + 32 * hf;
                  { v4u ha[6], hb2[6]; float rsv[6];
#pragma unroll
                      for (int k = 0; k < 6; ++k) { const int j = wave - 1 + 8 * k, row = rb + j, rowc = (j >= 0 && row >= r0 - halo) ? row : r0;
                          const unsigned so = (unsigned)rowc * (DM * ES);
                          ha[k] = PM_LDH(hvo, so); if constexpr (XF32) hb2[k] = PM_LDH(hvo, so + 16u); rsv[k] = rstdL[rowc - r0 + 15]; }
#pragma unroll
                      for (int k = 0; k < 6; ++k) { const int j = wave - 1 + 8 * k; const float rs_ = rsv[k]; float f[8];
                          if constexpr (XF32) { const f32x4 x0 = __builtin_bit_cast(f32x4, ha[k]), x1 = __builtin_bit_cast(f32x4, hb2[k]); f[0] = x0.x; f[1] = x0.y; f[2] = x0.z; f[3] = x0.w; f[4] = x1.x; f[5] = x1.y; f[6] = x1.z; f[7] = x1.w; }
                          else { PM_UNPK(ha[k], f); if (k >= 2) hk[4 * hf + k - 2] = ha[k]; }
                          v4u uq; uq.x = pk2(f[0] * rs_ * gm[0] + sh[0], f[1] * rs_ * gm[1] + sh[1]); uq.y = pk2(f[2] * rs_ * gm[2] + sh[2], f[3] * rs_ * gm[3] + sh[3]);
                          uq.z = pk2(f[4] * rs_ * gm[4] + sh[4], f[5] * rs_ * gm[5] + sh[5]); uq.w = pk2(f[6] * rs_ * gm[6] + sh[6], f[7] * rs_ * gm[7] + sh[7]);
                          if (j >= 0) *(LAS v4u*)(UT + j * 1024 + oct * 16) = uq; }
                  }
                  __syncthreads();
                  { const int il0 = 4 * wave, sl0 = il0 + 15, tp0 = tpos0 + 32 * hf + il0;
                    float S[8], uc[8];
#pragma unroll
                    for (int e = 0; e < 8; ++e) S[e] = 0.f;
                    { const int cnt = tp0 + 1 < w ? tp0 + 1 : w;
#define PM_WIN(J0, NJ) do { v4u qw[NJ]; \
                          _Pragma("unroll") for (int jj = 0; jj < NJ; ++jj) { const int sj = sl0 - (J0) - jj; qw[jj] = *(const LAS v4u*)(UT + (sj > 0 ? sj : 0) * 1024 + oct * 16); } \
                          _Pragma("unroll") for (int jj = 0; jj < NJ; ++jj) { float f[8]; PM_UNPK(qw[jj], f); const float m_ = (J0) + jj < cnt ? 1.0f : 0.0f; \
                              if ((J0) + jj == 0) { _Pragma("unroll") for (int e = 0; e < 8; ++e) uc[e] = f[e]; } \
                              _Pragma("unroll") for (int e = 0; e < 8; ++e) S[e] += m_ * f[e]; } } while (0)
                      PM_WIN(0, 4);
                      if (w > 4) { PM_WIN(4, 4); if (w > 8) PM_WIN(8, 8); }
#undef PM_WIN
                      const float inv = 1.0f / (float)cnt;
                      v4u o; o.x = pk2(S[0] * inv - uc[0], S[1] * inv - uc[1]); o.y = pk2(S[2] * inv - uc[2], S[3] * inv - uc[3]); o.z = pk2(S[4] * inv - uc[4], S[5] * inv - uc[5]); o.w = pk2(S[6] * inv - uc[6], S[7] * inv - uc[7]);
                      *(LAS v4u*)(lds + PA + PM_OFFP(32 * hf + il0, oct)) = o; }
#pragma unroll
                    for (int r = 1; r < 4; ++r) { const int tpr = tp0 + r, cnt = tpr + 1 < w ? tpr + 1 : w;
                        const v4u qn = *(const LAS v4u*)(UT + (sl0 + r) * 1024 + oct * 16), qo = *(const LAS v4u*)(UT + (sl0 + r - w) * 1024 + oct * 16);
                        float fn[8], fo[8]; PM_UNPK(qn, fn); PM_UNPK(qo, fo); const float m_ = tpr + 1 > w ? 1.0f : 0.0f;
#pragma unroll
                        for (int e = 0; e < 8; ++e) S[e] += fn[e] - m_ * fo[e];
                        const float inv = 1.0f / (float)cnt;
                        v4u o; o.x = pk2(S[0] * inv - fn[0], S[1] * inv - fn[1]); o.y = pk2(S[2] * inv - fn[2], S[3] * inv - fn[3]); o.z = pk2(S[4] * inv - fn[4], S[5] * inv - fn[5]); o.w = pk2(S[6] * inv - fn[6], S[7] * inv - fn[7]);
                        *(LAS v4u*)(lds + PA + PM_OFFP(32 * hf + il0 + r, oct)) = o; }
                  }
                  __syncthreads();
              }
            }
            f32x16 acc[2][2];
#pragma unroll
            for (int a = 0; a < 2; ++a)
#pragma unroll
                for (int c = 0; c < 2; ++c) acc[a][c] = zero16();
#define PM_CHUNK(kc, SET) do { \
                int la_ = lane; asm volatile("" : "+v"(la_)); const int l31_ = la_ & 31, h5_ = la_ >> 5; \
                s16x8 fb[2][2]; \
                _Pragma("unroll") for (int ks = 0; ks < 2; ++ks) _Pragma("unroll") for (int mt = 0; mt < 2; ++mt) fb[mt][ks] = *(const LAS s16x8*)(lds + PA + PM_OFFP(32 * mt + l31_, 4 * (kc) + 2 * ks + h5_)); \
                _Pragma("unroll") for (int ks = 0; ks < 2; ++ks) _Pragma("unroll") for (int nt = 0; nt < 2; ++nt) _Pragma("unroll") for (int mt = 0; mt < 2; ++mt) \
                    acc[nt][mt] = mfma32(__builtin_bit_cast(s16x8, SET[nt * 2 + ks]), fb[mt][ks], acc[nt][mt]); \
                if ((kc) + 3 < 16) PM_WLD(SET, (kc) + 3); } while (0)
            PM_CHUNK(0, wA); PM_CHUNK(1, wB); PM_CHUNK(2, wC); PM_CHUNK(3, wA); PM_CHUNK(4, wB); PM_CHUNK(5, wC); PM_CHUNK(6, wA); PM_CHUNK(7, wB);
            PM_CHUNK(8, wC); PM_CHUNK(9, wA); PM_CHUNK(10, wB); PM_CHUNK(11, wC); PM_CHUNK(12, wA); PM_CHUNK(13, wB); PM_CHUNK(14, wC); PM_CHUNK(15, wA);
#undef PM_CHUNK
#undef PM_WLD
            __syncthreads();
#pragma unroll
            for (int nt = 0; nt < 2; ++nt)
#pragma unroll
                for (int q = 0; q < 4; ++q)
#pragma unroll
                    for (int mt = 0; mt < 2; ++mt) { const int n = 32 * (2 * wave + nt) + 8 * q + 4 * h5, m = 32 * mt + l31;
                        const float y0 = acc[nt][mt][4 * q], y1 = acc[nt][mt][4 * q + 1], y2 = acc[nt][mt][4 * q + 2], y3 = acc[nt][mt][4 * q + 3];
                        v2u o; o.x = pk2(y0, y1); o.y = pk2(y2, y3);
                        *(LAS v2u*)(lds + PA + m * 1040 + n * 2) = o; }
            __syncthreads();
            { const int ch = tid & 63, col = g * 512 + ch * 8; const unsigned hvo = (unsigned)col * ES, ovo = (unsigned)col * 2u;
              const f32x4 gv0 = *(const GAS f32x4*)(gtp + col) * *(const GAS f32x4*)(pscale + col), gv1 = *(const GAS f32x4*)(gtp + col + 4) * *(const GAS f32x4*)(pscale + col + 4);
              if constexpr (XF32) {
#pragma unroll
                  for (int kb = 0; kb < 8; kb += 4) {
                      v4u ha[4], hb2[4];
#pragma unroll
                      for (int k = 0; k < 4; ++k) { const unsigned so = (unsigned)(r0 + wave + 8 * (kb + k)) * (DM * ES); ha[k] = PM_LDH(hvo, so); hb2[k] = PM_LDH(hvo, so + 16u); }
#pragma unroll
                      for (int k = 0; k < 4; ++k) { const int m = wave + 8 * (kb + k); float f[8], y[8];
                          const f32x4 x0 = __builtin_bit_cast(f32x4, ha[k]), x1 = __builtin_bit_cast(f32x4, hb2[k]); f[0] = x0.x; f[1] = x0.y; f[2] = x0.z; f[3] = x0.w; f[4] = x1.x; f[5] = x1.y; f[6] = x1.z; f[7] = x1.w;
                          const v4u yq = *(const LAS v4u*)(lds + PA + m * 1040 + ch * 16); PM_UNPK(yq, y);
                          v4u o; o.x = pk2(f[0] + gv0.x * y[0], f[1] + gv0.y * y[1]); o.y = pk2(f[2] + gv0.z * y[2], f[3] + gv0.w * y[3]); o.z = pk2(f[4] + gv1.x * y[4], f[5] + gv1.y * y[5]); o.w = pk2(f[6] + gv1.z * y[6], f[7] + gv1.w * y[7]);
                          __builtin_amdgcn_raw_buffer_store_b128(o, rsO, ovo, (unsigned)(r0 + m) * (DM * 2u), 0); }
                  }
              } else {
                  (void)hvo;
#pragma unroll
                  for (int kk = 0; kk < 8; ++kk) { const int m = wave + 8 * kk; float f[8], y[8]; PM_UNPK(hk[kk], f);
                      const v4u yq = *(const LAS v4u*)(lds + PA + m * 1040 + ch * 16); PM_UNPK(yq, y);
                      v4u o; o.x = pk2(f[0] + gv0.x * y[0], f[1] + gv0.y * y[1]); o.y = pk2(f[2] + gv0.z * y[2], f[3] + gv0.w * y[3]); o.z = pk2(f[4] + gv1.x * y[4], f[5] + gv1.y * y[5]); o.w = pk2(f[6] + gv1.z * y[6], f[7] + gv1.w * y[7]);
                      __builtin_amdgcn_raw_buffer_store_b128(o, rsO, ovo, (unsigned)(r0 + m) * (DM * 2u), 0);
                      if (U2) { float e[8]; PM_UNPK(o, e);
                          const float s2 = wave_sum(((e[0] * e[0] + e[1] * e[1]) + (e[2] * e[2] + e[3] * e[3])) + ((e[4] * e[4] + e[5] * e[5]) + (e[6] * e[6] + e[7] * e[7])));
                          if (lane == 0) rowss[m] = (g ? rowss[m] : 0.f) + s2; } }
              }
            }
            __syncthreads();
        }
        if (U2) {
            const __amdgpu_buffer_rsrc_t rsU = __builtin_amdgcn_make_buffer_rsrc((void*)U2, (short)0, M * DM * 2, 0x00020000);
            const float* sh2 = shift2 + (size_t)b * ADA_W; const float* sc2 = scale2 + (size_t)b * ADA_W;
            f32x4 mul[8], add[8];
#pragma unroll
            for (int j = 0; j < 8; ++j) { const int col = 8 * lane + 512 * (j >> 1) + 4 * (j & 1); const f32x4 gv = *(const GAS f32x4*)(g2 + col), s = *(const GAS f32x4*)(sc2 + col); mul[j] = gv * (s + 1.0f); add[j] = *(const GAS f32x4*)(sh2 + col); }
#pragma unroll 1
            for (int kb = 0; kb < 8; kb += 2) {
                v4u q[2][4]; float rs2[2];
#pragma unroll
                for (int z = 0; z < 2; ++z) { const int m = wave + 8 * (kb + z); rs2[z] = 1.0f / sqrtf(rowss[m] * (1.0f / DM) + EPS);
#pragma unroll
                    for (int j = 0; j < 4; ++j) q[z][j] = __builtin_amdgcn_raw_buffer_load_b128(rsO, (unsigned)lane * 16u + (unsigned)j * 1024u, (unsigned)(r0 + m) * (DM * 2u), 0); }
#pragma unroll
                for (int z = 0; z < 2; ++z) { const int m = wave + 8 * (kb + z); const float rstd = rs2[z];
#pragma unroll
                    for (int j = 0; j < 4; ++j) { float e[8]; PM_UNPK(q[z][j], e);
                        const f32x4 v0 = {e[0], e[1], e[2], e[3]}, v1 = {e[4], e[5], e[6], e[7]};
                        const f32x4 y0 = v0 * rstd * mul[2 * j] + add[2 * j], y1 = v1 * rstd * mul[2 * j + 1] + add[2 * j + 1];
                        v4u w; w.x = pk2(y0.x, y0.y); w.y = pk2(y0.z, y0.w); w.z = pk2(y1.x, y1.y); w.w = pk2(y1.z, y1.w);
                        __builtin_amdgcn_raw_buffer_store_b128(w, rsU, (unsigned)lane * 16u + (unsigned)j * 1024u, (unsigned)(r0 + m) * (DM * 2u), 0); } }
            }
        }
    }
#undef PM_OFFP
#undef PM_OFFW
#undef PM_LDH
#undef PM_UNPK
}

constexpr int NSUB = 6, PH_FINAL = 1 + NSUB * 2 * DEPTH, PH_END = PH_FINAL + 1;
__host__ __device__ constexpr bool phase_exists(int ph) {
    if (ph == 0 || ph == PH_FINAL) return true;
    const int hl = (ph - 1) / NSUB, s = (ph - 1) % NSUB, layer = hl >> 1;
    if (!(hl & 1) && layer % 3 == 0) return s == 1;
    if ((hl & 1) && layer % 3 == 0 && s == 0) return false;
    if (s == 2) return false;
    if (s == 3 || s == 4) return !(hl & 1) && (layer == 1 || layer == 2);
    return true;
}
__global__ void __launch_bounds__(NWAVES * 64, 2) trunk_fwd(Args a) {
    extern __shared__ __attribute__((aligned(16))) unsigned char lds_raw[];
    LAS unsigned char* lds = (LAS unsigned char*)lds_raw;
    volatile LAS unsigned* MISC = (volatile LAS unsigned*)(lds + MISC_OFF);
    const int G = gridDim.x; const int bx = blockIdx.x; const int vcu = (G % 8 == 0) ? (bx % 8) * (G / 8) + bx / 8 : bx;
    const int NGW = G * NWAVES;
    gu32* ctl = (gu32*)(a.ws + WS_CTL);
    const int wave0 = __builtin_amdgcn_readfirstlane((int)threadIdx.x >> 6);
    for (int u = (int)__builtin_amdgcn_mbcnt_hi(~0u, __builtin_amdgcn_mbcnt_lo(~0u, 0u)) + 64 * wave0; u < (LDS_BYTES - LDSCTL_OFF) / 4; u += NWAVES * 64) ((LAS unsigned*)(lds + LDSCTL_OFF))[u] = 0u;
    __syncthreads();
#define PHASE_IDS() const CAS Args* ap = (const CAS Args*)__builtin_amdgcn_kernarg_segment_ptr(); asm volatile("" : "+s"(ap)); unsigned char* ws = ap->ws; int lane = (int)__builtin_amdgcn_mbcnt_hi(~0u, __builtin_amdgcn_mbcnt_lo(~0u, 0u)); asm volatile("" : "+v"(lane)); const int wave = wave0, tid = wave * 64 + lane, gw = vcu * NWAVES + wave; (void)tid; (void)gw
#if MK_ONE_LAUNCH
    XcdBarrier bar = xcd_barrier_post((unsigned*)(ctl + CW_BAR), MISC + 8, wave0);
#define GRID_BAR() xcd_barrier(bar, wave0)
#else
#define GRID_BAR() do { } while (0)
#endif
    const int lo = a.ph_lo, hi = a.ph_hi;
#define IN(k) (lo <= (k) && (k) < hi)
#define ada ((float*)(ws + WS_ADA))
#define U ((bf16*)(ws + WS_U))
#define Pb ((bf16*)(ws + WS_P))
#define PROJ ((bf16*)(ws + WS_PROJ))
#define O ((bf16*)(ws + WS_O))
#define HQD ((bf16*)(ws + WS_PROJ + 256 * MiB))
#define HKI ((bf16*)(ws + WS_PROJ + 320 * MiB))
#define HKE ((bf16*)(ws + WS_P + 64 * MiB))
#define HDEC ((float*)(ws + WS_O + 128 * MiB))
#define HVV ((bf16*)(ws + WS_O + 136 * MiB))
#define H ((bf16*)(ws + (hl >= 7 ? WS_H2 : WS_H)))
#define HPOOL_OUT ((bf16*)(ws + (hl >= 6 ? WS_H2 : WS_H)))

    if (IN(0)) for (int rep = 0; rep < REP_P0; ++rep) { PHASE_IDS(); phase_prologue(ap, lds, tid, lane, wave, vcu, G); GRID_BAR(); }

    for (int hl = 0; hl < 2 * DEPTH; ++hl) {
        const int layer = hl >> 1, isffn = hl & 1, pb = 1 + NSUB * hl;
        const int kind = layer % 3, jj = layer / 3;
#define ada_l (ada + (size_t)layer * NB * ADA_W)
#define hin_is_x (hl == 0)
        if ((kind != 0) && IN(pb + 0)) for (int rep = 0; rep < REP_S0; ++rep) {
            PHASE_IDS();
            if (hin_is_x) phase_normmod(ap->x, ap->norm_mix_g, ada_l, ada_l + DM, U, gw, NGW, lane);
            else phase_normmod_bf(H, (isffn ? ap->norm_ffn_g : ap->norm_mix_g) + (size_t)layer * DM, ada_l + (isffn ? 3 : 0) * DM, ada_l + (isffn ? 4 : 1) * DM, U, gw, NGW, lane);
            GRID_BAR();
        }
        if (IN(pb + 1)) for (int rep = 0; rep < REP_S1; ++rep) {
            PHASE_IDS();
            if (isffn) {
                pg8::Gemm g{U, (const bf16*)(ws + WS_FFWIN) + (size_t)layer * FF2 * DM, M, FF2, DM, DM, DM, FF2 / 256, 0, 0};
                pg8::StaticOrder S; S.init(M, FF2, G, bx);
                pg8::EpiSwiGLU E{PROJ, FF};
                pg8::gemm_phase<pg8::EpiSwiGLU, pg8::StaticOrder, true>(lds + RING_OFF, g, S, E, tid);
            } else if (kind == 0) {
                phase_poolmix<false>(hin_is_x ? (const void*)(ws + WS_H2) : (const void*)H, hin_is_x ? (const float*)(ws + WS_XRS) : (const float*)nullptr, HPOOL_OUT,
                                     ap->norm_mix_g + (size_t)layer * DM, ada_l, ap->pool_scale + (size_t)jj * DM, (const bf16*)(ws + WS_POOLW) + (size_t)jj * 4 * 512 * 512,
                                     ap->norm_ffn_g + (size_t)layer * DM, ada_l + 3 * DM, ada_l + 4 * DM, U, lds, tid, vcu, G);
            } else {
                const int N = (kind == 1) ? HG_IN : RT_IN;
                pg8::Gemm g{U, (const bf16*)(ws + (kind == 1 ? WS_HGWIN : WS_RTWIN)), M, N, DM, DM, DM, N / 256, 0, 0};
                pg8::StaticOrder S; S.init(M, N, G, bx);
                const float* rot = (const float*)(ws + WS_ROT);
                pg8::EpiBf16Rot E{PROJ, N, rot, rot + (size_t)M * 128, kind == 2 ? 16 : 0, kind == 1 ? 16 : 0, (const float*)(ws + WS_LB), HQD, HKI, HKE, HDEC, HVV};
                pg8::gemm_phase<pg8::EpiBf16Rot, pg8::StaticOrder, true>(lds + RING_OFF, g, S, E, tid);
            }
            GRID_BAR();
        }
        if (0) for (int rep = 0; rep < REP_S2; ++rep) {
            PHASE_IDS();
            phase_hgrn_pre(PROJ, (const float*)(ws + WS_LB), HQD, HKI, HKE, HDEC, gw * 64 + lane, NGW * 64);
            GRID_BAR();
        }
        if (!isffn && kind != 0 && IN(pb + 3)) for (int rep = 0; rep < REP_S2; ++rep) {
            PHASE_IDS();
#if NAIVE_SCANS
            if (kind == 1) phase_hgrn_scan_naive(PROJ, (const float*)(ws + WS_LB), O, lds, tid, vcu, G);
            else phase_ret_scan_naive(PROJ, (const float*)(ws + WS_ROT), O, lds, tid, vcu, G);
#else
            if (kind == 1) { if ((vcu & 1) && G >= 2) phase_convert_late_tiles(ap, lds, lane, wave, vcu >> 1, G >> 1);
                             else phase_hgrn_scan(HVV, HQD, HKI, HKE, HDEC, O, lds, tid, G >= 2 ? (vcu >> 1) : vcu, G >= 2 ? ((G + 1) >> 1) : 1); }
            else phase_ret_scan(PROJ, O, lds, tid, vcu, G);
#endif
            GRID_BAR();
        }
        if (!isffn && kind != 0 && IN(pb + 4)) for (int rep = 0; rep < REP_S3; ++rep) {
            PHASE_IDS();
            if (kind == 1) phase_hgrn_post(O, PROJ, ap->hgrn_norm_g, Pb, gw, NGW, lane);
            else phase_ret_post(O, PROJ, ap->ret_norm_g, Pb, gw, NGW, lane);
            GRID_BAR();
        }
        if ((isffn || kind != 0) && IN(pb + 5)) {
            PHASE_IDS();
            pg8::Gemm g;
            const float* cs = nullptr;
            if (isffn) g = pg8::Gemm{PROJ, (const bf16*)(ws + WS_FFWOUT) + (size_t)layer * DM * FF, M, DM, FF, FF, FF, DM / 256, 0, 0};
            else if (kind == 0) { g = pg8::Gemm{Pb, (const bf16*)(ws + WS_POOLW) + (size_t)jj * 4 * 512 * 512, M, DM, 512, DM, 512, 2, 512, 512 * 512}; cs = ap->pool_scale + (size_t)jj * DM; }
            else if (kind == 1) g = pg8::Gemm{Pb, (const bf16*)(ws + WS_HGWOUT), M, DM, DM, DM, DM, DM / 256, 0, 0};
            else g = pg8::Gemm{Pb, (const bf16*)(ws + WS_RTWOUT), M, DM, RT_V, RT_V, RT_V, DM / 256, 0, 0};
            pg8::StaticOrder S; S.init(M, DM, G, bx);
            pg8::EpiResid E{hin_is_x ? ap->x : (const float*)nullptr, H, H, ada_l + (isffn ? 5 : 2) * DM, ADA_W, cs};
            pg8::gemm_phase<pg8::EpiResid, pg8::StaticOrder, true>(lds + RING_OFF, g, S, E, tid);
            GRID_BAR();
        }
    }
    if (IN(PH_FINAL)) { PHASE_IDS(); phase_finalnorm_bf((const bf16*)(ws + WS_H2), ap->final_g, ap->out, gw, NGW, lane); }
#undef IN
#undef ada
#undef U
#undef Pb
#undef PROJ
#undef O
#undef HQD
#undef HKI
#undef HKE
#undef HDEC
#undef HVV
#undef H
#undef HPOOL_OUT
#undef ada_l
#undef hin_is_x
}

extern "C" void kernel_launch(void* const* d_in, const int* in_sizes, int n_in, void* d_out, int out_size, void* d_ws, size_t ws_size, hipStream_t stream) {
    static int grid = 0;
    if (grid == 0) {
        if (n_in != 19 || in_sizes[0] != M * DM || out_size != M * DM || ws_size < WS_END) { fprintf(stderr, "kernel_launch: unexpected shapes (n_in %d, in0 %d, out %d, ws %zu < %zu); nothing launched\n", n_in, n_in > 0 ? in_sizes[0] : -1, out_size, ws_size, (size_t)WS_END); grid = -1; return; }
        int dev = 0, cus = 0, per_cu = 0;
        if (hipGetDevice(&dev) != hipSuccess || hipDeviceGetAttribute(&cus, hipDeviceAttributeMultiprocessorCount, dev) != hipSuccess) { grid = -1; return; }
        if (hipFuncSetAttribute((const void*)trunk_fwd, hipFuncAttributeMaxDynamicSharedMemorySize, LDS_BYTES) != hipSuccess) { fprintf(stderr, "kernel_launch: hipFuncSetAttribute failed\n"); grid = -1; return; }
        if (hipOccupancyMaxActiveBlocksPerMultiprocessor(&per_cu, (const void*)trunk_fwd, NWAVES * 64, LDS_BYTES) != hipSuccess || per_cu < 1)
            fprintf(stderr, "kernel_launch: note: occupancy query reports %d workgroups per CU\n", per_cu);
        (void)hipGetLastError();
        grid = cus;
    }
    if (grid < 0) return;
    if (hipMemsetAsync((char*)d_ws + WS_CTL, 0, CTL_ZERO_BYTES, stream) != hipSuccess) { fprintf(stderr, "kernel_launch: memset failed\n"); return; }
    Args a{};
    a.x = (const float*)d_in[0]; a.c = (const float*)d_in[1]; a.pos = (const int*)d_in[2]; a.w_ada = (const float*)d_in[3]; a.b_ada = (const float*)d_in[4];
    a.norm_mix_g = (const float*)d_in[5]; a.norm_ffn_g = (const float*)d_in[6]; a.pool_w = (const float*)d_in[7]; a.pool_scale = (const float*)d_in[8];
    a.hgrn_w_in = (const float*)d_in[9]; a.hgrn_lb = (const float*)d_in[10]; a.hgrn_norm_g = (const float*)d_in[11]; a.hgrn_w_out = (const float*)d_in[12];
    a.ret_w_in = (const float*)d_in[13]; a.ret_norm_g = (const float*)d_in[14]; a.ret_w_out = (const float*)d_in[15]; a.ffn_w_in = (const float*)d_in[16];
    a.ffn_w_out = (const float*)d_in[17]; a.final_g = (const float*)d_in[18];
    a.out = (float*)d_out; a.ws = (unsigned char*)d_ws;
#if MK_ONE_LAUNCH
    a.ph_lo = 0; a.ph_hi = PH_END;
    hipLaunchKernelGGL(trunk_fwd, dim3(grid), dim3(NWAVES * 64), LDS_BYTES, stream, a);
    { const hipError_t le = hipPeekAtLastError(); if (le != hipSuccess) fprintf(stderr, "kernel_launch: launch failed: %s\n", hipGetErrorName(le)); }
#else
    for (int ph = 0; ph < PH_END; ++ph) {
        if (!phase_exists(ph)) continue;
        a.ph_lo = ph; a.ph_hi = ph + 1;
        hipLaunchKernelGGL(trunk_fwd, dim3(grid), dim3(NWAVES * 64), LDS_BYTES, stream, a);
        const hipError_t le = hipPeekAtLastError();
        if (le != hipSuccess) { fprintf(stderr, "kernel_launch: launch %d failed: %s\n", ph, hipGetErrorName(le)); break; }
    }
#endif
}
```

```cpp
#include <hip/hip_runtime.h>
#include <cstdio>
#include <cstdint>

#ifndef MK_ONE_LAUNCH
#define MK_ONE_LAUNCH 1
#endif
#define REP_S0 1
#define REP_S1 1
#define REP_S2 1
#define REP_S3 1
#define REP_P0 1
#define NAIVE_SCANS 0

constexpr int DM = 2048, NB = 4, SEQ = 4096, DEPTH = 4, M = NB * SEQ;
constexpr int ADA_W = 6 * DM;
constexpr int HG_IN = 8192, HG_H = 16, HG_DK = 128;
constexpr int RT_IN = 12288, RT_H = 8, RT_DK = 256, RT_DV = 512, RT_V = 4096;
constexpr int FF = 5632, FF2 = 2 * FF;
constexpr float EPS = 1e-6f;

namespace pg8 {
#define PG8_LAS __attribute__((address_space(3)))
typedef unsigned short bf16_t;
typedef short bf16x8 __attribute__((ext_vector_type(8)));
typedef float f32x4 __attribute__((ext_vector_type(4)));
typedef unsigned u32x4 __attribute__((ext_vector_type(4)));
constexpr int BM = 256, BK = 64, HALF = 128, HTB = HALF * BK * 2  , STAGE_BYTES = 8 * HTB, NXCD = 8, WGM = 4;

__host__ __device__ __forceinline__ int lds_byte(int r, int c) { const int st = (r >> 4) * 2 + (c >> 5), rr = r & 15, cc = c & 31, ob = rr * 64 + cc * 2; return st * 1024 + (ob ^ (((ob >> 9) & 1) << 5)); }
__host__ __device__ __forceinline__ void stage_rc(int b, int& R, int& C) { const int st = b / 1024, sb = b % 1024, swz = sb ^ (((sb >> 9) & 1) << 5); R = (st >> 1) * 16 + swz / 64; C = (st & 1) * 32 + (swz % 64) / 2; }
__host__ __device__ __forceinline__ int perm32(int rho) { const int n = rho >> 4, i = rho & 15; return 8 * (i >> 2) + 4 * n + (i & 3); }

struct Unit { int pm, pn; };
struct Gemm { const bf16_t* A; const bf16_t* Bt; int M, N, K, lda, ldb, gpn; long a_gs, b_gs; };

struct StaticOrder {
    int nM, nN, nwg, G, c;
    __host__ __device__ void init(int M_, int N_, int G_, int c_) { nM = M_ / BM; nN = N_ / BM; nwg = nM * nN; G = G_; c = c_; }
    __host__ __device__ bool next(int i, Unit& u) const {
        const long L = (long)i * G + c; if (L >= nwg) return false;
        int wgid = (int)L; { const int q = nwg / NXCD, r = nwg % NXCD, xcd = wgid % NXCD, off = wgid / NXCD; wgid = (xcd < r ? xcd * (q + 1) : r * (q + 1) + (xcd - r) * q) + off; }
        const int nig = WGM * nN, gid = wgid / nig, fm = gid * WGM, gsz = (nM - fm) < WGM ? (nM - fm) : WGM;
        u.pm = fm + ((wgid % nig) % gsz); u.pn = (wgid % nig) / gsz; return true;
    }
    __device__ __forceinline__ void a_ready(const Unit&) const {}
    __device__ __forceinline__ void done(const Unit&) const {}
};

__device__ __forceinline__ unsigned cvt_pk_bf16(float lo, float hi) { unsigned r; asm volatile("v_cvt_pk_bf16_f32 %0, %1, %2" : "=v"(r) : "v"(lo), "v"(hi)); return r; }

struct EpiBf16 {
    static constexpr bool PERM = true, AFTER_DRAIN = false;
    bf16_t* O; int ldc;
    __device__ __forceinline__ void operator()(const f32x4 (&acc)[2][2][4][2], const Unit& u, int wr, int wc, int fr, int fq) const {
        const int row0 = u.pm * BM + wr * 64 + fr, col0 = u.pn * BM + wc * 32 + 8 * fq;
#pragma unroll
        for (int ai = 0; ai < 2; ++ai)
#pragma unroll
            for (int m = 0; m < 4; ++m) { bf16_t* rowp = O + (size_t)(row0 + ai * HALF + m * 16) * ldc + col0;
#pragma unroll
                for (int bj = 0; bj < 2; ++bj) { const f32x4 v0 = acc[ai][bj][m][0], v1 = acc[ai][bj][m][1];
                    u32x4 w; w.x = cvt_pk_bf16(v0[0], v0[1]); w.y = cvt_pk_bf16(v0[2], v0[3]); w.z = cvt_pk_bf16(v1[0], v1[1]); w.w = cvt_pk_bf16(v1[2], v1[3]);
                    *(u32x4*)(rowp + bj * HALF) = w; } }
    }
};
__device__ __forceinline__ float scan16_mul(float x) {
#define PG8_DPP_SHR(v, n) __builtin_bit_cast(float, __builtin_amdgcn_update_dpp(0x3f800000, __builtin_bit_cast(int, v), 0x110 + (n), 0xf, 0xf, false))
    x *= PG8_DPP_SHR(x, 1); x *= PG8_DPP_SHR(x, 2); x *= PG8_DPP_SHR(x, 4); x *= PG8_DPP_SHR(x, 8);
#undef PG8_DPP_SHR
    return x;
}
__device__ __forceinline__ float bcast15(float x, int lane) { (void)lane; return __builtin_bit_cast(float, __builtin_amdgcn_update_dpp(0, __builtin_bit_cast(int, x), 0x15F, 0xf, 0xf, false)); }
__device__ __forceinline__ float sigm_f(float x) { return __builtin_amdgcn_rcpf(1.0f + __builtin_amdgcn_exp2f(-1.4426950408889634f * x)); }
struct EpiBf16Rot {
    static constexpr bool PERM = true, AFTER_DRAIN = false;
    bf16_t* O; int ldc; const float* ct; const float* st; int rot_tiles;
    int hg_tiles; const float* lbv; bf16_t* QD; bf16_t* KI; bf16_t* KE; float* DEC; bf16_t* HV;
    __device__ __forceinline__ void operator()(const f32x4 (&acc)[2][2][4][2], const Unit& u, int wr, int wc, int fr, int fq) const {
        const int row0 = u.pm * BM + wr * 64 + fr, col0 = u.pn * BM + wc * 32 + 8 * fq;
        if (u.pn < hg_tiles) {
            const int lane = fq * 16 + fr, cg = u.pn * HALF + wc * 32 + 8 * fq;
            float lb[8];
            { const f32x4 l0 = *(const f32x4*)(lbv + cg), l1 = *(const f32x4*)(lbv + cg + 4);
#pragma unroll
              for (int e = 0; e < 4; ++e) { lb[e] = l0[e]; lb[4 + e] = l1[e]; } }
#pragma unroll
            for (int ai = 0; ai < 2; ++ai)
#pragma unroll
                for (int mp = 0; mp < 2; ++mp) {
                    float qd0[8], ki0[8], ke0[8], qd1[8], ki1[8], ke1[8], tot[8];
#pragma unroll
                    for (int c = 0; c < 8; ++c) {
                        const float z0 = acc[ai][1][2 * mp][c >> 2][c & 3], z1 = acc[ai][1][2 * mp + 1][c >> 2][c & 3];
                        const float q0 = acc[ai][0][2 * mp][c >> 2][c & 3], q1 = acc[ai][0][2 * mp + 1][c >> 2][c & 3];
                        const float s0 = sigm_f(z0), s1 = sigm_f(z1), om = 1.0f - lb[c];
                        const float e0 = scan16_mul(lb[c] + om * s0);
                        const float e1 = scan16_mul(lb[c] + om * s1) * bcast15(e0, lane);
                        const float tt = bcast15(e1, lane);
                        const float k0 = om * (1.0f - s0) * __builtin_amdgcn_rcpf(e0), k1 = om * (1.0f - s1) * __builtin_amdgcn_rcpf(e1);
                        qd0[c] = q0 * e0; ki0[c] = k0; ke0[c] = k0 * tt; qd1[c] = q1 * e1; ki1[c] = k1; ke1[c] = k1 * tt; tot[c] = tt;
                    }
                    const int rr0 = row0 + ai * HALF + 32 * mp;
                    const size_t r0 = ((size_t)((rr0 >> 12) * 16 + u.pn) * 4096 + (rr0 & 4095)) * 128 + (wc * 32 + 8 * fq), r1 = r0 + 16 * 128;
                    u32x4 w;
                    w.x = cvt_pk_bf16(qd0[0], qd0[1]); w.y = cvt_pk_bf16(qd0[2], qd0[3]); w.z = cvt_pk_bf16(qd0[4], qd0[5]); w.w = cvt_pk_bf16(qd0[6], qd0[7]); *(u32x4*)(QD + r0) = w;
                    w.x = cvt_pk_bf16(ki0[0], ki0[1]); w.y = cvt_pk_bf16(ki0[2], ki0[3]); w.z = cvt_pk_bf16(ki0[4], ki0[5]); w.w = cvt_pk_bf16(ki0[6], ki0[7]); *(u32x4*)(KI + r0) = w;
                    w.x = cvt_pk_bf16(ke0[0], ke0[1]); w.y = cvt_pk_bf16(ke0[2], ke0[3]); w.z = cvt_pk_bf16(ke0[4], ke0[5]); w.w = cvt_pk_bf16(ke0[6], ke0[7]); *(u32x4*)(KE + r0) = w;
                    w.x = cvt_pk_bf16(qd1[0], qd1[1]); w.y = cvt_pk_bf16(qd1[2], qd1[3]); w.z = cvt_pk_bf16(qd1[4], qd1[5]); w.w = cvt_pk_bf16(qd1[6], qd1[7]); *(u32x4*)(QD + r1) = w;
                    w.x = cvt_pk_bf16(ki1[0], ki1[1]); w.y = cvt_pk_bf16(ki1[2], ki1[3]); w.z = cvt_pk_bf16(ki1[4], ki1[5]); w.w = cvt_pk_bf16(ki1[6], ki1[7]); *(u32x4*)(KI + r1) = w;
                    w.x = cvt_pk_bf16(ke1[0], ke1[1]); w.y = cvt_pk_bf16(ke1[2], ke1[3]); w.z = cvt_pk_bf16(ke1[4], ke1[5]); w.w = cvt_pk_bf16(ke1[6], ke1[7]); *(u32x4*)(KE + r1) = w;
                    if (fr == 15) { const int crow = u.pm * BM + wr * 64 + ai * HALF + 32 * mp; float* dp = DEC + ((size_t)((crow >> 12) * 16 + u.pn) * 128 + ((crow & 4095) >> 5)) * 128 + (wc * 32 + 8 * fq);
                        *(f32x4*)dp = (f32x4){tot[0], tot[1], tot[2], tot[3]}; *(f32x4*)(dp + 4) = (f32x4){tot[4], tot[5], tot[6], tot[7]}; }
                }
        } else if (u.pn < rot_tiles) {
            const float sc = u.pn >= 8 ? 0.0625f : 1.0f; const int j0 = wc * 32 + 8 * fq;
#pragma unroll
            for (int ai = 0; ai < 2; ++ai)
#pragma unroll
                for (int m = 0; m < 4; ++m) { const int row = row0 + ai * HALF + m * 16; bf16_t* rowp = O + (size_t)row * ldc + col0;
                    const f32x4 c0 = *(const f32x4*)(ct + (size_t)row * 128 + j0), c1 = *(const f32x4*)(ct + (size_t)row * 128 + j0 + 4);
                    const f32x4 s0 = *(const f32x4*)(st + (size_t)row * 128 + j0), s1 = *(const f32x4*)(st + (size_t)row * 128 + j0 + 4);
                    const f32x4 a0 = acc[ai][0][m][0], a1 = acc[ai][0][m][1], b0 = acc[ai][1][m][0], b1 = acc[ai][1][m][1];
                    const f32x4 p0 = (a0 * c0 - b0 * s0) * sc, p1 = (a1 * c1 - b1 * s1) * sc, q0 = (a0 * s0 + b0 * c0) * sc, q1 = (a1 * s1 + b1 * c1) * sc;
                    u32x4 w; w.x = cvt_pk_bf16(p0[0], p0[1]); w.y = cvt_pk_bf16(p0[2], p0[3]); w.z = cvt_pk_bf16(p1[0], p1[1]); w.w = cvt_pk_bf16(p1[2], p1[3]);
                    *(u32x4*)rowp = w;
                    w.x = cvt_pk_bf16(q0[0], q0[1]); w.y = cvt_pk_bf16(q0[2], q0[3]); w.z = cvt_pk_bf16(q1[0], q1[1]); w.w = cvt_pk_bf16(q1[2], q1[3]);
                    *(u32x4*)(rowp + HALF) = w; }
        } else {
            const bool hv = hg_tiles > 0 && u.pn < 24;
#pragma unroll
            for (int ai = 0; ai < 2; ++ai)
#pragma unroll
                for (int m = 0; m < 4; ++m) { const int row = row0 + ai * HALF + m * 16; bf16_t* rowp = O + (size_t)row * ldc + col0;
#pragma unroll
                    for (int bj = 0; bj < 2; ++bj) { const f32x4 v0 = acc[ai][bj][m][0], v1 = acc[ai][bj][m][1];
                        u32x4 w; w.x = cvt_pk_bf16(v0[0], v0[1]); w.y = cvt_pk_bf16(v0[2], v0[3]); w.z = cvt_pk_bf16(v1[0], v1[1]); w.w = cvt_pk_bf16(v1[2], v1[3]);
                        if (hv) *(u32x4*)(HV + ((size_t)((row >> 12) * 16 + 2 * (u.pn - 16) + bj) * 4096 + (row & 4095)) * 128 + wc * 32 + 8 * fq) = w;
                        else *(u32x4*)(rowp + bj * HALF) = w; } }
        }
    }
};
__device__ __forceinline__ float silu_f(float x) { return x * __builtin_amdgcn_rcpf(1.0f + __builtin_amdgcn_exp2f(-1.4426950408889634f * x)); }
struct EpiSwiGLU {
    static constexpr bool PERM = true, AFTER_DRAIN = false;
    bf16_t* O; int ldc;
    __device__ __forceinline__ void operator()(const f32x4 (&acc)[2][2][4][2], const Unit& u, int wr, int wc, int fr, int fq) const {
        const int row0 = u.pm * BM + wr * 64 + fr, col0 = u.pn * HALF + wc * 32 + 8 * fq;
#pragma unroll
        for (int ai = 0; ai < 2; ++ai)
#pragma unroll
            for (int m = 0; m < 4; ++m) { bf16_t* rowp = O + (size_t)(row0 + ai * HALF + m * 16) * ldc + col0;
                const f32x4 g0 = acc[ai][0][m][0], g1 = acc[ai][0][m][1], u0 = acc[ai][1][m][0], u1 = acc[ai][1][m][1];
                f32x4 e0 = g0 * -1.4426950408889634f, e1 = g1 * -1.4426950408889634f;
                const f32x4 p0 = g0 * u0, p1 = g1 * u1;
                __builtin_amdgcn_sched_barrier(0);
#pragma unroll
                for (int i = 0; i < 4; ++i) { e0[i] = __builtin_amdgcn_exp2f(e0[i]); e1[i] = __builtin_amdgcn_exp2f(e1[i]); }
                __builtin_amdgcn_sched_barrier(0);
                e0 = e0 + 1.0f; e1 = e1 + 1.0f;
                __builtin_amdgcn_sched_barrier(0);
#pragma unroll
                for (int i = 0; i < 4; ++i) { e0[i] = __builtin_amdgcn_rcpf(e0[i]); e1[i] = __builtin_amdgcn_rcpf(e1[i]); }
                __builtin_amdgcn_sched_barrier(0);
                const f32x4 o0 = p0 * e0, o1 = p1 * e1;
                u32x4 w; w.x = cvt_pk_bf16(o0[0], o0[1]); w.y = cvt_pk_bf16(o0[2], o0[3]); w.z = cvt_pk_bf16(o1[0], o1[1]); w.w = cvt_pk_bf16(o1[2], o1[3]);
                *(u32x4*)rowp = w; }
    }
};
struct EpiResid {
    static constexpr bool PERM = true, AFTER_DRAIN = false;
    const float* xin; const bf16_t* hin; bf16_t* hout; const float* gate; int gate_bs; const float* cscale;
    __device__ __forceinline__ void operator()(const f32x4 (&acc)[2][2][4][2], const Unit& u, int wr, int wc, int fr, int fq) const {
        const int row0 = u.pm * BM + wr * 64 + fr, col0 = u.pn * BM + wc * 32 + 8 * fq;
        const float* gp = gate + (size_t)(u.pm >> 4) * gate_bs + col0;
        f32x4 gv[2][2];
#pragma unroll
        for (int bj = 0; bj < 2; ++bj)
#pragma unroll
            for (int n = 0; n < 2; ++n) { gv[bj][n] = *(const f32x4*)(gp + bj * HALF + n * 4); if (cscale) gv[bj][n] = gv[bj][n] * *(const f32x4*)(cscale + col0 + bj * HALF + n * 4); }
#pragma unroll
        for (int ai = 0; ai < 2; ++ai)
#pragma unroll
            for (int m = 0; m < 4; ++m) { const size_t ro = (size_t)(row0 + ai * HALF + m * 16) * DM + col0;
#pragma unroll
                for (int bj = 0; bj < 2; ++bj) {
                    f32x4 h0, h1;
                    if (xin) { h0 = *(const f32x4*)(xin + ro + bj * HALF); h1 = *(const f32x4*)(xin + ro + bj * HALF + 4); }
                    else { const u32x4 hb = *(const u32x4*)(hin + ro + bj * HALF);
                        h0 = (f32x4){__builtin_bit_cast(float, hb.x << 16), __builtin_bit_cast(float, hb.x & 0xffff0000u), __builtin_bit_cast(float, hb.y << 16), __builtin_bit_cast(float, hb.y & 0xffff0000u)};
                        h1 = (f32x4){__builtin_bit_cast(float, hb.z << 16), __builtin_bit_cast(float, hb.z & 0xffff0000u), __builtin_bit_cast(float, hb.w << 16), __builtin_bit_cast(float, hb.w & 0xffff0000u)}; }
                    const f32x4 o0 = h0 + gv[bj][0] * acc[ai][bj][m][0], o1 = h1 + gv[bj][1] * acc[ai][bj][m][1];
                    u32x4 w; w.x = cvt_pk_bf16(o0[0], o0[1]); w.y = cvt_pk_bf16(o0[2], o0[3]); w.z = cvt_pk_bf16(o1[0], o1[1]); w.w = cvt_pk_bf16(o1[2], o1[3]);
                    *(u32x4*)(hout + ro + bj * HALF) = w; } }
    }
};

template <class Epi, class Sched, bool ALIGN_EPI = false>
__device__ __forceinline__ void gemm_phase(PG8_LAS unsigned char* lds, const Gemm g, const Sched& S, const Epi& E, const int tid) {
    const int wid = __builtin_amdgcn_readfirstlane(tid >> 6), lane = tid & 63, wr = wid >> 2, wc = wid & 3, fr = lane & 15, fq = lane >> 4;
    const int K = g.K, nt = K / BK, lda = g.lda, ldb = g.ldb;
    unsigned voffA[2], voffB[2];
#pragma unroll
    for (int i = 0; i < 2; ++i) { int R, C; stage_rc(tid * 16 + i * 8192, R, C); const int Rb = Epi::PERM ? ((R & ~31) + perm32(R & 31)) : R;
        voffA[i] = (unsigned)(R * lda + C) * 2u; voffB[i] = (unsigned)(Rb * ldb + C) * 2u; }
    const unsigned kstep = (unsigned)(BK * 2);
    const unsigned hstepA = (unsigned)HALF * lda * 2u, hstepB = (unsigned)HALF * ldb * 2u;
    const __amdgpu_buffer_rsrc_t rsA = __builtin_amdgcn_make_buffer_rsrc((void*)g.A, (short)0, 0x7fffffff, 0x00020000), rsB = __builtin_amdgcn_make_buffer_rsrc((void*)g.Bt, (short)0, 0x7fffffff, 0x00020000);
    const unsigned ldsw = (unsigned)wid * 1024u;
    const int aoff = lds_byte(wr * 64 + fr, fq * 8), boff = lds_byte(wc * 32 + fr, fq * 8);
#define PG8_SA(b, h) (((b) * 2 + (h)) * HTB)
#define PG8_SB(b, h) ((4 + (b) * 2 + (h)) * HTB)
#define PG8_STAGEA(bufoff, soff, voff) do { _Pragma("unroll") for (int _i = 0; _i < 2; ++_i) \
        __builtin_amdgcn_raw_ptr_buffer_load_lds(rsA, (PG8_LAS unsigned*)(lds + (bufoff) + ldsw + _i * 8192), 16, (voff)[_i], (soff), 0, 0); } while (0)
#define PG8_STAGEB(bufoff, soff, voff) do { _Pragma("unroll") for (int _i = 0; _i < 2; ++_i) \
        __builtin_amdgcn_raw_ptr_buffer_load_lds(rsB, (PG8_LAS unsigned*)(lds + (bufoff) + ldsw + _i * 8192), 16, (voff)[_i], (soff), 0, 0); } while (0)
#define PG8_LDA(dst, b, h) do { _Pragma("unroll") for (int m = 0; m < 4; ++m) _Pragma("unroll") for (int k = 0; k < 2; ++k) dst[m][k] = *(const PG8_LAS bf16x8*)(lds + PG8_SA(b, h) + aoff + m * 2048 + k * 1024); } while (0)
#define PG8_LDB(dst, b, h) do { _Pragma("unroll") for (int n = 0; n < 2; ++n) _Pragma("unroll") for (int k = 0; k < 2; ++k) dst[n][k] = *(const PG8_LAS bf16x8*)(lds + PG8_SB(b, h) + boff + n * 2048 + k * 1024); } while (0)
#define PG8_MMA(ai, bj, At, Bt) do { __builtin_amdgcn_s_setprio(1); _Pragma("unroll") for (int m = 0; m < 4; ++m) _Pragma("unroll") for (int n = 0; n < 2; ++n) _Pragma("unroll") for (int k = 0; k < 2; ++k) \
        acc[ai][bj][m][n] = __builtin_amdgcn_mfma_f32_16x16x32_bf16(Bt[n][k], At[m][k], acc[ai][bj][m][n], 0, 0, 0); __builtin_amdgcn_s_setprio(0); } while (0)
#define PG8_WAIT_V(n) asm volatile("s_waitcnt vmcnt(" #n ")" ::: "memory")
#define PG8_WAIT_L(n) asm volatile("s_waitcnt lgkmcnt(" #n ")" ::: "memory")
#define PG8_BAR __builtin_amdgcn_s_barrier()
#define PG8_SCHED __builtin_amdgcn_sched_barrier(0)
#define PG8_ABASE(u) ((unsigned)(((size_t)((u).pn / g.gpn) * (size_t)g.a_gs + (size_t)(u).pm * BM * lda) * 2))
#define PG8_BBASE(u) ((unsigned)(((size_t)((u).pn / g.gpn) * (size_t)g.b_gs + (size_t)((u).pn % g.gpn) * BM * ldb) * 2))
    Unit cur, nxt; int ui = 0;
    if (!S.next(0, cur)) return;
    f32x4 acc[2][2][4][2];
#pragma unroll
    for (int a = 0; a < 2; ++a)
#pragma unroll
        for (int b = 0; b < 2; ++b)
#pragma unroll
            for (int m = 0; m < 4; ++m)
#pragma unroll
                for (int n = 0; n < 2; ++n) acc[a][b][m][n] = (f32x4){0.f, 0.f, 0.f, 0.f};
    bf16x8 At[4][2], B0[2][2], B1[2][2];
    unsigned cA = PG8_ABASE(cur), cB = PG8_BBASE(cur);
    S.a_ready(cur);
    PG8_STAGEB(PG8_SB(0, 0), cB, voffB); PG8_STAGEB(PG8_SB(0, 1), cB + hstepB, voffB); PG8_STAGEA(PG8_SA(0, 0), cA, voffA); PG8_STAGEA(PG8_SA(0, 1), cA + hstepA, voffA);
    PG8_STAGEB(PG8_SB(1, 0), cB + kstep, voffB); PG8_STAGEA(PG8_SA(1, 0), cA + kstep, voffA); PG8_STAGEB(PG8_SB(1, 1), cB + hstepB + kstep, voffB);
    if (wr == 1) PG8_BAR;
    PG8_WAIT_V(8); PG8_BAR;
    PG8_WAIT_V(6); PG8_BAR;
    for (;;) {
        const bool has_next = S.next(ui + 1, nxt);
        const unsigned nA = has_next ? PG8_ABASE(nxt) : cA, nB = has_next ? PG8_BBASE(nxt) : cB;
        for (int t = 0; t < nt; t += 2) {
            const bool last = (t == nt - 2);
            const unsigned a1 = cA + (unsigned)(t + 1) * kstep;
            const unsigned a2 = last ? nA : cA + (unsigned)(t + 2) * kstep, b2 = last ? nB : cB + (unsigned)(t + 2) * kstep;
            const unsigned a3 = a2 + kstep, b3 = b2 + kstep;
            if (last && has_next) S.a_ready(nxt);
            PG8_LDB(B0, 0, 0); PG8_LDB(B1, 0, 1); PG8_SCHED; PG8_LDA(At, 0, 0); PG8_STAGEA(PG8_SA(1, 1), a1 + hstepA, voffA);
            PG8_WAIT_V(8); PG8_WAIT_L(0); PG8_BAR; PG8_MMA(0, 0, At, B0); PG8_MMA(0, 1, At, B1); PG8_BAR; PG8_SCHED;
            PG8_LDA(At, 0, 1); PG8_STAGEB(PG8_SB(0, 0), b2, voffB); PG8_STAGEB(PG8_SB(0, 1), b2 + hstepB, voffB); PG8_STAGEA(PG8_SA(0, 0), a2, voffA);
            PG8_WAIT_V(8); PG8_WAIT_L(0); PG8_BAR; PG8_MMA(1, 0, At, B0); PG8_MMA(1, 1, At, B1); PG8_BAR; PG8_SCHED;
            PG8_LDB(B0, 1, 0); PG8_LDB(B1, 1, 1); PG8_SCHED; PG8_LDA(At, 1, 0); PG8_STAGEA(PG8_SA(0, 1), a2 + hstepA, voffA);
            PG8_WAIT_V(8); PG8_WAIT_L(0); PG8_BAR; PG8_MMA(0, 0, At, B0); PG8_MMA(0, 1, At, B1); PG8_BAR; PG8_SCHED;
            PG8_LDA(At, 1, 1); PG8_STAGEB(PG8_SB(1, 0), b3, voffB); PG8_STAGEB(PG8_SB(1, 1), b3 + hstepB, voffB); PG8_STAGEA(PG8_SA(1, 0), a3, voffA);
            PG8_WAIT_V(8); PG8_WAIT_L(0); PG8_BAR; PG8_MMA(1, 0, At, B0); PG8_MMA(1, 1, At, B1); PG8_BAR; PG8_SCHED;
        }
        if constexpr (ALIGN_EPI) { if (wr == 0) PG8_BAR; }
        E(acc, cur, wr, wc, fr, fq); S.done(cur);
        if (!has_next) break;
#pragma unroll
        for (int a = 0; a < 2; ++a)
#pragma unroll
            for (int b = 0; b < 2; ++b)
#pragma unroll
                for (int m = 0; m < 4; ++m)
#pragma unroll
                    for (int n = 0; n < 2; ++n) acc[a][b][m][n] = (f32x4){0.f, 0.f, 0.f, 0.f};
        cur = nxt; cA = nA; cB = nB; ++ui;
        if constexpr (ALIGN_EPI) { if (wr == 1) PG8_BAR; }
    }
    PG8_WAIT_V(0);
    if constexpr (!ALIGN_EPI) { if (wr == 0) PG8_BAR; }
    PG8_BAR;
#undef PG8_SA
#undef PG8_SB
#undef PG8_STAGEA
#undef PG8_STAGEB
#undef PG8_LDA
#undef PG8_LDB
#undef PG8_MMA
#undef PG8_WAIT_V
#undef PG8_WAIT_L
#undef PG8_BAR
#undef PG8_SCHED
#undef PG8_ABASE
#undef PG8_BBASE
}
}

constexpr size_t MiB = 1u << 20;
constexpr size_t WS_CTL = 0, CTL_ZERO_BYTES = 1 * MiB;
constexpr size_t WS_ADA = 1 * MiB;
constexpr size_t WS_LB = 2 * MiB;
constexpr size_t WS_XRS = 3 * MiB;
constexpr size_t WS_ROT = 4 * MiB;
constexpr size_t WS_POOLW = 20 * MiB;
constexpr size_t WS_HGWIN = 24 * MiB;
constexpr size_t WS_HGWOUT = 56 * MiB;
constexpr size_t WS_RTWIN = 64 * MiB;
constexpr size_t WS_RTWOUT = 112 * MiB;
constexpr size_t WS_FFWIN = 128 * MiB;
constexpr size_t WS_FFWOUT = 304 * MiB;
constexpr size_t WS_U = 392 * MiB;
constexpr size_t WS_P = 456 * MiB;
constexpr size_t WS_PROJ = 584 * MiB;
constexpr size_t WS_O = 968 * MiB;
constexpr size_t WS_H = 1224 * MiB;
constexpr size_t WS_H2 = 1288 * MiB;
constexpr size_t WS_END = 1352 * MiB;
constexpr int CW_TMO = 0, CW_CODE = 1, CW_BAR = 4096;

constexpr int RING_OFF = 0, RING_BYTES = 131072;
constexpr int LDSCTL_OFF = RING_BYTES, MISC_OFF = LDSCTL_OFF + 320;
constexpr int LDS_BYTES = 147456;
constexpr int NWAVES = 8;

#define GAS __attribute__((address_space(1)))
#define LAS __attribute__((address_space(3)))
#define CAS __attribute__((address_space(4)))
typedef unsigned short bf16;
typedef unsigned v4u __attribute__((ext_vector_type(4)));
typedef unsigned v2u __attribute__((ext_vector_type(2)));
typedef float f32x4 __attribute__((ext_vector_type(4)));
typedef GAS unsigned gu32;
#define RLX_AGENT __ATOMIC_RELAXED, __HIP_MEMORY_SCOPE_AGENT
#define LDS_WAIT() asm volatile("s_waitcnt lgkmcnt(0)" ::: "memory")
__device__ __forceinline__ unsigned f2bf(float f) { unsigned u = __builtin_bit_cast(unsigned, f); return (u + 0x7fffu + ((u >> 16) & 1u)) >> 16; }
typedef float pk_f2 __attribute__((ext_vector_type(2)));
typedef __bf16 pk_b2 __attribute__((ext_vector_type(2)));
__device__ __forceinline__ unsigned pk2(float lo, float hi) { const pk_f2 v = {lo, hi}; return __builtin_bit_cast(unsigned, __builtin_convertvector(v, pk_b2)); }
__device__ __forceinline__ float bflo(unsigned w) { return __builtin_bit_cast(float, w << 16); }
__device__ __forceinline__ float bfhi(unsigned w) { return __builtin_bit_cast(float, w & 0xffff0000u); }
__device__ __forceinline__ float bf1(bf16 b) { return __builtin_bit_cast(float, (unsigned)b << 16); }
__device__ __forceinline__ float sigmoid_f(float x) { return __builtin_amdgcn_rcpf(1.0f + __builtin_amdgcn_exp2f(-1.4426950408889634f * x)); }
__device__ __forceinline__ float silu1(float x) { return x * sigmoid_f(x); }

#define XB_TMO      128
#define XB_XCNT(j)  (256  + 64 * (j))
#define XB_XSUB(j)  (1280 + 64 * (j))
#define XB_XGEN(j)  (2304 + 64 * (j))
#define XB_TOP      3328
#define XB_TOPGEN   3392
#define XCD_BAR_WORDS 3456
#define XB_SPIN_CAP (1u << 18)

__device__ __forceinline__ unsigned xb_ld(unsigned* p)              { return __hip_atomic_load(p, __ATOMIC_RELAXED, __HIP_MEMORY_SCOPE_AGENT); }
__device__ __forceinline__ unsigned xb_add(unsigned* p, unsigned v) { return __hip_atomic_fetch_add(p, v, __ATOMIC_RELAXED, __HIP_MEMORY_SCOPE_AGENT); }
__device__ __forceinline__ unsigned xb_xcc_id() { return (unsigned)__builtin_amdgcn_s_getreg((3 << 11) | 20) & 0xFu; }
#define XB_SPIN(cond, bar) do { unsigned _sp = 0; while (cond) { __builtin_amdgcn_s_sleep(1); \
    if ((++_sp & 255u) == 0u) { if (xb_ld(&(bar)[XB_TMO])) break; if (_sp > XB_SPIN_CAP) { atomicAdd(&(bar)[XB_TMO], 1u); break; } } } } while (0)

struct XcdBarrier { unsigned* bar; unsigned x; volatile LAS unsigned* st; };
#define XB_TID() ((int)__builtin_amdgcn_mbcnt_hi(~0u, __builtin_amdgcn_mbcnt_lo(~0u, 0u)) + 64 * xb_wave_id)

__device__ __forceinline__ XcdBarrier xcd_barrier_post(unsigned* bar, volatile LAS unsigned* st, const int xb_wave_id) {
    XcdBarrier b; b.bar = bar; b.x = xb_xcc_id(); b.st = st;
    if (XB_TID() == 0) (void)xb_add(&bar[XB_XCNT(b.x)], 1u);
    return b;
}
__device__ __forceinline__ void xcd_barrier_complete(unsigned* bar, unsigned x, unsigned& nloc, unsigned& nx) {
    const unsigned G = gridDim.x * gridDim.y * gridDim.z;
    unsigned sum, cnt, mine, sp = 0u;
    for (;;) {
        sum = 0u; cnt = 0u; mine = 0u;
#pragma unroll
        for (unsigned j = 0; j < 16; ++j) { const unsigned c = xb_ld(&bar[XB_XCNT(j)]); sum += c; cnt += (c > 0u) ? 1u : 0u; mine = (j == x) ? c : mine; }
        if (sum == G) break;
        __builtin_amdgcn_s_sleep(1);
        if ((++sp & 255u) == 0u) { if (xb_ld(&bar[XB_TMO])) break; if (sp > XB_SPIN_CAP) { atomicAdd(&bar[XB_TMO], 1u); break; } }
    }
    nloc = mine > 0u ? mine : 1u; nx = cnt > 0u ? cnt : 1u;
}
__device__ __forceinline__ void xcd_barrier(const XcdBarrier& b, const int xb_wave_id) {
    asm volatile("s_waitcnt vmcnt(0)" ::: "memory");
    __syncthreads();
    if (XB_TID() == 0) {
        unsigned* bar = b.bar;
        __builtin_amdgcn_s_waitcnt(0);
        unsigned nloc = b.st[0], nx = b.st[1];
        if (nloc == 0u) { xcd_barrier_complete(bar, b.x, nloc, nx); b.st[0] = nloc; b.st[1] = nx; }
        const unsigned old = xb_add(&bar[XB_XSUB(b.x)], 1u);
        const unsigned gen = old / nloc;
        if (old + 1u == (gen + 1u) * nloc) {
            __builtin_amdgcn_fence(__ATOMIC_RELEASE, "agent");
            asm volatile("s_waitcnt vmcnt(0)" ::: "memory");
            const unsigned og = xb_add(&bar[XB_TOP], 1u);
            const unsigned tg = og / nx;
            if (og + 1u == (tg + 1u) * nx) xb_add(&bar[XB_TOPGEN], 1u);
            else XB_SPIN(xb_ld(&bar[XB_TOPGEN]) == tg, bar);
            __builtin_amdgcn_fence(__ATOMIC_ACQUIRE, "agent");
            xb_add(&bar[XB_XGEN(b.x)], 1u);
            asm volatile("s_waitcnt vmcnt(0)" ::: "memory");
        } else {
            XB_SPIN(xb_ld(&bar[XB_XGEN(b.x)]) == gen, bar);
            __builtin_amdgcn_fence(__ATOMIC_ACQUIRE, "agent");
            asm volatile("s_waitcnt vmcnt(0)" ::: "memory");
        }
    }
    __syncthreads();
}

struct Args {
    const float* x; const float* c; const int* pos; const float* w_ada; const float* b_ada; const float* norm_mix_g; const float* norm_ffn_g;
    const float* pool_w; const float* pool_scale; const float* hgrn_w_in; const float* hgrn_lb; const float* hgrn_norm_g; const float* hgrn_w_out;
    const float* ret_w_in; const float* ret_norm_g; const float* ret_w_out; const float* ffn_w_in; const float* ffn_w_out; const float* final_g;
    float* out; unsigned char* ws; int ph_lo, ph_hi;
};

#define WS_DPP(v, ctrl) __builtin_bit_cast(float, __builtin_amdgcn_update_dpp(0, __builtin_bit_cast(int, v), (ctrl), 0xf, 0xf, true))
__device__ __forceinline__ float row16_sum(float v) { v += WS_DPP(v, 0xB1); v += WS_DPP(v, 0x4E); v += WS_DPP(v, 0x141); v += WS_DPP(v, 0x140); return v; }
#define WS_RL(v, l) __builtin_bit_cast(float, __builtin_amdgcn_readlane(__builtin_bit_cast(int, v), (l)))
__device__ __forceinline__ float wave_sum(float v) { v = row16_sum(v); return (WS_RL(v, 0) + WS_RL(v, 16)) + (WS_RL(v, 32) + WS_RL(v, 48)); }
__device__ __forceinline__ float half_sum(float v) {
    v = row16_sum(v); const float lo = WS_RL(v, 0) + WS_RL(v, 16), hi = WS_RL(v, 32) + WS_RL(v, 48);
    return (__builtin_amdgcn_mbcnt_hi(~0u, __builtin_amdgcn_mbcnt_lo(~0u, 0u)) < 32u) ? lo : hi; }

struct TItem { const float* W; bf16* WT; int K, N, mode, item; };
__device__ __forceinline__ void titem_load(const TItem& t, int lane, f32x4 (&wv)[8]) {
    const int nblk = t.N / 32, kb = t.item / nblk, nb = t.item % nblk, k0 = 64 * kb, n0 = 32 * nb;
#pragma unroll
    for (int i = 0; i < 8; ++i) wv[i] = *(const GAS f32x4*)(t.W + (size_t)(k0 + 8 * i + (lane >> 3)) * t.N + n0 + 4 * (lane & 7));
}
__device__ __forceinline__ void titem_finish(const TItem& t, LAS float* scr, int lane, const f32x4 (&wv)[8]) {
    const int nblk = t.N / 32, kb = t.item / nblk, nb = t.item % nblk, k0 = 64 * kb, n0 = 32 * nb;
    int d0 = n0;
    if (t.mode == 1) { const int bj = n0 >= FF ? 1 : 0, j = n0 - bj * FF; d0 = 256 * (j >> 7) + 128 * bj + (j & 127); }
    if (t.mode == 2 && n0 < 4096) { const int bj = n0 >> 11, j = n0 & 2047; d0 = 256 * (j >> 7) + 128 * bj + (j & 127); }
#pragma unroll
    for (int i = 0; i < 8; ++i) { LAS float* d = scr + (8 * i + (lane >> 3)) * 33 + 4 * (lane & 7); d[0] = wv[i].x; d[1] = wv[i].y; d[2] = wv[i].z; d[3] = wv[i].w; }
    LDS_WAIT(); asm volatile("" ::: "memory");
    const int c = lane & 7;
#pragma unroll
    for (int j = 0; j < 4; ++j) { const int n = (lane >> 3) + 8 * j; const LAS float* s = scr + (8 * c) * 33 + n;
        v4u o; o.x = pk2(s[0 * 33], s[1 * 33]); o.y = pk2(s[2 * 33], s[3 * 33]); o.z = pk2(s[4 * 33], s[5 * 33]); o.w = pk2(s[6 * 33], s[7 * 33]);
        if (t.mode == 3) { const int nn = d0 + n, kk = k0 + 8 * c;
            *(GAS v4u*)(t.WT + (size_t)((((nn >> 5) * 32 + (kk >> 4)) * 64) + ((kk >> 3) & 1) * 32 + (nn & 31)) * 8) = o; }
        else *(GAS v4u*)(t.WT + (size_t)(d0 + n) * t.K + k0 + 8 * c) = o; }
    LDS_WAIT(); asm volatile("" ::: "memory");
}
__device__ __forceinline__ void transpose_item(const float* W, int K, int N, bf16* WT, int mode, LAS float* scr, int item, int lane) {
    const TItem t{W, WT, K, N, mode, item}; f32x4 wv[8]; titem_load(t, lane, wv); titem_finish(t, scr, lane, wv);
}
template <class AP> __device__ __forceinline__ void phase_prologue(const AP a, LAS unsigned char* lds, int tid, int lane, int wave, int vcu, int G) {
    unsigned char* ws = a->ws;
    float* ada = (float*)(ws + WS_ADA);
    LAS float* sc = (LAS float*)lds;
    LAS float* red = (LAS float*)(lds + 32768);
    for (int i = tid; i < NB * DM; i += 512) sc[i] = silu1(a->c[i]);
    __syncthreads();
    for (int it = vcu; it < DEPTH * (ADA_W / 256); it += G) {
        const int l = it / (ADA_W / 256), cb = it % (ADA_W / 256), e0 = cb * 256 + 4 * lane;
        const float* wp = a->w_ada + ((size_t)l * DM + (size_t)wave * 256) * ADA_W + e0;
        f32x4 acc[4];
#pragma unroll
        for (int b = 0; b < 4; ++b) acc[b] = (f32x4){0.f, 0.f, 0.f, 0.f};
#pragma unroll 16
        for (int d = 0; d < 256; ++d) {
            const f32x4 wv = *(const GAS f32x4*)(wp + (size_t)d * ADA_W);
#pragma unroll
            for (int b = 0; b < 4; ++b) { const float s = sc[b * DM + wave * 256 + d]; acc[b] = acc[b] + wv * s; }
        }
#pragma unroll
        for (int b = 0; b < 4; ++b) *(LAS f32x4*)(red + (wave * 4 + b) * 256 + 4 * lane) = acc[b];
        __syncthreads();
        for (int o = tid; o < 4 * 256; o += 512) { const int b = o >> 8, e = o & 255; float s = 0.f;
#pragma unroll
            for (int w = 0; w < 8; ++w) s += red[(w * 4 + b) * 256 + e];
            ada[((size_t)l * NB + b) * ADA_W + cb * 256 + e] = s + a->b_ada[(size_t)l * ADA_W + cb * 256 + e]; }
        __syncthreads();
    }
    const int gw = vcu * NWAVES + wave, NGW = G * NWAVES, gt = gw * 64 + lane, NGT = NGW * 64;
    { float* lb = (float*)(ws + WS_LB);
      for (int col = gt; col < DM; col += NGT) { float z[DEPTH], mx = -1e30f;
#pragma unroll
          for (int j = 0; j < DEPTH; ++j) { z[j] = a->hgrn_lb[j * DM + col]; mx = fmaxf(mx, z[j]); }
          float s = 0.f, e1 = 0.f;
#pragma unroll
          for (int j = 0; j < DEPTH; ++j) { const float e = __expf(z[j] - mx); s += e; if (j == 1) e1 = e; }
          lb[col] = e1 / s; } }
    { float* ct = (float*)(ws + WS_ROT); float* st = ct + (size_t)M * 128;
      for (int i = gt; i < M * 128; i += NGT) { const int m = i >> 7, f = i & 127;
          const float inv = exp2f(-(float)f * (13.287712379549449f / 128.0f));
          const float ang = (float)a->pos[m] * inv;
          const double rev = (double)ang * 0.15915494309189535; const float fr = (float)(rev - floor(rev));
          ct[i] = __builtin_amdgcn_cosf(fr); st[i] = __builtin_amdgcn_sinf(fr); } }
    LAS float* scr = (LAS float*)(lds + wave * 16384);
    constexpr int I_POOL = 8 * (512 / 64) * (512 / 32), I_HGI = (DM / 64) * (HG_IN / 32), I_FFI1 = (DM / 64) * (FF2 / 32), I_FFO1 = (FF / 64) * (DM / 32);
    constexpr int NITEMS = I_POOL + I_HGI + I_FFI1 + I_FFO1;
#define EARLY_DECODE(t_, it_) do { int r = (it_); \
        if (r < I_POOL) { const int mt = r / 128; t_ = TItem{a->pool_w + (size_t)mt * 512 * 512, (bf16*)(ws + WS_POOLW) + (size_t)mt * 512 * 512, 512, 512, 3, r % 128}; break; } r -= I_POOL; \
        if (r < I_HGI) { t_ = TItem{a->hgrn_w_in, (bf16*)(ws + WS_HGWIN), DM, HG_IN, 2, r}; break; } r -= I_HGI; \
        if (r < I_FFI1) { t_ = TItem{a->ffn_w_in, (bf16*)(ws + WS_FFWIN), DM, FF2, 1, r}; break; } r -= I_FFI1; \
        t_ = TItem{a->ffn_w_out, (bf16*)(ws + WS_FFWOUT), FF, DM, 0, r}; } while (0)
    { const bool balc = (G == 256); const int NGVC = DEPTH * (ADA_W / 256);
      const int lgs = (balc && vcu >= NGVC) ? 2 : 0, NGWV = balc ? NGVC * NWAVES + (G - NGVC) * NWAVES * 4 : NGW;
      const int vb = balc ? (vcu < NGVC ? gw : NGVC * NWAVES + ((vcu - NGVC) * NWAVES + wave) * 4) : gw;
#define QITEM(q) (vb + ((q) & ((1 << lgs) - 1)) + ((q) >> lgs) * NGWV)
      if (QITEM(0) < NITEMS) {
        TItem t0, t1, t2; f32x4 w0[8], w1[8], w2[8];
        EARLY_DECODE(t0, QITEM(0)); titem_load(t0, lane, w0);
        t1 = t0; if (QITEM(1) < NITEMS) { EARLY_DECODE(t1, QITEM(1)); titem_load(t1, lane, w1); }
        for (int q = 0; QITEM(q) < NITEMS; q += 3) {
            if (QITEM(q + 2) < NITEMS) { EARLY_DECODE(t2, QITEM(q + 2)); titem_load(t2, lane, w2); }
            __builtin_amdgcn_sched_barrier(0);
            titem_finish(t0, scr, lane, w0);
            if (QITEM(q + 1) >= NITEMS) break;
            if (QITEM(q + 3) < NITEMS) { EARLY_DECODE(t0, QITEM(q + 3)); titem_load(t0, lane, w0); }
            __builtin_amdgcn_sched_barrier(0);
            titem_finish(t1, scr, lane, w1);
            if (QITEM(q + 2) >= NITEMS) break;
            if (QITEM(q + 4) < NITEMS) { EARLY_DECODE(t1, QITEM(q + 4)); titem_load(t1, lane, w1); }
            __builtin_amdgcn_sched_barrier(0);
            titem_finish(t2, scr, lane, w2);
        }
      }
#undef QITEM
    }
#undef EARLY_DECODE
    { const int l31 = lane & 31, h5 = lane >> 5;
      const __amdgpu_buffer_rsrc_t rsX = __builtin_amdgcn_make_buffer_rsrc((void*)a->x, (short)0, M * DM * 4, 0x00020000);
      const __amdgpu_buffer_rsrc_t rsC = __builtin_amdgcn_make_buffer_rsrc((void*)(ws + WS_H2), (short)0, M * DM * 2, 0x00020000);
      const bool bal = (G == 256); const int NGV = DEPTH * (ADA_W / 256);
      const int rpa = bal ? (vcu < NGV ? gw : NGV * NWAVES + (vcu - NGV) * NWAVES + wave) : gw, rps = bal ? (vcu < NGV ? M : (G - NGV) * NWAVES) : NGW;
      for (int rp = rpa; rp < M / 2; rp += rps) {
          const int row = 2 * rp + h5; const unsigned vo = (unsigned)row * (DM * 4) + (unsigned)l31 * 32u, vob = (unsigned)row * (DM * 2) + (unsigned)l31 * 16u;
          v4u q0[8], q1[8];
#pragma unroll
          for (int j = 0; j < 8; ++j) { q0[j] = __builtin_amdgcn_raw_buffer_load_b128(rsX, vo, (unsigned)j * 1024u, 0); q1[j] = __builtin_amdgcn_raw_buffer_load_b128(rsX, vo, (unsigned)j * 1024u + 16u, 0); }
          float ss = 0.f;
#pragma unroll
          for (int j = 0; j < 8; ++j) { const f32x4 p = __builtin_bit_cast(f32x4, q0[j]), c = __builtin_bit_cast(f32x4, q1[j]);
              ss += ((p.x * p.x + p.y * p.y) + (p.z * p.z + p.w * p.w)) + ((c.x * c.x + c.y * c.y) + (c.z * c.z + c.w * c.w));
              v4u o; o.x = pk2(p.x, p.y); o.y = pk2(p.z, p.w); o.z = pk2(c.x, c.y); o.w = pk2(c.z, c.w);
              __builtin_amdgcn_raw_buffer_store_b128(o, rsC, vob, (unsigned)j * 512u, 0); }
          ss = half_sum(ss);
          if (l31 == 0) ((float*)(ws + WS_XRS))[row] = 1.0f / sqrtf(ss * (1.0f / DM) + EPS);
      }
    }
}
template <class AP> __device__ __forceinline__ void phase_convert_late(const AP a, LAS unsigned char* lds, int lane, int wave, int gwc, int NGWC) {
    unsigned char* ws = a->ws;
    LAS float* scr = (LAS float*)(lds + wave * 16384);
    constexpr int I_HGO = (DM / 64) * (DM / 32), I_RTI = (DM / 64) * (RT_IN / 32), I_RTO = (RT_V / 64) * (DM / 32), I_FFI1 = (DM / 64) * (FF2 / 32), I_FFO1 = (FF / 64) * (DM / 32);
    constexpr int NITEMS = I_HGO + I_RTI + I_RTO + 3 * I_FFI1 + 3 * I_FFO1;
#define LATE_DECODE(t_, it_) do { int r = (it_); \
        if (r < I_HGO) { t_ = TItem{a->hgrn_w_out, (bf16*)(ws + WS_HGWOUT), DM, DM, 0, r}; break; } r -= I_HGO; \
        if (r < I_RTI) { t_ = TItem{a->ret_w_in, (bf16*)(ws + WS_RTWIN), DM, RT_IN, 0, r}; break; } r -= I_RTI; \
        if (r < I_RTO) { t_ = TItem{a->ret_w_out, (bf16*)(ws + WS_RTWOUT), RT_V, DM, 0, r}; break; } r -= I_RTO; \
        if (r < 3 * I_FFI1) { const int l = 1 + r / I_FFI1; t_ = TItem{a->ffn_w_in + (size_t)l * DM * FF2, (bf16*)(ws + WS_FFWIN) + (size_t)l * FF2 * DM, DM, FF2, 1, r % I_FFI1}; break; } r -= 3 * I_FFI1; \
        { const int l = 1 + r / I_FFO1; t_ = TItem{a->ffn_w_out + (size_t)l * FF * DM, (bf16*)(ws + WS_FFWOUT) + (size_t)l * DM * FF, FF, DM, 0, r % I_FFO1}; } } while (0)
    if (gwc >= NITEMS) return;
    TItem t0, t1, t2; f32x4 w0[8], w1[8], w2[8];
    LATE_DECODE(t0, gwc); titem_load(t0, lane, w0);
    t1 = t0; if (gwc + NGWC < NITEMS) { LATE_DECODE(t1, gwc + NGWC); titem_load(t1, lane, w1); }
    for (int it = gwc; it < NITEMS; it += 3 * NGWC) {
        if (it + 2 * NGWC < NITEMS) { LATE_DECODE(t2, it + 2 * NGWC); titem_load(t2, lane, w2); }
        __builtin_amdgcn_sched_barrier(0);
        titem_finish(t0, scr, lane, w0);
        if (it + NGWC >= NITEMS) break;
        if (it + 3 * NGWC < NITEMS) { LATE_DECODE(t0, it + 3 * NGWC); titem_load(t0, lane, w0); }
        __builtin_amdgcn_sched_barrier(0);
        titem_finish(t1, scr, lane, w1);
        if (it + 2 * NGWC >= NITEMS) break;
        if (it + 4 * NGWC < NITEMS) { LATE_DECODE(t1, it + 4 * NGWC); titem_load(t1, lane, w1); }
        __builtin_amdgcn_sched_barrier(0);
        titem_finish(t2, scr, lane, w2);
    }
#undef LATE_DECODE
}

struct WTile { const float* W; bf16* WT; int K, N, mode, idx; };
__device__ __forceinline__ void wtile_load(const WTile& t, int lane, int wave, f32x4 (&wv)[8]) {
    const int nblk = t.N >> 7, k0 = 128 * (t.idx / nblk), n0 = 128 * (t.idx % nblk);
#pragma unroll
    for (int i = 0; i < 8; ++i) wv[i] = *(const GAS f32x4*)(t.W + (size_t)(k0 + 16 * wave + 2 * i + (lane >> 5)) * t.N + n0 + 4 * (lane & 31));
}
__device__ __forceinline__ void wtile_to_lds(LAS unsigned char* T, int lane, int wave, const f32x4 (&wv)[8]) {
#pragma unroll
    for (int i = 0; i < 8; ++i) { const int r = 16 * wave + 2 * i + (lane >> 5); *(LAS f32x4*)(T + r * 512 + (((lane & 31) ^ ((r >> 3) & 7)) << 4)) = wv[i]; }
}
__device__ __forceinline__ void wtile_store(const WTile& t, const LAS unsigned char* T, int lane, int wave) {
    const int nblk = t.N >> 7, k0 = 128 * (t.idx / nblk), n0 = 128 * (t.idx % nblk);
    const int c = (lane & 7) + 8 * (lane >> 5), nl = (lane >> 3) & 3;
#pragma unroll
    for (int p = 0; p < 4; ++p) { const int nloc = 16 * wave + 4 * p + nl, n = n0 + nloc;
        const LAS float* s = (const LAS float*)(T + (8 * c) * 512 + (((nloc >> 2) ^ (lane & 7)) << 4) + (nloc & 3) * 4);
        v4u o; o.x = pk2(s[0 * 128], s[1 * 128]); o.y = pk2(s[2 * 128], s[3 * 128]); o.z = pk2(s[4 * 128], s[5 * 128]); o.w = pk2(s[6 * 128], s[7 * 128]);
        int d = n;
        if (t.mode == 1) { const int nb = n & ~31, bj = nb >= FF ? 1 : 0, j = nb - bj * FF; d = 256 * (j >> 7) + 128 * bj + (j & 127) + (n & 31); }
        *(GAS v4u*)(t.WT + (size_t)d * t.K + k0 + 8 * c) = o; }
}
#define WT_BAR() do { asm volatile("s_waitcnt lgkmcnt(0)" ::: "memory"); __builtin_amdgcn_s_barrier(); asm volatile("" ::: "memory"); } while (0)
template <class AP> __device__ __forceinline__ void phase_convert_late_tiles(const AP a, LAS unsigned char* lds, int lane, int wave, int wgc, int NWGC) {
    unsigned char* ws = a->ws;
    constexpr int T_HGO = (DM / 128) * (DM / 128), T_RTI = (DM / 128) * (RT_IN / 128), T_RTO = (RT_V / 128) * (DM / 128), T_FFI = (DM / 128) * (FF2 / 128), T_FFO = (FF / 128) * (DM / 128);
    constexpr int NT = T_HGO + T_RTI + T_RTO + 3 * T_FFI + 3 * T_FFO;
#define LATE_TDEC(t_, it_) do { int r = (it_); \
        if (r < T_HGO) { t_ = WTile{a->hgrn_w_out, (bf16*)(ws + WS_HGWOUT), DM, DM, 0, r}; break; } r -= T_HGO; \
        if (r < T_RTI) { t_ = WTile{a->ret_w_in, (bf16*)(ws + WS_RTWIN), DM, RT_IN, 0, r}; break; } r -= T_RTI; \
        if (r < T_RTO) { t_ = WTile{a->ret_w_out, (bf16*)(ws + WS_RTWOUT), RT_V, DM, 0, r}; break; } r -= T_RTO; \
        if (r < 3 * T_FFI) { const int l = 1 + r / T_FFI; t_ = WTile{a->ffn_w_in + (size_t)l * DM * FF2, (bf16*)(ws + WS_FFWIN) + (size_t)l * FF2 * DM, DM, FF2, 1, r % T_FFI}; break; } r -= 3 * T_FFI; \
        { const int l = 1 + r / T_FFO; t_ = WTile{a->ffn_w_out + (size_t)l * FF * DM, (bf16*)(ws + WS_FFWOUT) + (size_t)l * DM * FF, FF, DM, 0, r % T_FFO}; } } while (0)
    if (wgc >= NT) return;
    WTile tc, tn; f32x4 wv[8];
    LATE_TDEC(tc, wgc); wtile_load(tc, lane, wave, wv);
    for (int it = wgc; it < NT; it += NWGC) {
        WT_BAR();
        wtile_to_lds(lds, lane, wave, wv);
        const bool more = it + NWGC < NT;
        tn = tc; if (more) { LATE_TDEC(tn, it + NWGC); wtile_load(tn, lane, wave, wv); }
        WT_BAR();
        wtile_store(tc, lds, lane, wave);
        tc = tn;
    }
    WT_BAR();
#undef LATE_TDEC
}

__device__ __forceinline__ void phase_normmod(const float* hin, const float* g, const float* shift, const float* scale  , bf16* U, int gw, int NGW, int lane) {
    for (int r0 = gw * 8; r0 < M; r0 += NGW * 8) {
        const int b = r0 >> 12; const float* sh = shift + (size_t)b * ADA_W; const float* scp = scale + (size_t)b * ADA_W;
        f32x4 mul[8], add[8];
#pragma unroll
        for (int j = 0; j < 8; ++j) { const int col = 4 * lane + 256 * j; const f32x4 gv = *(const GAS f32x4*)(g + col), s = *(const GAS f32x4*)(scp + col); mul[j] = gv * (s + 1.0f); add[j] = *(const GAS f32x4*)(sh + col); }
        for (int rr = 0; rr < 8; ++rr) {
            const GAS f32x4* xr = (const GAS f32x4*)(hin + (size_t)(r0 + rr) * DM) + lane;
            f32x4 v[8]; float ss = 0.f;
#pragma unroll
            for (int j = 0; j < 8; ++j) { v[j] = xr[64 * j]; ss += (v[j].x * v[j].x + v[j].y * v[j].y) + (v[j].z * v[j].z + v[j].w * v[j].w); }
            const float rstd = 1.0f / sqrtf(wave_sum(ss) * (1.0f / DM) + EPS);
            GAS v2u* o8 = (GAS v2u*)(U + (size_t)(r0 + rr) * DM) + lane;
#pragma unroll
            for (int j = 0; j < 8; ++j) { const f32x4 y = v[j] * rstd * mul[j] + add[j]; v2u w; w.x = pk2(y.x, y.y); w.y = pk2(y.z, y.w); o8[64 * j] = w; }
        }
    }
}
__device__ __forceinline__ void phase_normmod_bf(const bf16* hin, const float* g, const float* shift, const float* scale  , bf16* U, int gw, int NGW, int lane) {
    for (int r0 = gw * 8; r0 < M; r0 += NGW * 8) {
        const int b = r0 >> 12; const float* sh = shift + (size_t)b * ADA_W; const float* scp = scale + (size_t)b * ADA_W;
        f32x4 mul[8], add[8];
#pragma unroll
        for (int j = 0; j < 8; ++j) { const int col = 8 * lane + 512 * (j >> 1) + 4 * (j & 1); const f32x4 gv = *(const GAS f32x4*)(g + col), s = *(const GAS f32x4*)(scp + col); mul[j] = gv * (s + 1.0f); add[j] = *(const GAS f32x4*)(sh + col); }
        for (int rr = 0; rr < 8; ++rr) {
            const GAS v4u* xr = (const GAS v4u*)(hin + (size_t)(r0 + rr) * DM) + lane;
            f32x4 v[8]; float ss = 0.f;
#pragma unroll
            for (int j = 0; j < 4; ++j) { const v4u q = xr[64 * j]; v[2 * j] = (f32x4){bflo(q.x), bfhi(q.x), bflo(q.y), bfhi(q.y)}; v[2 * j + 1] = (f32x4){bflo(q.z), bfhi(q.z), bflo(q.w), bfhi(q.w)}; }
#pragma unroll
            for (int j = 0; j < 8; ++j) ss += (v[j].x * v[j].x + v[j].y * v[j].y) + (v[j].z * v[j].z + v[j].w * v[j].w);
            const float rstd = 1.0f / sqrtf(wave_sum(ss) * (1.0f / DM) + EPS);
            GAS v4u* o16 = (GAS v4u*)(U + (size_t)(r0 + rr) * DM) + lane;
#pragma unroll
            for (int j = 0; j < 4; ++j) { const f32x4 y0 = v[2 * j] * rstd * mul[2 * j] + add[2 * j], y1 = v[2 * j + 1] * rstd * mul[2 * j + 1] + add[2 * j + 1];
                v4u w; w.x = pk2(y0.x, y0.y); w.y = pk2(y0.z, y0.w); w.z = pk2(y1.x, y1.y); w.w = pk2(y1.z, y1.w); o16[64 * j] = w; }
        }
    }
}
__device__ __forceinline__ void phase_finalnorm_bf(const bf16* hin, const float* g, float* out, int gw, int NGW, int lane) {
    for (int r0 = gw * 8; r0 < M; r0 += NGW * 8) {
        f32x4 mul[8];
#pragma unroll
        for (int j = 0; j < 8; ++j) mul[j] = *(const GAS f32x4*)(g + 8 * lane + 512 * (j >> 1) + 4 * (j & 1));
        for (int rr = 0; rr < 8; ++rr) {
            const GAS v4u* xr = (const GAS v4u*)(hin + (size_t)(r0 + rr) * DM) + lane;
            f32x4 v[8]; float ss = 0.f;
#pragma unroll
            for (int j = 0; j < 4; ++j) { const v4u q = xr[64 * j]; v[2 * j] = (f32x4){bflo(q.x), bfhi(q.x), bflo(q.y), bfhi(q.y)}; v[2 * j + 1] = (f32x4){bflo(q.z), bfhi(q.z), bflo(q.w), bfhi(q.w)}; }
#pragma unroll
            for (int j = 0; j < 8; ++j) ss += (v[j].x * v[j].x + v[j].y * v[j].y) + (v[j].z * v[j].z + v[j].w * v[j].w);
            const float rstd = 1.0f / sqrtf(wave_sum(ss) * (1.0f / DM) + EPS);
            float* orow = out + (size_t)(r0 + rr) * DM + 8 * lane;
#pragma unroll
            for (int j = 0; j < 8; ++j) *(GAS f32x4*)(orow + 512 * (j >> 1) + 4 * (j & 1)) = v[j] * rstd * mul[j];
        }
    }
}
__device__ __forceinline__ void phase_finalnorm(const float* hin, const float* g, float* out, int gw, int NGW, int lane) {
    for (int r0 = gw * 8; r0 < M; r0 += NGW * 8) {
        f32x4 mul[8];
#pragma unroll
        for (int j = 0; j < 8; ++j) mul[j] = *(const GAS f32x4*)(g + 4 * lane + 256 * j);
        for (int rr = 0; rr < 8; ++rr) {
            const GAS f32x4* xr = (const GAS f32x4*)(hin + (size_t)(r0 + rr) * DM) + lane;
            f32x4 v[8]; float ss = 0.f;
#pragma unroll
            for (int j = 0; j < 8; ++j) { v[j] = xr[64 * j]; ss += (v[j].x * v[j].x + v[j].y * v[j].y) + (v[j].z * v[j].z + v[j].w * v[j].w); }
            const float rstd = 1.0f / sqrtf(wave_sum(ss) * (1.0f / DM) + EPS);
            GAS f32x4* o = (GAS f32x4*)(out + (size_t)(r0 + rr) * DM) + lane;
#pragma unroll
            for (int j = 0; j < 8; ++j) o[64 * j] = v[j] * rstd * mul[j];
        }
    }
}
__device__ __forceinline__ void phase_pool(const bf16* U, bf16* Pb, int gw, int NGW, int lane) {
    for (int it = gw; it < (M / 32) * 4; it += NGW) {
        const int gi = it & 3, rw = it >> 2, w = 2 << gi, col = gi * 512 + lane * 8;
        for (int rr = 0; rr < 32; ++rr) {
            const int m = rw * 32 + rr, tpos = m & (SEQ - 1), cnt = (tpos + 1 < w) ? tpos + 1 : w;
            float acc[8];
#pragma unroll
            for (int e = 0; e < 8; ++e) acc[e] = 0.f;
            float cur[8];
            for (int j = 0; j < cnt; ++j) {
                const v4u q = *(const GAS v4u*)(U + (size_t)(m - j) * DM + col);
                const float f0 = bflo(q.x), f1 = bfhi(q.x), f2 = bflo(q.y), f3 = bfhi(q.y), f4 = bflo(q.z), f5 = bfhi(q.z), f6 = bflo(q.w), f7 = bfhi(q.w);
                if (j == 0) { cur[0] = f0; cur[1] = f1; cur[2] = f2; cur[3] = f3; cur[4] = f4; cur[5] = f5; cur[6] = f6; cur[7] = f7; }
                acc[0] += f0; acc[1] += f1; acc[2] += f2; acc[3] += f3; acc[4] += f4; acc[5] += f5; acc[6] += f6; acc[7] += f7;
            }
            const float inv = 1.0f / (float)cnt;
            v4u o; o.x = pk2(acc[0] * inv - cur[0], acc[1] * inv - cur[1]); o.y = pk2(acc[2] * inv - cur[2], acc[3] * inv - cur[3]);
            o.z = pk2(acc[4] * inv - cur[4], acc[5] * inv - cur[5]); o.w = pk2(acc[6] * inv - cur[6], acc[7] * inv - cur[7]);
            *(GAS v4u*)(Pb + (size_t)m * DM + col) = o;
        }
    }
}

__device__ __forceinline__ void phase_hgrn_scan_naive(const bf16* PROJ, const float* lbv, float* O, LAS unsigned char* lds, int tid, int vcu, int G) {
    LAS float* qs = (LAS float*)lds;
    LAS float* fs = qs + 16 * 128;
    LAS float* ks = fs + 16 * 128;
    LAS float* vs = ks + 16 * 128;
    const int v = tid >> 4, dg = tid & 15;
    for (int unit = vcu; unit < NB * HG_H * 4; unit += G) {
        const int b = unit >> 6, h = (unit >> 2) & 15, vsl = unit & 3;
        float S[8];
#pragma unroll
        for (int e = 0; e < 8; ++e) S[e] = 0.f;
        const int lt = tid >> 5, ld4 = (tid & 31) * 4;
        float lbl[4];
#pragma unroll
        for (int e = 0; e < 4; ++e) lbl[e] = lbv[h * 128 + ld4 + e];
        for (int ch = 0; ch < SEQ / 16; ++ch) {
            const size_t m0 = (size_t)b * SEQ + (size_t)ch * 16;
            { const bf16* row = PROJ + (m0 + lt) * HG_IN + h * 128 + ld4;
              const v2u qv = *(const GAS v2u*)row, zv = *(const GAS v2u*)(row + 2048);
              const float qf[4] = {bflo(qv.x), bfhi(qv.x), bflo(qv.y), bfhi(qv.y)}, zf[4] = {bflo(zv.x), bfhi(zv.x), bflo(zv.y), bfhi(zv.y)};
#pragma unroll
              for (int e = 0; e < 4; ++e) { const float sg = sigmoid_f(zf[e]), l = lbl[e]; qs[lt * 128 + ld4 + e] = qf[e]; fs[lt * 128 + ld4 + e] = l + (1.0f - l) * sg; ks[lt * 128 + ld4 + e] = (1.0f - l) * (1.0f - sg); }
              vs[tid] = bf1(PROJ[(m0 + (tid >> 5)) * HG_IN + 4096 + h * 128 + vsl * 32 + (tid & 31)]); }
            __syncthreads();
            for (int tt = 0; tt < 16; ++tt) {
                const float vv = vs[tt * 32 + v]; float acc = 0.f;
#pragma unroll
                for (int e = 0; e < 8; ++e) { const int d = dg * 8 + e; S[e] = fs[tt * 128 + d] * S[e] + ks[tt * 128 + d] * vv; acc += S[e] * qs[tt * 128 + d]; }
                acc += __shfl_xor(acc, 1); acc += __shfl_xor(acc, 2); acc += __shfl_xor(acc, 4); acc += __shfl_xor(acc, 8);
                if (dg == 0) O[(m0 + tt) * DM + h * 128 + vsl * 32 + v] = acc;
            }
            __syncthreads();
        }
    }
}
__device__ __forceinline__ void phase_hgrn_post(const bf16* O, const bf16* PROJ, const float* ng, bf16* Pb, int gw, int NGW, int lane) {
    f32x4 nv[4][2];
#pragma unroll
    for (int j = 0; j < 4; ++j) { nv[j][0] = *(const GAS f32x4*)(ng + 512 * j + 8 * lane); nv[j][1] = *(const GAS f32x4*)(ng + 512 * j + 8 * lane + 4); }
    for (int m = gw; m < M; m += NGW) {
        const GAS v4u* orow = (const GAS v4u*)(O + (size_t)m * DM) + lane;
        const GAS v4u* grow = (const GAS v4u*)(PROJ + (size_t)m * HG_IN + 6144) + lane;
        GAS v4u* prow = (GAS v4u*)(Pb + (size_t)m * DM) + lane;
        v4u ob[4], gq[4];
#pragma unroll
        for (int j = 0; j < 4; ++j) { ob[j] = orow[64 * j]; gq[j] = grow[64 * j]; }
#pragma unroll
        for (int j = 0; j < 4; ++j) {
            const f32x4 o0 = (f32x4){bflo(ob[j].x), bfhi(ob[j].x), bflo(ob[j].y), bfhi(ob[j].y)}, o1 = (f32x4){bflo(ob[j].z), bfhi(ob[j].z), bflo(ob[j].w), bfhi(ob[j].w)};
            float ss = ((o0.x * o0.x + o0.y * o0.y) + (o0.z * o0.z + o0.w * o0.w)) + ((o1.x * o1.x + o1.y * o1.y) + (o1.z * o1.z + o1.w * o1.w));
            ss = row16_sum(ss);
            const float rstd = 1.0f / sqrtf(ss * (1.0f / 128.0f) + EPS);
            const v4u g = gq[j];
            v4u w; w.x = pk2(o0.x * rstd * nv[j][0].x * silu1(bflo(g.x)), o0.y * rstd * nv[j][0].y * silu1(bfhi(g.x))); w.y = pk2(o0.z * rstd * nv[j][0].z * silu1(bflo(g.y)), o0.w * rstd * nv[j][0].w * silu1(bfhi(g.y)));
            w.z = pk2(o1.x * rstd * nv[j][1].x * silu1(bflo(g.z)), o1.y * rstd * nv[j][1].y * silu1(bfhi(g.z))); w.w = pk2(o1.z * rstd * nv[j][1].z * silu1(bflo(g.w)), o1.w * rstd * nv[j][1].w * silu1(bfhi(g.w)));
            prow[64 * j] = w;
        }
    }
}
__device__ __forceinline__ void phase_ret_scan_naive(const bf16* PROJ, const float* rot, float* O, LAS unsigned char* lds, int tid, int vcu, int G) {
    LAS float* qs = (LAS float*)lds;
    LAS float* ks = qs + 16 * 256;
    LAS float* vs = ks + 16 * 256;
    const float* ct = rot; const float* st = rot + (size_t)M * 128;
    const int v = tid >> 3, dg = tid & 7;
    for (int unit = vcu; unit < NB * RT_H * 8; unit += G) {
        const int b = unit >> 6, h = (unit >> 3) & 7, vsl = unit & 7;
        const float gamma = 1.0f - exp2f(-5.0f - (float)h);
        float S[32];
#pragma unroll
        for (int e = 0; e < 32; ++e) S[e] = 0.f;
        const int lt = tid >> 5, li = (tid & 31) * 4;
        for (int ch = 0; ch < SEQ / 16; ++ch) {
            const size_t m0 = (size_t)b * SEQ + (size_t)ch * 16;
            { const size_t m = m0 + lt; const bf16* row = PROJ + m * RT_IN + h * 256 + li;
              const v2u q1 = *(const GAS v2u*)row, q2 = *(const GAS v2u*)(row + 128), k1 = *(const GAS v2u*)(row + 2048), k2 = *(const GAS v2u*)(row + 2048 + 128);
              const f32x4 cv = *(const GAS f32x4*)(ct + m * 128 + li), sv = *(const GAS f32x4*)(st + m * 128 + li);
              const float a1[4] = {bflo(q1.x), bfhi(q1.x), bflo(q1.y), bfhi(q1.y)}, a2[4] = {bflo(q2.x), bfhi(q2.x), bflo(q2.y), bfhi(q2.y)};
              const float b1[4] = {bflo(k1.x), bfhi(k1.x), bflo(k1.y), bfhi(k1.y)}, b2[4] = {bflo(k2.x), bfhi(k2.x), bflo(k2.y), bfhi(k2.y)};
#pragma unroll
              for (int e = 0; e < 4; ++e) { const float cc = cv[e], sn = sv[e];
                  qs[lt * 256 + li + e] = a1[e] * cc - a2[e] * sn; qs[lt * 256 + 128 + li + e] = a1[e] * sn + a2[e] * cc;
                  ks[lt * 256 + li + e] = (b1[e] * cc - b2[e] * sn) * 0.0625f; ks[lt * 256 + 128 + li + e] = (b1[e] * sn + b2[e] * cc) * 0.0625f; }
#pragma unroll
              for (int r = 0; r < 2; ++r) { const int idx = tid + r * 512, tt = idx >> 6, vv = idx & 63; vs[idx] = bf1(PROJ[(m0 + tt) * RT_IN + 4096 + h * 512 + vsl * 64 + vv]); } }
            __syncthreads();
            for (int tt = 0; tt < 16; ++tt) {
                const float vv = vs[tt * 64 + v]; float acc = 0.f;
#pragma unroll
                for (int e = 0; e < 32; ++e) { const int d = dg * 32 + e; S[e] = gamma * S[e] + ks[tt * 256 + d] * vv; acc += S[e] * qs[tt * 256 + d]; }
                acc += __shfl_xor(acc, 1); acc += __shfl_xor(acc, 2); acc += __shfl_xor(acc, 4);
                if (dg == 0) O[(m0 + tt) * RT_V + h * 512 + vsl * 64 + v] = acc;
            }
            __syncthreads();
        }
    }
}
__device__ __forceinline__ void phase_ret_post(const bf16* O, const bf16* PROJ, const float* ng, bf16* Pb, int gw, int NGW, int lane) {
    f32x4 nv[8][2];
#pragma unroll
    for (int hh = 0; hh < 8; ++hh) { nv[hh][0] = *(const GAS f32x4*)(ng + 512 * hh + 8 * lane); nv[hh][1] = *(const GAS f32x4*)(ng + 512 * hh + 8 * lane + 4); }
    for (int m = gw; m < M; m += NGW) {
        const GAS v4u* orow = (const GAS v4u*)(O + (size_t)m * RT_V) + lane;
        const GAS v4u* grow = (const GAS v4u*)(PROJ + (size_t)m * RT_IN + 8192) + lane;
        GAS v4u* prow = (GAS v4u*)(Pb + (size_t)m * RT_V) + lane;
        v4u ob[8], gq[8];
#pragma unroll
        for (int hh = 0; hh < 8; ++hh) { ob[hh] = orow[64 * hh]; gq[hh] = grow[64 * hh]; }
#pragma unroll
        for (int hh = 0; hh < 8; ++hh) {
            const f32x4 o0 = (f32x4){bflo(ob[hh].x), bfhi(ob[hh].x), bflo(ob[hh].y), bfhi(ob[hh].y)}, o1 = (f32x4){bflo(ob[hh].z), bfhi(ob[hh].z), bflo(ob[hh].w), bfhi(ob[hh].w)};
            const float ss = ((o0.x * o0.x + o0.y * o0.y) + (o0.z * o0.z + o0.w * o0.w)) + ((o1.x * o1.x + o1.y * o1.y) + (o1.z * o1.z + o1.w * o1.w));
            const float rstd = 1.0f / sqrtf(wave_sum(ss) * (1.0f / 512.0f) + EPS);
            const v4u g = gq[hh];
            v4u w; w.x = pk2(o0.x * rstd * nv[hh][0].x * silu1(bflo(g.x)), o0.y * rstd * nv[hh][0].y * silu1(bfhi(g.x))); w.y = pk2(o0.z * rstd * nv[hh][0].z * silu1(bflo(g.y)), o0.w * rstd * nv[hh][0].w * silu1(bfhi(g.y)));
            w.z = pk2(o1.x * rstd * nv[hh][1].x * silu1(bflo(g.z)), o1.y * rstd * nv[hh][1].y * silu1(bfhi(g.z))); w.w = pk2(o1.z * rstd * nv[hh][1].z * silu1(bflo(g.w)), o1.w * rstd * nv[hh][1].w * silu1(bfhi(g.w)));
            prow[64 * hh] = w;
        }
    }
}

typedef float f32x16 __attribute__((ext_vector_type(16)));
typedef short s16x4 __attribute__((ext_vector_type(4)));
typedef short s16x8 __attribute__((ext_vector_type(8)));
__device__ __forceinline__ unsigned off_b(unsigned row, unsigned ch) { return 256u * row + 16u * (ch ^ (((row & 3u) << 2) | ((row >> 2) & 3u))); }
__device__ __forceinline__ s16x8 tr_frag_b(LAS unsigned char* img, int lane, int c, int ks) {
    const unsigned h = lane >> 5, blk = (lane >> 4) & 1, q = (lane & 15) >> 2, p = lane & 3;
    const unsigned a0 = off_b(16 * ks + 8 * h + q, 4 * c + 2 * blk + (p >> 1)) + 8 * (p & 1), a1 = off_b(16 * ks + 8 * h + 4 + q, 4 * c + 2 * blk + (p >> 1)) + 8 * (p & 1);
    const s16x4 x = __builtin_amdgcn_ds_read_tr16_b64_v4i16((LAS s16x4*)(img + a0)), y = __builtin_amdgcn_ds_read_tr16_b64_v4i16((LAS s16x4*)(img + a1));
    return (s16x8){x[0], x[1], x[2], x[3], y[0], y[1], y[2], y[3]};
}
__device__ __forceinline__ unsigned trb_base(int lane, int c, int tt) {
    const unsigned h = lane >> 5, blk = (lane >> 4) & 1, q = (lane & 15) >> 2, p = lane & 3;
    return 256u * (8 * h + 4 * tt + q) + 16u * ((4 * c + 2 * blk + (p >> 1)) ^ ((q << 2) | ((2 * h + tt) & 3))) + 8 * (p & 1);
}
__device__ __forceinline__ s16x8 tr_frag_b2(LAS unsigned char* img, unsigned b0, unsigned b1, int ks) {
    const s16x4 x = __builtin_amdgcn_ds_read_tr16_b64_v4i16((LAS s16x4*)(img + b0 + 4096 * ks)), y = __builtin_amdgcn_ds_read_tr16_b64_v4i16((LAS s16x4*)(img + b1 + 4096 * ks));
    return (s16x8){x[0], x[1], x[2], x[3], y[0], y[1], y[2], y[3]};
}
__device__ __forceinline__ s16x8 tr_frag_plain(LAS unsigned char* img, int rs, int lane, int c, int ks) {
    const unsigned h = lane >> 5, blk = (lane >> 4) & 1, q = (lane & 15) >> 2, p = lane & 3;
    const unsigned a0 = (16 * ks + 8 * h + q) * rs + (32 * c + 16 * blk + 4 * p) * 2, a1 = a0 + 4 * rs;
    const s16x4 x = __builtin_amdgcn_ds_read_tr16_b64_v4i16((LAS s16x4*)(img + a0)), y = __builtin_amdgcn_ds_read_tr16_b64_v4i16((LAS s16x4*)(img + a1));
    return (s16x8){x[0], x[1], x[2], x[3], y[0], y[1], y[2], y[3]};
}
__device__ __forceinline__ f32x16 mfma32(s16x8 a, s16x8 b, f32x16 c) { return __builtin_amdgcn_mfma_f32_32x32x16_bf16(a, b, c, 0, 0, 0); }
__device__ __forceinline__ f32x16 zero16() { f32x16 z;
#pragma unroll
    for (int i = 0; i < 16; ++i) z[i] = 0.f; return z; }
__device__ __forceinline__ v4u scale_bf8(v4u q, float f) { v4u o; o.x = pk2(bflo(q.x) * f, bfhi(q.x) * f); o.y = pk2(bflo(q.y) * f, bfhi(q.y) * f); o.z = pk2(bflo(q.z) * f, bfhi(q.z) * f); o.w = pk2(bflo(q.w) * f, bfhi(q.w) * f); return o; }

__device__ __forceinline__ void phase_ret_scan(const bf16* PROJ, bf16* O, LAS unsigned char* lds, int tid, int vcu, int G) {
    constexpr int QN = 0, QRS = 528, KN = 33792, VV = KN + 32768, PI = VV + 16384, PRS = 144, ST = PI + 9216, SRS = 528, LDS_END = ST + 33792;
    static_assert(LDS_END <= RING_BYTES, "retention scan LDS map");
    const int lane = tid & 63, wave = __builtin_amdgcn_readfirstlane(tid >> 6);
    for (int unit = vcu; unit < NB * RT_H * 8; unit += G) {
        const int b = unit >> 6, h = (unit >> 3) & 7, vsl = unit & 7;
        const float lg = __log2f(1.0f - exp2f(-5.0f - (float)h));
        const float g64 = exp2f(64.0f * lg);
        f32x16 S[2][2];
#pragma unroll
        for (int a = 0; a < 2; ++a)
#pragma unroll
            for (int c = 0; c < 2; ++c) S[a][c] = zero16();
        for (int i = tid; i < 33792 / 16; i += 512) *(LAS v4u*)(lds + ST + i * 16) = (v4u){0u, 0u, 0u, 0u};
        v4u pq[4], pk[4], pv;
        const __amdgpu_buffer_rsrc_t rsP = __builtin_amdgcn_make_buffer_rsrc((void*)(PROJ + (size_t)b * SEQ * RT_IN), (short)0, SEQ * RT_IN * 2, 0x00020000);
        const __amdgpu_buffer_rsrc_t rsO = __builtin_amdgcn_make_buffer_rsrc((void*)(O + (size_t)b * SEQ * RT_V), (short)0, SEQ * RT_V * 2, 0x00020000);
        const int vrow = tid >> 3, vch = tid & 7;
        const unsigned voq = (unsigned)((tid >> 5) * RT_IN + (tid & 31) * 8) * 2u, vov = (unsigned)(vrow * RT_IN + vch * 8) * 2u;
        const unsigned soq = (unsigned)(h * 256) * 2u, sok = (unsigned)(2048 + h * 256) * 2u, sov = (unsigned)(4096 + h * 512 + vsl * 64) * 2u;
#define RS_PREFETCH(chn) do { const unsigned cb_ = (unsigned)(chn) * 64u * RT_IN * 2u; _Pragma("unroll") for (int i = 0; i < 4; ++i) { \
            pq[i] = __builtin_amdgcn_raw_buffer_load_b128(rsP, voq, cb_ + (unsigned)i * 16u * RT_IN * 2u + soq, 0); pk[i] = __builtin_amdgcn_raw_buffer_load_b128(rsP, voq, cb_ + (unsigned)i * 16u * RT_IN * 2u + sok, 0); } \
            pv = __builtin_amdgcn_raw_buffer_load_b128(rsP, vov, cb_ + sov, 0); } while (0)
        RS_PREFETCH(0);
        float dec[16];
        { const int a31 = lane & 31, a5 = lane >> 5, w4 = wave & 3, t_i = w4 >> 1, x_i = w4 & 1;
#pragma unroll
          for (int r = 0; r < 16; ++r) {
              if (wave < 4) { const int t = 32 * x_i + a31, s = 32 * t_i + 8 * (r >> 2) + 4 * a5 + (r & 3); dec[r] = (s <= t) ? __builtin_amdgcn_exp2f((float)(t - s) * lg) : 0.f; }
              else { const int t = 32 * t_i + (r & 3) + 8 * (r >> 2) + 4 * a5; dec[r] = __builtin_amdgcn_exp2f((float)(t + 1) * lg); } } }
        for (int ch = 0; ch < SEQ / 64; ++ch) {
#pragma unroll
            for (int i = 0; i < 4; ++i) { const int cid = tid + 512 * i, row = cid >> 5, chq = cid & 31;
                *(LAS v4u*)(lds + QN + row * QRS + chq * 16) = pq[i];
                *(LAS v4u*)(lds + KN + (chq >> 4) * 16384 + off_b(row, chq & 15)) = pk[i]; }
            *(LAS v4u*)(lds + VV + off_b(vrow, vch)) = pv;
            *(LAS v4u*)(lds + VV + off_b(vrow, 8 + vch)) = scale_bf8(pv, __builtin_amdgcn_exp2f((float)(63 - vrow) * lg));
            __syncthreads();
#define RS_STORE_O(chs) do { if (wave >= 4) { const int w4s = wave & 3, tis = w4s >> 1, vis = w4s & 1; int lnS = lane; asm volatile("" : "+v"(lnS)); \
                  \
                const LAS unsigned char* sg_ = lds + RING_BYTES + 4096 + w4s * 2048; \
                const unsigned voo = (unsigned)((lnS >> 2) * RT_V + h * 512 + vsl * 64 + 32 * vis + 8 * (lnS & 3)) * 2u; \
                _Pragma("unroll") for (int q = 0; q < 2; ++q) { const v4u ov_ = *(const LAS v4u*)(sg_ + (16 * q + (lnS >> 2)) * 64 + (lnS & 3) * 16); \
                    __builtin_amdgcn_raw_buffer_store_b128(ov_, rsO, voo, (unsigned)((chs) * 64 + 32 * tis + 16 * q) * RT_V * 2u, 0); } } } while (0)
            if (ch > 0) RS_STORE_O(ch - 1);
            if (ch + 1 < SEQ / 64) RS_PREFETCH(ch + 1);
            f32x16 acc = zero16();
            int lnA = lane; asm volatile("" : "+v"(lnA));
            const int a31 = lnA & 31, a5 = lnA >> 5;
            const int w4 = wave & 3, t_i = w4 >> 1, x_i = w4 & 1;
            s16x8 fa0[4], fb0[4], fa1[4], fb1[4];
            if (wave < 4) {
                const int si = t_i, ti = x_i;
#define RS_LD1A(fa, fb, g4) do { _Pragma("unroll") for (int j = 0; j < 2; ++j) { const int ks = 2 * (g4) + j; \
                    fa[j] = *(const LAS s16x8*)(lds + KN + (ks >> 3) * 16384 + off_b(32 * si + a31, 2 * (ks & 7) + a5)); \
                    fb[j] = *(const LAS s16x8*)(lds + QN + (32 * ti + a31) * QRS + (16 * ks + 8 * a5) * 2); } } while (0)
#define RS_MMA4(fa, fb) do { _Pragma("unroll") for (int j = 0; j < 4; ++j) acc = mfma32(fa[j], fb[j], acc); } while (0)
#define RS_MMA2(fa, fb) do { _Pragma("unroll") for (int j = 0; j < 2; ++j) acc = mfma32(fa[j], fb[j], acc); } while (0)
                RS_LD1A(fa0, fb0, 0); RS_LD1A(fa1, fb1, 1);
#pragma unroll
                for (int g2 = 0; g2 < 3; ++g2) { RS_MMA2(fa0, fb0); RS_LD1A(fa0, fb0, 2 * g2 + 2); RS_MMA2(fa1, fb1); RS_LD1A(fa1, fb1, 2 * g2 + 3); }
                RS_MMA2(fa0, fb0); RS_MMA2(fa1, fb1);
#undef RS_LD1A
                const int t = 32 * ti + a31;
#pragma unroll
                for (int g = 0; g < 4; ++g) { float pvv[4];
#pragma unroll
                    for (int e = 0; e < 4; ++e) pvv[e] = acc[4 * g + e] * dec[4 * g + e];
                    v2u w; w.x = pk2(pvv[0], pvv[1]); w.y = pk2(pvv[2], pvv[3]);
                    *(LAS v2u*)(lds + PI + t * PRS + (32 * si + 8 * g + 4 * a5) * 2) = w; }
            } else {
                const int ti = t_i, vi = x_i;
#define RS_LD1B(fa, fb, g4) do { _Pragma("unroll") for (int j = 0; j < 2; ++j) { const int ks = 2 * (g4) + j; \
                    fa[j] = *(const LAS s16x8*)(lds + QN + (32 * ti + a31) * QRS + (16 * ks + 8 * a5) * 2); \
                    fb[j] = *(const LAS s16x8*)(lds + ST + (32 * vi + a31) * SRS + (16 * ks + 8 * a5) * 2); } } while (0)
                RS_LD1B(fa0, fb0, 0); RS_LD1B(fa1, fb1, 1);
#pragma unroll
                for (int g2 = 0; g2 < 3; ++g2) { RS_MMA2(fa0, fb0); RS_LD1B(fa0, fb0, 2 * g2 + 2); RS_MMA2(fa1, fb1); RS_LD1B(fa1, fb1, 2 * g2 + 3); }
                RS_MMA2(fa0, fb0); RS_MMA2(fa1, fb1);
#undef RS_LD1B
#pragma unroll
                for (int r = 0; r < 16; ++r) acc[r] *= dec[r];
            }
            __syncthreads();
            if (wave < 4) {
                LAS unsigned char* kimg0 = lds + KN + ((2 * wave) >> 2) * 16384; LAS unsigned char* kimg1 = lds + KN + ((2 * wave + 1) >> 2) * 16384;
                const unsigned ka0 = trb_base(lnA, (2 * wave) & 3, 0), ka1 = trb_base(lnA, (2 * wave) & 3, 1), kb0 = trb_base(lnA, (2 * wave + 1) & 3, 0), kb1 = trb_base(lnA, (2 * wave + 1) & 3, 1);
                const unsigned va0 = trb_base(lnA, 2, 0), va1 = trb_base(lnA, 2, 1), vb0 = trb_base(lnA, 3, 0), vb1 = trb_base(lnA, 3, 1);
#define RS_LD2A(g2) do { _Pragma("unroll") for (int j = 0; j < 2; ++j) { const int ks = 2 * (g2) + j; fa0[j] = tr_frag_b2(kimg0, ka0, ka1, ks); fa1[j] = tr_frag_b2(kimg1, kb0, kb1, ks); fb0[j] = tr_frag_b2(lds + VV, va0, va1, ks); fb1[j] = tr_frag_b2(lds + VV, vb0, vb1, ks); } } while (0)
#define RS_MMA2A() do { _Pragma("unroll") for (int j = 0; j < 2; ++j) { S[0][0] = mfma32(fa0[j], fb0[j], S[0][0]); S[0][1] = mfma32(fa0[j], fb1[j], S[0][1]); S[1][0] = mfma32(fa1[j], fb0[j], S[1][0]); S[1][1] = mfma32(fa1[j], fb1[j], S[1][1]); } } while (0)
                RS_LD2A(0);
#pragma unroll
                for (int a = 0; a < 2; ++a)
#pragma unroll
                    for (int c = 0; c < 2; ++c)
#pragma unroll
                        for (int r = 0; r < 16; ++r) S[a][c][r] *= g64;
                RS_MMA2A(); RS_LD2A(1); RS_MMA2A();
#undef RS_LD2A
#undef RS_MMA2A
#pragma unroll
                for (int a = 0; a < 2; ++a)
#pragma unroll
                    for (int c = 0; c < 2; ++c)
#pragma unroll
                        for (int g = 0; g < 4; ++g) { const int d = 32 * (2 * wave + a) + 8 * g + 4 * a5, v = 32 * c + a31;
                            v2u w; w.x = pk2(S[a][c][4 * g], S[a][c][4 * g + 1]); w.y = pk2(S[a][c][4 * g + 2], S[a][c][4 * g + 3]);
                            *(LAS v2u*)(lds + ST + v * SRS + d * 2) = w; }
            } else {
                const int ti = t_i, vi = x_i;
#pragma unroll
                for (int ks = 0; ks < 4; ++ks) { fa0[ks] = *(const LAS s16x8*)(lds + PI + (32 * ti + a31) * PRS + (16 * ks + 8 * a5) * 2); fb0[ks] = tr_frag_b2(lds + VV, trb_base(lnA, vi, 0), trb_base(lnA, vi, 1), ks); }
                RS_MMA4(fa0, fb0);
#pragma unroll
                for (int i = 0; i < 8; ++i) { const float o0_ = acc[2 * i], o1_ = acc[2 * i + 1]; const unsigned pr_ = pk2(o0_, o1_);
                    LAS unsigned char* sp_ = lds + RING_BYTES + 4096 + w4 * 2048 + (2 * (i & 1) + 8 * (i >> 1) + 4 * a5) * 64 + a31 * 2;
                    *(LAS unsigned short*)sp_ = (unsigned short)(pr_ & 0xffffu); *(LAS unsigned short*)(sp_ + 64) = (unsigned short)(pr_ >> 16); }
            }
#undef RS_MMA4
#undef RS_PREFETCH_DUMMY
#undef RS_MMA2
            __syncthreads();
        }
        RS_STORE_O(SEQ / 64 - 1);
#undef RS_STORE_O
#undef RS_PREFETCH
    }
}

__device__ __forceinline__ void phase_hgrn_pre(const bf16* PROJ, const float* lbv, bf16* QD, bf16* KI, bf16* KE, float* DEC, int gt, int NGT) {
    for (int it = gt; it < (M / 32) * 256; it += NGT) {
        const int chunk = it >> 8, col = (it & 255) * 8; const size_t m0 = (size_t)chunk * 32;
        float lb[8], tot[8], cum[8];
        { const f32x4 l0 = *(const GAS f32x4*)(lbv + col), l1 = *(const GAS f32x4*)(lbv + col + 4);
#pragma unroll
          for (int e = 0; e < 4; ++e) { lb[e] = l0[e]; lb[4 + e] = l1[e]; } }
#pragma unroll
        for (int e = 0; e < 8; ++e) { tot[e] = 1.f; cum[e] = 1.f; }
#pragma unroll 4
        for (int t = 0; t < 32; ++t) { const v4u zz = *(const GAS v4u*)(PROJ + (m0 + t) * HG_IN + 2048 + col);
            const float z[8] = {bflo(zz.x), bfhi(zz.x), bflo(zz.y), bfhi(zz.y), bflo(zz.z), bfhi(zz.z), bflo(zz.w), bfhi(zz.w)};
#pragma unroll
            for (int e = 0; e < 8; ++e) tot[e] *= lb[e] + (1.0f - lb[e]) * sigmoid_f(z[e]); }
#pragma unroll 2
        for (int t = 0; t < 32; ++t) { const size_t m = m0 + t;
            const v4u zz = *(const GAS v4u*)(PROJ + m * HG_IN + 2048 + col), qq = *(const GAS v4u*)(PROJ + m * HG_IN + col);
            const float z[8] = {bflo(zz.x), bfhi(zz.x), bflo(zz.y), bfhi(zz.y), bflo(zz.z), bfhi(zz.z), bflo(zz.w), bfhi(zz.w)};
            const float q[8] = {bflo(qq.x), bfhi(qq.x), bflo(qq.y), bfhi(qq.y), bflo(qq.z), bfhi(qq.z), bflo(qq.w), bfhi(qq.w)};
            float qd[8], ki[8], ke[8];
#pragma unroll
            for (int e = 0; e < 8; ++e) { const float sg = sigmoid_f(z[e]); cum[e] *= lb[e] + (1.0f - lb[e]) * sg; const float kk = (1.0f - lb[e]) * (1.0f - sg);
                qd[e] = q[e] * cum[e]; ki[e] = kk * __builtin_amdgcn_rcpf(cum[e]); ke[e] = ki[e] * tot[e]; }
            v4u o; o.x = pk2(qd[0], qd[1]); o.y = pk2(qd[2], qd[3]); o.z = pk2(qd[4], qd[5]); o.w = pk2(qd[6], qd[7]); *(GAS v4u*)(QD + m * DM + col) = o;
            o.x = pk2(ki[0], ki[1]); o.y = pk2(ki[2], ki[3]); o.z = pk2(ki[4], ki[5]); o.w = pk2(ki[6], ki[7]); *(GAS v4u*)(KI + m * DM + col) = o;
            o.x = pk2(ke[0], ke[1]); o.y = pk2(ke[2], ke[3]); o.z = pk2(ke[4], ke[5]); o.w = pk2(ke[6], ke[7]); *(GAS v4u*)(KE + m * DM + col) = o; }
        f32x4 d0, d1;
#pragma unroll
        for (int e = 0; e < 4; ++e) { d0[e] = tot[e]; d1[e] = tot[4 + e]; }
        *(GAS f32x4*)(DEC + (size_t)chunk * DM + col) = d0; *(GAS f32x4*)(DEC + (size_t)chunk * DM + col + 4) = d1;
    }
}
__device__ __forceinline__ void phase_hgrn_scan(const bf16* HV, const bf16* QD, const bf16* KI, const bf16* KE, const float* DEC, bf16* Ob, LAS unsigned char* lds, int tid, int u0, int ustride) {
    constexpr int RS = 272, PRS = 80, VRS = 128, SET = 30208;
    constexpr int QI = 0, KII = 8704, KEI = 17408, VI = 25600, DCI = 29696, PI = 2 * SET, ST = PI + 2560, LDS_END = ST + 2 * 8704;
    static_assert(LDS_END <= RING_BYTES, "hgrn scan LDS map");
    const int lane = tid & 63, wave = __builtin_amdgcn_readfirstlane(tid >> 6), l31 = lane & 31, h5 = lane >> 5;
    const int vt = (wave >> 1) & 1;
    for (int unit = u0; unit < NB * HG_H * 2; unit += ustride) {
        const int b = unit >> 5, h = (unit >> 1) & 15, vp = unit & 1;
        f32x16 S0 = zero16(), S1 = zero16();
        for (int i = tid; i < 2 * 8704 / 16; i += 512) *(LAS v4u*)(lds + ST + i * 16) = (v4u){0u, 0u, 0u, 0u};
        const int row = tid >> 4, c16 = tid & 15;
        const size_t mb = (size_t)b * SEQ;
        v4u q0, ki0, ke0, x0 = (v4u){0u, 0u, 0u, 0u}, q1, ki1, ke1, x1 = (v4u){0u, 0u, 0u, 0u};
        unsigned opk[8];
#pragma unroll
        for (int i = 0; i < 8; ++i) opk[i] = 0u;
#define HS_CLAMP(c_) ((c_) < SEQ / 32 ? (c_) : SEQ / 32 - 1)
#define HS_LOAD(pq_, pki_, pke_, px_, chn) do { const size_t hb_ = (size_t)(b * 16 + h) * SEQ + (size_t)(chn) * 32; \
            pq_ = *(const GAS v4u*)(QD + (hb_ + row) * 128 + c16 * 8); pki_ = *(const GAS v4u*)(KI + (hb_ + row) * 128 + c16 * 8); pke_ = *(const GAS v4u*)(KE + (hb_ + row) * 128 + c16 * 8); \
            if (tid < 256) px_ = *(const GAS v4u*)(HV + (hb_ + (tid >> 3)) * 128 + vp * 64 + (tid & 7) * 8); \
            else if (tid < 288) px_ = *(const GAS v4u*)(DEC + ((size_t)(b * 16 + h) * (SEQ / 32) + (chn)) * 128 + (tid - 256) * 4); } while (0)
#define HS_WRITE(IB, pq_, pki_, pke_, px_) do { \
            *(LAS v4u*)(lds + (IB) + QI + row * RS + c16 * 16) = pq_; *(LAS v4u*)(lds + (IB) + KII + row * RS + c16 * 16) = pki_; *(LAS v4u*)(lds + (IB) + KEI + off_b(row, c16)) = pke_; \
            if (tid < 256) *(LAS v4u*)(lds + (IB) + VI + (tid >> 3) * VRS + (tid & 7) * 16) = px_; \
            else if (tid < 288) *(LAS v4u*)(lds + (IB) + DCI + (tid - 256) * 16) = px_; } while (0)
#define HS_STORE_O(chs) do { if (wave == 4 || wave == 6) { bf16* op = Ob + (mb + (size_t)(chs) * 32) * DM + h * 128 + vp * 64 + vt * 32 + l31; \
            _Pragma("unroll") for (int r = 0; r < 16; ++r) { const int t = (r & 3) + 8 * (r >> 2) + 4 * h5; const unsigned pr_ = opk[r >> 1]; op[(size_t)t * DM] = (bf16)((r & 1) ? (pr_ >> 16) : (pr_ & 0xffffu)); } } } while (0)
#define HS_CHUNK(IB, NIB, nq_, nki_, nke_, nx_) do { \
            f32x16 acc = zero16(); \
            if (wave == 5) { \
                s16x8 fa[8], fb[8]; \
                _Pragma("unroll") for (int ks = 0; ks < 8; ++ks) { fa[ks] = *(const LAS s16x8*)(lds + (IB) + KII + l31 * RS + (16 * ks + 8 * h5) * 2); fb[ks] = *(const LAS s16x8*)(lds + (IB) + QI + l31 * RS + (16 * ks + 8 * h5) * 2); } \
                _Pragma("unroll") for (int ks = 0; ks < 8; ++ks) acc = mfma32(fa[ks], fb[ks], acc); \
                const int t = l31; \
                _Pragma("unroll") for (int g = 0; g < 4; ++g) { float pvv[4]; \
                    _Pragma("unroll") for (int e = 0; e < 4; ++e) { const int s = 8 * g + 4 * h5 + e; pvv[e] = (s <= t) ? acc[4 * g + e] : 0.f; } \
                    v2u w; w.x = pk2(pvv[0], pvv[1]); w.y = pk2(pvv[2], pvv[3]); \
                    *(LAS v2u*)(lds + PI + t * PRS + (8 * g + 4 * h5) * 2) = w; } \
            } else if (wave == 4 || wave == 6) { \
                s16x8 fa[8], fb[8]; \
                _Pragma("unroll") for (int ks = 0; ks < 8; ++ks) { fa[ks] = *(const LAS s16x8*)(lds + (IB) + QI + l31 * RS + (16 * ks + 8 * h5) * 2); fb[ks] = *(const LAS s16x8*)(lds + ST + vt * 8704 + l31 * RS + (16 * ks + 8 * h5) * 2); } \
                _Pragma("unroll") for (int ks = 0; ks < 8; ++ks) acc = mfma32(fa[ks], fb[ks], acc); \
            } \
            __syncthreads(); \
            if (wave < 4) { \
                _Pragma("unroll") for (int g = 0; g < 4; ++g) { const f32x4 dv = *(const LAS f32x4*)(lds + (IB) + DCI + (32 * wave + 8 * g + 4 * h5) * 4); \
                    _Pragma("unroll") for (int e = 0; e < 4; ++e) { S0[4 * g + e] *= dv[e]; S1[4 * g + e] *= dv[e]; } } \
                _Pragma("unroll") for (int ks = 0; ks < 2; ++ks) { const s16x8 af = tr_frag_b(lds + (IB) + KEI, lane, wave, ks); \
                    const s16x8 b0 = tr_frag_plain(lds + (IB) + VI, VRS, lane, 0, ks), b1 = tr_frag_plain(lds + (IB) + VI, VRS, lane, 1, ks); S0 = mfma32(af, b0, S0); S1 = mfma32(af, b1, S1); } \
                _Pragma("unroll") for (int g = 0; g < 4; ++g) { const int d = 32 * wave + 8 * g + 4 * h5; \
                    v2u w; w.x = pk2(S0[4 * g], S0[4 * g + 1]); w.y = pk2(S0[4 * g + 2], S0[4 * g + 3]); \
                    *(LAS v2u*)(lds + ST + l31 * RS + d * 2) = w; \
                    w.x = pk2(S1[4 * g], S1[4 * g + 1]); w.y = pk2(S1[4 * g + 2], S1[4 * g + 3]); \
                    *(LAS v2u*)(lds + ST + 8704 + l31 * RS + d * 2) = w; } \
            } else if (wave == 4 || wave == 6) { \
                _Pragma("unroll") for (int ks = 0; ks < 2; ++ks) { const s16x8 af = *(const LAS s16x8*)(lds + PI + l31 * PRS + (16 * ks + 8 * h5) * 2); const s16x8 bfr = tr_frag_plain(lds + (IB) + VI, VRS, lane, vt, ks); acc = mfma32(af, bfr, acc); } \
                _Pragma("unroll") for (int i = 0; i < 8; ++i) { const float o0_ = acc[2 * i], o1_ = acc[2 * i + 1]; opk[i] = pk2(o0_, o1_); } \
            } \
            HS_WRITE(NIB, nq_, nki_, nke_, nx_); \
            __syncthreads(); } while (0)
        HS_LOAD(q0, ki0, ke0, x0, 0); HS_LOAD(q1, ki1, ke1, x1, 1);
        HS_WRITE(0, q0, ki0, ke0, x0); HS_LOAD(q0, ki0, ke0, x0, 2);
        __syncthreads();
        for (int ch = 0; ch < SEQ / 32; ch += 2) {
            HS_CHUNK(0, SET, q1, ki1, ke1, x1);     HS_LOAD(q1, ki1, ke1, x1, HS_CLAMP(ch + 3)); HS_STORE_O(ch);
            HS_CHUNK(SET, 0, q0, ki0, ke0, x0);     HS_LOAD(q0, ki0, ke0, x0, HS_CLAMP(ch + 4)); HS_STORE_O(ch + 1);
        }
#undef HS_CLAMP
#undef HS_LOAD
#undef HS_WRITE
#undef HS_STORE_O
#undef HS_CHUNK
    }
}

template <bool XF32>
__device__ __forceinline__ void phase_poolmix(const void* hsrc  , const float* rsrow  , bf16* hout, const float* gnorm, const float* ada_l  ,
                                              const float* pscale, const bf16* Wt  ,
                                              const float* g2, const float* shift2, const float* scale2  , bf16* U2,
                                              LAS unsigned char* lds, int tid, int vcu, int G) {
    constexpr int PA = 0, WB = 65536, RSTD = RING_BYTES, ES = XF32 ? 4 : 2;
    const int lane = tid & 63, wave = __builtin_amdgcn_readfirstlane(tid >> 6), l31 = lane & 31, h5 = lane >> 5;
    LAS float* rstdL = (LAS float*)(lds + RSTD);
    LAS float* rowss = (LAS float*)(lds + RING_BYTES + 4096);
    const __amdgpu_buffer_rsrc_t rsH = __builtin_amdgcn_make_buffer_rsrc((void*)hsrc, (short)0, M * DM * ES, 0x00020000);
    const __amdgpu_buffer_rsrc_t rsO = __builtin_amdgcn_make_buffer_rsrc((void*)hout, (short)0, M * DM * 2, 0x00020000);
    const __amdgpu_buffer_rsrc_t rsW = __builtin_amdgcn_make_buffer_rsrc((void*)Wt, (short)0, 4 * 512 * 512 * 2, 0x00020000);
#define PM_OFFP(row, ch) ((row) * 1024 + 16 * ((ch) ^ ((row) & 15)))
#define PM_OFFW(n, ch) ((n) * 64 + 16 * ((ch) ^ (((n) >> 2) & 3)))
#define PM_LDH(voff, soff) __builtin_amdgcn_raw_buffer_load_b128(rsH, (voff), (soff), 0)
#define PM_UNPK(q_, f_) do { f_[0] = bflo(q_.x); f_[1] = bfhi(q_.x); f_[2] = bflo(q_.y); f_[3] = bfhi(q_.y); f_[4] = bflo(q_.z); f_[5] = bfhi(q_.z); f_[6] = bflo(q_.w); f_[7] = bfhi(q_.w); } while (0)
    for (int unit = vcu; unit < M / 64; unit += G) {
        const int r0 = unit * 64, b = r0 >> 12, tpos0 = r0 & (SEQ - 1), halo = tpos0 < 15 ? tpos0 : 15;
        const float* shp = ada_l + (size_t)b * ADA_W; const float* scp = shp + DM; const float* gtp = shp + 2 * DM;
        if (rsrow) { if (tid < 64 + halo) rstdL[tid + 15 - halo] = rsrow[r0 - halo + tid]; }
        else for (int rp = wave; 2 * rp < 64 + halo; rp += 2 * NWAVES) {
            int rrq[2]; float ssq[2]; v4u qq[2][XF32 ? 16 : 8];
#pragma unroll
            for (int z = 0; z < 2; ++z) { const int rr = 2 * (rp + NWAVES * z) + h5, rrc = rr < 64 + halo ? rr : 63 + halo, row = r0 - halo + rrc; rrq[z] = rr;
                const unsigned vo = (unsigned)row * (DM * ES) + (unsigned)l31 * 16u;
#pragma unroll
                for (int j = 0; j < (XF32 ? 16 : 8); ++j) qq[z][j] = PM_LDH(vo, (unsigned)j * 512u); }
#pragma unroll
            for (int z = 0; z < 2; ++z) { float ss = 0.f;
#pragma unroll
                for (int j = 0; j < (XF32 ? 16 : 8); ++j) { const v4u q = qq[z][j];
                    if constexpr (XF32) { const f32x4 v = __builtin_bit_cast(f32x4, q); ss += (v.x * v.x + v.y * v.y) + (v.z * v.z + v.w * v.w); }
                    else { float f[8]; PM_UNPK(q, f); ss += ((f[0] * f[0] + f[1] * f[1]) + (f[2] * f[2] + f[3] * f[3])) + ((f[4] * f[4] + f[5] * f[5]) + (f[6] * f[6] + f[7] * f[7])); } }
                ssq[z] = ss; }
#pragma unroll
            for (int z = 0; z < 2; ++z) { float ss = ssq[z];
                ss = half_sum(ss);
                const float rstd = 1.0f / sqrtf(ss * (1.0f / DM) + EPS);
                if (l31 == 0 && rrq[z] < 64 + halo) rstdL[rrq[z] + 15 - halo] = rstd; }
        }
        __syncthreads();
#pragma unroll 1
        for (int g = 0; g < 4; ++g) {
            const int w = 2 << g;
            const unsigned wvo = (unsigned)lane * 16u, wso = ((unsigned)g * 16u + 2u * (unsigned)wave) * (32u * 1024u);
            v4u wA[4], wB[4], wC[4];
            v4u hk[8];
#define PM_WLD(dst, kc_) do { _Pragma("unroll") for (int nt = 0; nt < 2; ++nt) _Pragma("unroll") for (int ks = 0; ks < 2; ++ks) \
                dst[nt * 2 + ks] = __builtin_amdgcn_raw_buffer_load_b128(rsW, wvo, wso + (unsigned)(nt * 32 + 2 * (kc_) + ks) * 1024u, 0); } while (0)
            PM_WLD(wA, 0); PM_WLD(wB, 1); PM_WLD(wC, 2);
            { const int oct = tid & 63, col = g * 512 + oct * 8; const unsigned hvo = (unsigned)col * ES;
              float gm[8], sh[8];
              { const f32x4 g0 = *(const GAS f32x4*)(gnorm + col), g1 = *(const GAS f32x4*)(gnorm + col + 4), s0 = *(const GAS f32x4*)(scp + col), s1 = *(const GAS f32x4*)(scp + col + 4);
                const f32x4 a0 = *(const GAS f32x4*)(shp + col), a1 = *(const GAS f32x4*)(shp + col + 4);
#pragma unroll
                for (int e = 0; e < 4; ++e) { gm[e] = g0[e] * (1.0f + s0[e]); gm[4 + e] = g1[e] * (1.0f + s1[e]); sh[e] = a0[e]; sh[4 + e] = a1[e]; } }
              LAS unsigned char* UT = lds + WB;
#pragma unroll
              for (int hf = 0; hf < 2; ++hf) {
                  const int rb = r0 - 15 + 32 * hf;
                  { v4u ha[6], hb2[6]; float rsv[6];
#pragma unroll
                      for (int k = 0; k < 6; ++k) { const int j = wave - 1 + 8 * k, row = rb + j, rowc = (j >= 0 && row >= r0 - halo) ? row : r0;
                          const unsigned so = (unsigned)rowc * (DM * ES);
                          ha[k] = PM_LDH(hvo, so); if constexpr (XF32) hb2[k] = PM_LDH(hvo, so + 16u); rsv[k] = rstdL[rowc - r0 + 15]; }
#pragma unroll
                      for (int k = 0; k < 6; ++k) { const int j = wave - 1 + 8 * k; const float rs_ = rsv[k]; float f[8];
                          if constexpr (XF32) { const f32x4 x0 = __builtin_bit_cast(f32x4, ha[k]), x1 = __builtin_bit_cast(f32x4, hb2[k]); f[0] = x0.x; f[1] = x0.y; f[2] = x0.z; f[3] = x0.w; f[4] = x1.x; f[5] = x1.y; f[6] = x1.z; f[7] = x1.w; }
                          else { PM_UNPK(ha[k], f); if (k >= 2) hk[4 * hf + k - 2] = ha[k]; }
                          v4u uq; uq.x = pk2(f[0] * rs_ * gm[0] + sh[0], f[1] * rs_ * gm[1] + sh[1]); uq.y = pk2(f[2] * rs_ * gm[2] + sh[2], f[3] * rs_ * gm[3] + sh[3]);
                          uq.z = pk2(f[4] * rs_ * gm[4] + sh[4], f[5] * rs_ * gm[5] + sh[5]); uq.w = pk2(f[6] * rs_ * gm[6] + sh[6], f[7] * rs_ * gm[7] + sh[7]);
                          if (j >= 0) *(LAS v4u*)(UT + j * 1024 + oct * 16) = uq; }
                  }
                  __syncthreads();
                  { const int il0 = 4 * wave, sl0 = il0 + 15, tp0 = tpos0 + 32 * hf + il0;
                    float S[8], uc[8];
#pragma unroll
                    for (int e = 0; e < 8; ++e) S[e] = 0.f;
                    { const int cnt = tp0 + 1 < w ? tp0 + 1 : w;
#define PM_WIN(J0, NJ) do { v4u qw[NJ]; \
                          _Pragma("unroll") for (int jj = 0; jj < NJ; ++jj) { const int sj = sl0 - (J0) - jj; qw[jj] = *(const LAS v4u*)(UT + (sj > 0 ? sj : 0) * 1024 + oct * 16); } \
                          _Pragma("unroll") for (int jj = 0; jj < NJ; ++jj) { float f[8]; PM_UNPK(qw[jj], f); const float m_ = (J0) + jj < cnt ? 1.0f : 0.0f; \
                              if ((J0) + jj == 0) { _Pragma("unroll") for (int e = 0; e < 8; ++e) uc[e] = f[e]; } \
                              _Pragma("unroll") for (int e = 0; e < 8; ++e) S[e] += m_ * f[e]; } } while (0)
                      PM_WIN(0, 4);
                      if (w > 4) { PM_WIN(4, 4); if (w > 8) PM_WIN(8, 8); }
#undef PM_WIN
                      const float inv = 1.0f / (float)cnt;
                      v4u o; o.x = pk2(S[0] * inv - uc[0], S[1] * inv - uc[1]); o.y = pk2(S[2] * inv - uc[2], S[3] * inv - uc[3]); o.z = pk2(S[4] * inv - uc[4], S[5] * inv - uc[5]); o.w = pk2(S[6] * inv - uc[6], S[7] * inv - uc[7]);
                      *(LAS v4u*)(lds + PA + PM_OFFP(32 * hf + il0, oct)) = o; }
#pragma unroll
                    for (int r = 1; r < 4; ++r) { const int tpr = tp0 + r, cnt = tpr + 1 < w ? tpr + 1 : w;
                        const v4u qn = *(const LAS v4u*)(UT + (sl0 + r) * 1024 + oct * 16), qo = *(const LAS v4u*)(UT + (sl0 + r - w) * 1024 + oct * 16);
                        float fn[8], fo[8]; PM_UNPK(qn, fn); PM_UNPK(qo, fo); const float m_ = tpr + 1 > w ? 1.0f : 0.0f;
#pragma unroll
                        for (int e = 0; e < 8; ++e) S[e] += fn[e] - m_ * fo[e];
                        const float inv = 1.0f / (float)cnt;
                        v4u o; o.x = pk2(S[0] * inv - fn[0], S[1] * inv - fn[1]); o.y = pk2(S[2] * inv - fn[2], S[3] * inv - fn[3]); o.z = pk2(S[4] * inv - fn[4], S[5] * inv - fn[5]); o.w = pk2(S[6] * inv - fn[6], S[7] * inv - fn[7]);
                        *(LAS v4u*)(lds + PA + PM_OFFP(32 * hf + il0 + r, oct)) = o; }
                  }
                  __syncthreads();
              }
            }
            f32x16 acc[2][2];
#pragma unroll
            for (int a = 0; a < 2; ++a)
#pragma unroll
                for (int c = 0; c < 2; ++c) acc[a][c] = zero16();
#define PM_CHUNK(kc, SET) do { \
                int la_ = lane; asm volatile("" : "+v"(la_)); const int l31_ = la_ & 31, h5_ = la_ >> 5; \
                s16x8 fb[2][2]; \
                _Pragma("unroll") for (int ks = 0; ks < 2; ++ks) _Pragma("unroll") for (int mt = 0; mt < 2; ++mt) fb[mt][ks] = *(const LAS s16x8*)(lds + PA + PM_OFFP(32 * mt + l31_, 4 * (kc) + 2 * ks + h5_)); \
                _Pragma("unroll") for (int ks = 0; ks < 2; ++ks) _Pragma("unroll") for (int nt = 0; nt < 2; ++nt) _Pragma("unroll") for (int mt = 0; mt < 2; ++mt) \
                    acc[nt][mt] = mfma32(__builtin_bit_cast(s16x8, SET[nt * 2 + ks]), fb[mt][ks], acc[nt][mt]); \
                if ((kc) + 3 < 16) PM_WLD(SET, (kc) + 3); } while (0)
            PM_CHUNK(0, wA); PM_CHUNK(1, wB); PM_CHUNK(2, wC); PM_CHUNK(3, wA); PM_CHUNK(4, wB); PM_CHUNK(5, wC); PM_CHUNK(6, wA); PM_CHUNK(7, wB);
            PM_CHUNK(8, wC); PM_CHUNK(9, wA); PM_CHUNK(10, wB); PM_CHUNK(11, wC); PM_CHUNK(12, wA); PM_CHUNK(13, wB); PM_CHUNK(14, wC); PM_CHUNK(15, wA);
#undef PM_CHUNK
#undef PM_WLD
            __syncthreads();
#pragma unroll
            for (int nt = 0; nt < 2; ++nt)
#pragma unroll
                for (int q = 0; q < 4; ++q)
#pragma unroll
                    for (int mt = 0; mt < 2; ++mt) { const int n = 32 * (2 * wave + nt) + 8 * q + 4 * h5, m = 32 * mt + l31;
                        const float y0 = acc[nt][mt][4 * q], y1 = acc[nt][mt][4 * q + 1], y2 = acc[nt][mt][4 * q + 2], y3 = acc[nt][mt][4 * q + 3];
                        v2u o; o.x = pk2(y0, y1); o.y = pk2(y2, y3);
                        *(LAS v2u*)(lds + PA + m * 1040 + n * 2) = o; }
            __syncthreads();
            { const int ch = tid & 63, col = g * 512 + ch * 8; const unsigned hvo = (unsigned)col * ES, ovo = (unsigned)col * 2u;
              const f32x4 gv0 = *(const GAS f32x4*)(gtp + col) * *(const GAS f32x4*)(pscale + col), gv1 = *(const GAS f32x4*)(gtp + col + 4) * *(const GAS f32x4*)(pscale + col + 4);
              if constexpr (XF32) {
#pragma unroll
                  for (int kb = 0; kb < 8; kb += 4) {
                      v4u ha[4], hb2[4];
#pragma unroll
                      for (int k = 0; k < 4; ++k) { const unsigned so = (unsigned)(r0 + wave + 8 * (kb + k)) * (DM * ES); ha[k] = PM_LDH(hvo, so); hb2[k] = PM_LDH(hvo, so + 16u); }
#pragma unroll
                      for (int k = 0; k < 4; ++k) { const int m = wave + 8 * (kb + k); float f[8], y[8];
                          const f32x4 x0 = __builtin_bit_cast(f32x4, ha[k]), x1 = __builtin_bit_cast(f32x4, hb2[k]); f[0] = x0.x; f[1] = x0.y; f[2] = x0.z; f[3] = x0.w; f[4] = x1.x; f[5] = x1.y; f[6] = x1.z; f[7] = x1.w;
                          const v4u yq = *(const LAS v4u*)(lds + PA + m * 1040 + ch * 16); PM_UNPK(yq, y);
                          v4u o; o.x = pk2(f[0] + gv0.x * y[0], f[1] + gv0.y * y[1]); o.y = pk2(f[2] + gv0.z * y[2], f[3] + gv0.w * y[3]); o.z = pk2(f[4] + gv1.x * y[4], f[5] + gv1.y * y[5]); o.w = pk2(f[6] + gv1.z * y[6], f[7] + gv1.w * y[7]);
                          __builtin_amdgcn_raw_buffer_store_b128(o, rsO, ovo, (unsigned)(r0 + m) * (DM * 2u), 0); }
                  }
              } else {
                  (void)hvo;
#pragma unroll
                  for (int kk = 0; kk < 8; ++kk) { const int m = wave + 8 * kk; float f[8], y[8]; PM_UNPK(hk[kk], f);
                      const v4u yq = *(const LAS v4u*)(lds + PA + m * 1040 + ch * 16); PM_UNPK(yq, y);
                      v4u o; o.x = pk2(f[0] + gv0.x * y[0], f[1] + gv0.y * y[1]); o.y = pk2(f[2] + gv0.z * y[2], f[3] + gv0.w * y[3]); o.z = pk2(f[4] + gv1.x * y[4], f[5] + gv1.y * y[5]); o.w = pk2(f[6] + gv1.z * y[6], f[7] + gv1.w * y[7]);
                      __builtin_amdgcn_raw_buffer_store_b128(o, rsO, ovo, (unsigned)(r0 + m) * (DM * 2u), 0);
                      if (U2) { float e[8]; PM_UNPK(o, e);
                          const float s2 = wave_sum(((e[0] * e[0] + e[1] * e[1]) + (e[2] * e[2] + e[3] * e[3])) + ((e[4] * e[4] + e[5] * e[5]) + (e[6] * e[6] + e[7] * e[7])));
                          if (lane == 0) rowss[m] = (g ? rowss[m] : 0.f) + s2; } }
              }
            }
            __syncthreads();
        }
        if (U2) {
            const __amdgpu_buffer_rsrc_t rsU = __builtin_amdgcn_make_buffer_rsrc((void*)U2, (short)0, M * DM * 2, 0x00020000);
            const float* sh2 = shift2 + (size_t)b * ADA_W; const float* sc2 = scale2 + (size_t)b * ADA_W;
            f32x4 mul[8], add[8];
#pragma unroll
            for (int j = 0; j < 8; ++j) { const int col = 8 * lane + 512 * (j >> 1) + 4 * (j & 1); const f32x4 gv = *(const GAS f32x4*)(g2 + col), s = *(const GAS f32x4*)(sc2 + col); mul[j] = gv * (s + 1.0f); add[j] = *(const GAS f32x4*)(sh2 + col); }
#pragma unroll 1
            for (int kb = 0; kb < 8; kb += 2) {
                v4u q[2][4]; float rs2[2];
#pragma unroll
                for (int z = 0; z < 2; ++z) { const int m = wave + 8 * (kb + z); rs2[z] = 1.0f / sqrtf(rowss[m] * (1.0f / DM) + EPS);
#pragma unroll
                    for (int j = 0; j < 4; ++j) q[z][j] = __builtin_amdgcn_raw_buffer_load_b128(rsO, (unsigned)lane * 16u + (unsigned)j * 1024u, (unsigned)(r0 + m) * (DM * 2u), 0); }
#pragma unroll
                for (int z = 0; z < 2; ++z) { const int m = wave + 8 * (kb + z); const float rstd = rs2[z];
#pragma unroll
                    for (int j = 0; j < 4; ++j) { float e[8]; PM_UNPK(q[z][j], e);
                        const f32x4 v0 = {e[0], e[1], e[2], e[3]}, v1 = {e[4], e[5], e[6], e[7]};
                        const f32x4 y0 = v0 * rstd * mul[2 * j] + add[2 * j], y1 = v1 * rstd * mul[2 * j + 1] + add[2 * j + 1];
                        v4u w; w.x = pk2(y0.x, y0.y); w.y = pk2(y0.z, y0.w); w.z = pk2(y1.x, y1.y); w.w = pk2(y1.z, y1.w);
                        __builtin_amdgcn_raw_buffer_store_b128(w, rsU, (unsigned)lane * 16u + (unsigned)j * 1024u, (unsigned)(r0 + m) * (DM * 2u), 0); } }
            }
        }
    }
#undef PM_OFFP
#undef PM_OFFW
#undef PM_LDH
#undef PM_UNPK
}

constexpr int NSUB = 6, PH_FINAL = 1 + NSUB * 2 * DEPTH, PH_END = PH_FINAL + 1;
__host__ __device__ constexpr bool phase_exists(int ph) {
    if (ph == 0 || ph == PH_FINAL) return true;
    const int hl = (ph - 1) / NSUB, s = (ph - 1) % NSUB, layer = hl >> 1;
    if (!(hl & 1) && layer % 3 == 0) return s == 1;
    if ((hl & 1) && layer % 3 == 0 && s == 0) return false;
    if (s == 2) return false;
    if (s == 3 || s == 4) return !(hl & 1) && (layer == 1 || layer == 2);
    return true;
}
__global__ void __launch_bounds__(NWAVES * 64, 2) trunk_fwd(Args a) {
    extern __shared__ __attribute__((aligned(16))) unsigned char lds_raw[];
    LAS unsigned char* lds = (LAS unsigned char*)lds_raw;
    volatile LAS unsigned* MISC = (volatile LAS unsigned*)(lds + MISC_OFF);
    const int G = gridDim.x; const int bx = blockIdx.x; const int vcu = (G % 8 == 0) ? (bx % 8) * (G / 8) + bx / 8 : bx;
    const int NGW = G * NWAVES;
    gu32* ctl = (gu32*)(a.ws + WS_CTL);
    const int wave0 = __builtin_amdgcn_readfirstlane((int)threadIdx.x >> 6);
    for (int u = (int)__builtin_amdgcn_mbcnt_hi(~0u, __builtin_amdgcn_mbcnt_lo(~0u, 0u)) + 64 * wave0; u < (LDS_BYTES - LDSCTL_OFF) / 4; u += NWAVES * 64) ((LAS unsigned*)(lds + LDSCTL_OFF))[u] = 0u;
    __syncthreads();
#define PHASE_IDS() const CAS Args* ap = (const CAS Args*)__builtin_amdgcn_kernarg_segment_ptr(); asm volatile("" : "+s"(ap)); unsigned char* ws = ap->ws; int lane = (int)__builtin_amdgcn_mbcnt_hi(~0u, __builtin_amdgcn_mbcnt_lo(~0u, 0u)); asm volatile("" : "+v"(lane)); const int wave = wave0, tid = wave * 64 + lane, gw = vcu * NWAVES + wave; (void)tid; (void)gw
#if MK_ONE_LAUNCH
    XcdBarrier bar = xcd_barrier_post((unsigned*)(ctl + CW_BAR), MISC + 8, wave0);
#define GRID_BAR() xcd_barrier(bar, wave0)
#else
#define GRID_BAR() do { } while (0)
#endif
    const int lo = a.ph_lo, hi = a.ph_hi;
#define IN(k) (lo <= (k) && (k) < hi)
#define ada ((float*)(ws + WS_ADA))
#define U ((bf16*)(ws + WS_U))
#define Pb ((bf16*)(ws + WS_P))
#define PROJ ((bf16*)(ws + WS_PROJ))
#define O ((bf16*)(ws + WS_O))
#define HQD ((bf16*)(ws + WS_PROJ + 256 * MiB))
#define HKI ((bf16*)(ws + WS_PROJ + 320 * MiB))
#define HKE ((bf16*)(ws + WS_P + 64 * MiB))
#define HDEC ((float*)(ws + WS_O + 128 * MiB))
#define HVV ((bf16*)(ws + WS_O + 136 * MiB))
#define H ((bf16*)(ws + (hl >= 7 ? WS_H2 : WS_H)))
#define HPOOL_OUT ((bf16*)(ws + (hl >= 6 ? WS_H2 : WS_H)))

    if (IN(0)) for (int rep = 0; rep < REP_P0; ++rep) { PHASE_IDS(); phase_prologue(ap, lds, tid, lane, wave, vcu, G); GRID_BAR(); }

    for (int hl = 0; hl < 2 * DEPTH; ++hl) {
        const int layer = hl >> 1, isffn = hl & 1, pb = 1 + NSUB * hl;
        const int kind = layer % 3, jj = layer / 3;
#define ada_l (ada + (size_t)layer * NB * ADA_W)
#define hin_is_x (hl == 0)
        if ((kind != 0) && IN(pb + 0)) for (int rep = 0; rep < REP_S0; ++rep) {
            PHASE_IDS();
            if (hin_is_x) phase_normmod(ap->x, ap->norm_mix_g, ada_l, ada_l + DM, U, gw, NGW, lane);
            else phase_normmod_bf(H, (isffn ? ap->norm_ffn_g : ap->norm_mix_g) + (size_t)layer * DM, ada_l + (isffn ? 3 : 0) * DM, ada_l + (isffn ? 4 : 1) * DM, U, gw, NGW, lane);
            GRID_BAR();
        }
        if (IN(pb + 1)) for (int rep = 0; rep < REP_S1; ++rep) {
            PHASE_IDS();
            if (isffn) {
                pg8::Gemm g{U, (const bf16*)(ws + WS_FFWIN) + (size_t)layer * FF2 * DM, M, FF2, DM, DM, DM, FF2 / 256, 0, 0};
                pg8::StaticOrder S; S.init(M, FF2, G, bx);
                pg8::EpiSwiGLU E{PROJ, FF};
                pg8::gemm_phase<pg8::EpiSwiGLU, pg8::StaticOrder, true>(lds + RING_OFF, g, S, E, tid);
            } else if (kind == 0) {
                phase_poolmix<false>(hin_is_x ? (const void*)(ws + WS_H2) : (const void*)H, hin_is_x ? (const float*)(ws + WS_XRS) : (const float*)nullptr, HPOOL_OUT,
                                     ap->norm_mix_g + (size_t)layer * DM, ada_l, ap->pool_scale + (size_t)jj * DM, (const bf16*)(ws + WS_POOLW) + (size_t)jj * 4 * 512 * 512,
                                     ap->norm_ffn_g + (size_t)layer * DM, ada_l + 3 * DM, ada_l + 4 * DM, U, lds, tid, vcu, G);
            } else {
                const int N = (kind == 1) ? HG_IN : RT_IN;
                pg8::Gemm g{U, (const bf16*)(ws + (kind == 1 ? WS_HGWIN : WS_RTWIN)), M, N, DM, DM, DM, N / 256, 0, 0};
                pg8::StaticOrder S; S.init(M, N, G, bx);
                const float* rot = (const float*)(ws + WS_ROT);
                pg8::EpiBf16Rot E{PROJ, N, rot, rot + (size_t)M * 128, kind == 2 ? 16 : 0, kind == 1 ? 16 : 0, (const float*)(ws + WS_LB), HQD, HKI, HKE, HDEC, HVV};
                pg8::gemm_phase<pg8::EpiBf16Rot, pg8::StaticOrder, true>(lds + RING_OFF, g, S, E, tid);
            }
            GRID_BAR();
        }
        if (0) for (int rep = 0; rep < REP_S2; ++rep) {
            PHASE_IDS();
            phase_hgrn_pre(PROJ, (const float*)(ws + WS_LB), HQD, HKI, HKE, HDEC, gw * 64 + lane, NGW * 64);
            GRID_BAR();
        }
        if (!isffn && kind != 0 && IN(pb + 3)) for (int rep = 0; rep < REP_S2; ++rep) {
            PHASE_IDS();
#if NAIVE_SCANS
            if (kind == 1) phase_hgrn_scan_naive(PROJ, (const float*)(ws + WS_LB), O, lds, tid, vcu, G);
            else phase_ret_scan_naive(PROJ, (const float*)(ws + WS_ROT), O, lds, tid, vcu, G);
#else
            if (kind == 1) { if ((vcu & 1) && G >= 2) phase_convert_late_tiles(ap, lds, lane, wave, vcu >> 1, G >> 1);
                             else phase_hgrn_scan(HVV, HQD, HKI, HKE, HDEC, O, lds, tid, G >= 2 ? (vcu >> 1) : vcu, G >= 2 ? ((G + 1) >> 1) : 1); }
            else phase_ret_scan(PROJ, O, lds, tid, vcu, G);
#endif
            GRID_BAR();
        }
        if (!isffn && kind != 0 && IN(pb + 4)) for (int rep = 0; rep < REP_S3; ++rep) {
            PHASE_IDS();
            if (kind == 1) phase_hgrn_post(O, PROJ, ap->hgrn_norm_g, Pb, gw, NGW, lane);
            else phase_ret_post(O, PROJ, ap->ret_norm_g, Pb, gw, NGW, lane);
            GRID_BAR();
        }
        if ((isffn || kind != 0) && IN(pb + 5)) {
            PHASE_IDS();
            pg8::Gemm g;
            const float* cs = nullptr;
            if (isffn) g = pg8::Gemm{PROJ, (const bf16*)(ws + WS_FFWOUT) + (size_t)layer * DM * FF, M, DM, FF, FF, FF, DM / 256, 0, 0};
            else if (kind == 0) { g = pg8::Gemm{Pb, (const bf16*)(ws + WS_POOLW) + (size_t)jj * 4 * 512 * 512, M, DM, 512, DM, 512, 2, 512, 512 * 512}; cs = ap->pool_scale + (size_t)jj * DM; }
            else if (kind == 1) g = pg8::Gemm{Pb, (const bf16*)(ws + WS_HGWOUT), M, DM, DM, DM, DM, DM / 256, 0, 0};
            else g = pg8::Gemm{Pb, (const bf16*)(ws + WS_RTWOUT), M, DM, RT_V, RT_V, RT_V, DM / 256, 0, 0};
            pg8::StaticOrder S; S.init(M, DM, G, bx);
            pg8::EpiResid E{hin_is_x ? ap->x : (const float*)nullptr, H, H, ada_l + (isffn ? 5 : 2) * DM, ADA_W, cs};
            pg8::gemm_phase<pg8::EpiResid, pg8::StaticOrder, true>(lds + RING_OFF, g, S, E, tid);
            GRID_BAR();
        }
    }
    if (IN(PH_FINAL)) { PHASE_IDS(); phase_finalnorm_bf((const bf16*)(ws + WS_H2), ap->final_g, ap->out, gw, NGW, lane); }
#undef IN
#undef ada
#undef U
#undef Pb
#undef PROJ
#undef O
#undef HQD
#undef HKI
#undef HKE
#undef HDEC
#undef HVV
#undef H
#undef HPOOL_OUT
#undef ada_l
#undef hin_is_x
}

extern "C" void kernel_launch(void* const* d_in, const int* in_sizes, int n_in, void* d_out, int out_size, void* d_ws, size_t ws_size, hipStream_t stream) {
    static int grid = 0;
    if (grid == 0) {
        if (n_in != 19 || in_sizes[0] != M * DM || out_size != M * DM || ws_size < WS_END) { fprintf(stderr, "kernel_launch: unexpected shapes (n_in %d, in0 %d, out %d, ws %zu < %zu); nothing launched\n", n_in, n_in > 0 ? in_sizes[0] : -1, out_size, ws_size, (size_t)WS_END); grid = -1; return; }
        int dev = 0, cus = 0, per_cu = 0;
        if (hipGetDevice(&dev) != hipSuccess || hipDeviceGetAttribute(&cus, hipDeviceAttributeMultiprocessorCount, dev) != hipSuccess) { grid = -1; return; }
        if (hipFuncSetAttribute((const void*)trunk_fwd, hipFuncAttributeMaxDynamicSharedMemorySize, LDS_BYTES) != hipSuccess) { fprintf(stderr, "kernel_launch: hipFuncSetAttribute failed\n"); grid = -1; return; }
        if (hipOccupancyMaxActiveBlocksPerMultiprocessor(&per_cu, (const void*)trunk_fwd, NWAVES * 64, LDS_BYTES) != hipSuccess || per_cu < 1)
            fprintf(stderr, "kernel_launch: note: occupancy query reports %d workgroups per CU\n", per_cu);
        (void)hipGetLastError();
        grid = cus;
    }
    if (grid < 0) return;
    if (hipMemsetAsync((char*)d_ws + WS_CTL, 0, CTL_ZERO_BYTES, stream) != hipSuccess) { fprintf(stderr, "kernel_launch: memset failed\n"); return; }
    Args a{};
    a.x = (const float*)d_in[0]; a.c = (const float*)d_in[1]; a.pos = (const int*)d_in[2]; a.w_ada = (const float*)d_in[3]; a.b_ada = (const float*)d_in[4];
    a.norm_mix_g = (const float*)d_in[5]; a.norm_ffn_g = (const float*)d_in[6]; a.pool_w = (const float*)d_in[7]; a.pool_scale = (const float*)d_in[8];
    a.hgrn_w_in = (const float*)d_in[9]; a.hgrn_lb = (const float*)d_in[10]; a.hgrn_norm_g = (const float*)d_in[11]; a.hgrn_w_out = (const float*)d_in[12];
    a.ret_w_in = (const float*)d_in[13]; a.ret_norm_g = (const float*)d_in[14]; a.ret_w_out = (const float*)d_in[15]; a.ffn_w_in = (const float*)d_in[16];
    a.ffn_w_out = (const float*)d_in[17]; a.final_g = (const float*)d_in[18];
    a.out = (float*)d_out; a.ws = (unsigned char*)d_ws;
#if MK_ONE_LAUNCH
    a.ph_lo = 0; a.ph_hi = PH_END;
    hipLaunchKernelGGL(trunk_fwd, dim3(grid), dim3(NWAVES * 64), LDS_BYTES, stream, a);
    { const hipError_t le = hipPeekAtLastError(); if (le != hipSuccess) fprintf(stderr, "kernel_launch: launch failed: %s\n", hipGetErrorName(le)); }
#else
    for (int ph = 0; ph < PH_END; ++ph) {
        if (!phase_exists(ph)) continue;
        a.ph_lo = ph; a.ph_hi = ph + 1;
        hipLaunchKernelGGL(trunk_fwd, dim3(grid), dim3(NWAVES * 64), LDS_BYTES, stream, a);
        const hipError_t le = hipPeekAtLastError();
        if (le != hipSuccess) { fprintf(stderr, "kernel_launch: launch %d failed: %s\n", ph, hipGetErrorName(le)); break; }
    }
#endif
}
```

```cpp
#include <hip/hip_runtime.h>
#include <cstdio>
#include <cstdint>

#ifndef MK_ONE_LAUNCH
#define MK_ONE_LAUNCH 1
#endif
#define REP_S0 1
#define REP_S1 1
#define REP_S2 1
#define REP_S3 1
#define REP_P0 1
#define NAIVE_SCANS 0

constexpr int DM = 2048, NB = 4, SEQ = 4096, DEPTH = 4, M = NB * SEQ;
constexpr int ADA_W = 6 * DM;
constexpr int HG_IN = 8192, HG_H = 16, HG_DK = 128;
constexpr int RT_IN = 12288, RT_H = 8, RT_DK = 256, RT_DV = 512, RT_V = 4096;
constexpr int FF = 5632, FF2 = 2 * FF;
constexpr float EPS = 1e-6f;

namespace pg8 {
#define PG8_LAS __attribute__((address_space(3)))
typedef unsigned short bf16_t;
typedef short bf16x8 __attribute__((ext_vector_type(8)));
typedef float f32x4 __attribute__((ext_vector_type(4)));
typedef unsigned u32x4 __attribute__((ext_vector_type(4)));
constexpr int BM = 256, BK = 64, HALF = 128, HTB = HALF * BK * 2  , STAGE_BYTES = 8 * HTB, NXCD = 8, WGM = 4;

__host__ __device__ __forceinline__ int lds_byte(int r, int c) { const int st = (r >> 4) * 2 + (c >> 5), rr = r & 15, cc = c & 31, ob = rr * 64 + cc * 2; return st * 1024 + (ob ^ (((ob >> 9) & 1) << 5)); }
__host__ __device__ __forceinline__ void stage_rc(int b, int& R, int& C) { const int st = b / 1024, sb = b % 1024, swz = sb ^ (((sb >> 9) & 1) << 5); R = (st >> 1) * 16 + swz / 64; C = (st & 1) * 32 + (swz % 64) / 2; }
__host__ __device__ __forceinline__ int perm32(int rho) { const int n = rho >> 4, i = rho & 15; return 8 * (i >> 2) + 4 * n + (i & 3); }

struct Unit { int pm, pn; };
struct Gemm { const bf16_t* A; const bf16_t* Bt; int M, N, K, lda, ldb, gpn; long a_gs, b_gs; };

struct StaticOrder {
    int nM, nN, nwg, G, c;
    __host__ __device__ void init(int M_, int N_, int G_, int c_) { nM = M_ / BM; nN = N_ / BM; nwg = nM * nN; G = G_; c = c_; }
    __host__ __device__ bool next(int i, Unit& u) const {
        const long L = (long)i * G + c; if (L >= nwg) return false;
        int wgid = (int)L; { const int q = nwg / NXCD, r = nwg % NXCD, xcd = wgid % NXCD, off = wgid / NXCD; wgid = (xcd < r ? xcd * (q + 1) : r * (q + 1) + (xcd - r) * q) + off; }
        const int nig = WGM * nN, gid = wgid / nig, fm = gid * WGM, gsz = (nM - fm) < WGM ? (nM - fm) : WGM;
        u.pm = fm + ((wgid % nig) % gsz); u.pn = (wgid % nig) / gsz; return true;
    }
    __device__ __forceinline__ void a_ready(const Unit&) const {}
    __device__ __forceinline__ void done(const Unit&) const {}
};

__device__ __forceinline__ unsigned cvt_pk_bf16(float lo, float hi) { unsigned r; asm volatile("v_cvt_pk_bf16_f32 %0, %1, %2" : "=v"(r) : "v"(lo), "v"(hi)); return r; }

struct EpiBf16 {
    static constexpr bool PERM = true, AFTER_DRAIN = false;
    bf16_t* O; int ldc;
    __device__ __forceinline__ void operator()(const f32x4 (&acc)[2][2][4][2], const Unit& u, int wr, int wc, int fr, int fq) const {
        const int row0 = u.pm * BM + wr * 64 + fr, col0 = u.pn * BM + wc * 32 + 8 * fq;
#pragma unroll
        for (int ai = 0; ai < 2; ++ai)
#pragma unroll
            for (int m = 0; m < 4; ++m) { bf16_t* rowp = O + (size_t)(row0 + ai * HALF + m * 16) * ldc + col0;
#pragma unroll
                for (int bj = 0; bj < 2; ++bj) { const f32x4 v0 = acc[ai][bj][m][0], v1 = acc[ai][bj][m][1];
                    u32x4 w; w.x = cvt_pk_bf16(v0[0], v0[1]); w.y = cvt_pk_bf16(v0[2], v0[3]); w.z = cvt_pk_bf16(v1[0], v1[1]); w.w = cvt_pk_bf16(v1[2], v1[3]);
                    *(u32x4*)(rowp + bj * HALF) = w; } }
    }
};
__device__ __forceinline__ float scan16_mul(float x) {
#define PG8_DPP_SHR(v, n) __builtin_bit_cast(float, __builtin_amdgcn_update_dpp(0x3f800000, __builtin_bit_cast(int, v), 0x110 + (n), 0xf, 0xf, false))
    x *= PG8_DPP_SHR(x, 1); x *= PG8_DPP_SHR(x, 2); x *= PG8_DPP_SHR(x, 4); x *= PG8_DPP_SHR(x, 8);
#undef PG8_DPP_SHR
    return x;
}
__device__ __forceinline__ float bcast15(float x, int lane) { (void)lane; return __builtin_bit_cast(float, __builtin_amdgcn_update_dpp(0, __builtin_bit_cast(int, x), 0x15F, 0xf, 0xf, false)); }
__device__ __forceinline__ float sigm_f(float x) { return __builtin_amdgcn_rcpf(1.0f + __builtin_amdgcn_exp2f(-1.4426950408889634f * x)); }
struct EpiBf16Rot {
    static constexpr bool PERM = true, AFTER_DRAIN = false;
    bf16_t* O; int ldc; const float* ct; const float* st; int rot_tiles;
    int hg_tiles; const float* lbv; bf16_t* QD; bf16_t* KI; bf16_t* KE; float* DEC; bf16_t* HV;
    __device__ __forceinline__ void operator()(const f32x4 (&acc)[2][2][4][2], const Unit& u, int wr, int wc, int fr, int fq) const {
        const int row0 = u.pm * BM + wr * 64 + fr, col0 = u.pn * BM + wc * 32 + 8 * fq;
        if (u.pn < hg_tiles) {
            const int lane = fq * 16 + fr, cg = u.pn * HALF + wc * 32 + 8 * fq;
            float lb[8];
            { const f32x4 l0 = *(const f32x4*)(lbv + cg), l1 = *(const f32x4*)(lbv + cg + 4);
#pragma unroll
              for (int e = 0; e < 4; ++e) { lb[e] = l0[e]; lb[4 + e] = l1[e]; } }
#pragma unroll
            for (int ai = 0; ai < 2; ++ai)
#pragma unroll
                for (int mp = 0; mp < 2; ++mp) {
                    float qd0[8], ki0[8], ke0[8], qd1[8], ki1[8], ke1[8], tot[8];
#pragma unroll
                    for (int c = 0; c < 8; ++c) {
                        const float z0 = acc[ai][1][2 * mp][c >> 2][c & 3], z1 = acc[ai][1][2 * mp + 1][c >> 2][c & 3];
                        const float q0 = acc[ai][0][2 * mp][c >> 2][c & 3], q1 = acc[ai][0][2 * mp + 1][c >> 2][c & 3];
                        const float s0 = sigm_f(z0), s1 = sigm_f(z1), om = 1.0f - lb[c];
                        const float e0 = scan16_mul(lb[c] + om * s0);
                        const float e1 = scan16_mul(lb[c] + om * s1) * bcast15(e0, lane);
                        const float tt = bcast15(e1, lane);
                        const float k0 = om * (1.0f - s0) * __builtin_amdgcn_rcpf(e0), k1 = om * (1.0f - s1) * __builtin_amdgcn_rcpf(e1);
                        qd0[c] = q0 * e0; ki0[c] = k0; ke0[c] = k0 * tt; qd1[c] = q1 * e1; ki1[c] = k1; ke1[c] = k1 * tt; tot[c] = tt;
                    }
                    const int rr0 = row0 + ai * HALF + 32 * mp;
                    const size_t r0 = ((size_t)((rr0 >> 12) * 16 + u.pn) * 4096 + (rr0 & 4095)) * 128 + (wc * 32 + 8 * fq), r1 = r0 + 16 * 128;
                    u32x4 w;
                    w.x = cvt_pk_bf16(qd0[0], qd0[1]); w.y = cvt_pk_bf16(qd0[2], qd0[3]); w.z = cvt_pk_bf16(qd0[4], qd0[5]); w.w = cvt_pk_bf16(qd0[6], qd0[7]); *(u32x4*)(QD + r0) = w;
                    w.x = cvt_pk_bf16(ki0[0], ki0[1]); w.y = cvt_pk_bf16(ki0[2], ki0[3]); w.z = cvt_pk_bf16(ki0[4], ki0[5]); w.w = cvt_pk_bf16(ki0[6], ki0[7]); *(u32x4*)(KI + r0) = w;
                    w.x = cvt_pk_bf16(ke0[0], ke0[1]); w.y = cvt_pk_bf16(ke0[2], ke0[3]); w.z = cvt_pk_bf16(ke0[4], ke0[5]); w.w = cvt_pk_bf16(ke0[6], ke0[7]); *(u32x4*)(KE + r0) = w;
                    w.x = cvt_pk_bf16(qd1[0], qd1[1]); w.y = cvt_pk_bf16(qd1[2], qd1[3]); w.z = cvt_pk_bf16(qd1[4], qd1[5]); w.w = cvt_pk_bf16(qd1[6], qd1[7]); *(u32x4*)(QD + r1) = w;
                    w.x = cvt_pk_bf16(ki1[0], ki1[1]); w.y = cvt_pk_bf16(ki1[2], ki1[3]); w.z = cvt_pk_bf16(ki1[4], ki1[5]); w.w = cvt_pk_bf16(ki1[6], ki1[7]); *(u32x4*)(KI + r1) = w;
                    w.x = cvt_pk_bf16(ke1[0], ke1[1]); w.y = cvt_pk_bf16(ke1[2], ke1[3]); w.z = cvt_pk_bf16(ke1[4], ke1[5]); w.w = cvt_pk_bf16(ke1[6], ke1[7]); *(u32x4*)(KE + r1) = w;
                    if (fr == 15) { const int crow = u.pm * BM + wr * 64 + ai * HALF + 32 * mp; float* dp = DEC + ((size_t)((crow >> 12) * 16 + u.pn) * 128 + ((crow & 4095) >> 5)) * 128 + (wc * 32 + 8 * fq);
                        *(f32x4*)dp = (f32x4){tot[0], tot[1], tot[2], tot[3]}; *(f32x4*)(dp + 4) = (f32x4){tot[4], tot[5], tot[6], tot[7]}; }
                }
        } else if (u.pn < rot_tiles) {
            const float sc = u.pn >= 8 ? 0.0625f : 1.0f; const int j0 = wc * 32 + 8 * fq;
#pragma unroll
            for (int ai = 0; ai < 2; ++ai)
#pragma unroll
                for (int m = 0; m < 4; ++m) { const int row = row0 + ai * HALF + m * 16; bf16_t* rowp = O + (size_t)row * ldc + col0;
                    const f32x4 c0 = *(const f32x4*)(ct + (size_t)row * 128 + j0), c1 = *(const f32x4*)(ct + (size_t)row * 128 + j0 + 4);
                    const f32x4 s0 = *(const f32x4*)(st + (size_t)row * 128 + j0), s1 = *(const f32x4*)(st + (size_t)row * 128 + j0 + 4);
                    const f32x4 a0 = acc[ai][0][m][0], a1 = acc[ai][0][m][1], b0 = acc[ai][1][m][0], b1 = acc[ai][1][m][1];
                    const f32x4 p0 = (a0 * c0 - b0 * s0) * sc, p1 = (a1 * c1 - b1 * s1) * sc, q0 = (a0 * s0 + b0 * c0) * sc, q1 = (a1 * s1 + b1 * c1) * sc;
                    u32x4 w; w.x = cvt_pk_bf16(p0[0], p0[1]); w.y = cvt_pk_bf16(p0[2], p0[3]); w.z = cvt_pk_bf16(p1[0], p1[1]); w.w = cvt_pk_bf16(p1[2], p1[3]);
                    *(u32x4*)rowp = w;
                    w.x = cvt_pk_bf16(q0[0], q0[1]); w.y = cvt_pk_bf16(q0[2], q0[3]); w.z = cvt_pk_bf16(q1[0], q1[1]); w.w = cvt_pk_bf16(q1[2], q1[3]);
                    *(u32x4*)(rowp + HALF) = w; }
        } else {
            const bool hv = hg_tiles > 0 && u.pn < 24;
#pragma unroll
            for (int ai = 0; ai < 2; ++ai)
#pragma unroll
                for (int m = 0; m < 4; ++m) { const int row = row0 + ai * HALF + m * 16; bf16_t* rowp = O + (size_t)row * ldc + col0;
#pragma unroll
                    for (int bj = 0; bj < 2; ++bj) { const f32x4 v0 = acc[ai][bj][m][0], v1 = acc[ai][bj][m][1];
                        u32x4 w; w.x = cvt_pk_bf16(v0[0], v0[1]); w.y = cvt_pk_bf16(v0[2], v0[3]); w.z = cvt_pk_bf16(v1[0], v1[1]); w.w = cvt_pk_bf16(v1[2], v1[3]);
                        if (hv) *(u32x4*)(HV + ((size_t)((row >> 12) * 16 + 2 * (u.pn - 16) + bj) * 4096 + (row & 4095)) * 128 + wc * 32 + 8 * fq) = w;
                        else *(u32x4*)(rowp + bj * HALF) = w; } }
        }
    }
};
__device__ __forceinline__ float silu_f(float x) { return x * __builtin_amdgcn_rcpf(1.0f + __builtin_amdgcn_exp2f(-1.4426950408889634f * x)); }
struct EpiSwiGLU {
    static constexpr bool PERM = true, AFTER_DRAIN = false;
    bf16_t* O; int ldc;
    __device__ __forceinline__ void operator()(const f32x4 (&acc)[2][2][4][2], const Unit& u, int wr, int wc, int fr, int fq) const {
        const int row0 = u.pm * BM + wr * 64 + fr, col0 = u.pn * HALF + wc * 32 + 8 * fq;
#pragma unroll
        for (int ai = 0; ai < 2; ++ai)
#pragma unroll
            for (int m = 0; m < 4; ++m) { bf16_t* rowp = O + (size_t)(row0 + ai * HALF + m * 16) * ldc + col0;
                const f32x4 g0 = acc[ai][0][m][0], g1 = acc[ai][0][m][1], u0 = acc[ai][1][m][0], u1 = acc[ai][1][m][1];
                f32x4 e0 = g0 * -1.4426950408889634f, e1 = g1 * -1.4426950408889634f;
                const f32x4 p0 = g0 * u0, p1 = g1 * u1;
                __builtin_amdgcn_sched_barrier(0);
#pragma unroll
                for (int i = 0; i < 4; ++i) { e0[i] = __builtin_amdgcn_exp2f(e0[i]); e1[i] = __builtin_amdgcn_exp2f(e1[i]); }
                __builtin_amdgcn_sched_barrier(0);
                e0 = e0 + 1.0f; e1 = e1 + 1.0f;
                __builtin_amdgcn_sched_barrier(0);
#pragma unroll
                for (int i = 0; i < 4; ++i) { e0[i] = __builtin_amdgcn_rcpf(e0[i]); e1[i] = __builtin_amdgcn_rcpf(e1[i]); }
                __builtin_amdgcn_sched_barrier(0);
                const f32x4 o0 = p0 * e0, o1 = p1 * e1;
                u32x4 w; w.x = cvt_pk_bf16(o0[0], o0[1]); w.y = cvt_pk_bf16(o0[2], o0[3]); w.z = cvt_pk_bf16(o1[0], o1[1]); w.w = cvt_pk_bf16(o1[2], o1[3]);
                *(u32x4*)rowp = w; }
    }
};
struct EpiResid {
    static constexpr bool PERM = true, AFTER_DRAIN = false;
    const float* xin; const bf16_t* hin; bf16_t* hout; const float* gate; int gate_bs; const float* cscale;
    __device__ __forceinline__ void operator()(const f32x4 (&acc)[2][2][4][2], const Unit& u, int wr, int wc, int fr, int fq) const {
        const int row0 = u.pm * BM + wr * 64 + fr, col0 = u.pn * BM + wc * 32 + 8 * fq;
        const float* gp = gate + (size_t)(u.pm >> 4) * gate_bs + col0;
        f32x4 gv[2][2];
#pragma unroll
        for (int bj = 0; bj < 2; ++bj)
#pragma unroll
            for (int n = 0; n < 2; ++n) { gv[bj][n] = *(const f32x4*)(gp + bj * HALF + n * 4); if (cscale) gv[bj][n] = gv[bj][n] * *(const f32x4*)(cscale + col0 + bj * HALF + n * 4); }
#pragma unroll
        for (int ai = 0; ai < 2; ++ai)
#pragma unroll
            for (int m = 0; m < 4; ++m) { const size_t ro = (size_t)(row0 + ai * HALF + m * 16) * DM + col0;
#pragma unroll
                for (int bj = 0; bj < 2; ++bj) {
                    f32x4 h0, h1;
                    if (xin) { h0 = *(const f32x4*)(xin + ro + bj * HALF); h1 = *(const f32x4*)(xin + ro + bj * HALF + 4); }
                    else { const u32x4 hb = *(const u32x4*)(hin + ro + bj * HALF);
                        h0 = (f32x4){__builtin_bit_cast(float, hb.x << 16), __builtin_bit_cast(float, hb.x & 0xffff0000u), __builtin_bit_cast(float, hb.y << 16), __builtin_bit_cast(float, hb.y & 0xffff0000u)};
                        h1 = (f32x4){__builtin_bit_cast(float, hb.z << 16), __builtin_bit_cast(float, hb.z & 0xffff0000u), __builtin_bit_cast(float, hb.w << 16), __builtin_bit_cast(float, hb.w & 0xffff0000u)}; }
                    const f32x4 o0 = h0 + gv[bj][0] * acc[ai][bj][m][0], o1 = h1 + gv[bj][1] * acc[ai][bj][m][1];
                    u32x4 w; w.x = cvt_pk_bf16(o0[0], o0[1]); w.y = cvt_pk_bf16(o0[2], o0[3]); w.z = cvt_pk_bf16(o1[0], o1[1]); w.w = cvt_pk_bf16(o1[2], o1[3]);
                    *(u32x4*)(hout + ro + bj * HALF) = w; } }
    }
};

template <class Epi, class Sched, bool ALIGN_EPI = false>
__device__ __forceinline__ void gemm_phase(PG8_LAS unsigned char* lds, const Gemm g, const Sched& S, const Epi& E, const int tid) {
    const int wid = __builtin_amdgcn_readfirstlane(tid >> 6), lane = tid & 63, wr = wid >> 2, wc = wid & 3, fr = lane & 15, fq = lane >> 4;
    const int K = g.K, nt = K / BK, lda = g.lda, ldb = g.ldb;
    unsigned voffA[2], voffB[2];
#pragma unroll
    for (int i = 0; i < 2; ++i) { int R, C; stage_rc(tid * 16 + i * 8192, R, C); const int Rb = Epi::PERM ? ((R & ~31) + perm32(R & 31)) : R;
        voffA[i] = (unsigned)(R * lda + C) * 2u; voffB[i] = (unsigned)(Rb * ldb + C) * 2u; }
    const unsigned kstep = (unsigned)(BK * 2);
    const unsigned hstepA = (unsigned)HALF * lda * 2u, hstepB = (unsigned)HALF * ldb * 2u;
    const __amdgpu_buffer_rsrc_t rsA = __builtin_amdgcn_make_buffer_rsrc((void*)g.A, (short)0, 0x7fffffff, 0x00020000), rsB = __builtin_amdgcn_make_buffer_rsrc((void*)g.Bt, (short)0, 0x7fffffff, 0x00020000);
    const unsigned ldsw = (unsigned)wid * 1024u;
    const int aoff = lds_byte(wr * 64 + fr, fq * 8), boff = lds_byte(wc * 32 + fr, fq * 8);
#define PG8_SA(b, h) (((b) * 2 + (h)) * HTB)
#define PG8_SB(b, h) ((4 + (b) * 2 + (h)) * HTB)
#define PG8_STAGEA(bufoff, soff, voff) do { _Pragma("unroll") for (int _i = 0; _i < 2; ++_i) \
        __builtin_amdgcn_raw_ptr_buffer_load_lds(rsA, (PG8_LAS unsigned*)(lds + (bufoff) + ldsw + _i * 8192), 16, (voff)[_i], (soff), 0, 0); } while (0)
#define PG8_STAGEB(bufoff, soff, voff) do { _Pragma("unroll") for (int _i = 0; _i < 2; ++_i) \
        __builtin_amdgcn_raw_ptr_buffer_load_lds(rsB, (PG8_LAS unsigned*)(lds + (bufoff) + ldsw + _i * 8192), 16, (voff)[_i], (soff), 0, 0); } while (0)
#define PG8_LDA(dst, b, h) do { _Pragma("unroll") for (int m = 0; m < 4; ++m) _Pragma("unroll") for (int k = 0; k < 2; ++k) dst[m][k] = *(const PG8_LAS bf16x8*)(lds + PG8_SA(b, h) + aoff + m * 2048 + k * 1024); } while (0)
#define PG8_LDB(dst, b, h) do { _Pragma("unroll") for (int n = 0; n < 2; ++n) _Pragma("unroll") for (int k = 0; k < 2; ++k) dst[n][k] = *(const PG8_LAS bf16x8*)(lds + PG8_SB(b, h) + boff + n * 2048 + k * 1024); } while (0)
#define PG8_MMA(ai, bj, At, Bt) do { __builtin_amdgcn_s_setprio(1); _Pragma("unroll") for (int m = 0; m < 4; ++m) _Pragma("unroll") for (int n = 0; n < 2; ++n) _Pragma("unroll") for (int k = 0; k < 2; ++k) \
        acc[ai][bj][m][n] = __builtin_amdgcn_mfma_f32_16x16x32_bf16(Bt[n][k], At[m][k], acc[ai][bj][m][n], 0, 0, 0); __builtin_amdgcn_s_setprio(0); } while (0)
#define PG8_WAIT_V(n) asm volatile("s_waitcnt vmcnt(" #n ")" ::: "memory")
#define PG8_WAIT_L(n) asm volatile("s_waitcnt lgkmcnt(" #n ")" ::: "memory")
#define PG8_BAR __builtin_amdgcn_s_barrier()
#define PG8_SCHED __builtin_amdgcn_sched_barrier(0)
#define PG8_ABASE(u) ((unsigned)(((size_t)((u).pn / g.gpn) * (size_t)g.a_gs + (size_t)(u).pm * BM * lda) * 2))
#define PG8_BBASE(u) ((unsigned)(((size_t)((u).pn / g.gpn) * (size_t)g.b_gs + (size_t)((u).pn % g.gpn) * BM * ldb) * 2))
    Unit cur, nxt; int ui = 0;
    if (!S.next(0, cur)) return;
    f32x4 acc[2][2][4][2];
#pragma unroll
    for (int a = 0; a < 2; ++a)
#pragma unroll
        for (int b = 0; b < 2; ++b)
#pragma unroll
            for (int m = 0; m < 4; ++m)
#pragma unroll
                for (int n = 0; n < 2; ++n) acc[a][b][m][n] = (f32x4){0.f, 0.f, 0.f, 0.f};
    bf16x8 At[4][2], B0[2][2], B1[2][2];
    unsigned cA = PG8_ABASE(cur), cB = PG8_BBASE(cur);
    S.a_ready(cur);
    PG8_STAGEB(PG8_SB(0, 0), cB, voffB); PG8_STAGEB(PG8_SB(0, 1), cB + hstepB, voffB); PG8_STAGEA(PG8_SA(0, 0), cA, voffA); PG8_STAGEA(PG8_SA(0, 1), cA + hstepA, voffA);
    PG8_STAGEB(PG8_SB(1, 0), cB + kstep, voffB); PG8_STAGEA(PG8_SA(1, 0), cA + kstep, voffA); PG8_STAGEB(PG8_SB(1, 1), cB + hstepB + kstep, voffB);
    if (wr == 1) PG8_BAR;
    PG8_WAIT_V(8); PG8_BAR;
    PG8_WAIT_V(6); PG8_BAR;
    for (;;) {
        const bool has_next = S.next(ui + 1, nxt);
        const unsigned nA = has_next ? PG8_ABASE(nxt) : cA, nB = has_next ? PG8_BBASE(nxt) : cB;
        for (int t = 0; t < nt; t += 2) {
            const bool last = (t == nt - 2);
            const unsigned a1 = cA + (unsigned)(t + 1) * kstep;
            const unsigned a2 = last ? nA : cA + (unsigned)(t + 2) * kstep, b2 = last ? nB : cB + (unsigned)(t + 2) * kstep;
            const unsigned a3 = a2 + kstep, b3 = b2 + kstep;
            if (last && has_next) S.a_ready(nxt);
            PG8_LDB(B0, 0, 0); PG8_LDB(B1, 0, 1); PG8_SCHED; PG8_LDA(At, 0, 0); PG8_STAGEA(PG8_SA(1, 1), a1 + hstepA, voffA);
            PG8_WAIT_V(8); PG8_WAIT_L(0); PG8_BAR; PG8_MMA(0, 0, At, B0); PG8_MMA(0, 1, At, B1); PG8_BAR; PG8_SCHED;
            PG8_LDA(At, 0, 1); PG8_STAGEB(PG8_SB(0, 0), b2, voffB); PG8_STAGEB(PG8_SB(0, 1), b2 + hstepB, voffB); PG8_STAGEA(PG8_SA(0, 0), a2, voffA);
            PG8_WAIT_V(8); PG8_WAIT_L(0); PG8_BAR; PG8_MMA(1, 0, At, B0); PG8_MMA(1, 1, At, B1); PG8_BAR; PG8_SCHED;
            PG8_LDB(B0, 1, 0); PG8_LDB(B1, 1, 1); PG8_SCHED; PG8_LDA(At, 1, 0); PG8_STAGEA(PG8_SA(0, 1), a2 + hstepA, voffA);
            PG8_WAIT_V(8); PG8_WAIT_L(0); PG8_BAR; PG8_MMA(0, 0, At, B0); PG8_MMA(0, 1, At, B1); PG8_BAR; PG8_SCHED;
            PG8_LDA(At, 1, 1); PG8_STAGEB(PG8_SB(1, 0), b3, voffB); PG8_STAGEB(PG8_SB(1, 1), b3 + hstepB, voffB); PG8_STAGEA(PG8_SA(1, 0), a3, voffA);
            PG8_WAIT_V(8); PG8_WAIT_L(0); PG8_BAR; PG8_MMA(1, 0, At, B0); PG8_MMA(1, 1, At, B1); PG8_BAR; PG8_SCHED;
        }
        if constexpr (ALIGN_EPI) { if (wr == 0) PG8_BAR; }
        E(acc, cur, wr, wc, fr, fq); S.done(cur);
        if (!has_next) break;
#pragma unroll
        for (int a = 0; a < 2; ++a)
#pragma unroll
            for (int b = 0; b < 2; ++b)
#pragma unroll
                for (int m = 0; m < 4; ++m)
#pragma unroll
                    for (int n = 0; n < 2; ++n) acc[a][b][m][n] = (f32x4){0.f, 0.f, 0.f, 0.f};
        cur = nxt; cA = nA; cB = nB; ++ui;
        if constexpr (ALIGN_EPI) { if (wr == 1) PG8_BAR; }
    }
    PG8_WAIT_V(0);
    if constexpr (!ALIGN_EPI) { if (wr == 0) PG8_BAR; }
    PG8_BAR;
#undef PG8_SA
#undef PG8_SB
#undef PG8_STAGEA
#undef PG8_STAGEB
#undef PG8_LDA
#undef PG8_LDB
#undef PG8_MMA
#undef PG8_WAIT_V
#undef PG8_WAIT_L
#undef PG8_BAR
#undef PG8_SCHED
#undef PG8_ABASE
#undef PG8_BBASE
}
}

constexpr size_t MiB = 1u << 20;
constexpr size_t WS_CTL = 0, CTL_ZERO_BYTES = 1 * MiB;
constexpr size_t WS_ADA = 1 * MiB;
constexpr size_t WS_LB = 2 * MiB;
constexpr size_t WS_XRS = 3 * MiB;
constexpr size_t WS_ROT = 4 * MiB;
constexpr size_t WS_POOLW = 20 * MiB;
constexpr size_t WS_HGWIN = 24 * MiB;
constexpr size_t WS_HGWOUT = 56 * MiB;
constexpr size_t WS_RTWIN = 64 * MiB;
constexpr size_t WS_RTWOUT = 112 * MiB;
constexpr size_t WS_FFWIN = 128 * MiB;
constexpr size_t WS_FFWOUT = 304 * MiB;
constexpr size_t WS_U = 392 * MiB;
constexpr size_t WS_P = 456 * MiB;
constexpr size_t WS_PROJ = 584 * MiB;
constexpr size_t WS_O = 968 * MiB;
constexpr size_t WS_H = 1224 * MiB;
constexpr size_t WS_H2 = 1288 * MiB;
constexpr size_t WS_END = 1352 * MiB;
constexpr int CW_TMO = 0, CW_CODE = 1, CW_BAR = 4096;

constexpr int RING_OFF = 0, RING_BYTES = 131072;
constexpr int LDSCTL_OFF = RING_BYTES, MISC_OFF = LDSCTL_OFF + 320;
constexpr int LDS_BYTES = 147456;
constexpr int NWAVES = 8;

#define GAS __attribute__((address_space(1)))
#define LAS __attribute__((address_space(3)))
#define CAS __attribute__((address_space(4)))
typedef unsigned short bf16;
typedef unsigned v4u __attribute__((ext_vector_type(4)));
typedef unsigned v2u __attribute__((ext_vector_type(2)));
typedef float f32x4 __attribute__((ext_vector_type(4)));
typedef GAS unsigned gu32;
#define RLX_AGENT __ATOMIC_RELAXED, __HIP_MEMORY_SCOPE_AGENT
#define LDS_WAIT() asm volatile("s_waitcnt lgkmcnt(0)" ::: "memory")
__device__ __forceinline__ unsigned f2bf(float f) { unsigned u = __builtin_bit_cast(unsigned, f); return (u + 0x7fffu + ((u >> 16) & 1u)) >> 16; }
typedef float pk_f2 __attribute__((ext_vector_type(2)));
typedef __bf16 pk_b2 __attribute__((ext_vector_type(2)));
__device__ __forceinline__ unsigned pk2(float lo, float hi) { const pk_f2 v = {lo, hi}; return __builtin_bit_cast(unsigned, __builtin_convertvector(v, pk_b2)); }
__device__ __forceinline__ float bflo(unsigned w) { return __builtin_bit_cast(float, w << 16); }
__device__ __forceinline__ float bfhi(unsigned w) { return __builtin_bit_cast(float, w & 0xffff0000u); }
__device__ __forceinline__ float bf1(bf16 b) { return __builtin_bit_cast(float, (unsigned)b << 16); }
__device__ __forceinline__ float sigmoid_f(float x) { return __builtin_amdgcn_rcpf(1.0f + __builtin_amdgcn_exp2f(-1.4426950408889634f * x)); }
__device__ __forceinline__ float silu1(float x) { return x * sigmoid_f(x); }

#define XB_TMO      128
#define XB_XCNT(j)  (256  + 64 * (j))
#define XB_XSUB(j)  (1280 + 64 * (j))
#define XB_XGEN(j)  (2304 + 64 * (j))
#define XB_TOP      3328
#define XB_TOPGEN   3392
#define XCD_BAR_WORDS 3456
#define XB_SPIN_CAP (1u << 18)

__device__ __forceinline__ unsigned xb_ld(unsigned* p)              { return __hip_atomic_load(p, __ATOMIC_RELAXED, __HIP_MEMORY_SCOPE_AGENT); }
__device__ __forceinline__ unsigned xb_add(unsigned* p, unsigned v) { return __hip_atomic_fetch_add(p, v, __ATOMIC_RELAXED, __HIP_MEMORY_SCOPE_AGENT); }
__device__ __forceinline__ unsigned xb_xcc_id() { return (unsigned)__builtin_amdgcn_s_getreg((3 << 11) | 20) & 0xFu; }
#define XB_SPIN(cond, bar) do { unsigned _sp = 0; while (cond) { __builtin_amdgcn_s_sleep(1); \
    if ((++_sp & 255u) == 0u) { if (xb_ld(&(bar)[XB_TMO])) break; if (_sp > XB_SPIN_CAP) { atomicAdd(&(bar)[XB_TMO], 1u); break; } } } } while (0)

struct XcdBarrier { unsigned* bar; unsigned x; volatile LAS unsigned* st; };
#define XB_TID() ((int)__builtin_amdgcn_mbcnt_hi(~0u, __builtin_amdgcn_mbcnt_lo(~0u, 0u)) + 64 * xb_wave_id)

__device__ __forceinline__ XcdBarrier xcd_barrier_post(unsigned* bar, volatile LAS unsigned* st, const int xb_wave_id) {
    XcdBarrier b; b.bar = bar; b.x = xb_xcc_id(); b.st = st;
    if (XB_TID() == 0) (void)xb_add(&bar[XB_XCNT(b.x)], 1u);
    return b;
}
__device__ __forceinline__ void xcd_barrier_complete(unsigned* bar, unsigned x, unsigned& nloc, unsigned& nx) {
    const unsigned G = gridDim.x * gridDim.y * gridDim.z;
    unsigned sum, cnt, mine, sp = 0u;
    for (;;) {
        sum = 0u; cnt = 0u; mine = 0u;
#pragma unroll
        for (unsigned j = 0; j < 16; ++j) { const unsigned c = xb_ld(&bar[XB_XCNT(j)]); sum += c; cnt += (c > 0u) ? 1u : 0u; mine = (j == x) ? c : mine; }
        if (sum == G) break;
        __builtin_amdgcn_s_sleep(1);
        if ((++sp & 255u) == 0u) { if (xb_ld(&bar[XB_TMO])) break; if (sp > XB_SPIN_CAP) { atomicAdd(&bar[XB_TMO], 1u); break; } }
    }
    nloc = mine > 0u ? mine : 1u; nx = cnt > 0u ? cnt : 1u;
}
__device__ __forceinline__ void xcd_barrier(const XcdBarrier& b, const int xb_wave_id) {
    asm volatile("s_waitcnt vmcnt(0)" ::: "memory");
    __syncthreads();
    if (XB_TID() == 0) {
        unsigned* bar = b.bar;
        __builtin_amdgcn_s_waitcnt(0);
        unsigned nloc = b.st[0], nx = b.st[1];
        if (nloc == 0u) { xcd_barrier_complete(bar, b.x, nloc, nx); b.st[0] = nloc; b.st[1] = nx; }
        const unsigned old = xb_add(&bar[XB_XSUB(b.x)], 1u);
        const unsigned gen = old / nloc;
        if (old + 1u == (gen + 1u) * nloc) {
            __builtin_amdgcn_fence(__ATOMIC_RELEASE, "agent");
            asm volatile("s_waitcnt vmcnt(0)" ::: "memory");
            const unsigned og = xb_add(&bar[XB_TOP], 1u);
            const unsigned tg = og / nx;
            if (og + 1u == (tg + 1u) * nx) xb_add(&bar[XB_TOPGEN], 1u);
            else XB_SPIN(xb_ld(&bar[XB_TOPGEN]) == tg, bar);
            __builtin_amdgcn_fence(__ATOMIC_ACQUIRE, "agent");
            xb_add(&bar[XB_XGEN(b.x)], 1u);
            asm volatile("s_waitcnt vmcnt(0)" ::: "memory");
        } else {
            XB_SPIN(xb_ld(&bar[XB_XGEN(b.x)]) == gen, bar);
            __builtin_amdgcn_fence(__ATOMIC_ACQUIRE, "agent");
            asm volatile("s_waitcnt vmcnt(0)" ::: "memory");
        }
    }
    __syncthreads();
}

struct Args {
    const float* x; const float* c; const int* pos; const float* w_ada; const float* b_ada; const float* norm_mix_g; const float* norm_ffn_g;
    const float* pool_w; const float* pool_scale; const float* hgrn_w_in; const float* hgrn_lb; const float* hgrn_norm_g; const float* hgrn_w_out;
    const float* ret_w_in; const float* ret_norm_g; const float* ret_w_out; const float* ffn_w_in; const float* ffn_w_out; const float* final_g;
    float* out; unsigned char* ws; int ph_lo, ph_hi;
};

#define WS_DPP(v, ctrl) __builtin_bit_cast(float, __builtin_amdgcn_update_dpp(0, __builtin_bit_cast(int, v), (ctrl), 0xf, 0xf, true))
__device__ __forceinline__ float row16_sum(float v) { v += WS_DPP(v, 0xB1); v += WS_DPP(v, 0x4E); v += WS_DPP(v, 0x141); v += WS_DPP(v, 0x140); return v; }
#define WS_RL(v, l) __builtin_bit_cast(float, __builtin_amdgcn_readlane(__builtin_bit_cast(int, v), (l)))
__device__ __forceinline__ float wave_sum(float v) { v = row16_sum(v); return (WS_RL(v, 0) + WS_RL(v, 16)) + (WS_RL(v, 32) + WS_RL(v, 48)); }
__device__ __forceinline__ float half_sum(float v) {
    v = row16_sum(v); const float lo = WS_RL(v, 0) + WS_RL(v, 16), hi = WS_RL(v, 32) + WS_RL(v, 48);
    return (__builtin_amdgcn_mbcnt_hi(~0u, __builtin_amdgcn_mbcnt_lo(~0u, 0u)) < 32u) ? lo : hi; }

struct TItem { const float* W; bf16* WT; int K, N, mode, item; };
__device__ __forceinline__ void titem_load(const TItem& t, int lane, f32x4 (&wv)[8]) {
    const int nblk = t.N / 32, kb = t.item / nblk, nb = t.item % nblk, k0 = 64 * kb, n0 = 32 * nb;
#pragma unroll
    for (int i = 0; i < 8; ++i) wv[i] = *(const GAS f32x4*)(t.W + (size_t)(k0 + 8 * i + (lane >> 3)) * t.N + n0 + 4 * (lane & 7));
}
__device__ __forceinline__ void titem_finish(const TItem& t, LAS float* scr, int lane, const f32x4 (&wv)[8]) {
    const int nblk = t.N / 32, kb = t.item / nblk, nb = t.item % nblk, k0 = 64 * kb, n0 = 32 * nb;
    int d0 = n0;
    if (t.mode == 1) { const int bj = n0 >= FF ? 1 : 0, j = n0 - bj * FF; d0 = 256 * (j >> 7) + 128 * bj + (j & 127); }
    if (t.mode == 2 && n0 < 4096) { const int bj = n0 >> 11, j = n0 & 2047; d0 = 256 * (j >> 7) + 128 * bj + (j & 127); }
#pragma unroll
    for (int i = 0; i < 8; ++i) { LAS float* d = scr + (8 * i + (lane >> 3)) * 33 + 4 * (lane & 7); d[0] = wv[i].x; d[1] = wv[i].y; d[2] = wv[i].z; d[3] = wv[i].w; }
    LDS_WAIT(); asm volatile("" ::: "memory");
    const int c = lane & 7;
#pragma unroll
    for (int j = 0; j < 4; ++j) { const int n = (lane >> 3) + 8 * j; const LAS float* s = scr + (8 * c) * 33 + n;
        v4u o; o.x = pk2(s[0 * 33], s[1 * 33]); o.y = pk2(s[2 * 33], s[3 * 33]); o.z = pk2(s[4 * 33], s[5 * 33]); o.w = pk2(s[6 * 33], s[7 * 33]);
        if (t.mode == 3) { const int nn = d0 + n, kk = k0 + 8 * c;
            *(GAS v4u*)(t.WT + (size_t)((((nn >> 5) * 32 + (kk >> 4)) * 64) + ((kk >> 3) & 1) * 32 + (nn & 31)) * 8) = o; }
        else *(GAS v4u*)(t.WT + (size_t)(d0 + n) * t.K + k0 + 8 * c) = o; }
    LDS_WAIT(); asm volatile("" ::: "memory");
}
__device__ __forceinline__ void transpose_item(const float* W, int K, int N, bf16* WT, int mode, LAS float* scr, int item, int lane) {
    const TItem t{W, WT, K, N, mode, item}; f32x4 wv[8]; titem_load(t, lane, wv); titem_finish(t, scr, lane, wv);
}
template <class AP> __device__ __forceinline__ void phase_prologue(const AP a, LAS unsigned char* lds, int tid, int lane, int wave, int vcu, int G) {
    unsigned char* ws = a->ws;
    float* ada = (float*)(ws + WS_ADA);
    LAS float* sc = (LAS float*)lds;
    LAS float* red = (LAS float*)(lds + 32768);
    for (int i = tid; i < NB * DM; i += 512) sc[i] = silu1(a->c[i]);
    __syncthreads();
    for (int it = vcu; it < DEPTH * (ADA_W / 256); it += G) {
        const int l = it / (ADA_W / 256), cb = it % (ADA_W / 256), e0 = cb * 256 + 4 * lane;
        const float* wp = a->w_ada + ((size_t)l * DM + (size_t)wave * 256) * ADA_W + e0;
        f32x4 acc[4];
#pragma unroll
        for (int b = 0; b < 4; ++b) acc[b] = (f32x4){0.f, 0.f, 0.f, 0.f};
#pragma unroll 16
        for (int d = 0; d < 256; ++d) {
            const f32x4 wv = *(const GAS f32x4*)(wp + (size_t)d * ADA_W);
#pragma unroll
            for (int b = 0; b < 4; ++b) { const float s = sc[b * DM + wave * 256 + d]; acc[b] = acc[b] + wv * s; }
        }
#pragma unroll
        for (int b = 0; b < 4; ++b) *(LAS f32x4*)(red + (wave * 4 + b) * 256 + 4 * lane) = acc[b];
        __syncthreads();
        for (int o = tid; o < 4 * 256; o += 512) { const int b = o >> 8, e = o & 255; float s = 0.f;
#pragma unroll
            for (int w = 0; w < 8; ++w) s += red[(w * 4 + b) * 256 + e];
            ada[((size_t)l * NB + b) * ADA_W + cb * 256 + e] = s + a->b_ada[(size_t)l * ADA_W + cb * 256 + e]; }
        __syncthreads();
    }
    const int gw = vcu * NWAVES + wave, NGW = G * NWAVES, gt = gw * 64 + lane, NGT = NGW * 64;
    { float* lb = (float*)(ws + WS_LB);
      for (int col = gt; col < DM; col += NGT) { float z[DEPTH], mx = -1e30f;
#pragma unroll
          for (int j = 0; j < DEPTH; ++j) { z[j] = a->hgrn_lb[j * DM + col]; mx = fmaxf(mx, z[j]); }
          float s = 0.f, e1 = 0.f;
#pragma unroll
          for (int j = 0; j < DEPTH; ++j) { const float e = __expf(z[j] - mx); s += e; if (j == 1) e1 = e; }
          lb[col] = e1 / s; } }
    { float* ct = (float*)(ws + WS_ROT); float* st = ct + (size_t)M * 128;
      for (int i = gt; i < M * 128; i += NGT) { const int m = i >> 7, f = i & 127;
          const float inv = exp2f(-(float)f * (13.287712379549449f / 128.0f));
          const float ang = (float)a->pos[m] * inv;
          const double rev = (double)ang * 0.15915494309189535; const float fr = (float)(rev - floor(rev));
          ct[i] = __builtin_amdgcn_cosf(fr); st[i] = __builtin_amdgcn_sinf(fr); } }
    LAS float* scr = (LAS float*)(lds + wave * 16384);
    constexpr int I_POOL = 8 * (512 / 64) * (512 / 32), I_HGI = (DM / 64) * (HG_IN / 32), I_FFI1 = (DM / 64) * (FF2 / 32), I_FFO1 = (FF / 64) * (DM / 32);
    constexpr int NITEMS = I_POOL + I_HGI + I_FFI1 + I_FFO1;
#define EARLY_DECODE(t_, it_) do { int r = (it_); \
        if (r < I_POOL) { const int mt = r / 128; t_ = TItem{a->pool_w + (size_t)mt * 512 * 512, (bf16*)(ws + WS_POOLW) + (size_t)mt * 512 * 512, 512, 512, 3, r % 128}; break; } r -= I_POOL; \
        if (r < I_HGI) { t_ = TItem{a->hgrn_w_in, (bf16*)(ws + WS_HGWIN), DM, HG_IN, 2, r}; break; } r -= I_HGI; \
        if (r < I_FFI1) { t_ = TItem{a->ffn_w_in, (bf16*)(ws + WS_FFWIN), DM, FF2, 1, r}; break; } r -= I_FFI1; \
        t_ = TItem{a->ffn_w_out, (bf16*)(ws + WS_FFWOUT), FF, DM, 0, r}; } while (0)
    { const bool balc = (G == 256); const int NGVC = DEPTH * (ADA_W / 256);
      const int lgs = (balc && vcu >= NGVC) ? 2 : 0, NGWV = balc ? NGVC * NWAVES + (G - NGVC) * NWAVES * 4 : NGW;
      const int vb = balc ? (vcu < NGVC ? gw : NGVC * NWAVES + ((vcu - NGVC) * NWAVES + wave) * 4) : gw;
#define QITEM(q) (vb + ((q) & ((1 << lgs) - 1)) + ((q) >> lgs) * NGWV)
      if (QITEM(0) < NITEMS) {
        TItem t0, t1, t2; f32x4 w0[8], w1[8], w2[8];
        EARLY_DECODE(t0, QITEM(0)); titem_load(t0, lane, w0);
        t1 = t0; if (QITEM(1) < NITEMS) { EARLY_DECODE(t1, QITEM(1)); titem_load(t1, lane, w1); }
        for (int q = 0; QITEM(q) < NITEMS; q += 3) {
            if (QITEM(q + 2) < NITEMS) { EARLY_DECODE(t2, QITEM(q + 2)); titem_load(t2, lane, w2); }
            __builtin_amdgcn_sched_barrier(0);
            titem_finish(t0, scr, lane, w0);
            if (QITEM(q + 1) >= NITEMS) break;
            if (QITEM(q + 3) < NITEMS) { EARLY_DECODE(t0, QITEM(q + 3)); titem_load(t0, lane, w0); }
            __builtin_amdgcn_sched_barrier(0);
            titem_finish(t1, scr, lane, w1);
            if (QITEM(q + 2) >= NITEMS) break;
            if (QITEM(q + 4) < NITEMS) { EARLY_DECODE(t1, QITEM(q + 4)); titem_load(t1, lane, w1); }
            __builtin_amdgcn_sched_barrier(0);
            titem_finish(t2, scr, lane, w2);
        }
      }
#undef QITEM
    }
#undef EARLY_DECODE
    { const int l31 = lane & 31, h5 = lane >> 5;
      const __amdgpu_buffer_rsrc_t rsX = __builtin_amdgcn_make_buffer_rsrc((void*)a->x, (short)0, M * DM * 4, 0x00020000);
      const __amdgpu_buffer_rsrc_t rsC = __builtin_amdgcn_make_buffer_rsrc((void*)(ws + WS_H2), (short)0, M * DM * 2, 0x00020000);
      const bool bal = (G == 256); const int NGV = DEPTH * (ADA_W / 256);
      const int rpa = bal ? (vcu < NGV ? gw : NGV * NWAVES + (vcu - NGV) * NWAVES + wave) : gw, rps = bal ? (vcu < NGV ? M : (G - NGV) * NWAVES) : NGW;
      for (int rp = rpa; rp < M / 2; rp += rps) {
          const int row = 2 * rp + h5; const unsigned vo = (unsigned)row * (DM * 4) + (unsigned)l31 * 32u, vob = (unsigned)row * (DM * 2) + (unsigned)l31 * 16u;
          v4u q0[8], q1[8];
#pragma unroll
          for (int j = 0; j < 8; ++j) { q0[j] = __builtin_amdgcn_raw_buffer_load_b128(rsX, vo, (unsigned)j * 1024u, 0); q1[j] = __builtin_amdgcn_raw_buffer_load_b128(rsX, vo, (unsigned)j * 1024u + 16u, 0); }
          float ss = 0.f;
#pragma unroll
          for (int j = 0; j < 8; ++j) { const f32x4 p = __builtin_bit_cast(f32x4, q0[j]), c = __builtin_bit_cast(f32x4, q1[j]);
              ss += ((p.x * p.x + p.y * p.y) + (p.z * p.z + p.w * p.w)) + ((c.x * c.x + c.y * c.y) + (c.z * c.z + c.w * c.w));
              v4u o; o.x = pk2(p.x, p.y); o.y = pk2(p.z, p.w); o.z = pk2(c.x, c.y); o.w = pk2(c.z, c.w);
              __builtin_amdgcn_raw_buffer_store_b128(o, rsC, vob, (unsigned)j * 512u, 0); }
          ss = half_sum(ss);
          if (l31 == 0) ((float*)(ws + WS_XRS))[row] = 1.0f / sqrtf(ss * (1.0f / DM) + EPS);
      }
    }
}
template <class AP> __device__ __forceinline__ void phase_convert_late(const AP a, LAS unsigned char* lds, int lane, int wave, int gwc, int NGWC) {
    unsigned char* ws = a->ws;
    LAS float* scr = (LAS float*)(lds + wave * 16384);
    constexpr int I_HGO = (DM / 64) * (DM / 32), I_RTI = (DM / 64) * (RT_IN / 32), I_RTO = (RT_V / 64) * (DM / 32), I_FFI1 = (DM / 64) * (FF2 / 32), I_FFO1 = (FF / 64) * (DM / 32);
    constexpr int NITEMS = I_HGO + I_RTI + I_RTO + 3 * I_FFI1 + 3 * I_FFO1;
#define LATE_DECODE(t_, it_) do { int r = (it_); \
        if (r < I_HGO) { t_ = TItem{a->hgrn_w_out, (bf16*)(ws + WS_HGWOUT), DM, DM, 0, r}; break; } r -= I_HGO; \
        if (r < I_RTI) { t_ = TItem{a->ret_w_in, (bf16*)(ws + WS_RTWIN), DM, RT_IN, 0, r}; break; } r -= I_RTI; \
        if (r < I_RTO) { t_ = TItem{a->ret_w_out, (bf16*)(ws + WS_RTWOUT), RT_V, DM, 0, r}; break; } r -= I_RTO; \
        if (r < 3 * I_FFI1) { const int l = 1 + r / I_FFI1; t_ = TItem{a->ffn_w_in + (size_t)l * DM * FF2, (bf16*)(ws + WS_FFWIN) + (size_t)l * FF2 * DM, DM, FF2, 1, r % I_FFI1}; break; } r -= 3 * I_FFI1; \
        { const int l = 1 + r / I_FFO1; t_ = TItem{a->ffn_w_out + (size_t)l * FF * DM, (bf16*)(ws + WS_FFWOUT) + (size_t)l * DM * FF, FF, DM, 0, r % I_FFO1}; } } while (0)
    if (gwc >= NITEMS) return;
    TItem t0, t1, t2; f32x4 w0[8], w1[8], w2[8];
    LATE_DECODE(t0, gwc); titem_load(t0, lane, w0);
    t1 = t0; if (gwc + NGWC < NITEMS) { LATE_DECODE(t1, gwc + NGWC); titem_load(t1, lane, w1); }
    for (int it = gwc; it < NITEMS; it += 3 * NGWC) {
        if (it + 2 * NGWC < NITEMS) { LATE_DECODE(t2, it + 2 * NGWC); titem_load(t2, lane, w2); }
        __builtin_amdgcn_sched_barrier(0);
        titem_finish(t0, scr, lane, w0);
        if (it + NGWC >= NITEMS) break;
        if (it + 3 * NGWC < NITEMS) { LATE_DECODE(t0, it + 3 * NGWC); titem_load(t0, lane, w0); }
        __builtin_amdgcn_sched_barrier(0);
        titem_finish(t1, scr, lane, w1);
        if (it + 2 * NGWC >= NITEMS) break;
        if (it + 4 * NGWC < NITEMS) { LATE_DECODE(t1, it + 4 * NGWC); titem_load(t1, lane, w1); }
        __builtin_amdgcn_sched_barrier(0);
        titem_finish(t2, scr, lane, w2);
    }
#undef LATE_DECODE
}

struct WTile { const float* W; bf16* WT; int K, N, mode, idx; };
__device__ __forceinline__ void wtile_load(const WTile& t, int lane, int wave, f32x4 (&wv)[8]) {
    const int nblk = t.N >> 7, k0 = 128 * (t.idx / nblk), n0 = 128 * (t.idx % nblk);
#pragma unroll
    for (int i = 0; i < 8; ++i) wv[i] = *(const GAS f32x4*)(t.W + (size_t)(k0 + 16 * wave + 2 * i + (lane >> 5)) * t.N + n0 + 4 * (lane & 31));
}
__device__ __forceinline__ void wtile_to_lds(LAS unsigned char* T, int lane, int wave, const f32x4 (&wv)[8]) {
#pragma unroll
    for (int i = 0; i < 8; ++i) { const int r = 16 * wave + 2 * i + (lane >> 5); *(LAS f32x4*)(T + r * 512 + (((lane & 31) ^ ((r >> 3) & 7)) << 4)) = wv[i]; }
}
__device__ __forceinline__ void wtile_store(const WTile& t, const LAS unsigned char* T, int lane, int wave) {
    const int nblk = t.N >> 7, k0 = 128 * (t.idx / nblk), n0 = 128 * (t.idx % nblk);
    const int c = (lane & 7) + 8 * (lane >> 5), nl = (lane >> 3) & 3;
#pragma unroll
    for (int p = 0; p < 4; ++p) { const int nloc = 16 * wave + 4 * p + nl, n = n0 + nloc;
        const LAS float* s = (const LAS float*)(T + (8 * c) * 512 + (((nloc >> 2) ^ (lane & 7)) << 4) + (nloc & 3) * 4);
        v4u o; o.x = pk2(s[0 * 128], s[1 * 128]); o.y = pk2(s[2 * 128], s[3 * 128]); o.z = pk2(s[4 * 128], s[5 * 128]); o.w = pk2(s[6 * 128], s[7 * 128]);
        int d = n;
        if (t.mode == 1) { const int nb = n & ~31, bj = nb >= FF ? 1 : 0, j = nb - bj * FF; d = 256 * (j >> 7) + 128 * bj + (j & 127) + (n & 31); }
        *(GAS v4u*)(t.WT + (size_t)d * t.K + k0 + 8 * c) = o; }
}
#define WT_BAR() do { asm volatile("s_waitcnt lgkmcnt(0)" ::: "memory"); __builtin_amdgcn_s_barrier(); asm volatile("" ::: "memory"); } while (0)
template <class AP> __device__ __forceinline__ void phase_convert_late_tiles(const AP a, LAS unsigned char* lds, int lane, int wave, int wgc, int NWGC) {
    unsigned char* ws = a->ws;
    constexpr int T_HGO = (DM / 128) * (DM / 128), T_RTI = (DM / 128) * (RT_IN / 128), T_RTO = (RT_V / 128) * (DM / 128), T_FFI = (DM / 128) * (FF2 / 128), T_FFO = (FF / 128) * (DM / 128);
    constexpr int NT = T_HGO + T_RTI + T_RTO + 3 * T_FFI + 3 * T_FFO;
#define LATE_TDEC(t_, it_) do { int r = (it_); \
        if (r < T_HGO) { t_ = WTile{a->hgrn_w_out, (bf16*)(ws + WS_HGWOUT), DM, DM, 0, r}; break; } r -= T_HGO; \
        if (r < T_RTI) { t_ = WTile{a->ret_w_in, (bf16*)(ws + WS_RTWIN), DM, RT_IN, 0, r}; break; } r -= T_RTI; \
        if (r < T_RTO) { t_ = WTile{a->ret_w_out, (bf16*)(ws + WS_RTWOUT), RT_V, DM, 0, r}; break; } r -= T_RTO; \
        if (r < 3 * T_FFI) { const int l = 1 + r / T_FFI; t_ = WTile{a->ffn_w_in + (size_t)l * DM * FF2, (bf16*)(ws + WS_FFWIN) + (size_t)l * FF2 * DM, DM, FF2, 1, r % T_FFI}; break; } r -= 3 * T_FFI; \
        { const int l = 1 + r / T_FFO; t_ = WTile{a->ffn_w_out + (size_t)l * FF * DM, (bf16*)(ws + WS_FFWOUT) + (size_t)l * DM * FF, FF, DM, 0, r % T_FFO}; } } while (0)
    if (wgc >= NT) return;
    WTile tc, tn; f32x4 wv[8];
    LATE_TDEC(tc, wgc); wtile_load(tc, lane, wave, wv);
    for (int it = wgc; it < NT; it += NWGC) {
        WT_BAR();
        wtile_to_lds(lds, lane, wave, wv);
        const bool more = it + NWGC < NT;
        tn = tc; if (more) { LATE_TDEC(tn, it + NWGC); wtile_load(tn, lane, wave, wv); }
        WT_BAR();
        wtile_store(tc, lds, lane, wave);
        tc = tn;
    }
    WT_BAR();
#undef LATE_TDEC
}

__device__ __forceinline__ void phase_normmod(const float* hin, const float* g, const float* shift, const float* scale  , bf16* U, int gw, int NGW, int lane) {
    for (int r0 = gw * 8; r0 < M; r0 += NGW * 8) {
        const int b = r0 >> 12; const float* sh = shift + (size_t)b * ADA_W; const float* scp = scale + (size_t)b * ADA_W;
        f32x4 mul[8], add[8];
#pragma unroll
        for (int j = 0; j < 8; ++j) { const int col = 4 * lane + 256 * j; const f32x4 gv = *(const GAS f32x4*)(g + col), s = *(const GAS f32x4*)(scp + col); mul[j] = gv * (s + 1.0f); add[j] = *(const GAS f32x4*)(sh + col); }
        for (int rr = 0; rr < 8; ++rr) {
            const GAS f32x4* xr = (const GAS f32x4*)(hin + (size_t)(r0 + rr) * DM) + lane;
            f32x4 v[8]; float ss = 0.f;
#pragma unroll
            for (int j = 0; j < 8; ++j) { v[j] = xr[64 * j]; ss += (v[j].x * v[j].x + v[j].y * v[j].y) + (v[j].z * v[j].z + v[j].w * v[j].w); }
            const float rstd = 1.0f / sqrtf(wave_sum(ss) * (1.0f / DM) + EPS);
            GAS v2u* o8 = (GAS v2u*)(U + (size_t)(r0 + rr) * DM) + lane;
#pragma unroll
            for (int j = 0; j < 8; ++j) { const f32x4 y = v[j] * rstd * mul[j] + add[j]; v2u w; w.x = pk2(y.x, y.y); w.y = pk2(y.z, y.w); o8[64 * j] = w; }
        }
    }
}
__device__ __forceinline__ void phase_normmod_bf(const bf16* hin, const float* g, const float* shift, const float* scale  , bf16* U, int gw, int NGW, int lane) {
    for (int r0 = gw * 8; r0 < M; r0 += NGW * 8) {
        const int b = r0 >> 12; const float* sh = shift + (size_t)b * ADA_W; const float* scp = scale + (size_t)b * ADA_W;
        f32x4 mul[8], add[8];
#pragma unroll
        for (int j = 0; j < 8; ++j) { const int col = 8 * lane + 512 * (j >> 1) + 4 * (j & 1); const f32x4 gv = *(const GAS f32x4*)(g + col), s = *(const GAS f32x4*)(scp + col); mul[j] = gv * (s + 1.0f); add[j] = *(const GAS f32x4*)(sh + col); }
        for (int rr = 0; rr < 8; ++rr) {
            const GAS v4u* xr = (const GAS v4u*)(hin + (size_t)(r0 + rr) * DM) + lane;
            f32x4 v[8]; float ss = 0.f;
#pragma unroll
            for (int j = 0; j < 4; ++j) { const v4u q = xr[64 * j]; v[2 * j] = (f32x4){bflo(q.x), bfhi(q.x), bflo(q.y), bfhi(q.y)}; v[2 * j + 1] = (f32x4){bflo(q.z), bfhi(q.z), bflo(q.w), bfhi(q.w)}; }
#pragma unroll
            for (int j = 0; j < 8; ++j) ss += (v[j].x * v[j].x + v[j].y * v[j].y) + (v[j].z * v[j].z + v[j].w * v[j].w);
            const float rstd = 1.0f / sqrtf(wave_sum(ss) * (1.0f / DM) + EPS);
            GAS v4u* o16 = (GAS v4u*)(U + (size_t)(r0 + rr) * DM) + lane;
#pragma unroll
            for (int j = 0; j < 4; ++j) { const f32x4 y0 = v[2 * j] * rstd * mul[2 * j] + add[2 * j], y1 = v[2 * j + 1] * rstd * mul[2 * j + 1] + add[2 * j + 1];
                v4u w; w.x = pk2(y0.x, y0.y); w.y = pk2(y0.z, y0.w); w.z = pk2(y1.x, y1.y); w.w = pk2(y1.z, y1.w); o16[64 * j] = w; }
        }
    }
}
__device__ __forceinline__ void phase_finalnorm_bf(const bf16* hin, const float* g, float* out, int gw, int NGW, int lane) {
    for (int r0 = gw * 8; r0 < M; r0 += NGW * 8) {
        f32x4 mul[8];
#pragma unroll
        for (int j = 0; j < 8; ++j) mul[j] = *(const GAS f32x4*)(g + 8 * lane + 512 * (j >> 1) + 4 * (j & 1));
        for (int rr = 0; rr < 8; ++rr) {
            const GAS v4u* xr = (const GAS v4u*)(hin + (size_t)(r0 + rr) * DM) + lane;
            f32x4 v[8]; float ss = 0.f;
#pragma unroll
            for (int j = 0; j < 4; ++j) { const v4u q = xr[64 * j]; v[2 * j] = (f32x4){bflo(q.x), bfhi(q.x), bflo(q.y), bfhi(q.y)}; v[2 * j + 1] = (f32x4){bflo(q.z), bfhi(q.z), bflo(q.w), bfhi(q.w)}; }
#pragma unroll
            for (int j = 0; j < 8; ++j) ss += (v[j].x * v[j].x + v[j].y * v[j].y) + (v[j].z * v[j].z + v[j].w * v[j].w);
            const float rstd = 1.0f / sqrtf(wave_sum(ss) * (1.0f / DM) + EPS);
            float* orow = out + (size_t)(r0 + rr) * DM + 8 * lane;
#pragma unroll
            for (int j = 0; j < 8; ++j) *(GAS f32x4*)(orow + 512 * (j >> 1) + 4 * (j & 1)) = v[j] * rstd * mul[j];
        }
    }
}
__device__ __forceinline__ void phase_finalnorm(const float* hin, const float* g, float* out, int gw, int NGW, int lane) {
    for (int r0 = gw * 8; r0 < M; r0 += NGW * 8) {
        f32x4 mul[8];
#pragma unroll
        for (int j = 0; j < 8; ++j) mul[j] = *(const GAS f32x4*)(g + 4 * lane + 256 * j);
        for (int rr = 0; rr < 8; ++rr) {
            const GAS f32x4* xr = (const GAS f32x4*)(hin + (size_t)(r0 + rr) * DM) + lane;
            f32x4 v[8]; float ss = 0.f;
#pragma unroll
            for (int j = 0; j < 8; ++j) { v[j] = xr[64 * j]; ss += (v[j].x * v[j].x + v[j].y * v[j].y) + (v[j].z * v[j].z + v[j].w * v[j].w); }
            const float rstd = 1.0f / sqrtf(wave_sum(ss) * (1.0f / DM) + EPS);
            GAS f32x4* o = (GAS f32x4*)(out + (size_t)(r0 + rr) * DM) + lane;
#pragma unroll
            for (int j = 0; j < 8; ++j) o[64 * j] = v[j] * rstd * mul[j];
        }
    }
}
__device__ __forceinline__ void phase_pool(const bf16* U, bf16* Pb, int gw, int NGW, int lane) {
    for (int it = gw; it < (M / 32) * 4; it += NGW) {
        const int gi = it & 3, rw = it >> 2, w = 2 << gi, col = gi * 512 + lane * 8;
        for (int rr = 0; rr < 32; ++rr) {
            const int m = rw * 32 + rr, tpos = m & (SEQ - 1), cnt = (tpos + 1 < w) ? tpos + 1 : w;
            float acc[8];
#pragma unroll
            for (int e = 0; e < 8; ++e) acc[e] = 0.f;
            float cur[8];
            for (int j = 0; j < cnt; ++j) {
                const v4u q = *(const GAS v4u*)(U + (size_t)(m - j) * DM + col);
                const float f0 = bflo(q.x), f1 = bfhi(q.x), f2 = bflo(q.y), f3 = bfhi(q.y), f4 = bflo(q.z), f5 = bfhi(q.z), f6 = bflo(q.w), f7 = bfhi(q.w);
                if (j == 0) { cur[0] = f0; cur[1] = f1; cur[2] = f2; cur[3] = f3; cur[4] = f4; cur[5] = f5; cur[6] = f6; cur[7] = f7; }
                acc[0] += f0; acc[1] += f1; acc[2] += f2; acc[3] += f3; acc[4] += f4; acc[5] += f5; acc[6] += f6; acc[7] += f7;
            }
            const float inv = 1.0f / (float)cnt;
            v4u o; o.x = pk2(acc[0] * inv - cur[0], acc[1] * inv - cur[1]); o.y = pk2(acc[2] * inv - cur[2], acc[3] * inv - cur[3]);
            o.z = pk2(acc[4] * inv - cur[4], acc[5] * inv - cur[5]); o.w = pk2(acc[6] * inv - cur[6], acc[7] * inv - cur[7]);
            *(GAS v4u*)(Pb + (size_t)m * DM + col) = o;
        }
    }
}

__device__ __forceinline__ void phase_hgrn_scan_naive(const bf16* PROJ, const float* lbv, float* O, LAS unsigned char* lds, int tid, int vcu, int G) {
    LAS float* qs = (LAS float*)lds;
    LAS float* fs = qs + 16 * 128;
    LAS float* ks = fs + 16 * 128;
    LAS float* vs = ks + 16 * 128;
    const int v = tid >> 4, dg = tid & 15;
    for (int unit = vcu; unit < NB * HG_H * 4; unit += G) {
        const int b = unit >> 6, h = (unit >> 2) & 15, vsl = unit & 3;
        float S[8];
#pragma unroll
        for (int e = 0; e < 8; ++e) S[e] = 0.f;
        const int lt = tid >> 5, ld4 = (tid & 31) * 4;
        float lbl[4];
#pragma unroll
        for (int e = 0; e < 4; ++e) lbl[e] = lbv[h * 128 + ld4 + e];
        for (int ch = 0; ch < SEQ / 16; ++ch) {
            const size_t m0 = (size_t)b * SEQ + (size_t)ch * 16;
            { const bf16* row = PROJ + (m0 + lt) * HG_IN + h * 128 + ld4;
              const v2u qv = *(const GAS v2u*)row, zv = *(const GAS v2u*)(row + 2048);
              const float qf[4] = {bflo(qv.x), bfhi(qv.x), bflo(qv.y), bfhi(qv.y)}, zf[4] = {bflo(zv.x), bfhi(zv.x), bflo(zv.y), bfhi(zv.y)};
#pragma unroll
              for (int e = 0; e < 4; ++e) { const float sg = sigmoid_f(zf[e]), l = lbl[e]; qs[lt * 128 + ld4 + e] = qf[e]; fs[lt * 128 + ld4 + e] = l + (1.0f - l) * sg; ks[lt * 128 + ld4 + e] = (1.0f - l) * (1.0f - sg); }
              vs[tid] = bf1(PROJ[(m0 + (tid >> 5)) * HG_IN + 4096 + h * 128 + vsl * 32 + (tid & 31)]); }
            __syncthreads();
            for (int tt = 0; tt < 16; ++tt) {
                const float vv = vs[tt * 32 + v]; float acc = 0.f;
#pragma unroll
                for (int e = 0; e < 8; ++e) { const int d = dg * 8 + e; S[e] = fs[tt * 128 + d] * S[e] + ks[tt * 128 + d] * vv; acc += S[e] * qs[tt * 128 + d]; }
                acc += __shfl_xor(acc, 1); acc += __shfl_xor(acc, 2); acc += __shfl_xor(acc, 4); acc += __shfl_xor(acc, 8);
                if (dg == 0) O[(m0 + tt) * DM + h * 128 + vsl * 32 + v] = acc;
            }
            __syncthreads();
        }
    }
}
__device__ __forceinline__ void phase_hgrn_post(const bf16* O, const bf16* PROJ, const float* ng, bf16* Pb, int gw, int NGW, int lane) {
    f32x4 nv[4][2];
#pragma unroll
    for (int j = 0; j < 4; ++j) { nv[j][0] = *(const GAS f32x4*)(ng + 512 * j + 8 * lane); nv[j][1] = *(const GAS f32x4*)(ng + 512 * j + 8 * lane + 4); }
    for (int m = gw; m < M; m += NGW) {
        const GAS v4u* orow = (const GAS v4u*)(O + (size_t)m * DM) + lane;
        const GAS v4u* grow = (const GAS v4u*)(PROJ + (size_t)m * HG_IN + 6144) + lane;
        GAS v4u* prow = (GAS v4u*)(Pb + (size_t)m * DM) + lane;
        v4u ob[4], gq[4];
#pragma unroll
        for (int j = 0; j < 4; ++j) { ob[j] = orow[64 * j]; gq[j] = grow[64 * j]; }
#pragma unroll
        for (int j = 0; j < 4; ++j) {
            const f32x4 o0 = (f32x4){bflo(ob[j].x), bfhi(ob[j].x), bflo(ob[j].y), bfhi(ob[j].y)}, o1 = (f32x4){bflo(ob[j].z), bfhi(ob[j].z), bflo(ob[j].w), bfhi(ob[j].w)};
            float ss = ((o0.x * o0.x + o0.y * o0.y) + (o0.z * o0.z + o0.w * o0.w)) + ((o1.x * o1.x + o1.y * o1.y) + (o1.z * o1.z + o1.w * o1.w));
            ss = row16_sum(ss);
            const float rstd = 1.0f / sqrtf(ss * (1.0f / 128.0f) + EPS);
            const v4u g = gq[j];
            v4u w; w.x = pk2(o0.x * rstd * nv[j][0].x * silu1(bflo(g.x)), o0.y * rstd * nv[j][0].y * silu1(bfhi(g.x))); w.y = pk2(o0.z * rstd * nv[j][0].z * silu1(bflo(g.y)), o0.w * rstd * nv[j][0].w * silu1(bfhi(g.y)));
            w.z = pk2(o1.x * rstd * nv[j][1].x * silu1(bflo(g.z)), o1.y * rstd * nv[j][1].y * silu1(bfhi(g.z))); w.w = pk2(o1.z * rstd * nv[j][1].z * silu1(bflo(g.w)), o1.w * rstd * nv[j][1].w * silu1(bfhi(g.w)));
            prow[64 * j] = w;
        }
    }
}
__device__ __forceinline__ void phase_ret_scan_naive(const bf16* PROJ, const float* rot, float* O, LAS unsigned char* lds, int tid, int vcu, int G) {
    LAS float* qs = (LAS float*)lds;
    LAS float* ks = qs + 16 * 256;
    LAS float* vs = ks + 16 * 256;
    const float* ct = rot; const float* st = rot + (size_t)M * 128;
    const int v = tid >> 3, dg = tid & 7;
    for (int unit = vcu; unit < NB * RT_H * 8; unit += G) {
        const int b = unit >> 6, h = (unit >> 3) & 7, vsl = unit & 7;
        const float gamma = 1.0f - exp2f(-5.0f - (float)h);
        float S[32];
#pragma unroll
        for (int e = 0; e < 32; ++e) S[e] = 0.f;
        const int lt = tid >> 5, li = (tid & 31) * 4;
        for (int ch = 0; ch < SEQ / 16; ++ch) {
            const size_t m0 = (size_t)b * SEQ + (size_t)ch * 16;
            { const size_t m = m0 + lt; const bf16* row = PROJ + m * RT_IN + h * 256 + li;
              const v2u q1 = *(const GAS v2u*)row, q2 = *(const GAS v2u*)(row + 128), k1 = *(const GAS v2u*)(row + 2048), k2 = *(const GAS v2u*)(row + 2048 + 128);
              const f32x4 cv = *(const GAS f32x4*)(ct + m * 128 + li), sv = *(const GAS f32x4*)(st + m * 128 + li);
              const float a1[4] = {bflo(q1.x), bfhi(q1.x), bflo(q1.y), bfhi(q1.y)}, a2[4] = {bflo(q2.x), bfhi(q2.x), bflo(q2.y), bfhi(q2.y)};
              const float b1[4] = {bflo(k1.x), bfhi(k1.x), bflo(k1.y), bfhi(k1.y)}, b2[4] = {bflo(k2.x), bfhi(k2.x), bflo(k2.y), bfhi(k2.y)};
#pragma unroll
              for (int e = 0; e < 4; ++e) { const float cc = cv[e], sn = sv[e];
                  qs[lt * 256 + li + e] = a1[e] * cc - a2[e] * sn; qs[lt * 256 + 128 + li + e] = a1[e] * sn + a2[e] * cc;
                  ks[lt * 256 + li + e] = (b1[e] * cc - b2[e] * sn) * 0.0625f; ks[lt * 256 + 128 + li + e] = (b1[e] * sn + b2[e] * cc) * 0.0625f; }
#pragma unroll
              for (int r = 0; r < 2; ++r) { const int idx = tid + r * 512, tt = idx >> 6, vv = idx & 63; vs[idx] = bf1(PROJ[(m0 + tt) * RT_IN + 4096 + h * 512 + vsl * 64 + vv]); } }
            __syncthreads();
            for (int tt = 0; tt < 16; ++tt) {
                const float vv = vs[tt * 64 + v]; float acc = 0.f;
#pragma unroll
                for (int e = 0; e < 32; ++e) { const int d = dg * 32 + e; S[e] = gamma * S[e] + ks[tt * 256 + d] * vv; acc += S[e] * qs[tt * 256 + d]; }
                acc += __shfl_xor(acc, 1); acc += __shfl_xor(acc, 2); acc += __shfl_xor(acc, 4);
                if (dg == 0) O[(m0 + tt) * RT_V + h * 512 + vsl * 64 + v] = acc;
            }
            __syncthreads();
        }
    }
}
__device__ __forceinline__ void phase_ret_post(const bf16* O, const bf16* PROJ, const float* ng, bf16* Pb, int gw, int NGW, int lane) {
    f32x4 nv[8][2];
#pragma unroll
    for (int hh = 0; hh < 8; ++hh) { nv[hh][0] = *(const GAS f32x4*)(ng + 512 * hh + 8 * lane); nv[hh][1] = *(const GAS f32x4*)(ng + 512 * hh + 8 * lane + 4); }
    for (int m = gw; m < M; m += NGW) {
        const GAS v4u* orow = (const GAS v4u*)(O + (size_t)m * RT_V) + lane;
        const GAS v4u* grow = (const GAS v4u*)(PROJ + (size_t)m * RT_IN + 8192) + lane;
        GAS v4u* prow = (GAS v4u*)(Pb + (size_t)m * RT_V) + lane;
        v4u ob[8], gq[8];
#pragma unroll
        for (int hh = 0; hh < 8; ++hh) { ob[hh] = orow[64 * hh]; gq[hh] = grow[64 * hh]; }
#pragma unroll
        for (int hh = 0; hh < 8; ++hh) {
            const f32x4 o0 = (f32x4){bflo(ob[hh].x), bfhi(ob[hh].x), bflo(ob[hh].y), bfhi(ob[hh].y)}, o1 = (f32x4){bflo(ob[hh].z), bfhi(ob[hh].z), bflo(ob[hh].w), bfhi(ob[hh].w)};
            const float ss = ((o0.x * o0.x + o0.y * o0.y) + (o0.z * o0.z + o0.w * o0.w)) + ((o1.x * o1.x + o1.y * o1.y) + (o1.z * o1.z + o1.w * o1.w));
            const float rstd = 1.0f / sqrtf(wave_sum(ss) * (1.0f / 512.0f) + EPS);
            const v4u g = gq[hh];
            v4u w; w.x = pk2(o0.x * rstd * nv[hh][0].x * silu1(bflo(g.x)), o0.y * rstd * nv[hh][0].y * silu1(bfhi(g.x))); w.y = pk2(o0.z * rstd * nv[hh][0].z * silu1(bflo(g.y)), o0.w * rstd * nv[hh][0].w * silu1(bfhi(g.y)));
            w.z = pk2(o1.x * rstd * nv[hh][1].x * silu1(bflo(g.z)), o1.y * rstd * nv[hh][1].y * silu1(bfhi(g.z))); w.w = pk2(o1.z * rstd * nv[hh][1].z * silu1(bflo(g.w)), o1.w * rstd * nv[hh][1].w * silu1(bfhi(g.w)));
            prow[64 * hh] = w;
        }
    }
}

typedef float f32x16 __attribute__((ext_vector_type(16)));
typedef short s16x4 __attribute__((ext_vector_type(4)));
typedef short s16x8 __attribute__((ext_vector_type(8)));
__device__ __forceinline__ unsigned off_b(unsigned row, unsigned ch) { return 256u * row + 16u * (ch ^ (((row & 3u) << 2) | ((row >> 2) & 3u))); }
__device__ __forceinline__ s16x8 tr_frag_b(LAS unsigned char* img, int lane, int c, int ks) {
    const unsigned h = lane >> 5, blk = (lane >> 4) & 1, q = (lane & 15) >> 2, p = lane & 3;
    const unsigned a0 = off_b(16 * ks + 8 * h + q, 4 * c + 2 * blk + (p >> 1)) + 8 * (p & 1), a1 = off_b(16 * ks + 8 * h + 4 + q, 4 * c + 2 * blk + (p >> 1)) + 8 * (p & 1);
    const s16x4 x = __builtin_amdgcn_ds_read_tr16_b64_v4i16((LAS s16x4*)(img + a0)), y = __builtin_amdgcn_ds_read_tr16_b64_v4i16((LAS s16x4*)(img + a1));
    return (s16x8){x[0], x[1], x[2], x[3], y[0], y[1], y[2], y[3]};
}
__device__ __forceinline__ unsigned trb_base(int lane, int c, int tt) {
    const unsigned h = lane >> 5, blk = (lane >> 4) & 1, q = (lane & 15) >> 2, p = lane & 3;
    return 256u * (8 * h + 4 * tt + q) + 16u * ((4 * c + 2 * blk + (p >> 1)) ^ ((q << 2) | ((2 * h + tt) & 3))) + 8 * (p & 1);
}
__device__ __forceinline__ s16x8 tr_frag_b2(LAS unsigned char* img, unsigned b0, unsigned b1, int ks) {
    const s16x4 x = __builtin_amdgcn_ds_read_tr16_b64_v4i16((LAS s16x4*)(img + b0 + 4096 * ks)), y = __builtin_amdgcn_ds_read_tr16_b64_v4i16((LAS s16x4*)(img + b1 + 4096 * ks));
    return (s16x8){x[0], x[1], x[2], x[3], y[0], y[1], y[2], y[3]};
}
__device__ __forceinline__ s16x8 tr_frag_plain(LAS unsigned char* img, int rs, int lane, int c, int ks) {
    const unsigned h = lane >> 5, blk = (lane >> 4) & 1, q = (lane & 15) >> 2, p = lane & 3;
    const unsigned a0 = (16 * ks + 8 * h + q) * rs + (32 * c + 16 * blk + 4 * p) * 2, a1 = a0 + 4 * rs;
    const s16x4 x = __builtin_amdgcn_ds_read_tr16_b64_v4i16((LAS s16x4*)(img + a0)), y = __builtin_amdgcn_ds_read_tr16_b64_v4i16((LAS s16x4*)(img + a1));
    return (s16x8){x[0], x[1], x[2], x[3], y[0], y[1], y[2], y[3]};
}
__device__ __forceinline__ f32x16 mfma32(s16x8 a, s16x8 b, f32x16 c) { return __builtin_amdgcn_mfma_f32_32x32x16_bf16(a, b, c, 0, 0, 0); }
__device__ __forceinline__ f32x16 zero16() { f32x16 z;
#pragma unroll
    for (int i = 0; i < 16; ++i) z[i] = 0.f; return z; }
__device__ __forceinline__ v4u scale_bf8(v4u q, float f) { v4u o; o.x = pk2(bflo(q.x) * f, bfhi(q.x) * f); o.y = pk2(bflo(q.y) * f, bfhi(q.y) * f); o.z = pk2(bflo(q.z) * f, bfhi(q.z) * f); o.w = pk2(bflo(q.w) * f, bfhi(q.w) * f); return o; }

__device__ __forceinline__ void phase_ret_scan(const bf16* PROJ, bf16* O, LAS unsigned char* lds, int tid, int vcu, int G) {
    constexpr int QN = 0, QRS = 528, KN = 33792, VV = KN + 32768, PI = VV + 16384, PRS = 144, ST = PI + 9216, SRS = 528, LDS_END = ST + 33792;
    static_assert(LDS_END <= RING_BYTES, "retention scan LDS map");
    const int lane = tid & 63, wave = __builtin_amdgcn_readfirstlane(tid >> 6);
    for (int unit = vcu; unit < NB * RT_H * 8; unit += G) {
        const int b = unit >> 6, h = (unit >> 3) & 7, vsl = unit & 7;
        const float lg = __log2f(1.0f - exp2f(-5.0f - (float)h));
        const float g64 = exp2f(64.0f * lg);
        f32x16 S[2][2];
#pragma unroll
        for (int a = 0; a < 2; ++a)
#pragma unroll
            for (int c = 0; c < 2; ++c) S[a][c] = zero16();
        for (int i = tid; i < 33792 / 16; i += 512) *(LAS v4u*)(lds + ST + i * 16) = (v4u){0u, 0u, 0u, 0u};
        v4u pq[4], pk[4], pv;
        const __amdgpu_buffer_rsrc_t rsP = __builtin_amdgcn_make_buffer_rsrc((void*)(PROJ + (size_t)b * SEQ * RT_IN), (short)0, SEQ * RT_IN * 2, 0x00020000);
        const __amdgpu_buffer_rsrc_t rsO = __builtin_amdgcn_make_buffer_rsrc((void*)(O + (size_t)b * SEQ * RT_V), (short)0, SEQ * RT_V * 2, 0x00020000);
        const int vrow = tid >> 3, vch = tid & 7;
        const unsigned voq = (unsigned)((tid >> 5) * RT_IN + (tid & 31) * 8) * 2u, vov = (unsigned)(vrow * RT_IN + vch * 8) * 2u;
        const unsigned soq = (unsigned)(h * 256) * 2u, sok = (unsigned)(2048 + h * 256) * 2u, sov = (unsigned)(4096 + h * 512 + vsl * 64) * 2u;
#define RS_PREFETCH(chn) do { const unsigned cb_ = (unsigned)(chn) * 64u * RT_IN * 2u; _Pragma("unroll") for (int i = 0; i < 4; ++i) { \
            pq[i] = __builtin_amdgcn_raw_buffer_load_b128(rsP, voq, cb_ + (unsigned)i * 16u * RT_IN * 2u + soq, 0); pk[i] = __builtin_amdgcn_raw_buffer_load_b128(rsP, voq, cb_ + (unsigned)i * 16u * RT_IN * 2u + sok, 0); } \
            pv = __builtin_amdgcn_raw_buffer_load_b128(rsP, vov, cb_ + sov, 0); } while (0)
        RS_PREFETCH(0);
        float dec[16];
        { const int a31 = lane & 31, a5 = lane >> 5, w4 = wave & 3, t_i = w4 >> 1, x_i = w4 & 1;
#pragma unroll
          for (int r = 0; r < 16; ++r) {
              if (wave < 4) { const int t = 32 * x_i + a31, s = 32 * t_i + 8 * (r >> 2) + 4 * a5 + (r & 3); dec[r] = (s <= t) ? __builtin_amdgcn_exp2f((float)(t - s) * lg) : 0.f; }
              else { const int t = 32 * t_i + (r & 3) + 8 * (r >> 2) + 4 * a5; dec[r] = __builtin_amdgcn_exp2f((float)(t + 1) * lg); } } }
        for (int ch = 0; ch < SEQ / 64; ++ch) {
#pragma unroll
            for (int i = 0; i < 4; ++i) { const int cid = tid + 512 * i, row = cid >> 5, chq = cid & 31;
                *(LAS v4u*)(lds + QN + row * QRS + chq * 16) = pq[i];
                *(LAS v4u*)(lds + KN + (chq >> 4) * 16384 + off_b(row, chq & 15)) = pk[i]; }
            *(LAS v4u*)(lds + VV + off_b(vrow, vch)) = pv;
            *(LAS v4u*)(lds + VV + off_b(vrow, 8 + vch)) = scale_bf8(pv, __builtin_amdgcn_exp2f((float)(63 - vrow) * lg));
            __syncthreads();
#define RS_STORE_O(chs) do { if (wave >= 4) { const int w4s = wave & 3, tis = w4s >> 1, vis = w4s & 1; int lnS = lane; asm volatile("" : "+v"(lnS)); \
                  \
                const LAS unsigned char* sg_ = lds + RING_BYTES + 4096 + w4s * 2048; \
                const unsigned voo = (unsigned)((lnS >> 2) * RT_V + h * 512 + vsl * 64 + 32 * vis + 8 * (lnS & 3)) * 2u; \
                _Pragma("unroll") for (int q = 0; q < 2; ++q) { const v4u ov_ = *(const LAS v4u*)(sg_ + (16 * q + (lnS >> 2)) * 64 + (lnS & 3) * 16); \
                    __builtin_amdgcn_raw_buffer_store_b128(ov_, rsO, voo, (unsigned)((chs) * 64 + 32 * tis + 16 * q) * RT_V * 2u, 0); } } } while (0)
            if (ch > 0) RS_STORE_O(ch - 1);
            if (ch + 1 < SEQ / 64) RS_PREFETCH(ch + 1);
            f32x16 acc = zero16();
            int lnA = lane; asm volatile("" : "+v"(lnA));
            const int a31 = lnA & 31, a5 = lnA >> 5;
            const int w4 = wave & 3, t_i = w4 >> 1, x_i = w4 & 1;
            s16x8 fa0[4], fb0[4], fa1[4], fb1[4];
            if (wave < 4) {
                const int si = t_i, ti = x_i;
#define RS_LD1A(fa, fb, g4) do { _Pragma("unroll") for (int j = 0; j < 2; ++j) { const int ks = 2 * (g4) + j; \
                    fa[j] = *(const LAS s16x8*)(lds + KN + (ks >> 3) * 16384 + off_b(32 * si + a31, 2 * (ks & 7) + a5)); \
                    fb[j] = *(const LAS s16x8*)(lds + QN + (32 * ti + a31) * QRS + (16 * ks + 8 * a5) * 2); } } while (0)
#define RS_MMA4(fa, fb) do { _Pragma("unroll") for (int j = 0; j < 4; ++j) acc = mfma32(fa[j], fb[j], acc); } while (0)
#define RS_MMA2(fa, fb) do { _Pragma("unroll") for (int j = 0; j < 2; ++j) acc = mfma32(fa[j], fb[j], acc); } while (0)
                RS_LD1A(fa0, fb0, 0); RS_LD1A(fa1, fb1, 1);
#pragma unroll
                for (int g2 = 0; g2 < 3; ++g2) { RS_MMA2(fa0, fb0); RS_LD1A(fa0, fb0, 2 * g2 + 2); RS_MMA2(fa1, fb1); RS_LD1A(fa1, fb1, 2 * g2 + 3); }
                RS_MMA2(fa0, fb0); RS_MMA2(fa1, fb1);
#undef RS_LD1A
                const int t = 32 * ti + a31;
#pragma unroll
                for (int g = 0; g < 4; ++g) { float pvv[4];
#pragma unroll
                    for (int e = 0; e < 4; ++e) pvv[e] = acc[4 * g + e] * dec[4 * g + e];
                    v2u w; w.x = pk2(pvv[0], pvv[1]); w.y = pk2(pvv[2], pvv[3]);
                    *(LAS v2u*)(lds + PI + t * PRS + (32 * si + 8 * g + 4 * a5) * 2) = w; }
            } else {
                const int ti = t_i, vi = x_i;
#define RS_LD1B(fa, fb, g4) do { _Pragma("unroll") for (int j = 0; j < 2; ++j) { const int ks = 2 * (g4) + j; \
                    fa[j] = *(const LAS s16x8*)(lds + QN + (32 * ti + a31) * QRS + (16 * ks + 8 * a5) * 2); \
                    fb[j] = *(const LAS s16x8*)(lds + ST + (32 * vi + a31) * SRS + (16 * ks + 8 * a5) * 2); } } while (0)
                RS_LD1B(fa0, fb0, 0); RS_LD1B(fa1, fb1, 1);
#pragma unroll
                for (int g2 = 0; g2 < 3; ++g2) { RS_MMA2(fa0, fb0); RS_LD1B(fa0, fb0, 2 * g2 + 2); RS_MMA2(fa1, fb1); RS_LD1B(fa1, fb1, 2 * g2 + 3); }
                RS_MMA2(fa0, fb0); RS_MMA2(fa1, fb1);
#undef RS_LD1B
#pragma unroll
                for (int r = 0; r < 16; ++r) acc[r] *= dec[r];
            }
            __syncthreads();
            if (wave < 4) {
                LAS unsigned char* kimg0 = lds + KN + ((2 * wave) >> 2) * 16384; LAS unsigned char* kimg1 = lds + KN + ((2 * wave + 1) >> 2) * 16384;
                const unsigned ka0 = trb_base(lnA, (2 * wave) & 3, 0), ka1 = trb_base(lnA, (2 * wave) & 3, 1), kb0 = trb_base(lnA, (2 * wave + 1) & 3, 0), kb1 = trb_base(lnA, (2 * wave + 1) & 3, 1);
                const unsigned va0 = trb_base(lnA, 2, 0), va1 = trb_base(lnA, 2, 1), vb0 = trb_base(lnA, 3, 0), vb1 = trb_base(lnA, 3, 1);
#define RS_LD2A(g2) do { _Pragma("unroll") for (int j = 0; j < 2; ++j) { const int ks = 2 * (g2) + j; fa0[j] = tr_frag_b2(kimg0, ka0, ka1, ks); fa1[j] = tr_frag_b2(kimg1, kb0, kb1, ks); fb0[j] = tr_frag_b2(lds + VV, va0, va1, ks); fb1[j] = tr_frag_b2(lds + VV, vb0, vb1, ks); } } while (0)
#define RS_MMA2A() do { _Pragma("unroll") for (int j = 0; j < 2; ++j) { S[0][0] = mfma32(fa0[j], fb0[j], S[0][0]); S[0][1] = mfma32(fa0[j], fb1[j], S[0][1]); S[1][0] = mfma32(fa1[j], fb0[j], S[1][0]); S[1][1] = mfma32(fa1[j], fb1[j], S[1][1]); } } while (0)
                RS_LD2A(0);
#pragma unroll
                for (int a = 0; a < 2; ++a)
#pragma unroll
                    for (int c = 0; c < 2; ++c)
#pragma unroll
                        for (int r = 0; r < 16; ++r) S[a][c][r] *= g64;
                RS_MMA2A(); RS_LD2A(1); RS_MMA2A();
#undef RS_LD2A
#undef RS_MMA2A
#pragma unroll
                for (int a = 0; a < 2; ++a)
#pragma unroll
                    for (int c = 0; c < 2; ++c)
#pragma unroll
                        for (int g = 0; g < 4; ++g) { const int d = 32 * (2 * wave + a) + 8 * g + 4 * a5, v = 32 * c + a31;
                            v2u w; w.x = pk2(S[a][c][4 * g], S[a][c][4 * g + 1]); w.y = pk2(S[a][c][4 * g + 2], S[a][c][4 * g + 3]);
                            *(LAS v2u*)(lds + ST + v * SRS + d * 2) = w; }
            } else {
                const int ti = t_i, vi = x_i;
#pragma unroll
                for (int ks = 0; ks < 4; ++ks) { fa0[ks] = *(const LAS s16x8*)(lds + PI + (32 * ti + a31) * PRS + (16 * ks + 8 * a5) * 2); fb0[ks] = tr_frag_b2(lds + VV, trb_base(lnA, vi, 0), trb_base(lnA, vi, 1), ks); }
                RS_MMA4(fa0, fb0);
#pragma unroll
                for (int i = 0; i < 8; ++i) { const float o0_ = acc[2 * i], o1_ = acc[2 * i + 1]; const unsigned pr_ = pk2(o0_, o1_);
                    LAS unsigned char* sp_ = lds + RING_BYTES + 4096 + w4 * 2048 + (2 * (i & 1) + 8 * (i >> 1) + 4 * a5) * 64 + a31 * 2;
                    *(LAS unsigned short*)sp_ = (unsigned short)(pr_ & 0xffffu); *(LAS unsigned short*)(sp_ + 64) = (unsigned short)(pr_ >> 16); }
            }
#undef RS_MMA4
#undef RS_PREFETCH_DUMMY
#undef RS_MMA2
            __syncthreads();
        }
        RS_STORE_O(SEQ / 64 - 1);
#undef RS_STORE_O
#undef RS_PREFETCH
    }
}

__device__ __forceinline__ void phase_hgrn_pre(const bf16* PROJ, const float* lbv, bf16* QD, bf16* KI, bf16* KE, float* DEC, int gt, int NGT) {
    for (int it = gt; it < (M / 32) * 256; it += NGT) {
        const int chunk = it >> 8, col = (it & 255) * 8; const size_t m0 = (size_t)chunk * 32;
        float lb[8], tot[8], cum[8];
        { const f32x4 l0 = *(const GAS f32x4*)(lbv + col), l1 = *(const GAS f32x4*)(lbv + col + 4);
#pragma unroll
          for (int e = 0; e < 4; ++e) { lb[e] = l0[e]; lb[4 + e] = l1[e]; } }
#pragma unroll
        for (int e = 0; e < 8; ++e) { tot[e] = 1.f; cum[e] = 1.f; }
#pragma unroll 4
        for (int t = 0; t < 32; ++t) { const v4u zz = *(const GAS v4u*)(PROJ + (m0 + t) * HG_IN + 2048 + col);
            const float z[8] = {bflo(zz.x), bfhi(zz.x), bflo(zz.y), bfhi(zz.y), bflo(zz.z), bfhi(zz.z), bflo(zz.w), bfhi(zz.w)};
#pragma unroll
            for (int e = 0; e < 8; ++e) tot[e] *= lb[e] + (1.0f - lb[e]) * sigmoid_f(z[e]); }
#pragma unroll 2
        for (int t = 0; t < 32; ++t) { const size_t m = m0 + t;
            const v4u zz = *(const GAS v4u*)(PROJ + m * HG_IN + 2048 + col), qq = *(const GAS v4u*)(PROJ + m * HG_IN + col);
            const float z[8] = {bflo(zz.x), bfhi(zz.x), bflo(zz.y), bfhi(zz.y), bflo(zz.z), bfhi(zz.z), bflo(zz.w), bfhi(zz.w)};
            const float q[8] = {bflo(qq.x), bfhi(qq.x), bflo(qq.y), bfhi(qq.y), bflo(qq.z), bfhi(qq.z), bflo(qq.w), bfhi(qq.w)};
            float qd[8], ki[8], ke[8];
#pragma unroll
            for (int e = 0; e < 8; ++e) { const float sg = sigmoid_f(z[e]); cum[e] *= lb[e] + (1.0f - lb[e]) * sg; const float kk = (1.0f - lb[e]) * (1.0f - sg);
                qd[e] = q[e] * cum[e]; ki[e] = kk * __builtin_amdgcn_rcpf(cum[e]); ke[e] = ki[e] * tot[e]; }
            v4u o; o.x = pk2(qd[0], qd[1]); o.y = pk2(qd[2], qd[3]); o.z = pk2(qd[4], qd[5]); o.w = pk2(qd[6], qd[7]); *(GAS v4u*)(QD + m * DM + col) = o;
            o.x = pk2(ki[0], ki[1]); o.y = pk2(ki[2], ki[3]); o.z = pk2(ki[4], ki[5]); o.w = pk2(ki[6], ki[7]); *(GAS v4u*)(KI + m * DM + col) = o;
            o.x = pk2(ke[0], ke[1]); o.y = pk2(ke[2], ke[3]); o.z = pk2(ke[4], ke[5]); o.w = pk2(ke[6], ke[7]); *(GAS v4u*)(KE + m * DM + col) = o; }
        f32x4 d0, d1;
#pragma unroll
        for (int e = 0; e < 4; ++e) { d0[e] = tot[e]; d1[e] = tot[4 + e]; }
        *(GAS f32x4*)(DEC + (size_t)chunk * DM + col) = d0; *(GAS f32x4*)(DEC + (size_t)chunk * DM + col + 4) = d1;
    }
}
__device__ __forceinline__ void phase_hgrn_scan(const bf16* HV, const bf16* QD, const bf16* KI, const bf16* KE, const float* DEC, bf16* Ob, LAS unsigned char* lds, int tid, int u0, int ustride) {
    constexpr int RS = 272, PRS = 80, VRS = 128, SET = 30208;
    constexpr int QI = 0, KII = 8704, KEI = 17408, VI = 25600, DCI = 29696, PI = 2 * SET, ST = PI + 2560, LDS_END = ST + 2 * 8704;
    static_assert(LDS_END + 4096 <= RING_BYTES, "hgrn scan LDS map (+ 2 x 2 KiB output staging)");
    const int lane = tid & 63, wave = __builtin_amdgcn_readfirstlane(tid >> 6), l31 = lane & 31, h5 = lane >> 5;
    const int vt = (wave >> 1) & 1;
    for (int unit = u0; unit < NB * HG_H * 2; unit += ustride) {
        const int b = unit >> 5, h = (unit >> 1) & 15, vp = unit & 1;
        f32x16 S0 = zero16(), S1 = zero16();
        for (int i = tid; i < 2 * 8704 / 16; i += 512) *(LAS v4u*)(lds + ST + i * 16) = (v4u){0u, 0u, 0u, 0u};
        const int row = tid >> 4, c16 = tid & 15;
        const size_t mb = (size_t)b * SEQ;
        v4u q0, ki0, ke0, x0 = (v4u){0u, 0u, 0u, 0u}, q1, ki1, ke1, x1 = (v4u){0u, 0u, 0u, 0u};
#define HS_CLAMP(c_) ((c_) < SEQ / 32 ? (c_) : SEQ / 32 - 1)
#define HS_LOAD(pq_, pki_, pke_, px_, chn) do { const size_t hb_ = (size_t)(b * 16 + h) * SEQ + (size_t)(chn) * 32; \
            pq_ = *(const GAS v4u*)(QD + (hb_ + row) * 128 + c16 * 8); pki_ = *(const GAS v4u*)(KI + (hb_ + row) * 128 + c16 * 8); pke_ = *(const GAS v4u*)(KE + (hb_ + row) * 128 + c16 * 8); \
            if (tid < 256) px_ = *(const GAS v4u*)(HV + (hb_ + (tid >> 3)) * 128 + vp * 64 + (tid & 7) * 8); \
            else if (tid < 288) px_ = *(const GAS v4u*)(DEC + ((size_t)(b * 16 + h) * (SEQ / 32) + (chn)) * 128 + (tid - 256) * 4); } while (0)
#define HS_WRITE(IB, pq_, pki_, pke_, px_) do { \
            *(LAS v4u*)(lds + (IB) + QI + row * RS + c16 * 16) = pq_; *(LAS v4u*)(lds + (IB) + KII + row * RS + c16 * 16) = pki_; *(LAS v4u*)(lds + (IB) + KEI + off_b(row, c16)) = pke_; \
            if (tid < 256) *(LAS v4u*)(lds + (IB) + VI + (tid >> 3) * VRS + (tid & 7) * 16) = px_; \
            else if (tid < 288) *(LAS v4u*)(lds + (IB) + DCI + (tid - 256) * 16) = px_; } while (0)
#define HS_STORE_O(chs) do { if (wave == 4 || wave == 6) {   \
            const LAS unsigned char* sg_ = lds + LDS_END + vt * 2048; bf16* op = Ob + (mb + (size_t)(chs) * 32 + (lane >> 2)) * DM + h * 128 + vp * 64 + vt * 32 + 8 * (lane & 3); \
            _Pragma("unroll") for (int q = 0; q < 2; ++q) { const v4u ov_ = *(const LAS v4u*)(sg_ + (16 * q + (lane >> 2)) * 64 + (lane & 3) * 16); *(GAS v4u*)(op + (size_t)(16 * q) * DM) = ov_; } } } while (0)
#define HS_CHUNK(IB, NIB, nq_, nki_, nke_, nx_) do { \
            f32x16 acc = zero16(); \
            if (wave == 5) { \
                s16x8 fa[8], fb[8]; \
                _Pragma("unroll") for (int ks = 0; ks < 8; ++ks) { fa[ks] = *(const LAS s16x8*)(lds + (IB) + KII + l31 * RS + (16 * ks + 8 * h5) * 2); fb[ks] = *(const LAS s16x8*)(lds + (IB) + QI + l31 * RS + (16 * ks + 8 * h5) * 2); } \
                _Pragma("unroll") for (int ks = 0; ks < 8; ++ks) acc = mfma32(fa[ks], fb[ks], acc); \
                const int t = l31; \
                _Pragma("unroll") for (int g = 0; g < 4; ++g) { float pvv[4]; \
                    _Pragma("unroll") for (int e = 0; e < 4; ++e) { const int s = 8 * g + 4 * h5 + e; pvv[e] = (s <= t) ? acc[4 * g + e] : 0.f; } \
                    v2u w; w.x = pk2(pvv[0], pvv[1]); w.y = pk2(pvv[2], pvv[3]); \
                    *(LAS v2u*)(lds + PI + t * PRS + (8 * g + 4 * h5) * 2) = w; } \
            } else if (wave == 4 || wave == 6) { \
                s16x8 fa[8], fb[8]; \
                _Pragma("unroll") for (int ks = 0; ks < 8; ++ks) { fa[ks] = *(const LAS s16x8*)(lds + (IB) + QI + l31 * RS + (16 * ks + 8 * h5) * 2); fb[ks] = *(const LAS s16x8*)(lds + ST + vt * 8704 + l31 * RS + (16 * ks + 8 * h5) * 2); } \
                _Pragma("unroll") for (int ks = 0; ks < 8; ++ks) acc = mfma32(fa[ks], fb[ks], acc); \
            } \
            __syncthreads(); \
            if (wave < 4) { \
                _Pragma("unroll") for (int g = 0; g < 4; ++g) { const f32x4 dv = *(const LAS f32x4*)(lds + (IB) + DCI + (32 * wave + 8 * g + 4 * h5) * 4); \
                    _Pragma("unroll") for (int e = 0; e < 4; ++e) { S0[4 * g + e] *= dv[e]; S1[4 * g + e] *= dv[e]; } } \
                _Pragma("unroll") for (int ks = 0; ks < 2; ++ks) { const s16x8 af = tr_frag_b(lds + (IB) + KEI, lane, wave, ks); \
                    const s16x8 b0 = tr_frag_plain(lds + (IB) + VI, VRS, lane, 0, ks), b1 = tr_frag_plain(lds + (IB) + VI, VRS, lane, 1, ks); S0 = mfma32(af, b0, S0); S1 = mfma32(af, b1, S1); } \
                _Pragma("unroll") for (int g = 0; g < 4; ++g) { const int d = 32 * wave + 8 * g + 4 * h5; \
                    v2u w; w.x = pk2(S0[4 * g], S0[4 * g + 1]); w.y = pk2(S0[4 * g + 2], S0[4 * g + 3]); \
                    *(LAS v2u*)(lds + ST + l31 * RS + d * 2) = w; \
                    w.x = pk2(S1[4 * g], S1[4 * g + 1]); w.y = pk2(S1[4 * g + 2], S1[4 * g + 3]); \
                    *(LAS v2u*)(lds + ST + 8704 + l31 * RS + d * 2) = w; } \
            } else if (wave == 4 || wave == 6) { \
                _Pragma("unroll") for (int ks = 0; ks < 2; ++ks) { const s16x8 af = *(const LAS s16x8*)(lds + PI + l31 * PRS + (16 * ks + 8 * h5) * 2); const s16x8 bfr = tr_frag_plain(lds + (IB) + VI, VRS, lane, vt, ks); acc = mfma32(af, bfr, acc); } \
                _Pragma("unroll") for (int i = 0; i < 8; ++i) { const float o0_ = acc[2 * i], o1_ = acc[2 * i + 1]; const unsigned pr_ = pk2(o0_, o1_); \
                    LAS unsigned char* sp_ = lds + LDS_END + vt * 2048 + (2 * (i & 1) + 8 * (i >> 1) + 4 * h5) * 64 + l31 * 2; \
                    *(LAS unsigned short*)sp_ = (unsigned short)(pr_ & 0xffffu); *(LAS unsigned short*)(sp_ + 64) = (unsigned short)(pr_ >> 16); } \
            } \
            HS_WRITE(NIB, nq_, nki_, nke_, nx_); \
            __syncthreads(); } while (0)
        HS_LOAD(q0, ki0, ke0, x0, 0); HS_LOAD(q1, ki1, ke1, x1, 1);
        HS_WRITE(0, q0, ki0, ke0, x0); HS_LOAD(q0, ki0, ke0, x0, 2);
        __syncthreads();
        for (int ch = 0; ch < SEQ / 32; ch += 2) {
            HS_CHUNK(0, SET, q1, ki1, ke1, x1);     HS_LOAD(q1, ki1, ke1, x1, HS_CLAMP(ch + 3)); HS_STORE_O(ch);
            HS_CHUNK(SET, 0, q0, ki0, ke0, x0);     HS_LOAD(q0, ki0, ke0, x0, HS_CLAMP(ch + 4)); HS_STORE_O(ch + 1);
        }
#undef HS_CLAMP
#undef HS_LOAD
#undef HS_WRITE
#undef HS_STORE_O
#undef HS_CHUNK
    }
}

template <bool XF32>
__device__ __forceinline__ void phase_poolmix(const void* hsrc  , const float* rsrow  , bf16* hout, const float* gnorm, const float* ada_l  ,
                                              const float* pscale, const bf16* Wt  ,
                                              const float* g2, const float* shift2, const float* scale2  , bf16* U2,
                                              LAS unsigned char* lds, int tid, int vcu, int G) {
    constexpr int PA = 0, WB = 65536, RSTD = RING_BYTES, ES = XF32 ? 4 : 2;
    const int lane = tid & 63, wave = __builtin_amdgcn_readfirstlane(tid >> 6), l31 = lane & 31, h5 = lane >> 5;
    LAS float* rstdL = (LAS float*)(lds + RSTD);
    LAS float* rowss = (LAS float*)(lds + RING_BYTES + 4096);
    const __amdgpu_buffer_rsrc_t rsH = __builtin_amdgcn_make_buffer_rsrc((void*)hsrc, (short)0, M * DM * ES, 0x00020000);
    const __amdgpu_buffer_rsrc_t rsO = __builtin_amdgcn_make_buffer_rsrc((void*)hout, (short)0, M * DM * 2, 0x00020000);
    const __amdgpu_buffer_rsrc_t rsW = __builtin_amdgcn_make_buffer_rsrc((void*)Wt, (short)0, 4 * 512 * 512 * 2, 0x00020000);
#define PM_OFFP(row, ch) ((row) * 1024 + 16 * ((ch) ^ ((row) & 15)))
#define PM_OFFW(n, ch) ((n) * 64 + 16 * ((ch) ^ (((n) >> 2) & 3)))
#define PM_LDH(voff, soff) __builtin_amdgcn_raw_buffer_load_b128(rsH, (voff), (soff), 0)
#define PM_UNPK(q_, f_) do { f_[0] = bflo(q_.x); f_[1] = bfhi(q_.x); f_[2] = bflo(q_.y); f_[3] = bfhi(q_.y); f_[4] = bflo(q_.z); f_[5] = bfhi(q_.z); f_[6] = bflo(q_.w); f_[7] = bfhi(q_.w); } while (0)
    for (int unit = vcu; unit < M / 64; unit += G) {
        const int r0 = unit * 64, b = r0 >> 12, tpos0 = r0 & (SEQ - 1), halo = tpos0 < 15 ? tpos0 : 15;
        const float* shp = ada_l + (size_t)b * ADA_W; const float* scp = shp + DM; const float* gtp = shp + 2 * DM;
        if (rsrow) { if (tid < 64 + halo) rstdL[tid + 15 - halo] = rsrow[r0 - halo + tid]; }
        else for (int rp = wave; 2 * rp < 64 + halo; rp += 2 * NWAVES) {
            int rrq[2]; float ssq[2]; v4u qq[2][XF32 ? 16 : 8];
#pragma unroll
            for (int z = 0; z < 2; ++z) { const int rr = 2 * (rp + NWAVES * z) + h5, rrc = rr < 64 + halo ? rr : 63 + halo, row = r0 - halo + rrc; rrq[z] = rr;
                const unsigned vo = (unsigned)row * (DM * ES) + (unsigned)l31 * 16u;
#pragma unroll
                for (int j = 0; j < (XF32 ? 16 : 8); ++j) qq[z][j] = PM_LDH(vo, (unsigned)j * 512u); }
#pragma unroll
            for (int z = 0; z < 2; ++z) { float ss = 0.f;
#pragma unroll
                for (int j = 0; j < (XF32 ? 16 : 8); ++j) { const v4u q = qq[z][j];
                    if constexpr (XF32) { const f32x4 v = __builtin_bit_cast(f32x4, q); ss += (v.x * v.x + v.y * v.y) + (v.z * v.z + v.w * v.w); }
                    else { float f[8]; PM_UNPK(q, f); ss += ((f[0] * f[0] + f[1] * f[1]) + (f[2] * f[2] + f[3] * f[3])) + ((f[4] * f[4] + f[5] * f[5]) + (f[6] * f[6] + f[7] * f[7])); } }
                ssq[z] = ss; }
#pragma unroll
            for (int z = 0; z < 2; ++z) { float ss = ssq[z];
                ss = half_sum(ss);
                const float rstd = 1.0f / sqrtf(ss * (1.0f / DM) + EPS);
                if (l31 == 0 && rrq[z] < 64 + halo) rstdL[rrq[z] + 15 - halo] = rstd; }
        }
        __syncthreads();
#pragma unroll 1
        for (int g = 0; g < 4; ++g) {
            const int w = 2 << g;
            const unsigned wvo = (unsigned)lane * 16u, wso = ((unsigned)g * 16u + 2u * (unsigned)wave) * (32u * 1024u);
            v4u wA[4], wB[4], wC[4];
            v4u hk[8];
#define PM_WLD(dst, kc_) do { _Pragma("unroll") for (int nt = 0; nt < 2; ++nt) _Pragma("unroll") for (int ks = 0; ks < 2; ++ks) \
                dst[nt * 2 + ks] = __builtin_amdgcn_raw_buffer_load_b128(rsW, wvo, wso + (unsigned)(nt * 32 + 2 * (kc_) + ks) * 1024u, 0); } while (0)
            PM_WLD(wA, 0); PM_WLD(wB, 1); PM_WLD(wC, 2);
            { const int oct = tid & 63, col = g * 512 + oct * 8; const unsigned hvo = (unsigned)col * ES;
              float gm[8], sh[8];
              { const f32x4 g0 = *(const GAS f32x4*)(gnorm + col), g1 = *(const GAS f32x4*)(gnorm + col + 4), s0 = *(const GAS f32x4*)(scp + col), s1 = *(const GAS f32x4*)(scp + col + 4);
                const f32x4 a0 = *(const GAS f32x4*)(shp + col), a1 = *(const GAS f32x4*)(shp + col + 4);
#pragma unroll
                for (int e = 0; e < 4; ++e) { gm[e] = g0[e] * (1.0f + s0[e]); gm[4 + e] = g1[e] * (1.0f + s1[e]); sh[e] = a0[e]; sh[4 + e] = a1[e]; } }
              LAS unsigned char* UT = lds + WB;
#pragma unroll
              for (int hf = 0; hf < 2; ++hf) {
                  const int rb = r0 - 15 + 32 * hf;
                  { v4u ha[6], hb2[6]; float rsv[6];
#pragma unroll
                      for (int k = 0; k < 6; ++k) { const int j = wave - 1 + 8 * k, row = rb + j, rowc = (j >= 0 && row >= r0 - halo) ? row : r0;
                          const unsigned so = (unsigned)rowc * (DM * ES);
                          ha[k] = PM_LDH(hvo, so); if constexpr (XF32) hb2[k] = PM_LDH(hvo, so + 16u); rsv[k] = rstdL[rowc - r0 + 15]; }
#pragma unroll
                      for (int k = 0; k < 6; ++k) { const int j = wave - 1 + 8 * k; const float rs_ = rsv[k]; float f[8];
                          if constexpr (XF32) { const f32x4 x0 = __builtin_bit_cast(f32x4, ha[k]), x1 = __builtin_bit_cast(f32x4, hb2[k]); f[0] = x0.x; f[1] = x0.y; f[2] = x0.z; f[3] = x0.w; f[4] = x1.x; f[5] = x1.y; f[6] = x1.z; f[7] = x1.w; }
                          else { PM_UNPK(ha[k], f); if (k >= 2) hk[4 * hf + k - 2] = ha[k]; }
                          v4u uq; uq.x = pk2(f[0] * rs_ * gm[0] + sh[0], f[1] * rs_ * gm[1] + sh[1]); uq.y = pk2(f[2] * rs_ * gm[2] + sh[2], f[3] * rs_ * gm[3] + sh[3]);
                          uq.z = pk2(f[4] * rs_ * gm[4] + sh[4], f[5] * rs_ * gm[5] + sh[5]); uq.w = pk2(f[6] * rs_ * gm[6] + sh[6], f[7] * rs_ * gm[7] + sh[7]);
                          if (j >= 0) *(LAS v4u*)(UT + j * 1024 + oct * 16) = uq; }
                  }
                  __syncthreads();
                  { const int il0 = 4 * wave, sl0 = il0 + 15, tp0 = tpos0 + 32 * hf + il0;
                    float S[8], uc[8];
#pragma unroll
                    for (int e = 0; e < 8; ++e) S[e] = 0.f;
                    { const int cnt = tp0 + 1 < w ? tp0 + 1 : w;
#define PM_WIN(J0, NJ) do { v4u qw[NJ]; \
                          _Pragma("unroll") for (int jj = 0; jj < NJ; ++jj) { const int sj = sl0 - (J0) - jj; qw[jj] = *(const LAS v4u*)(UT + (sj > 0 ? sj : 0) * 1024 + oct * 16); } \
                          _Pragma("unroll") for (int jj = 0; jj < NJ; ++jj) { float f[8]; PM_UNPK(qw[jj], f); const float m_ = (J0) + jj < cnt ? 1.0f : 0.0f; \
                              if ((J0) + jj == 0) { _Pragma("unroll") for (int e = 0; e < 8; ++e) uc[e] = f[e]; } \
                              _Pragma("unroll") for (int e = 0; e < 8; ++e) S[e] += m_ * f[e]; } } while (0)
                      PM_WIN(0, 4);
                      if (w > 4) { PM_WIN(4, 4); if (w > 8) PM_WIN(8, 8); }
#undef PM_WIN
                      const float inv = 1.0f / (float)cnt;
                      v4u o; o.x = pk2(S[0] * inv - uc[0], S[1] * inv - uc[1]); o.y = pk2(S[2] * inv - uc[2], S[3] * inv - uc[3]); o.z = pk2(S[4] * inv - uc[4], S[5] * inv - uc[5]); o.w = pk2(S[6] * inv - uc[6], S[7] * inv - uc[7]);
                      *(LAS v4u*)(lds + PA + PM_OFFP(32 * hf + il0, oct)) = o; }
#pragma unroll
                    for (int r = 1; r < 4; ++r) { const int tpr = tp0 + r, cnt = tpr + 1 < w ? tpr + 1 : w;
                        const v4u qn = *(const LAS v4u*)(UT + (sl0 + r) * 1024 + oct * 16), qo = *(const LAS v4u*)(UT + (sl0 + r - w) * 1024 + oct * 16);
                        float fn[8], fo[8]; PM_UNPK(qn, fn); PM_UNPK(qo, fo); const float m_ = tpr + 1 > w ? 1.0f : 0.0f;
#pragma unroll
                        for (int e = 0; e < 8; ++e) S[e] += fn[e] - m_ * fo[e];
                        const float inv = 1.0f / (float)cnt;
                        v4u o; o.x = pk2(S[0] * inv - fn[0], S[1] * inv - fn[1]); o.y = pk2(S[2] * inv - fn[2], S[3] * inv - fn[3]); o.z = pk2(S[4] * inv - fn[4], S[5] * inv - fn[5]); o.w = pk2(S[6] * inv - fn[6], S[7] * inv - fn[7]);
                        *(LAS v4u*)(lds + PA + PM_OFFP(32 * hf + il0 + r, oct)) = o; }
                  }
                  __syncthreads();
              }
            }
            f32x16 acc[2][2];
#pragma unroll
            for (int a = 0; a < 2; ++a)
#pragma unroll
                for (int c = 0; c < 2; ++c) acc[a][c] = zero16();
#define PM_CHUNK(kc, SET) do { \
                int la_ = lane; asm volatile("" : "+v"(la_)); const int l31_ = la_ & 31, h5_ = la_ >> 5; \
                s16x8 fb[2][2]; \
                _Pragma("unroll") for (int ks = 0; ks < 2; ++ks) _Pragma("unroll") for (int mt = 0; mt < 2; ++mt) fb[mt][ks] = *(const LAS s16x8*)(lds + PA + PM_OFFP(32 * mt + l31_, 4 * (kc) + 2 * ks + h5_)); \
                _Pragma("unroll") for (int ks = 0; ks < 2; ++ks) _Pragma("unroll") for (int nt = 0; nt < 2; ++nt) _Pragma("unroll") for (int mt = 0; mt < 2; ++mt) \
                    acc[nt][mt] = mfma32(__builtin_bit_cast(s16x8, SET[nt * 2 + ks]), fb[mt][ks], acc[nt][mt]); \
                if ((kc) + 3 < 16) PM_WLD(SET, (kc) + 3); } while (0)
            PM_CHUNK(0, wA); PM_CHUNK(1, wB); PM_CHUNK(2, wC); PM_CHUNK(3, wA); PM_CHUNK(4, wB); PM_CHUNK(5, wC); PM_CHUNK(6, wA); PM_CHUNK(7, wB);
            PM_CHUNK(8, wC); PM_CHUNK(9, wA); PM_CHUNK(10, wB); PM_CHUNK(11, wC); PM_CHUNK(12, wA); PM_CHUNK(13, wB); PM_CHUNK(14, wC); PM_CHUNK(15, wA);
#undef PM_CHUNK
#undef PM_WLD
            __syncthreads();
#pragma unroll
            for (int nt = 0; nt < 2; ++nt)
#pragma unroll
                for (int q = 0; q < 4; ++q)
#pragma unroll
                    for (int mt = 0; mt < 2; ++mt) { const int n = 32 * (2 * wave + nt) + 8 * q + 4 * h5, m = 32 * mt + l31;
                        const float y0 = acc[nt][mt][4 * q], y1 = acc[nt][mt][4 * q + 1], y2 = acc[nt][mt][4 * q + 2], y3 = acc[nt][mt][4 * q + 3];
                        v2u o; o.x = pk2(y0, y1); o.y = pk2(y2, y3);
                        *(LAS v2u*)(lds + PA + m * 1040 + n * 2) = o; }
            __syncthreads();
            { const int ch = tid & 63, col = g * 512 + ch * 8; const unsigned hvo = (unsigned)col * ES, ovo = (unsigned)col * 2u;
              const f32x4 gv0 = *(const GAS f32x4*)(gtp + col) * *(const GAS f32x4*)(pscale + col), gv1 = *(const GAS f32x4*)(gtp + col + 4) * *(const GAS f32x4*)(pscale + col + 4);
              if constexpr (XF32) {
#pragma unroll
                  for (int kb = 0; kb < 8; kb += 4) {
                      v4u ha[4], hb2[4];
#pragma unroll
                      for (int k = 0; k < 4; ++k) { const unsigned so = (unsigned)(r0 + wave + 8 * (kb + k)) * (DM * ES); ha[k] = PM_LDH(hvo, so); hb2[k] = PM_LDH(hvo, so + 16u); }
#pragma unroll
                      for (int k = 0; k < 4; ++k) { const int m = wave + 8 * (kb + k); float f[8], y[8];
                          const f32x4 x0 = __builtin_bit_cast(f32x4, ha[k]), x1 = __builtin_bit_cast(f32x4, hb2[k]); f[0] = x0.x; f[1] = x0.y; f[2] = x0.z; f[3] = x0.w; f[4] = x1.x; f[5] = x1.y; f[6] = x1.z; f[7] = x1.w;
                          const v4u yq = *(const LAS v4u*)(lds + PA + m * 1040 + ch * 16); PM_UNPK(yq, y);
                          v4u o; o.x = pk2(f[0] + gv0.x * y[0], f[1] + gv0.y * y[1]); o.y = pk2(f[2] + gv0.z * y[2], f[3] + gv0.w * y[3]); o.z = pk2(f[4] + gv1.x * y[4], f[5] + gv1.y * y[5]); o.w = pk2(f[6] + gv1.z * y[6], f[7] + gv1.w * y[7]);
                          __builtin_amdgcn_raw_buffer_store_b128(o, rsO, ovo, (unsigned)(r0 + m) * (DM * 2u), 0); }
                  }
              } else {
                  (void)hvo;
#pragma unroll
                  for (int kk = 0; kk < 8; ++kk) { const int m = wave + 8 * kk; float f[8], y[8]; PM_UNPK(hk[kk], f);
                      const v4u yq = *(const LAS v4u*)(lds + PA + m * 1040 + ch * 16); PM_UNPK(yq, y);
                      v4u o; o.x = pk2(f[0] + gv0.x * y[0], f[1] + gv0.y * y[1]); o.y = pk2(f[2] + gv0.z * y[2], f[3] + gv0.w * y[3]); o.z = pk2(f[4] + gv1.x * y[4], f[5] + gv1.y * y[5]); o.w = pk2(f[6] + gv1.z * y[6], f[7] + gv1.w * y[7]);
                      __builtin_amdgcn_raw_buffer_store_b128(o, rsO, ovo, (unsigned)(r0 + m) * (DM * 2u), 0);
                      if (U2) { float e[8]; PM_UNPK(o, e);
                          const float s2 = wave_sum(((e[0] * e[0] + e[1] * e[1]) + (e[2] * e[2] + e[3] * e[3])) + ((e[4] * e[4] + e[5] * e[5]) + (e[6] * e[6] + e[7] * e[7])));
                          if (lane == 0) rowss[m] = (g ? rowss[m] : 0.f) + s2; } }
              }
            }
            __syncthreads();
        }
        if (U2) {
            const __amdgpu_buffer_rsrc_t rsU = __builtin_amdgcn_make_buffer_rsrc((void*)U2, (short)0, M * DM * 2, 0x00020000);
            const float* sh2 = shift2 + (size_t)b * ADA_W; const float* sc2 = scale2 + (size_t)b * ADA_W;
            f32x4 mul[8], add[8];
#pragma unroll
            for (int j = 0; j < 8; ++j) { const int col = 8 * lane + 512 * (j >> 1) + 4 * (j & 1); const f32x4 gv = *(const GAS f32x4*)(g2 + col), s = *(const GAS f32x4*)(sc2 + col); mul[j] = gv * (s + 1.0f); add[j] = *(const GAS f32x4*)(sh2 + col); }
#pragma unroll 1
            for (int kb = 0; kb < 8; kb += 2) {
                v4u q[2][4]; float rs2[2];
#pragma unroll
                for (int z = 0; z < 2; ++z) { const int m = wave + 8 * (kb + z); rs2[z] = 1.0f / sqrtf(rowss[m] * (1.0f / DM) + EPS);
#pragma unroll
                    for (int j = 0; j < 4; ++j) q[z][j] = __builtin_amdgcn_raw_buffer_load_b128(rsO, (unsigned)lane * 16u + (unsigned)j * 1024u, (unsigned)(r0 + m) * (DM * 2u), 0); }
#pragma unroll
                for (int z = 0; z < 2; ++z) { const int m = wave + 8 * (kb + z); const float rstd = rs2[z];
#pragma unroll
                    for (int j = 0; j < 4; ++j) { float e[8]; PM_UNPK(q[z][j], e);
                        const f32x4 v0 = {e[0], e[1], e[2], e[3]}, v1 = {e[4], e[5], e[6], e[7]};
                        const f32x4 y0 = v0 * rstd * mul[2 * j] + add[2 * j], y1 = v1 * rstd * mul[2 * j + 1] + add[2 * j + 1];
                        v4u w; w.x = pk2(y0.x, y0.y); w.y = pk2(y0.z, y0.w); w.z = pk2(y1.x, y1.y); w.w = pk2(y1.z, y1.w);
                        __builtin_amdgcn_raw_buffer_store_b128(w, rsU, (unsigned)lane * 16u + (unsigned)j * 1024u, (unsigned)(r0 + m) * (DM * 2u), 0); } }
            }
        }
    }
#undef PM_OFFP
#undef PM_OFFW
#undef PM_LDH
#undef PM_UNPK
}

constexpr int NSUB = 6, PH_FINAL = 1 + NSUB * 2 * DEPTH, PH_END = PH_FINAL + 1;
__host__ __device__ constexpr bool phase_exists(int ph) {
    if (ph == 0 || ph == PH_FINAL) return true;
    const int hl = (ph - 1) / NSUB, s = (ph - 1) % NSUB, layer = hl >> 1;
    if (!(hl & 1) && layer % 3 == 0) return s == 1;
    if ((hl & 1) && layer % 3 == 0 && s == 0) return false;
    if (s == 2) return false;
    if (s == 3 || s == 4) return !(hl & 1) && (layer == 1 || layer == 2);
    return true;
}
__global__ void __launch_bounds__(NWAVES * 64, 2) trunk_fwd(Args a) {
    extern __shared__ __attribute__((aligned(16))) unsigned char lds_raw[];
    LAS unsigned char* lds = (LAS unsigned char*)lds_raw;
    volatile LAS unsigned* MISC = (volatile LAS unsigned*)(lds + MISC_OFF);
    const int G = gridDim.x; const int bx = blockIdx.x; const int vcu = (G % 8 == 0) ? (bx % 8) * (G / 8) + bx / 8 : bx;
    const int NGW = G * NWAVES;
    gu32* ctl = (gu32*)(a.ws + WS_CTL);
    const int wave0 = __builtin_amdgcn_readfirstlane((int)threadIdx.x >> 6);
    for (int u = (int)__builtin_amdgcn_mbcnt_hi(~0u, __builtin_amdgcn_mbcnt_lo(~0u, 0u)) + 64 * wave0; u < (LDS_BYTES - LDSCTL_OFF) / 4; u += NWAVES * 64) ((LAS unsigned*)(lds + LDSCTL_OFF))[u] = 0u;
    __syncthreads();
#define PHASE_IDS() const CAS Args* ap = (const CAS Args*)__builtin_amdgcn_kernarg_segment_ptr(); asm volatile("" : "+s"(ap)); unsigned char* ws = ap->ws; int lane = (int)__builtin_amdgcn_mbcnt_hi(~0u, __builtin_amdgcn_mbcnt_lo(~0u, 0u)); asm volatile("" : "+v"(lane)); const int wave = wave0, tid = wave * 64 + lane, gw = vcu * NWAVES + wave; (void)tid; (void)gw
#if MK_ONE_LAUNCH
    XcdBarrier bar = xcd_barrier_post((unsigned*)(ctl + CW_BAR), MISC + 8, wave0);
#define GRID_BAR() xcd_barrier(bar, wave0)
#else
#define GRID_BAR() do { } while (0)
#endif
    const int lo = a.ph_lo, hi = a.ph_hi;
#define IN(k) (lo <= (k) && (k) < hi)
#define ada ((float*)(ws + WS_ADA))
#define U ((bf16*)(ws + WS_U))
#define Pb ((bf16*)(ws + WS_P))
#define PROJ ((bf16*)(ws + WS_PROJ))
#define O ((bf16*)(ws + WS_O))
#define HQD ((bf16*)(ws + WS_PROJ + 256 * MiB))
#define HKI ((bf16*)(ws + WS_PROJ + 320 * MiB))
#define HKE ((bf16*)(ws + WS_P + 64 * MiB))
#define HDEC ((float*)(ws + WS_O + 128 * MiB))
#define HVV ((bf16*)(ws + WS_O + 136 * MiB))
#define H ((bf16*)(ws + (hl >= 7 ? WS_H2 : WS_H)))
#define HPOOL_OUT ((bf16*)(ws + (hl >= 6 ? WS_H2 : WS_H)))

    if (IN(0)) for (int rep = 0; rep < REP_P0; ++rep) { PHASE_IDS(); phase_prologue(ap, lds, tid, lane, wave, vcu, G); GRID_BAR(); }

    for (int hl = 0; hl < 2 * DEPTH; ++hl) {
        const int layer = hl >> 1, isffn = hl & 1, pb = 1 + NSUB * hl;
        const int kind = layer % 3, jj = layer / 3;
#define ada_l (ada + (size_t)layer * NB * ADA_W)
#define hin_is_x (hl == 0)
        if ((kind != 0) && IN(pb + 0)) for (int rep = 0; rep < REP_S0; ++rep) {
            PHASE_IDS();
            if (hin_is_x) phase_normmod(ap->x, ap->norm_mix_g, ada_l, ada_l + DM, U, gw, NGW, lane);
            else phase_normmod_bf(H, (isffn ? ap->norm_ffn_g : ap->norm_mix_g) + (size_t)layer * DM, ada_l + (isffn ? 3 : 0) * DM, ada_l + (isffn ? 4 : 1) * DM, U, gw, NGW, lane);
            GRID_BAR();
        }
        if (IN(pb + 1)) for (int rep = 0; rep < REP_S1; ++rep) {
            PHASE_IDS();
            if (isffn) {
                pg8::Gemm g{U, (const bf16*)(ws + WS_FFWIN) + (size_t)layer * FF2 * DM, M, FF2, DM, DM, DM, FF2 / 256, 0, 0};
                pg8::StaticOrder S; S.init(M, FF2, G, bx);
                pg8::EpiSwiGLU E{PROJ, FF};
                pg8::gemm_phase<pg8::EpiSwiGLU, pg8::StaticOrder, true>(lds + RING_OFF, g, S, E, tid);
            } else if (kind == 0) {
                phase_poolmix<false>(hin_is_x ? (const void*)(ws + WS_H2) : (const void*)H, hin_is_x ? (const float*)(ws + WS_XRS) : (const float*)nullptr, HPOOL_OUT,
                                     ap->norm_mix_g + (size_t)layer * DM, ada_l, ap->pool_scale + (size_t)jj * DM, (const bf16*)(ws + WS_POOLW) + (size_t)jj * 4 * 512 * 512,
                                     ap->norm_ffn_g + (size_t)layer * DM, ada_l + 3 * DM, ada_l + 4 * DM, U, lds, tid, vcu, G);
            } else {
                const int N = (kind == 1) ? HG_IN : RT_IN;
                pg8::Gemm g{U, (const bf16*)(ws + (kind == 1 ? WS_HGWIN : WS_RTWIN)), M, N, DM, DM, DM, N / 256, 0, 0};
                pg8::StaticOrder S; S.init(M, N, G, bx);
                const float* rot = (const float*)(ws + WS_ROT);
                pg8::EpiBf16Rot E{PROJ, N, rot, rot + (size_t)M * 128, kind == 2 ? 16 : 0, kind == 1 ? 16 : 0, (const float*)(ws + WS_LB), HQD, HKI, HKE, HDEC, HVV};
                pg8::gemm_phase<pg8::EpiBf16Rot, pg8::StaticOrder, true>(lds + RING_OFF, g, S, E, tid);
            }
            GRID_BAR();
        }
        if (0) for (int rep = 0; rep < REP_S2; ++rep) {
            PHASE_IDS();
            phase_hgrn_pre(PROJ, (const float*)(ws + WS_LB), HQD, HKI, HKE, HDEC, gw * 64 + lane, NGW * 64);
            GRID_BAR();
        }
        if (!isffn && kind != 0 && IN(pb + 3)) for (int rep = 0; rep < REP_S2; ++rep) {
            PHASE_IDS();
#if NAIVE_SCANS
            if (kind == 1) phase_hgrn_scan_naive(PROJ, (const float*)(ws + WS_LB), O, lds, tid, vcu, G);
            else phase_ret_scan_naive(PROJ, (const float*)(ws + WS_ROT), O, lds, tid, vcu, G);
#else
            if (kind == 1) { if ((vcu & 1) && G >= 2) phase_convert_late_tiles(ap, lds, lane, wave, vcu >> 1, G >> 1);
                             else phase_hgrn_scan(HVV, HQD, HKI, HKE, HDEC, O, lds, tid, G >= 2 ? (vcu >> 1) : vcu, G >= 2 ? ((G + 1) >> 1) : 1); }
            else phase_ret_scan(PROJ, O, lds, tid, vcu, G);
#endif
            GRID_BAR();
        }
        if (!isffn && kind != 0 && IN(pb + 4)) for (int rep = 0; rep < REP_S3; ++rep) {
            PHASE_IDS();
            if (kind == 1) phase_hgrn_post(O, PROJ, ap->hgrn_norm_g, Pb, gw, NGW, lane);
            else phase_ret_post(O, PROJ, ap->ret_norm_g, Pb, gw, NGW, lane);
            GRID_BAR();
        }
        if ((isffn || kind != 0) && IN(pb + 5)) {
            PHASE_IDS();
            pg8::Gemm g;
            const float* cs = nullptr;
            if (isffn) g = pg8::Gemm{PROJ, (const bf16*)(ws + WS_FFWOUT) + (size_t)layer * DM * FF, M, DM, FF, FF, FF, DM / 256, 0, 0};
            else if (kind == 0) { g = pg8::Gemm{Pb, (const bf16*)(ws + WS_POOLW) + (size_t)jj * 4 * 512 * 512, M, DM, 512, DM, 512, 2, 512, 512 * 512}; cs = ap->pool_scale + (size_t)jj * DM; }
            else if (kind == 1) g = pg8::Gemm{Pb, (const bf16*)(ws + WS_HGWOUT), M, DM, DM, DM, DM, DM / 256, 0, 0};
            else g = pg8::Gemm{Pb, (const bf16*)(ws + WS_RTWOUT), M, DM, RT_V, RT_V, RT_V, DM / 256, 0, 0};
            pg8::StaticOrder S; S.init(M, DM, G, bx);
            pg8::EpiResid E{hin_is_x ? ap->x : (const float*)nullptr, H, H, ada_l + (isffn ? 5 : 2) * DM, ADA_W, cs};
            pg8::gemm_phase<pg8::EpiResid, pg8::StaticOrder, true>(lds + RING_OFF, g, S, E, tid);
            GRID_BAR();
        }
    }
    if (IN(PH_FINAL)) { PHASE_IDS(); phase_finalnorm_bf((const bf16*)(ws + WS_H2), ap->final_g, ap->out, gw, NGW, lane); }
#undef IN
#undef ada
#undef U
#undef Pb
#undef PROJ
#undef O
#undef HQD
#undef HKI
#undef HKE
#undef HDEC
#undef HVV
#undef H
#undef HPOOL_OUT
#undef ada_l
#undef hin_is_x
}

extern "C" void kernel_launch(void* const* d_in, const int* in_sizes, int n_in, void* d_out, int out_size, void* d_ws, size_t ws_size, hipStream_t stream) {
    static int grid = 0;
    if (grid == 0) {
        if (n_in != 19 || in_sizes[0] != M * DM || out_size != M * DM || ws_size < WS_END) { fprintf(stderr, "kernel_launch: unexpected shapes (n_in %d, in0 %d, out %d, ws %zu < %zu); nothing launched\n", n_in, n_in > 0 ? in_sizes[0] : -1, out_size, ws_size, (size_t)WS_END); grid = -1; return; }
        int dev = 0, cus = 0, per_cu = 0;
        if (hipGetDevice(&dev) != hipSuccess || hipDeviceGetAttribute(&cus, hipDeviceAttributeMultiprocessorCount, dev) != hipSuccess) { grid = -1; return; }
        if (hipFuncSetAttribute((const void*)trunk_fwd, hipFuncAttributeMaxDynamicSharedMemorySize, LDS_BYTES) != hipSuccess) { fprintf(stderr, "kernel_launch: hipFuncSetAttribute failed\n"); grid = -1; return; }
        if (hipOccupancyMaxActiveBlocksPerMultiprocessor(&per_cu, (const void*)trunk_fwd, NWAVES * 64, LDS_BYTES) != hipSuccess || per_cu < 1)
            fprintf(stderr, "kernel_launch: note: occupancy query reports %d workgroups per CU\n", per_cu);
        (void)hipGetLastError();
        grid = cus;
    }
    if (grid < 0) return;
    if (hipMemsetAsync((char*)d_ws + WS_CTL, 0, CTL_ZERO_BYTES, stream) != hipSuccess) { fprintf(stderr, "kernel_launch: memset failed\n"); return; }
    Args a{};
    a.x = (const float*)d_in[0]; a.c = (const float*)d_in[1]; a.pos = (const int*)d_in[2]; a.w_ada = (const float*)d_in[3]; a.b_ada = (const float*)d_in[4];
    a.norm_mix_g = (const float*)d_in[5]; a.norm_ffn_g = (const float*)d_in[6]; a.pool_w = (const float*)d_in[7]; a.pool_scale = (const float*)d_in[8];
    a.hgrn_w_in = (const float*)d_in[9]; a.hgrn_lb = (const float*)d_in[10]; a.hgrn_norm_g = (const float*)d_in[11]; a.hgrn_w_out = (const float*)d_in[12];
    a.ret_w_in = (const float*)d_in[13]; a.ret_norm_g = (const float*)d_in[14]; a.ret_w_out = (const float*)d_in[15]; a.ffn_w_in = (const float*)d_in[16];
    a.ffn_w_out = (const float*)d_in[17]; a.final_g = (const float*)d_in[18];
    a.out = (float*)d_out; a.ws = (unsigned char*)d_ws;
#if MK_ONE_LAUNCH
    a.ph_lo = 0; a.ph_hi = PH_END;
    hipLaunchKernelGGL(trunk_fwd, dim3(grid), dim3(NWAVES * 64), LDS_BYTES, stream, a);
    { const hipError_t le = hipPeekAtLastError(); if (le != hipSuccess) fprintf(stderr, "kernel_launch: launch failed: %s\n", hipGetErrorName(le)); }
#else
    for (int ph = 0; ph < PH_END; ++ph) {
        if (!phase_exists(ph)) continue;
        a.ph_lo = ph; a.ph_hi = ph + 1;
        hipLaunchKernelGGL(trunk_fwd, dim3(grid), dim3(NWAVES * 64), LDS_BYTES, stream, a);
        const hipError_t le = hipPeekAtLastError();
        if (le != hipSuccess) { fprintf(stderr, "kernel_launch: launch %d failed: %s\n", ph, hipGetErrorName(le)); break; }
    }
#endif
}
```

```cpp
#include <hip/hip_runtime.h>
#include <cstdio>
#include <cstdint>

#ifndef MK_ONE_LAUNCH
#define MK_ONE_LAUNCH 1
#endif
#define REP_S0 1
#define REP_S1 1
#define REP_S2 1
#define REP_S3 1
#define REP_P0 1
#define NAIVE_SCANS 0

constexpr int DM = 2048, NB = 4, SEQ = 4096, DEPTH = 4, M = NB * SEQ;
constexpr int ADA_W = 6 * DM;
constexpr int HG_IN = 8192, HG_H = 16, HG_DK = 128;
constexpr int RT_IN = 12288, RT_H = 8, RT_DK = 256, RT_DV = 512, RT_V = 4096;
constexpr int FF = 5632, FF2 = 2 * FF;
constexpr float EPS = 1e-6f;

namespace pg8 {
#define PG8_LAS __attribute__((address_space(3)))
typedef unsigned short bf16_t;
typedef short bf16x8 __attribute__((ext_vector_type(8)));
typedef float f32x4 __attribute__((ext_vector_type(4)));
typedef unsigned u32x4 __attribute__((ext_vector_type(4)));
constexpr int BM = 256, BK = 64, HALF = 128, HTB = HALF * BK * 2  , STAGE_BYTES = 8 * HTB, NXCD = 8, WGM = 4;

__host__ __device__ __forceinline__ int lds_byte(int r, int c) { const int st = (r >> 4) * 2 + (c >> 5), rr = r & 15, cc = c & 31, ob = rr * 64 + cc * 2; return st * 1024 + (ob ^ (((ob >> 9) & 1) << 5)); }
__host__ __device__ __forceinline__ void stage_rc(int b, int& R, int& C) { const int st = b / 1024, sb = b % 1024, swz = sb ^ (((sb >> 9) & 1) << 5); R = (st >> 1) * 16 + swz / 64; C = (st & 1) * 32 + (swz % 64) / 2; }
__host__ __device__ __forceinline__ int perm32(int rho) { const int n = rho >> 4, i = rho & 15; return 8 * (i >> 2) + 4 * n + (i & 3); }

struct Unit { int pm, pn; };
struct Gemm { const bf16_t* A; const bf16_t* Bt; int M, N, K, lda, ldb, gpn; long a_gs, b_gs; };

struct StaticOrder {
    int nM, nN, nwg, G, c;
    __host__ __device__ void init(int M_, int N_, int G_, int c_) { nM = M_ / BM; nN = N_ / BM; nwg = nM * nN; G = G_; c = c_; }
    __host__ __device__ bool next(int i, Unit& u) const {
        const long L = (long)i * G + c; if (L >= nwg) return false;
        int wgid = (int)L; { const int q = nwg / NXCD, r = nwg % NXCD, xcd = wgid % NXCD, off = wgid / NXCD; wgid = (xcd < r ? xcd * (q + 1) : r * (q + 1) + (xcd - r) * q) + off; }
        const int nig = WGM * nN, gid = wgid / nig, fm = gid * WGM, gsz = (nM - fm) < WGM ? (nM - fm) : WGM;
        u.pm = fm + ((wgid % nig) % gsz); u.pn = (wgid % nig) / gsz; return true;
    }
    __device__ __forceinline__ void a_ready(const Unit&) const {}
    __device__ __forceinline__ void done(const Unit&) const {}
};

__device__ __forceinline__ unsigned cvt_pk_bf16(float lo, float hi) { unsigned r; asm volatile("v_cvt_pk_bf16_f32 %0, %1, %2" : "=v"(r) : "v"(lo), "v"(hi)); return r; }

struct EpiBf16 {
    static constexpr bool PERM = true, AFTER_DRAIN = false;
    bf16_t* O; int ldc;
    __device__ __forceinline__ void operator()(const f32x4 (&acc)[2][2][4][2], const Unit& u, int wr, int wc, int fr, int fq) const {
        const int row0 = u.pm * BM + wr * 64 + fr, col0 = u.pn * BM + wc * 32 + 8 * fq;
#pragma unroll
        for (int ai = 0; ai < 2; ++ai)
#pragma unroll
            for (int m = 0; m < 4; ++m) { bf16_t* rowp = O + (size_t)(row0 + ai * HALF + m * 16) * ldc + col0;
#pragma unroll
                for (int bj = 0; bj < 2; ++bj) { const f32x4 v0 = acc[ai][bj][m][0], v1 = acc[ai][bj][m][1];
                    u32x4 w; w.x = cvt_pk_bf16(v0[0], v0[1]); w.y = cvt_pk_bf16(v0[2], v0[3]); w.z = cvt_pk_bf16(v1[0], v1[1]); w.w = cvt_pk_bf16(v1[2], v1[3]);
                    *(u32x4*)(rowp + bj * HALF) = w; } }
    }
};
__device__ __forceinline__ float scan16_mul(float x) {
#define PG8_DPP_SHR(v, n) __builtin_bit_cast(float, __builtin_amdgcn_update_dpp(0x3f800000, __builtin_bit_cast(int, v), 0x110 + (n), 0xf, 0xf, false))
    x *= PG8_DPP_SHR(x, 1); x *= PG8_DPP_SHR(x, 2); x *= PG8_DPP_SHR(x, 4); x *= PG8_DPP_SHR(x, 8);
#undef PG8_DPP_SHR
    return x;
}
__device__ __forceinline__ float bcast15(float x, int lane) { (void)lane; return __builtin_bit_cast(float, __builtin_amdgcn_update_dpp(0, __builtin_bit_cast(int, x), 0x15F, 0xf, 0xf, false)); }
__device__ __forceinline__ float sigm_f(float x) { return __builtin_amdgcn_rcpf(1.0f + __builtin_amdgcn_exp2f(-1.4426950408889634f * x)); }
struct EpiBf16Rot {
    static constexpr bool PERM = true, AFTER_DRAIN = false;
    bf16_t* O; int ldc; const float* ct; const float* st; int rot_tiles;
    int hg_tiles; const float* lbv; bf16_t* QD; bf16_t* KI; bf16_t* KE; float* DEC; bf16_t* HV;
    __device__ __forceinline__ void operator()(const f32x4 (&acc)[2][2][4][2], const Unit& u, int wr, int wc, int fr, int fq) const {
        const int row0 = u.pm * BM + wr * 64 + fr, col0 = u.pn * BM + wc * 32 + 8 * fq;
        if (u.pn < hg_tiles) {
            const int lane = fq * 16 + fr, cg = u.pn * HALF + wc * 32 + 8 * fq;
            float lb[8];
            { const f32x4 l0 = *(const f32x4*)(lbv + cg), l1 = *(const f32x4*)(lbv + cg + 4);
#pragma unroll
              for (int e = 0; e < 4; ++e) { lb[e] = l0[e]; lb[4 + e] = l1[e]; } }
#pragma unroll
            for (int ai = 0; ai < 2; ++ai)
#pragma unroll
                for (int mp = 0; mp < 2; ++mp) {
                    float qd0[8], ki0[8], ke0[8], qd1[8], ki1[8], ke1[8], tot[8];
#pragma unroll
                    for (int c = 0; c < 8; ++c) {
                        const float z0 = acc[ai][1][2 * mp][c >> 2][c & 3], z1 = acc[ai][1][2 * mp + 1][c >> 2][c & 3];
                        const float q0 = acc[ai][0][2 * mp][c >> 2][c & 3], q1 = acc[ai][0][2 * mp + 1][c >> 2][c & 3];
                        const float s0 = sigm_f(z0), s1 = sigm_f(z1), om = 1.0f - lb[c];
                        const float e0 = scan16_mul(lb[c] + om * s0);
                        const float e1 = scan16_mul(lb[c] + om * s1) * bcast15(e0, lane);
                        const float tt = bcast15(e1, lane);
                        const float k0 = om * (1.0f - s0) * __builtin_amdgcn_rcpf(e0), k1 = om * (1.0f - s1) * __builtin_amdgcn_rcpf(e1);
                        qd0[c] = q0 * e0; ki0[c] = k0; ke0[c] = k0 * tt; qd1[c] = q1 * e1; ki1[c] = k1; ke1[c] = k1 * tt; tot[c] = tt;
                    }
                    const int rr0 = row0 + ai * HALF + 32 * mp;
                    const size_t r0 = ((size_t)((rr0 >> 12) * 16 + u.pn) * 4096 + (rr0 & 4095)) * 128 + (wc * 32 + 8 * fq), r1 = r0 + 16 * 128;
                    u32x4 w;
                    w.x = cvt_pk_bf16(qd0[0], qd0[1]); w.y = cvt_pk_bf16(qd0[2], qd0[3]); w.z = cvt_pk_bf16(qd0[4], qd0[5]); w.w = cvt_pk_bf16(qd0[6], qd0[7]); *(u32x4*)(QD + r0) = w;
                    w.x = cvt_pk_bf16(ki0[0], ki0[1]); w.y = cvt_pk_bf16(ki0[2], ki0[3]); w.z = cvt_pk_bf16(ki0[4], ki0[5]); w.w = cvt_pk_bf16(ki0[6], ki0[7]); *(u32x4*)(KI + r0) = w;
                    w.x = cvt_pk_bf16(ke0[0], ke0[1]); w.y = cvt_pk_bf16(ke0[2], ke0[3]); w.z = cvt_pk_bf16(ke0[4], ke0[5]); w.w = cvt_pk_bf16(ke0[6], ke0[7]); *(u32x4*)(KE + r0) = w;
                    w.x = cvt_pk_bf16(qd1[0], qd1[1]); w.y = cvt_pk_bf16(qd1[2], qd1[3]); w.z = cvt_pk_bf16(qd1[4], qd1[5]); w.w = cvt_pk_bf16(qd1[6], qd1[7]); *(u32x4*)(QD + r1) = w;
                    w.x = cvt_pk_bf16(ki1[0], ki1[1]); w.y = cvt_pk_bf16(ki1[2], ki1[3]); w.z = cvt_pk_bf16(ki1[4], ki1[5]); w.w = cvt_pk_bf16(ki1[6], ki1[7]); *(u32x4*)(KI + r1) = w;
                    w.x = cvt_pk_bf16(ke1[0], ke1[1]); w.y = cvt_pk_bf16(ke1[2], ke1[3]); w.z = cvt_pk_bf16(ke1[4], ke1[5]); w.w = cvt_pk_bf16(ke1[6], ke1[7]); *(u32x4*)(KE + r1) = w;
                    if (fr == 15) { const int crow = u.pm * BM + wr * 64 + ai * HALF + 32 * mp; float* dp = DEC + ((size_t)((crow >> 12) * 16 + u.pn) * 128 + ((crow & 4095) >> 5)) * 128 + (wc * 32 + 8 * fq);
                        *(f32x4*)dp = (f32x4){tot[0], tot[1], tot[2], tot[3]}; *(f32x4*)(dp + 4) = (f32x4){tot[4], tot[5], tot[6], tot[7]}; }
                }
        } else if (u.pn < rot_tiles) {
            const float sc = u.pn >= 8 ? 0.0625f : 1.0f; const int j0 = wc * 32 + 8 * fq;
#pragma unroll
            for (int ai = 0; ai < 2; ++ai)
#pragma unroll
                for (int m = 0; m < 4; ++m) { const int row = row0 + ai * HALF + m * 16; bf16_t* rowp = O + (size_t)row * ldc + col0;
                    const u32x4 t0 = *(const u32x4*)((const unsigned*)ct + (size_t)row * 128 + j0), t1 = *(const u32x4*)((const unsigned*)ct + (size_t)row * 128 + j0 + 4);
                    f32x4 c0, c1, s0, s1;
#pragma unroll
                    for (int e = 0; e < 4; ++e) { c0[e] = (float)__builtin_bit_cast(_Float16, (unsigned short)(t0[e] & 0xffffu)); s0[e] = (float)__builtin_bit_cast(_Float16, (unsigned short)(t0[e] >> 16));
                        c1[e] = (float)__builtin_bit_cast(_Float16, (unsigned short)(t1[e] & 0xffffu)); s1[e] = (float)__builtin_bit_cast(_Float16, (unsigned short)(t1[e] >> 16)); }
                    const f32x4 a0 = acc[ai][0][m][0], a1 = acc[ai][0][m][1], b0 = acc[ai][1][m][0], b1 = acc[ai][1][m][1];
                    const f32x4 p0 = (a0 * c0 - b0 * s0) * sc, p1 = (a1 * c1 - b1 * s1) * sc, q0 = (a0 * s0 + b0 * c0) * sc, q1 = (a1 * s1 + b1 * c1) * sc;
                    u32x4 w; w.x = cvt_pk_bf16(p0[0], p0[1]); w.y = cvt_pk_bf16(p0[2], p0[3]); w.z = cvt_pk_bf16(p1[0], p1[1]); w.w = cvt_pk_bf16(p1[2], p1[3]);
                    *(u32x4*)rowp = w;
                    w.x = cvt_pk_bf16(q0[0], q0[1]); w.y = cvt_pk_bf16(q0[2], q0[3]); w.z = cvt_pk_bf16(q1[0], q1[1]); w.w = cvt_pk_bf16(q1[2], q1[3]);
                    *(u32x4*)(rowp + HALF) = w; }
        } else {
            const bool hv = hg_tiles > 0 && u.pn < 24;
#pragma unroll
            for (int ai = 0; ai < 2; ++ai)
#pragma unroll
                for (int m = 0; m < 4; ++m) { const int row = row0 + ai * HALF + m * 16; bf16_t* rowp = O + (size_t)row * ldc + col0;
#pragma unroll
                    for (int bj = 0; bj < 2; ++bj) { const f32x4 v0 = acc[ai][bj][m][0], v1 = acc[ai][bj][m][1];
                        u32x4 w; w.x = cvt_pk_bf16(v0[0], v0[1]); w.y = cvt_pk_bf16(v0[2], v0[3]); w.z = cvt_pk_bf16(v1[0], v1[1]); w.w = cvt_pk_bf16(v1[2], v1[3]);
                        if (hv) *(u32x4*)(HV + ((size_t)((row >> 12) * 16 + 2 * (u.pn - 16) + bj) * 4096 + (row & 4095)) * 128 + wc * 32 + 8 * fq) = w;
                        else *(u32x4*)(rowp + bj * HALF) = w; } }
        }
    }
};
__device__ __forceinline__ float silu_f(float x) { return x * __builtin_amdgcn_rcpf(1.0f + __builtin_amdgcn_exp2f(-1.4426950408889634f * x)); }
struct EpiSwiGLU {
    static constexpr bool PERM = true, AFTER_DRAIN = false;
    bf16_t* O; int ldc;
    __device__ __forceinline__ void operator()(const f32x4 (&acc)[2][2][4][2], const Unit& u, int wr, int wc, int fr, int fq) const {
        const int row0 = u.pm * BM + wr * 64 + fr, col0 = u.pn * HALF + wc * 32 + 8 * fq;
#pragma unroll
        for (int ai = 0; ai < 2; ++ai)
#pragma unroll
            for (int m = 0; m < 4; ++m) { bf16_t* rowp = O + (size_t)(row0 + ai * HALF + m * 16) * ldc + col0;
                const f32x4 g0 = acc[ai][0][m][0], g1 = acc[ai][0][m][1], u0 = acc[ai][1][m][0], u1 = acc[ai][1][m][1];
                f32x4 e0 = g0 * -1.4426950408889634f, e1 = g1 * -1.4426950408889634f;
                const f32x4 p0 = g0 * u0, p1 = g1 * u1;
                __builtin_amdgcn_sched_barrier(0);
#pragma unroll
                for (int i = 0; i < 4; ++i) { e0[i] = __builtin_amdgcn_exp2f(e0[i]); e1[i] = __builtin_amdgcn_exp2f(e1[i]); }
                __builtin_amdgcn_sched_barrier(0);
                e0 = e0 + 1.0f; e1 = e1 + 1.0f;
                __builtin_amdgcn_sched_barrier(0);
#pragma unroll
                for (int i = 0; i < 4; ++i) { e0[i] = __builtin_amdgcn_rcpf(e0[i]); e1[i] = __builtin_amdgcn_rcpf(e1[i]); }
                __builtin_amdgcn_sched_barrier(0);
                const f32x4 o0 = p0 * e0, o1 = p1 * e1;
                u32x4 w; w.x = cvt_pk_bf16(o0[0], o0[1]); w.y = cvt_pk_bf16(o0[2], o0[3]); w.z = cvt_pk_bf16(o1[0], o1[1]); w.w = cvt_pk_bf16(o1[2], o1[3]);
                *(u32x4*)rowp = w; }
    }
};
struct EpiResid {
    static constexpr bool PERM = true, AFTER_DRAIN = false;
    const float* xin; const bf16_t* hin; bf16_t* hout; const float* gate; int gate_bs; const float* cscale;
    __device__ __forceinline__ void operator()(const f32x4 (&acc)[2][2][4][2], const Unit& u, int wr, int wc, int fr, int fq) const {
        const int row0 = u.pm * BM + wr * 64 + fr, col0 = u.pn * BM + wc * 32 + 8 * fq;
        const float* gp = gate + (size_t)(u.pm >> 4) * gate_bs + col0;
        f32x4 gv[2][2];
#pragma unroll
        for (int bj = 0; bj < 2; ++bj)
#pragma unroll
            for (int n = 0; n < 2; ++n) { gv[bj][n] = *(const f32x4*)(gp + bj * HALF + n * 4); if (cscale) gv[bj][n] = gv[bj][n] * *(const f32x4*)(cscale + col0 + bj * HALF + n * 4); }
#pragma unroll
        for (int ai = 0; ai < 2; ++ai)
#pragma unroll
            for (int m = 0; m < 4; ++m) { const size_t ro = (size_t)(row0 + ai * HALF + m * 16) * DM + col0;
#pragma unroll
                for (int bj = 0; bj < 2; ++bj) {
                    f32x4 h0, h1;
                    if (xin) { h0 = *(const f32x4*)(xin + ro + bj * HALF); h1 = *(const f32x4*)(xin + ro + bj * HALF + 4); }
                    else { const u32x4 hb = *(const u32x4*)(hin + ro + bj * HALF);
                        h0 = (f32x4){__builtin_bit_cast(float, hb.x << 16), __builtin_bit_cast(float, hb.x & 0xffff0000u), __builtin_bit_cast(float, hb.y << 16), __builtin_bit_cast(float, hb.y & 0xffff0000u)};
                        h1 = (f32x4){__builtin_bit_cast(float, hb.z << 16), __builtin_bit_cast(float, hb.z & 0xffff0000u), __builtin_bit_cast(float, hb.w << 16), __builtin_bit_cast(float, hb.w & 0xffff0000u)}; }
                    const f32x4 o0 = h0 + gv[bj][0] * acc[ai][bj][m][0], o1 = h1 + gv[bj][1] * acc[ai][bj][m][1];
                    u32x4 w; w.x = cvt_pk_bf16(o0[0], o0[1]); w.y = cvt_pk_bf16(o0[2], o0[3]); w.z = cvt_pk_bf16(o1[0], o1[1]); w.w = cvt_pk_bf16(o1[2], o1[3]);
                    *(u32x4*)(hout + ro + bj * HALF) = w; } }
    }
};

template <class Epi, class Sched, bool ALIGN_EPI = false>
__device__ __forceinline__ void gemm_phase(PG8_LAS unsigned char* lds, const Gemm g, const Sched& S, const Epi& E, const int tid) {
    const int wid = __builtin_amdgcn_readfirstlane(tid >> 6), lane = tid & 63, wr = wid >> 2, wc = wid & 3, fr = lane & 15, fq = lane >> 4;
    const int K = g.K, nt = K / BK, lda = g.lda, ldb = g.ldb;
    unsigned voffA[2], voffB[2];
#pragma unroll
    for (int i = 0; i < 2; ++i) { int R, C; stage_rc(tid * 16 + i * 8192, R, C); const int Rb = Epi::PERM ? ((R & ~31) + perm32(R & 31)) : R;
        voffA[i] = (unsigned)(R * lda + C) * 2u; voffB[i] = (unsigned)(Rb * ldb + C) * 2u; }
    const unsigned kstep = (unsigned)(BK * 2);
    const unsigned hstepA = (unsigned)HALF * lda * 2u, hstepB = (unsigned)HALF * ldb * 2u;
    const __amdgpu_buffer_rsrc_t rsA = __builtin_amdgcn_make_buffer_rsrc((void*)g.A, (short)0, 0x7fffffff, 0x00020000), rsB = __builtin_amdgcn_make_buffer_rsrc((void*)g.Bt, (short)0, 0x7fffffff, 0x00020000);
    const unsigned ldsw = (unsigned)wid * 1024u;
    const int aoff = lds_byte(wr * 64 + fr, fq * 8), boff = lds_byte(wc * 32 + fr, fq * 8);
#define PG8_SA(b, h) (((b) * 2 + (h)) * HTB)
#define PG8_SB(b, h) ((4 + (b) * 2 + (h)) * HTB)
#define PG8_STAGEA(bufoff, soff, voff) do { _Pragma("unroll") for (int _i = 0; _i < 2; ++_i) \
        __builtin_amdgcn_raw_ptr_buffer_load_lds(rsA, (PG8_LAS unsigned*)(lds + (bufoff) + ldsw + _i * 8192), 16, (voff)[_i], (soff), 0, 0); } while (0)
#define PG8_STAGEB(bufoff, soff, voff) do { _Pragma("unroll") for (int _i = 0; _i < 2; ++_i) \
        __builtin_amdgcn_raw_ptr_buffer_load_lds(rsB, (PG8_LAS unsigned*)(lds + (bufoff) + ldsw + _i * 8192), 16, (voff)[_i], (soff), 0, 0); } while (0)
#define PG8_LDA(dst, b, h) do { _Pragma("unroll") for (int m = 0; m < 4; ++m) _Pragma("unroll") for (int k = 0; k < 2; ++k) dst[m][k] = *(const PG8_LAS bf16x8*)(lds + PG8_SA(b, h) + aoff + m * 2048 + k * 1024); } while (0)
#define PG8_LDB(dst, b, h) do { _Pragma("unroll") for (int n = 0; n < 2; ++n) _Pragma("unroll") for (int k = 0; k < 2; ++k) dst[n][k] = *(const PG8_LAS bf16x8*)(lds + PG8_SB(b, h) + boff + n * 2048 + k * 1024); } while (0)
#define PG8_MMA(ai, bj, At, Bt) do { __builtin_amdgcn_s_setprio(1); _Pragma("unroll") for (int m = 0; m < 4; ++m) _Pragma("unroll") for (int n = 0; n < 2; ++n) _Pragma("unroll") for (int k = 0; k < 2; ++k) \
        acc[ai][bj][m][n] = __builtin_amdgcn_mfma_f32_16x16x32_bf16(Bt[n][k], At[m][k], acc[ai][bj][m][n], 0, 0, 0); __builtin_amdgcn_s_setprio(0); } while (0)
#define PG8_WAIT_V(n) asm volatile("s_waitcnt vmcnt(" #n ")" ::: "memory")
#define PG8_WAIT_L(n) asm volatile("s_waitcnt lgkmcnt(" #n ")" ::: "memory")
#define PG8_BAR __builtin_amdgcn_s_barrier()
#define PG8_SCHED __builtin_amdgcn_sched_barrier(0)
#define PG8_ABASE(u) ((unsigned)(((size_t)((u).pn / g.gpn) * (size_t)g.a_gs + (size_t)(u).pm * BM * lda) * 2))
#define PG8_BBASE(u) ((unsigned)(((size_t)((u).pn / g.gpn) * (size_t)g.b_gs + (size_t)((u).pn % g.gpn) * BM * ldb) * 2))
    Unit cur, nxt; int ui = 0;
    if (!S.next(0, cur)) return;
    f32x4 acc[2][2][4][2];
#pragma unroll
    for (int a = 0; a < 2; ++a)
#pragma unroll
        for (int b = 0; b < 2; ++b)
#pragma unroll
            for (int m = 0; m < 4; ++m)
#pragma unroll
                for (int n = 0; n < 2; ++n) acc[a][b][m][n] = (f32x4){0.f, 0.f, 0.f, 0.f};
    bf16x8 At[4][2], B0[2][2], B1[2][2];
    unsigned cA = PG8_ABASE(cur), cB = PG8_BBASE(cur);
    S.a_ready(cur);
    PG8_STAGEB(PG8_SB(0, 0), cB, voffB); PG8_STAGEB(PG8_SB(0, 1), cB + hstepB, voffB); PG8_STAGEA(PG8_SA(0, 0), cA, voffA); PG8_STAGEA(PG8_SA(0, 1), cA + hstepA, voffA);
    PG8_STAGEB(PG8_SB(1, 0), cB + kstep, voffB); PG8_STAGEA(PG8_SA(1, 0), cA + kstep, voffA); PG8_STAGEB(PG8_SB(1, 1), cB + hstepB + kstep, voffB);
    if (wr == 1) PG8_BAR;
    PG8_WAIT_V(8); PG8_BAR;
    PG8_WAIT_V(6); PG8_BAR;
    for (;;) {
        const bool has_next = S.next(ui + 1, nxt);
        const unsigned nA = has_next ? PG8_ABASE(nxt) : cA, nB = has_next ? PG8_BBASE(nxt) : cB;
        for (int t = 0; t < nt; t += 2) {
            const bool last = (t == nt - 2);
            const unsigned a1 = cA + (unsigned)(t + 1) * kstep;
            const unsigned a2 = last ? nA : cA + (unsigned)(t + 2) * kstep, b2 = last ? nB : cB + (unsigned)(t + 2) * kstep;
            const unsigned a3 = a2 + kstep, b3 = b2 + kstep;
            if (last && has_next) S.a_ready(nxt);
            PG8_LDB(B0, 0, 0); PG8_LDB(B1, 0, 1); PG8_SCHED; PG8_LDA(At, 0, 0); PG8_STAGEA(PG8_SA(1, 1), a1 + hstepA, voffA);
            PG8_WAIT_V(8); PG8_WAIT_L(0); PG8_BAR; PG8_MMA(0, 0, At, B0); PG8_MMA(0, 1, At, B1); PG8_BAR; PG8_SCHED;
            PG8_LDA(At, 0, 1); PG8_STAGEB(PG8_SB(0, 0), b2, voffB); PG8_STAGEB(PG8_SB(0, 1), b2 + hstepB, voffB); PG8_STAGEA(PG8_SA(0, 0), a2, voffA);
            PG8_WAIT_V(8); PG8_WAIT_L(0); PG8_BAR; PG8_MMA(1, 0, At, B0); PG8_MMA(1, 1, At, B1); PG8_BAR; PG8_SCHED;
            PG8_LDB(B0, 1, 0); PG8_LDB(B1, 1, 1); PG8_SCHED; PG8_LDA(At, 1, 0); PG8_STAGEA(PG8_SA(0, 1), a2 + hstepA, voffA);
            PG8_WAIT_V(8); PG8_WAIT_L(0); PG8_BAR; PG8_MMA(0, 0, At, B0); PG8_MMA(0, 1, At, B1); PG8_BAR; PG8_SCHED;
            PG8_LDA(At, 1, 1); PG8_STAGEB(PG8_SB(1, 0), b3, voffB); PG8_STAGEB(PG8_SB(1, 1), b3 + hstepB, voffB); PG8_STAGEA(PG8_SA(1, 0), a3, voffA);
            PG8_WAIT_V(8); PG8_WAIT_L(0); PG8_BAR; PG8_MMA(1, 0, At, B0); PG8_MMA(1, 1, At, B1); PG8_BAR; PG8_SCHED;
        }
        if constexpr (ALIGN_EPI) { if (wr == 0) PG8_BAR; }
        E(acc, cur, wr, wc, fr, fq); S.done(cur);
        if (!has_next) break;
#pragma unroll
        for (int a = 0; a < 2; ++a)
#pragma unroll
            for (int b = 0; b < 2; ++b)
#pragma unroll
                for (int m = 0; m < 4; ++m)
#pragma unroll
                    for (int n = 0; n < 2; ++n) acc[a][b][m][n] = (f32x4){0.f, 0.f, 0.f, 0.f};
        cur = nxt; cA = nA; cB = nB; ++ui;
        if constexpr (ALIGN_EPI) { if (wr == 1) PG8_BAR; }
    }
    PG8_WAIT_V(0);
    if constexpr (!ALIGN_EPI) { if (wr == 0) PG8_BAR; }
    PG8_BAR;
#undef PG8_SA
#undef PG8_SB
#undef PG8_STAGEA
#undef PG8_STAGEB
#undef PG8_LDA
#undef PG8_LDB
#undef PG8_MMA
#undef PG8_WAIT_V
#undef PG8_WAIT_L
#undef PG8_BAR
#undef PG8_SCHED
#undef PG8_ABASE
#undef PG8_BBASE
}
}

constexpr size_t MiB = 1u << 20;
constexpr size_t WS_CTL = 0, CTL_ZERO_BYTES = 1 * MiB;
constexpr size_t WS_ADA = 1 * MiB;
constexpr size_t WS_LB = 2 * MiB;
constexpr size_t WS_XRS = 3 * MiB;
constexpr size_t WS_ROT = 4 * MiB;
constexpr size_t WS_POOLW = 20 * MiB;
constexpr size_t WS_HGWIN = 24 * MiB;
constexpr size_t WS_HGWOUT = 56 * MiB;
constexpr size_t WS_RTWIN = 64 * MiB;
constexpr size_t WS_RTWOUT = 112 * MiB;
constexpr size_t WS_FFWIN = 128 * MiB;
constexpr size_t WS_FFWOUT = 304 * MiB;
constexpr size_t WS_U = 392 * MiB;
constexpr size_t WS_P = 456 * MiB;
constexpr size_t WS_PROJ = 584 * MiB;
constexpr size_t WS_O = 968 * MiB;
constexpr size_t WS_H = 1224 * MiB;
constexpr size_t WS_H2 = 1288 * MiB;
constexpr size_t WS_END = 1352 * MiB;
constexpr int CW_TMO = 0, CW_CODE = 1, CW_BAR = 4096;

constexpr int RING_OFF = 0, RING_BYTES = 131072;
constexpr int LDSCTL_OFF = RING_BYTES, MISC_OFF = LDSCTL_OFF + 320;
constexpr int LDS_BYTES = 147456;
constexpr int NWAVES = 8;

#define GAS __attribute__((address_space(1)))
#define LAS __attribute__((address_space(3)))
#define CAS __attribute__((address_space(4)))
typedef unsigned short bf16;
typedef unsigned v4u __attribute__((ext_vector_type(4)));
typedef unsigned v2u __attribute__((ext_vector_type(2)));
typedef float f32x4 __attribute__((ext_vector_type(4)));
typedef GAS unsigned gu32;
#define RLX_AGENT __ATOMIC_RELAXED, __HIP_MEMORY_SCOPE_AGENT
#define LDS_WAIT() asm volatile("s_waitcnt lgkmcnt(0)" ::: "memory")
__device__ __forceinline__ unsigned f2bf(float f) { unsigned u = __builtin_bit_cast(unsigned, f); return (u + 0x7fffu + ((u >> 16) & 1u)) >> 16; }
typedef float pk_f2 __attribute__((ext_vector_type(2)));
typedef __bf16 pk_b2 __attribute__((ext_vector_type(2)));
__device__ __forceinline__ unsigned pk2(float lo, float hi) { const pk_f2 v = {lo, hi}; return __builtin_bit_cast(unsigned, __builtin_convertvector(v, pk_b2)); }
__device__ __forceinline__ float bflo(unsigned w) { return __builtin_bit_cast(float, w << 16); }
__device__ __forceinline__ float bfhi(unsigned w) { return __builtin_bit_cast(float, w & 0xffff0000u); }
__device__ __forceinline__ float bf1(bf16 b) { return __builtin_bit_cast(float, (unsigned)b << 16); }
__device__ __forceinline__ float sigmoid_f(float x) { return __builtin_amdgcn_rcpf(1.0f + __builtin_amdgcn_exp2f(-1.4426950408889634f * x)); }
__device__ __forceinline__ float silu1(float x) { return x * sigmoid_f(x); }

#define XB_TMO      128
#define XB_XCNT(j)  (256  + 64 * (j))
#define XB_XSUB(j)  (1280 + 64 * (j))
#define XB_XGEN(j)  (2304 + 64 * (j))
#define XB_TOP      3328
#define XB_TOPGEN   3392
#define XCD_BAR_WORDS 3456
#define XB_SPIN_CAP (1u << 18)

__device__ __forceinline__ unsigned xb_ld(unsigned* p)              { return __hip_atomic_load(p, __ATOMIC_RELAXED, __HIP_MEMORY_SCOPE_AGENT); }
__device__ __forceinline__ unsigned xb_add(unsigned* p, unsigned v) { return __hip_atomic_fetch_add(p, v, __ATOMIC_RELAXED, __HIP_MEMORY_SCOPE_AGENT); }
__device__ __forceinline__ unsigned xb_xcc_id() { return (unsigned)__builtin_amdgcn_s_getreg((3 << 11) | 20) & 0xFu; }
#define XB_SPIN(cond, bar) do { unsigned _sp = 0; while (cond) { __builtin_amdgcn_s_sleep(1); \
    if ((++_sp & 255u) == 0u) { if (xb_ld(&(bar)[XB_TMO])) break; if (_sp > XB_SPIN_CAP) { atomicAdd(&(bar)[XB_TMO], 1u); break; } } } } while (0)

struct XcdBarrier { unsigned* bar; unsigned x; volatile LAS unsigned* st; };
#define XB_TID() ((int)__builtin_amdgcn_mbcnt_hi(~0u, __builtin_amdgcn_mbcnt_lo(~0u, 0u)) + 64 * xb_wave_id)

__device__ __forceinline__ XcdBarrier xcd_barrier_post(unsigned* bar, volatile LAS unsigned* st, const int xb_wave_id) {
    XcdBarrier b; b.bar = bar; b.x = xb_xcc_id(); b.st = st;
    if (XB_TID() == 0) (void)xb_add(&bar[XB_XCNT(b.x)], 1u);
    return b;
}
__device__ __forceinline__ void xcd_barrier_complete(unsigned* bar, unsigned x, unsigned& nloc, unsigned& nx) {
    const unsigned G = gridDim.x * gridDim.y * gridDim.z;
    unsigned sum, cnt, mine, sp = 0u;
    for (;;) {
        sum = 0u; cnt = 0u; mine = 0u;
#pragma unroll
        for (unsigned j = 0; j < 16; ++j) { const unsigned c = xb_ld(&bar[XB_XCNT(j)]); sum += c; cnt += (c > 0u) ? 1u : 0u; mine = (j == x) ? c : mine; }
        if (sum == G) break;
        __builtin_amdgcn_s_sleep(1);
        if ((++sp & 255u) == 0u) { if (xb_ld(&bar[XB_TMO])) break; if (sp > XB_SPIN_CAP) { atomicAdd(&bar[XB_TMO], 1u); break; } }
    }
    nloc = mine > 0u ? mine : 1u; nx = cnt > 0u ? cnt : 1u;
}
__device__ __forceinline__ void xcd_barrier(const XcdBarrier& b, const int xb_wave_id) {
    asm volatile("s_waitcnt vmcnt(0)" ::: "memory");
    __syncthreads();
    if (XB_TID() == 0) {
        unsigned* bar = b.bar;
        __builtin_amdgcn_s_waitcnt(0);
        unsigned nloc = b.st[0], nx = b.st[1];
        if (nloc == 0u) { xcd_barrier_complete(bar, b.x, nloc, nx); b.st[0] = nloc; b.st[1] = nx; }
        const unsigned old = xb_add(&bar[XB_XSUB(b.x)], 1u);
        const unsigned gen = old / nloc;
        if (old + 1u == (gen + 1u) * nloc) {
            __builtin_amdgcn_fence(__ATOMIC_RELEASE, "agent");
            asm volatile("s_waitcnt vmcnt(0)" ::: "memory");
            const unsigned og = xb_add(&bar[XB_TOP], 1u);
            const unsigned tg = og / nx;
            if (og + 1u == (tg + 1u) * nx) xb_add(&bar[XB_TOPGEN], 1u);
            else XB_SPIN(xb_ld(&bar[XB_TOPGEN]) == tg, bar);
            __builtin_amdgcn_fence(__ATOMIC_ACQUIRE, "agent");
            xb_add(&bar[XB_XGEN(b.x)], 1u);
            asm volatile("s_waitcnt vmcnt(0)" ::: "memory");
        } else {
            XB_SPIN(xb_ld(&bar[XB_XGEN(b.x)]) == gen, bar);
            __builtin_amdgcn_fence(__ATOMIC_ACQUIRE, "agent");
            asm volatile("s_waitcnt vmcnt(0)" ::: "memory");
        }
    }
    __syncthreads();
}

struct Args {
    const float* x; const float* c; const int* pos; const float* w_ada; const float* b_ada; const float* norm_mix_g; const float* norm_ffn_g;
    const float* pool_w; const float* pool_scale; const float* hgrn_w_in; const float* hgrn_lb; const float* hgrn_norm_g; const float* hgrn_w_out;
    const float* ret_w_in; const float* ret_norm_g; const float* ret_w_out; const float* ffn_w_in; const float* ffn_w_out; const float* final_g;
    float* out; unsigned char* ws; int ph_lo, ph_hi;
};

#define WS_DPP(v, ctrl) __builtin_bit_cast(float, __builtin_amdgcn_update_dpp(0, __builtin_bit_cast(int, v), (ctrl), 0xf, 0xf, true))
__device__ __forceinline__ float row16_sum(float v) { v += WS_DPP(v, 0xB1); v += WS_DPP(v, 0x4E); v += WS_DPP(v, 0x141); v += WS_DPP(v, 0x140); return v; }
#define WS_RL(v, l) __builtin_bit_cast(float, __builtin_amdgcn_readlane(__builtin_bit_cast(int, v), (l)))
__device__ __forceinline__ float wave_sum(float v) { v = row16_sum(v); return (WS_RL(v, 0) + WS_RL(v, 16)) + (WS_RL(v, 32) + WS_RL(v, 48)); }
__device__ __forceinline__ float half_sum(float v) {
    v = row16_sum(v); const float lo = WS_RL(v, 0) + WS_RL(v, 16), hi = WS_RL(v, 32) + WS_RL(v, 48);
    return (__builtin_amdgcn_mbcnt_hi(~0u, __builtin_amdgcn_mbcnt_lo(~0u, 0u)) < 32u) ? lo : hi; }

struct TItem { const float* W; bf16* WT; int K, N, mode, item; };
__device__ __forceinline__ void titem_load(const TItem& t, int lane, f32x4 (&wv)[8]) {
    const int nblk = t.N / 32, kb = t.item / nblk, nb = t.item % nblk, k0 = 64 * kb, n0 = 32 * nb;
#pragma unroll
    for (int i = 0; i < 8; ++i) wv[i] = *(const GAS f32x4*)(t.W + (size_t)(k0 + 8 * i + (lane >> 3)) * t.N + n0 + 4 * (lane & 7));
}
__device__ __forceinline__ void titem_finish(const TItem& t, LAS float* scr, int lane, const f32x4 (&wv)[8]) {
    const int nblk = t.N / 32, kb = t.item / nblk, nb = t.item % nblk, k0 = 64 * kb, n0 = 32 * nb;
    int d0 = n0;
    if (t.mode == 1) { const int bj = n0 >= FF ? 1 : 0, j = n0 - bj * FF; d0 = 256 * (j >> 7) + 128 * bj + (j & 127); }
    if (t.mode == 2 && n0 < 4096) { const int bj = n0 >> 11, j = n0 & 2047; d0 = 256 * (j >> 7) + 128 * bj + (j & 127); }
#pragma unroll
    for (int i = 0; i < 8; ++i) { LAS float* d = scr + (8 * i + (lane >> 3)) * 33 + 4 * (lane & 7); d[0] = wv[i].x; d[1] = wv[i].y; d[2] = wv[i].z; d[3] = wv[i].w; }
    LDS_WAIT(); asm volatile("" ::: "memory");
    const int c = lane & 7;
#pragma unroll
    for (int j = 0; j < 4; ++j) { const int n = (lane >> 3) + 8 * j; const LAS float* s = scr + (8 * c) * 33 + n;
        v4u o; o.x = pk2(s[0 * 33], s[1 * 33]); o.y = pk2(s[2 * 33], s[3 * 33]); o.z = pk2(s[4 * 33], s[5 * 33]); o.w = pk2(s[6 * 33], s[7 * 33]);
        if (t.mode == 3) { const int nn = d0 + n, kk = k0 + 8 * c;
            *(GAS v4u*)(t.WT + (size_t)((((nn >> 5) * 32 + (kk >> 4)) * 64) + ((kk >> 3) & 1) * 32 + (nn & 31)) * 8) = o; }
        else *(GAS v4u*)(t.WT + (size_t)(d0 + n) * t.K + k0 + 8 * c) = o; }
    LDS_WAIT(); asm volatile("" ::: "memory");
}
__device__ __forceinline__ void transpose_item(const float* W, int K, int N, bf16* WT, int mode, LAS float* scr, int item, int lane) {
    const TItem t{W, WT, K, N, mode, item}; f32x4 wv[8]; titem_load(t, lane, wv); titem_finish(t, scr, lane, wv);
}
template <class AP> __device__ __forceinline__ void phase_prologue(const AP a, LAS unsigned char* lds, int tid, int lane, int wave, int vcu, int G) {
    unsigned char* ws = a->ws;
    float* ada = (float*)(ws + WS_ADA);
    LAS float* sc = (LAS float*)lds;
    LAS float* red = (LAS float*)(lds + 32768);
    for (int i = tid; i < NB * DM; i += 512) sc[i] = silu1(a->c[i]);
    __syncthreads();
    for (int it = vcu; it < DEPTH * (ADA_W / 256); it += G) {
        const int l = it / (ADA_W / 256), cb = it % (ADA_W / 256), e0 = cb * 256 + 4 * lane;
        const float* wp = a->w_ada + ((size_t)l * DM + (size_t)wave * 256) * ADA_W + e0;
        f32x4 acc[4];
#pragma unroll
        for (int b = 0; b < 4; ++b) acc[b] = (f32x4){0.f, 0.f, 0.f, 0.f};
#pragma unroll 16
        for (int d = 0; d < 256; ++d) {
            const f32x4 wv = *(const GAS f32x4*)(wp + (size_t)d * ADA_W);
#pragma unroll
            for (int b = 0; b < 4; ++b) { const float s = sc[b * DM + wave * 256 + d]; acc[b] = acc[b] + wv * s; }
        }
#pragma unroll
        for (int b = 0; b < 4; ++b) *(LAS f32x4*)(red + (wave * 4 + b) * 256 + 4 * lane) = acc[b];
        __syncthreads();
        for (int o = tid; o < 4 * 256; o += 512) { const int b = o >> 8, e = o & 255; float s = 0.f;
#pragma unroll
            for (int w = 0; w < 8; ++w) s += red[(w * 4 + b) * 256 + e];
            ada[((size_t)l * NB + b) * ADA_W + cb * 256 + e] = s + a->b_ada[(size_t)l * ADA_W + cb * 256 + e]; }
        __syncthreads();
    }
    const int gw = vcu * NWAVES + wave, NGW = G * NWAVES, gt = gw * 64 + lane, NGT = NGW * 64;
    { float* lb = (float*)(ws + WS_LB);
      for (int col = gt; col < DM; col += NGT) { float z[DEPTH], mx = -1e30f;
#pragma unroll
          for (int j = 0; j < DEPTH; ++j) { z[j] = a->hgrn_lb[j * DM + col]; mx = fmaxf(mx, z[j]); }
          float s = 0.f, e1 = 0.f;
#pragma unroll
          for (int j = 0; j < DEPTH; ++j) { const float e = __expf(z[j] - mx); s += e; if (j == 1) e1 = e; }
          lb[col] = e1 / s; } }
    { unsigned* rt = (unsigned*)(ws + WS_ROT);
      for (int i = gt; i < M * 128; i += NGT) { const int m = i >> 7, f = i & 127;
          const float inv = exp2f(-(float)f * (13.287712379549449f / 128.0f));
          const float ang = (float)a->pos[m] * inv;
          const double rev = (double)ang * 0.15915494309189535; const float fr = (float)(rev - floor(rev));
          const _Float16 ch = (_Float16)__builtin_amdgcn_cosf(fr), sh = (_Float16)__builtin_amdgcn_sinf(fr);
          rt[i] = (unsigned)__builtin_bit_cast(unsigned short, ch) | ((unsigned)__builtin_bit_cast(unsigned short, sh) << 16); } }
    LAS float* scr = (LAS float*)(lds + wave * 16384);
    constexpr int I_POOL = 8 * (512 / 64) * (512 / 32), I_HGI = (DM / 64) * (HG_IN / 32), I_FFI1 = (DM / 64) * (FF2 / 32), I_FFO1 = (FF / 64) * (DM / 32);
    constexpr int NITEMS = I_POOL + I_HGI + I_FFI1 + I_FFO1;
#define EARLY_DECODE(t_, it_) do { int r = (it_); \
        if (r < I_POOL) { const int mt = r / 128; t_ = TItem{a->pool_w + (size_t)mt * 512 * 512, (bf16*)(ws + WS_POOLW) + (size_t)mt * 512 * 512, 512, 512, 3, r % 128}; break; } r -= I_POOL; \
        if (r < I_HGI) { t_ = TItem{a->hgrn_w_in, (bf16*)(ws + WS_HGWIN), DM, HG_IN, 2, r}; break; } r -= I_HGI; \
        if (r < I_FFI1) { t_ = TItem{a->ffn_w_in, (bf16*)(ws + WS_FFWIN), DM, FF2, 1, r}; break; } r -= I_FFI1; \
        t_ = TItem{a->ffn_w_out, (bf16*)(ws + WS_FFWOUT), FF, DM, 0, r}; } while (0)
    { const bool balc = (G == 256); const int NGVC = DEPTH * (ADA_W / 256);
      const int lgs = (balc && vcu >= NGVC) ? 2 : 0, NGWV = balc ? NGVC * NWAVES + (G - NGVC) * NWAVES * 4 : NGW;
      const int vb = balc ? (vcu < NGVC ? gw : NGVC * NWAVES + ((vcu - NGVC) * NWAVES + wave) * 4) : gw;
#define QITEM(q) (vb + ((q) & ((1 << lgs) - 1)) + ((q) >> lgs) * NGWV)
      if (QITEM(0) < NITEMS) {
        TItem t0, t1, t2; f32x4 w0[8], w1[8], w2[8];
        EARLY_DECODE(t0, QITEM(0)); titem_load(t0, lane, w0);
        t1 = t0; if (QITEM(1) < NITEMS) { EARLY_DECODE(t1, QITEM(1)); titem_load(t1, lane, w1); }
        for (int q = 0; QITEM(q) < NITEMS; q += 3) {
            if (QITEM(q + 2) < NITEMS) { EARLY_DECODE(t2, QITEM(q + 2)); titem_load(t2, lane, w2); }
            __builtin_amdgcn_sched_barrier(0);
            titem_finish(t0, scr, lane, w0);
            if (QITEM(q + 1) >= NITEMS) break;
            if (QITEM(q + 3) < NITEMS) { EARLY_DECODE(t0, QITEM(q + 3)); titem_load(t0, lane, w0); }
            __builtin_amdgcn_sched_barrier(0);
            titem_finish(t1, scr, lane, w1);
            if (QITEM(q + 2) >= NITEMS) break;
            if (QITEM(q + 4) < NITEMS) { EARLY_DECODE(t1, QITEM(q + 4)); titem_load(t1, lane, w1); }
            __builtin_amdgcn_sched_barrier(0);
            titem_finish(t2, scr, lane, w2);
        }
      }
#undef QITEM
    }
#undef EARLY_DECODE
    { const int l31 = lane & 31, h5 = lane >> 5;
      const __amdgpu_buffer_rsrc_t rsX = __builtin_amdgcn_make_buffer_rsrc((void*)a->x, (short)0, M * DM * 4, 0x00020000);
      const __amdgpu_buffer_rsrc_t rsC = __builtin_amdgcn_make_buffer_rsrc((void*)(ws + WS_H2), (short)0, M * DM * 2, 0x00020000);
      const bool bal = (G == 256); const int NGV = DEPTH * (ADA_W / 256);
      const int rpa = bal ? (vcu < NGV ? gw : NGV * NWAVES + (vcu - NGV) * NWAVES + wave) : gw, rps = bal ? (vcu < NGV ? M : (G - NGV) * NWAVES) : NGW;
      for (int rp = rpa; rp < M / 2; rp += rps) {
          const int row = 2 * rp + h5; const unsigned vo = (unsigned)row * (DM * 4) + (unsigned)l31 * 32u, vob = (unsigned)row * (DM * 2) + (unsigned)l31 * 16u;
          v4u q0[8], q1[8];
#pragma unroll
          for (int j = 0; j < 8; ++j) { q0[j] = __builtin_amdgcn_raw_buffer_load_b128(rsX, vo, (unsigned)j * 1024u, 0); q1[j] = __builtin_amdgcn_raw_buffer_load_b128(rsX, vo, (unsigned)j * 1024u + 16u, 0); }
          float ss = 0.f;
#pragma unroll
          for (int j = 0; j < 8; ++j) { const f32x4 p = __builtin_bit_cast(f32x4, q0[j]), c = __builtin_bit_cast(f32x4, q1[j]);
              ss += ((p.x * p.x + p.y * p.y) + (p.z * p.z + p.w * p.w)) + ((c.x * c.x + c.y * c.y) + (c.z * c.z + c.w * c.w));
              v4u o; o.x = pk2(p.x, p.y); o.y = pk2(p.z, p.w); o.z = pk2(c.x, c.y); o.w = pk2(c.z, c.w);
              __builtin_amdgcn_raw_buffer_store_b128(o, rsC, vob, (unsigned)j * 512u, 0); }
          ss = half_sum(ss);
          if (l31 == 0) ((float*)(ws + WS_XRS))[row] = 1.0f / sqrtf(ss * (1.0f / DM) + EPS);
      }
    }
}
template <class AP> __device__ __forceinline__ void phase_convert_late(const AP a, LAS unsigned char* lds, int lane, int wave, int gwc, int NGWC) {
    unsigned char* ws = a->ws;
    LAS float* scr = (LAS float*)(lds + wave * 16384);
    constexpr int I_HGO = (DM / 64) * (DM / 32), I_RTI = (DM / 64) * (RT_IN / 32), I_RTO = (RT_V / 64) * (DM / 32), I_FFI1 = (DM / 64) * (FF2 / 32), I_FFO1 = (FF / 64) * (DM / 32);
    constexpr int NITEMS = I_HGO + I_RTI + I_RTO + 3 * I_FFI1 + 3 * I_FFO1;
#define LATE_DECODE(t_, it_) do { int r = (it_); \
        if (r < I_HGO) { t_ = TItem{a->hgrn_w_out, (bf16*)(ws + WS_HGWOUT), DM, DM, 0, r}; break; } r -= I_HGO; \
        if (r < I_RTI) { t_ = TItem{a->ret_w_in, (bf16*)(ws + WS_RTWIN), DM, RT_IN, 0, r}; break; } r -= I_RTI; \
        if (r < I_RTO) { t_ = TItem{a->ret_w_out, (bf16*)(ws + WS_RTWOUT), RT_V, DM, 0, r}; break; } r -= I_RTO; \
        if (r < 3 * I_FFI1) { const int l = 1 + r / I_FFI1; t_ = TItem{a->ffn_w_in + (size_t)l * DM * FF2, (bf16*)(ws + WS_FFWIN) + (size_t)l * FF2 * DM, DM, FF2, 1, r % I_FFI1}; break; } r -= 3 * I_FFI1; \
        { const int l = 1 + r / I_FFO1; t_ = TItem{a->ffn_w_out + (size_t)l * FF * DM, (bf16*)(ws + WS_FFWOUT) + (size_t)l * DM * FF, FF, DM, 0, r % I_FFO1}; } } while (0)
    if (gwc >= NITEMS) return;
    TItem t0, t1, t2; f32x4 w0[8], w1[8], w2[8];
    LATE_DECODE(t0, gwc); titem_load(t0, lane, w0);
    t1 = t0; if (gwc + NGWC < NITEMS) { LATE_DECODE(t1, gwc + NGWC); titem_load(t1, lane, w1); }
    for (int it = gwc; it < NITEMS; it += 3 * NGWC) {
        if (it + 2 * NGWC < NITEMS) { LATE_DECODE(t2, it + 2 * NGWC); titem_load(t2, lane, w2); }
        __builtin_amdgcn_sched_barrier(0);
        titem_finish(t0, scr, lane, w0);
        if (it + NGWC >= NITEMS) break;
        if (it + 3 * NGWC < NITEMS) { LATE_DECODE(t0, it + 3 * NGWC); titem_load(t0, lane, w0); }
        __builtin_amdgcn_sched_barrier(0);
        titem_finish(t1, scr, lane, w1);
        if (it + 2 * NGWC >= NITEMS) break;
        if (it + 4 * NGWC < NITEMS) { LATE_DECODE(t1, it + 4 * NGWC); titem_load(t1, lane, w1); }
        __builtin_amdgcn_sched_barrier(0);
        titem_finish(t2, scr, lane, w2);
    }
#undef LATE_DECODE
}

struct WTile { const float* W; bf16* WT; int K, N, mode, idx; };
__device__ __forceinline__ void wtile_load(const WTile& t, int lane, int wave, f32x4 (&wv)[8]) {
    const int nblk = t.N >> 7, k0 = 128 * (t.idx / nblk), n0 = 128 * (t.idx % nblk);
#pragma unroll
    for (int i = 0; i < 8; ++i) wv[i] = *(const GAS f32x4*)(t.W + (size_t)(k0 + 16 * wave + 2 * i + (lane >> 5)) * t.N + n0 + 4 * (lane & 31));
}
__device__ __forceinline__ void wtile_to_lds(LAS unsigned char* T, int lane, int wave, const f32x4 (&wv)[8]) {
#pragma unroll
    for (int i = 0; i < 8; ++i) { const int r = 16 * wave + 2 * i + (lane >> 5); *(LAS f32x4*)(T + r * 512 + (((lane & 31) ^ ((r >> 3) & 7)) << 4)) = wv[i]; }
}
__device__ __forceinline__ void wtile_store(const WTile& t, const LAS unsigned char* T, int lane, int wave) {
    const int nblk = t.N >> 7, k0 = 128 * (t.idx / nblk), n0 = 128 * (t.idx % nblk);
    const int c = (lane & 7) + 8 * (lane >> 5), nl = (lane >> 3) & 3;
#pragma unroll
    for (int p = 0; p < 4; ++p) { const int nloc = 16 * wave + 4 * p + nl, n = n0 + nloc;
        const LAS float* s = (const LAS float*)(T + (8 * c) * 512 + (((nloc >> 2) ^ (lane & 7)) << 4) + (nloc & 3) * 4);
        v4u o; o.x = pk2(s[0 * 128], s[1 * 128]); o.y = pk2(s[2 * 128], s[3 * 128]); o.z = pk2(s[4 * 128], s[5 * 128]); o.w = pk2(s[6 * 128], s[7 * 128]);
        int d = n;
        if (t.mode == 1) { const int nb = n & ~31, bj = nb >= FF ? 1 : 0, j = nb - bj * FF; d = 256 * (j >> 7) + 128 * bj + (j & 127) + (n & 31); }
        *(GAS v4u*)(t.WT + (size_t)d * t.K + k0 + 8 * c) = o; }
}
#define WT_BAR() do { asm volatile("s_waitcnt lgkmcnt(0)" ::: "memory"); __builtin_amdgcn_s_barrier(); asm volatile("" ::: "memory"); } while (0)
template <class AP> __device__ __forceinline__ void phase_convert_late_tiles(const AP a, LAS unsigned char* lds, int lane, int wave, int wgc, int NWGC) {
    unsigned char* ws = a->ws;
    constexpr int T_HGO = (DM / 128) * (DM / 128), T_RTI = (DM / 128) * (RT_IN / 128), T_RTO = (RT_V / 128) * (DM / 128), T_FFI = (DM / 128) * (FF2 / 128), T_FFO = (FF / 128) * (DM / 128);
    constexpr int NT = T_HGO + T_RTI + T_RTO + 3 * T_FFI + 3 * T_FFO;
#define LATE_TDEC(t_, it_) do { int r = (it_); \
        if (r < T_HGO) { t_ = WTile{a->hgrn_w_out, (bf16*)(ws + WS_HGWOUT), DM, DM, 0, r}; break; } r -= T_HGO; \
        if (r < T_RTI) { t_ = WTile{a->ret_w_in, (bf16*)(ws + WS_RTWIN), DM, RT_IN, 0, r}; break; } r -= T_RTI; \
        if (r < T_RTO) { t_ = WTile{a->ret_w_out, (bf16*)(ws + WS_RTWOUT), RT_V, DM, 0, r}; break; } r -= T_RTO; \
        if (r < 3 * T_FFI) { const int l = 1 + r / T_FFI; t_ = WTile{a->ffn_w_in + (size_t)l * DM * FF2, (bf16*)(ws + WS_FFWIN) + (size_t)l * FF2 * DM, DM, FF2, 1, r % T_FFI}; break; } r -= 3 * T_FFI; \
        { const int l = 1 + r / T_FFO; t_ = WTile{a->ffn_w_out + (size_t)l * FF * DM, (bf16*)(ws + WS_FFWOUT) + (size_t)l * DM * FF, FF, DM, 0, r % T_FFO}; } } while (0)
    if (wgc >= NT) return;
    WTile tc, tn; f32x4 wv[8];
    LATE_TDEC(tc, wgc); wtile_load(tc, lane, wave, wv);
    for (int it = wgc; it < NT; it += NWGC) {
        WT_BAR();
        wtile_to_lds(lds, lane, wave, wv);
        const bool more = it + NWGC < NT;
        tn = tc; if (more) { LATE_TDEC(tn, it + NWGC); wtile_load(tn, lane, wave, wv); }
        WT_BAR();
        wtile_store(tc, lds, lane, wave);
        tc = tn;
    }
    WT_BAR();
#undef LATE_TDEC
}

__device__ __forceinline__ void phase_normmod(const float* hin, const float* g, const float* shift, const float* scale  , bf16* U, int gw, int NGW, int lane) {
    for (int r0 = gw * 8; r0 < M; r0 += NGW * 8) {
        const int b = r0 >> 12; const float* sh = shift + (size_t)b * ADA_W; const float* scp = scale + (size_t)b * ADA_W;
        f32x4 mul[8], add[8];
#pragma unroll
        for (int j = 0; j < 8; ++j) { const int col = 4 * lane + 256 * j; const f32x4 gv = *(const GAS f32x4*)(g + col), s = *(const GAS f32x4*)(scp + col); mul[j] = gv * (s + 1.0f); add[j] = *(const GAS f32x4*)(sh + col); }
        for (int rr = 0; rr < 8; ++rr) {
            const GAS f32x4* xr = (const GAS f32x4*)(hin + (size_t)(r0 + rr) * DM) + lane;
            f32x4 v[8]; float ss = 0.f;
#pragma unroll
            for (int j = 0; j < 8; ++j) { v[j] = xr[64 * j]; ss += (v[j].x * v[j].x + v[j].y * v[j].y) + (v[j].z * v[j].z + v[j].w * v[j].w); }
            const float rstd = 1.0f / sqrtf(wave_sum(ss) * (1.0f / DM) + EPS);
            GAS v2u* o8 = (GAS v2u*)(U + (size_t)(r0 + rr) * DM) + lane;
#pragma unroll
            for (int j = 0; j < 8; ++j) { const f32x4 y = v[j] * rstd * mul[j] + add[j]; v2u w; w.x = pk2(y.x, y.y); w.y = pk2(y.z, y.w); o8[64 * j] = w; }
        }
    }
}
__device__ __forceinline__ void phase_normmod_bf(const bf16* hin, const float* g, const float* shift, const float* scale  , bf16* U, int gw, int NGW, int lane) {
    for (int r0 = gw * 8; r0 < M; r0 += NGW * 8) {
        const int b = r0 >> 12; const float* sh = shift + (size_t)b * ADA_W; const float* scp = scale + (size_t)b * ADA_W;
        f32x4 mul[8], add[8];
#pragma unroll
        for (int j = 0; j < 8; ++j) { const int col = 8 * lane + 512 * (j >> 1) + 4 * (j & 1); const f32x4 gv = *(const GAS f32x4*)(g + col), s = *(const GAS f32x4*)(scp + col); mul[j] = gv * (s + 1.0f); add[j] = *(const GAS f32x4*)(sh + col); }
        for (int rr = 0; rr < 8; ++rr) {
            const GAS v4u* xr = (const GAS v4u*)(hin + (size_t)(r0 + rr) * DM) + lane;
            f32x4 v[8]; float ss = 0.f;
#pragma unroll
            for (int j = 0; j < 4; ++j) { const v4u q = xr[64 * j]; v[2 * j] = (f32x4){bflo(q.x), bfhi(q.x), bflo(q.y), bfhi(q.y)}; v[2 * j + 1] = (f32x4){bflo(q.z), bfhi(q.z), bflo(q.w), bfhi(q.w)}; }
#pragma unroll
            for (int j = 0; j < 8; ++j) ss += (v[j].x * v[j].x + v[j].y * v[j].y) + (v[j].z * v[j].z + v[j].w * v[j].w);
            const float rstd = 1.0f / sqrtf(wave_sum(ss) * (1.0f / DM) + EPS);
            GAS v4u* o16 = (GAS v4u*)(U + (size_t)(r0 + rr) * DM) + lane;
#pragma unroll
            for (int j = 0; j < 4; ++j) { const f32x4 y0 = v[2 * j] * rstd * mul[2 * j] + add[2 * j], y1 = v[2 * j + 1] * rstd * mul[2 * j + 1] + add[2 * j + 1];
                v4u w; w.x = pk2(y0.x, y0.y); w.y = pk2(y0.z, y0.w); w.z = pk2(y1.x, y1.y); w.w = pk2(y1.z, y1.w); o16[64 * j] = w; }
        }
    }
}
__device__ __forceinline__ void phase_finalnorm_bf(const bf16* hin, const float* g, float* out, int gw, int NGW, int lane) {
    for (int r0 = gw * 8; r0 < M; r0 += NGW * 8) {
        f32x4 mul[8];
#pragma unroll
        for (int j = 0; j < 8; ++j) mul[j] = *(const GAS f32x4*)(g + 8 * lane + 512 * (j >> 1) + 4 * (j & 1));
        for (int rr = 0; rr < 8; ++rr) {
            const GAS v4u* xr = (const GAS v4u*)(hin + (size_t)(r0 + rr) * DM) + lane;
            f32x4 v[8]; float ss = 0.f;
#pragma unroll
            for (int j = 0; j < 4; ++j) { const v4u q = xr[64 * j]; v[2 * j] = (f32x4){bflo(q.x), bfhi(q.x), bflo(q.y), bfhi(q.y)}; v[2 * j + 1] = (f32x4){bflo(q.z), bfhi(q.z), bflo(q.w), bfhi(q.w)}; }
#pragma unroll
            for (int j = 0; j < 8; ++j) ss += (v[j].x * v[j].x + v[j].y * v[j].y) + (v[j].z * v[j].z + v[j].w * v[j].w);
            const float rstd = 1.0f / sqrtf(wave_sum(ss) * (1.0f / DM) + EPS);
            float* orow = out + (size_t)(r0 + rr) * DM + 8 * lane;
#pragma unroll
            for (int j = 0; j < 8; ++j) *(GAS f32x4*)(orow + 512 * (j >> 1) + 4 * (j & 1)) = v[j] * rstd * mul[j];
        }
    }
}
__device__ __forceinline__ void phase_finalnorm(const float* hin, const float* g, float* out, int gw, int NGW, int lane) {
    for (int r0 = gw * 8; r0 < M; r0 += NGW * 8) {
        f32x4 mul[8];
#pragma unroll
        for (int j = 0; j < 8; ++j) mul[j] = *(const GAS f32x4*)(g + 4 * lane + 256 * j);
        for (int rr = 0; rr < 8; ++rr) {
            const GAS f32x4* xr = (const GAS f32x4*)(hin + (size_t)(r0 + rr) * DM) + lane;
            f32x4 v[8]; float ss = 0.f;
#pragma unroll
            for (int j = 0; j < 8; ++j) { v[j] = xr[64 * j]; ss += (v[j].x * v[j].x + v[j].y * v[j].y) + (v[j].z * v[j].z + v[j].w * v[j].w); }
            const float rstd = 1.0f / sqrtf(wave_sum(ss) * (1.0f / DM) + EPS);
            GAS f32x4* o = (GAS f32x4*)(out + (size_t)(r0 + rr) * DM) + lane;
#pragma unroll
            for (int j = 0; j < 8; ++j) o[64 * j] = v[j] * rstd * mul[j];
        }
    }
}
__device__ __forceinline__ void phase_pool(const bf16* U, bf16* Pb, int gw, int NGW, int lane) {
    for (int it = gw; it < (M / 32) * 4; it += NGW) {
        const int gi = it & 3, rw = it >> 2, w = 2 << gi, col = gi * 512 + lane * 8;
        for (int rr = 0; rr < 32; ++rr) {
            const int m = rw * 32 + rr, tpos = m & (SEQ - 1), cnt = (tpos + 1 < w) ? tpos + 1 : w;
            float acc[8];
#pragma unroll
            for (int e = 0; e < 8; ++e) acc[e] = 0.f;
            float cur[8];
            for (int j = 0; j < cnt; ++j) {
                const v4u q = *(const GAS v4u*)(U + (size_t)(m - j) * DM + col);
                const float f0 = bflo(q.x), f1 = bfhi(q.x), f2 = bflo(q.y), f3 = bfhi(q.y), f4 = bflo(q.z), f5 = bfhi(q.z), f6 = bflo(q.w), f7 = bfhi(q.w);
                if (j == 0) { cur[0] = f0; cur[1] = f1; cur[2] = f2; cur[3] = f3; cur[4] = f4; cur[5] = f5; cur[6] = f6; cur[7] = f7; }
                acc[0] += f0; acc[1] += f1; acc[2] += f2; acc[3] += f3; acc[4] += f4; acc[5] += f5; acc[6] += f6; acc[7] += f7;
            }
            const float inv = 1.0f / (float)cnt;
            v4u o; o.x = pk2(acc[0] * inv - cur[0], acc[1] * inv - cur[1]); o.y = pk2(acc[2] * inv - cur[2], acc[3] * inv - cur[3]);
            o.z = pk2(acc[4] * inv - cur[4], acc[5] * inv - cur[5]); o.w = pk2(acc[6] * inv - cur[6], acc[7] * inv - cur[7]);
            *(GAS v4u*)(Pb + (size_t)m * DM + col) = o;
        }
    }
}

__device__ __forceinline__ void phase_hgrn_scan_naive(const bf16* PROJ, const float* lbv, float* O, LAS unsigned char* lds, int tid, int vcu, int G) {
    LAS float* qs = (LAS float*)lds;
    LAS float* fs = qs + 16 * 128;
    LAS float* ks = fs + 16 * 128;
    LAS float* vs = ks + 16 * 128;
    const int v = tid >> 4, dg = tid & 15;
    for (int unit = vcu; unit < NB * HG_H * 4; unit += G) {
        const int b = unit >> 6, h = (unit >> 2) & 15, vsl = unit & 3;
        float S[8];
#pragma unroll
        for (int e = 0; e < 8; ++e) S[e] = 0.f;
        const int lt = tid >> 5, ld4 = (tid & 31) * 4;
        float lbl[4];
#pragma unroll
        for (int e = 0; e < 4; ++e) lbl[e] = lbv[h * 128 + ld4 + e];
        for (int ch = 0; ch < SEQ / 16; ++ch) {
            const size_t m0 = (size_t)b * SEQ + (size_t)ch * 16;
            { const bf16* row = PROJ + (m0 + lt) * HG_IN + h * 128 + ld4;
              const v2u qv = *(const GAS v2u*)row, zv = *(const GAS v2u*)(row + 2048);
              const float qf[4] = {bflo(qv.x), bfhi(qv.x), bflo(qv.y), bfhi(qv.y)}, zf[4] = {bflo(zv.x), bfhi(zv.x), bflo(zv.y), bfhi(zv.y)};
#pragma unroll
              for (int e = 0; e < 4; ++e) { const float sg = sigmoid_f(zf[e]), l = lbl[e]; qs[lt * 128 + ld4 + e] = qf[e]; fs[lt * 128 + ld4 + e] = l + (1.0f - l) * sg; ks[lt * 128 + ld4 + e] = (1.0f - l) * (1.0f - sg); }
              vs[tid] = bf1(PROJ[(m0 + (tid >> 5)) * HG_IN + 4096 + h * 128 + vsl * 32 + (tid & 31)]); }
            __syncthreads();
            for (int tt = 0; tt < 16; ++tt) {
                const float vv = vs[tt * 32 + v]; float acc = 0.f;
#pragma unroll
                for (int e = 0; e < 8; ++e) { const int d = dg * 8 + e; S[e] = fs[tt * 128 + d] * S[e] + ks[tt * 128 + d] * vv; acc += S[e] * qs[tt * 128 + d]; }
                acc += __shfl_xor(acc, 1); acc += __shfl_xor(acc, 2); acc += __shfl_xor(acc, 4); acc += __shfl_xor(acc, 8);
                if (dg == 0) O[(m0 + tt) * DM + h * 128 + vsl * 32 + v] = acc;
            }
            __syncthreads();
        }
    }
}
__device__ __forceinline__ void phase_hgrn_post(const bf16* O, const bf16* PROJ, const float* ng, bf16* Pb, int gw, int NGW, int lane) {
    f32x4 nv[4][2];
#pragma unroll
    for (int j = 0; j < 4; ++j) { nv[j][0] = *(const GAS f32x4*)(ng + 512 * j + 8 * lane); nv[j][1] = *(const GAS f32x4*)(ng + 512 * j + 8 * lane + 4); }
    for (int m = gw; m < M; m += NGW) {
        const GAS v4u* orow = (const GAS v4u*)(O + (size_t)m * DM) + lane;
        const GAS v4u* grow = (const GAS v4u*)(PROJ + (size_t)m * HG_IN + 6144) + lane;
        GAS v4u* prow = (GAS v4u*)(Pb + (size_t)m * DM) + lane;
        v4u ob[4], gq[4];
#pragma unroll
        for (int j = 0; j < 4; ++j) { ob[j] = orow[64 * j]; gq[j] = grow[64 * j]; }
#pragma unroll
        for (int j = 0; j < 4; ++j) {
            const f32x4 o0 = (f32x4){bflo(ob[j].x), bfhi(ob[j].x), bflo(ob[j].y), bfhi(ob[j].y)}, o1 = (f32x4){bflo(ob[j].z), bfhi(ob[j].z), bflo(ob[j].w), bfhi(ob[j].w)};
            float ss = ((o0.x * o0.x + o0.y * o0.y) + (o0.z * o0.z + o0.w * o0.w)) + ((o1.x * o1.x + o1.y * o1.y) + (o1.z * o1.z + o1.w * o1.w));
            ss = row16_sum(ss);
            const float rstd = 1.0f / sqrtf(ss * (1.0f / 128.0f) + EPS);
            const v4u g = gq[j];
            v4u w; w.x = pk2(o0.x * rstd * nv[j][0].x * silu1(bflo(g.x)), o0.y * rstd * nv[j][0].y * silu1(bfhi(g.x))); w.y = pk2(o0.z * rstd * nv[j][0].z * silu1(bflo(g.y)), o0.w * rstd * nv[j][0].w * silu1(bfhi(g.y)));
            w.z = pk2(o1.x * rstd * nv[j][1].x * silu1(bflo(g.z)), o1.y * rstd * nv[j][1].y * silu1(bfhi(g.z))); w.w = pk2(o1.z * rstd * nv[j][1].z * silu1(bflo(g.w)), o1.w * rstd * nv[j][1].w * silu1(bfhi(g.w)));
            prow[64 * j] = w;
        }
    }
}
__device__ __forceinline__ void phase_ret_scan_naive(const bf16* PROJ, const float* rot, float* O, LAS unsigned char* lds, int tid, int vcu, int G) {
    LAS float* qs = (LAS float*)lds;
    LAS float* ks = qs + 16 * 256;
    LAS float* vs = ks + 16 * 256;
    const float* ct = rot; const float* st = rot + (size_t)M * 128;
    const int v = tid >> 3, dg = tid & 7;
    for (int unit = vcu; unit < NB * RT_H * 8; unit += G) {
        const int b = unit >> 6, h = (unit >> 3) & 7, vsl = unit & 7;
        const float gamma = 1.0f - exp2f(-5.0f - (float)h);
        float S[32];
#pragma unroll
        for (int e = 0; e < 32; ++e) S[e] = 0.f;
        const int lt = tid >> 5, li = (tid & 31) * 4;
        for (int ch = 0; ch < SEQ / 16; ++ch) {
            const size_t m0 = (size_t)b * SEQ + (size_t)ch * 16;
            { const size_t m = m0 + lt; const bf16* row = PROJ + m * RT_IN + h * 256 + li;
              const v2u q1 = *(const GAS v2u*)row, q2 = *(const GAS v2u*)(row + 128), k1 = *(const GAS v2u*)(row + 2048), k2 = *(const GAS v2u*)(row + 2048 + 128);
              const f32x4 cv = *(const GAS f32x4*)(ct + m * 128 + li), sv = *(const GAS f32x4*)(st + m * 128 + li);
              const float a1[4] = {bflo(q1.x), bfhi(q1.x), bflo(q1.y), bfhi(q1.y)}, a2[4] = {bflo(q2.x), bfhi(q2.x), bflo(q2.y), bfhi(q2.y)};
              const float b1[4] = {bflo(k1.x), bfhi(k1.x), bflo(k1.y), bfhi(k1.y)}, b2[4] = {bflo(k2.x), bfhi(k2.x), bflo(k2.y), bfhi(k2.y)};
#pragma unroll
              for (int e = 0; e < 4; ++e) { const float cc = cv[e], sn = sv[e];
                  qs[lt * 256 + li + e] = a1[e] * cc - a2[e] * sn; qs[lt * 256 + 128 + li + e] = a1[e] * sn + a2[e] * cc;
                  ks[lt * 256 + li + e] = (b1[e] * cc - b2[e] * sn) * 0.0625f; ks[lt * 256 + 128 + li + e] = (b1[e] * sn + b2[e] * cc) * 0.0625f; }
#pragma unroll
              for (int r = 0; r < 2; ++r) { const int idx = tid + r * 512, tt = idx >> 6, vv = idx & 63; vs[idx] = bf1(PROJ[(m0 + tt) * RT_IN + 4096 + h * 512 + vsl * 64 + vv]); } }
            __syncthreads();
            for (int tt = 0; tt < 16; ++tt) {
                const float vv = vs[tt * 64 + v]; float acc = 0.f;
#pragma unroll
                for (int e = 0; e < 32; ++e) { const int d = dg * 32 + e; S[e] = gamma * S[e] + ks[tt * 256 + d] * vv; acc += S[e] * qs[tt * 256 + d]; }
                acc += __shfl_xor(acc, 1); acc += __shfl_xor(acc, 2); acc += __shfl_xor(acc, 4);
                if (dg == 0) O[(m0 + tt) * RT_V + h * 512 + vsl * 64 + v] = acc;
            }
            __syncthreads();
        }
    }
}
__device__ __forceinline__ void phase_ret_post(const bf16* O, const bf16* PROJ, const float* ng, bf16* Pb, int gw, int NGW, int lane) {
    f32x4 nv[8][2];
#pragma unroll
    for (int hh = 0; hh < 8; ++hh) { nv[hh][0] = *(const GAS f32x4*)(ng + 512 * hh + 8 * lane); nv[hh][1] = *(const GAS f32x4*)(ng + 512 * hh + 8 * lane + 4); }
    for (int m = gw; m < M; m += NGW) {
        const GAS v4u* orow = (const GAS v4u*)(O + (size_t)m * RT_V) + lane;
        const GAS v4u* grow = (const GAS v4u*)(PROJ + (size_t)m * RT_IN + 8192) + lane;
        GAS v4u* prow = (GAS v4u*)(Pb + (size_t)m * RT_V) + lane;
        v4u ob[8], gq[8];
#pragma unroll
        for (int hh = 0; hh < 8; ++hh) { ob[hh] = orow[64 * hh]; gq[hh] = grow[64 * hh]; }
#pragma unroll
        for (int hh = 0; hh < 8; ++hh) {
            const f32x4 o0 = (f32x4){bflo(ob[hh].x), bfhi(ob[hh].x), bflo(ob[hh].y), bfhi(ob[hh].y)}, o1 = (f32x4){bflo(ob[hh].z), bfhi(ob[hh].z), bflo(ob[hh].w), bfhi(ob[hh].w)};
            const float ss = ((o0.x * o0.x + o0.y * o0.y) + (o0.z * o0.z + o0.w * o0.w)) + ((o1.x * o1.x + o1.y * o1.y) + (o1.z * o1.z + o1.w * o1.w));
            const float rstd = 1.0f / sqrtf(wave_sum(ss) * (1.0f / 512.0f) + EPS);
            const v4u g = gq[hh];
            v4u w; w.x = pk2(o0.x * rstd * nv[hh][0].x * silu1(bflo(g.x)), o0.y * rstd * nv[hh][0].y * silu1(bfhi(g.x))); w.y = pk2(o0.z * rstd * nv[hh][0].z * silu1(bflo(g.y)), o0.w * rstd * nv[hh][0].w * silu1(bfhi(g.y)));
            w.z = pk2(o1.x * rstd * nv[hh][1].x * silu1(bflo(g.z)), o1.y * rstd * nv[hh][1].y * silu1(bfhi(g.z))); w.w = pk2(o1.z * rstd * nv[hh][1].z * silu1(bflo(g.w)), o1.w * rstd * nv[hh][1].w * silu1(bfhi(g.w)));
            prow[64 * hh] = w;
        }
    }
}

typedef float f32x16 __attribute__((ext_vector_type(16)));
typedef short s16x4 __attribute__((ext_vector_type(4)));
typedef short s16x8 __attribute__((ext_vector_type(8)));
__device__ __forceinline__ unsigned off_b(unsigned row, unsigned ch) { return 256u * row + 16u * (ch ^ (((row & 3u) << 2) | ((row >> 2) & 3u))); }
__device__ __forceinline__ s16x8 tr_frag_b(LAS unsigned char* img, int lane, int c, int ks) {
    const unsigned h = lane >> 5, blk = (lane >> 4) & 1, q = (lane & 15) >> 2, p = lane & 3;
    const unsigned a0 = off_b(16 * ks + 8 * h + q, 4 * c + 2 * blk + (p >> 1)) + 8 * (p & 1), a1 = off_b(16 * ks + 8 * h + 4 + q, 4 * c + 2 * blk + (p >> 1)) + 8 * (p & 1);
    const s16x4 x = __builtin_amdgcn_ds_read_tr16_b64_v4i16((LAS s16x4*)(img + a0)), y = __builtin_amdgcn_ds_read_tr16_b64_v4i16((LAS s16x4*)(img + a1));
    return (s16x8){x[0], x[1], x[2], x[3], y[0], y[1], y[2], y[3]};
}
__device__ __forceinline__ unsigned trb_base(int lane, int c, int tt) {
    const unsigned h = lane >> 5, blk = (lane >> 4) & 1, q = (lane & 15) >> 2, p = lane & 3;
    return 256u * (8 * h + 4 * tt + q) + 16u * ((4 * c + 2 * blk + (p >> 1)) ^ ((q << 2) | ((2 * h + tt) & 3))) + 8 * (p & 1);
}
__device__ __forceinline__ s16x8 tr_frag_b2(LAS unsigned char* img, unsigned b0, unsigned b1, int ks) {
    const s16x4 x = __builtin_amdgcn_ds_read_tr16_b64_v4i16((LAS s16x4*)(img + b0 + 4096 * ks)), y = __builtin_amdgcn_ds_read_tr16_b64_v4i16((LAS s16x4*)(img + b1 + 4096 * ks));
    return (s16x8){x[0], x[1], x[2], x[3], y[0], y[1], y[2], y[3]};
}
__device__ __forceinline__ s16x8 tr_frag_plain(LAS unsigned char* img, int rs, int lane, int c, int ks) {
    const unsigned h = lane >> 5, blk = (lane >> 4) & 1, q = (lane & 15) >> 2, p = lane & 3;
    const unsigned a0 = (16 * ks + 8 * h + q) * rs + (32 * c + 16 * blk + 4 * p) * 2, a1 = a0 + 4 * rs;
    const s16x4 x = __builtin_amdgcn_ds_read_tr16_b64_v4i16((LAS s16x4*)(img + a0)), y = __builtin_amdgcn_ds_read_tr16_b64_v4i16((LAS s16x4*)(img + a1));
    return (s16x8){x[0], x[1], x[2], x[3], y[0], y[1], y[2], y[3]};
}
__device__ __forceinline__ f32x16 mfma32(s16x8 a, s16x8 b, f32x16 c) { return __builtin_amdgcn_mfma_f32_32x32x16_bf16(a, b, c, 0, 0, 0); }
__device__ __forceinline__ f32x16 zero16() { f32x16 z;
#pragma unroll
    for (int i = 0; i < 16; ++i) z[i] = 0.f; return z; }
__device__ __forceinline__ v4u scale_bf8(v4u q, float f) { v4u o; o.x = pk2(bflo(q.x) * f, bfhi(q.x) * f); o.y = pk2(bflo(q.y) * f, bfhi(q.y) * f); o.z = pk2(bflo(q.z) * f, bfhi(q.z) * f); o.w = pk2(bflo(q.w) * f, bfhi(q.w) * f); return o; }

__device__ __forceinline__ void phase_ret_scan(const bf16* PROJ, bf16* O, LAS unsigned char* lds, int tid, int vcu, int G) {
    constexpr int QN = 0, QRS = 528, KN = 33792, VV = KN + 32768, PI = VV + 16384, PRS = 144, ST = PI + 9216, SRS = 528, LDS_END = ST + 33792;
    static_assert(LDS_END <= RING_BYTES, "retention scan LDS map");
    const int lane = tid & 63, wave = __builtin_amdgcn_readfirstlane(tid >> 6);
    for (int unit = vcu; unit < NB * RT_H * 8; unit += G) {
        const int b = unit >> 6, h = (unit >> 3) & 7, vsl = unit & 7;
        const float lg = __log2f(1.0f - exp2f(-5.0f - (float)h));
        const float g64 = exp2f(64.0f * lg);
        f32x16 S[2][2];
#pragma unroll
        for (int a = 0; a < 2; ++a)
#pragma unroll
            for (int c = 0; c < 2; ++c) S[a][c] = zero16();
        for (int i = tid; i < 33792 / 16; i += 512) *(LAS v4u*)(lds + ST + i * 16) = (v4u){0u, 0u, 0u, 0u};
        v4u pq[4], pk[4], pv;
        const __amdgpu_buffer_rsrc_t rsP = __builtin_amdgcn_make_buffer_rsrc((void*)(PROJ + (size_t)b * SEQ * RT_IN), (short)0, SEQ * RT_IN * 2, 0x00020000);
        const __amdgpu_buffer_rsrc_t rsO = __builtin_amdgcn_make_buffer_rsrc((void*)(O + (size_t)b * SEQ * RT_V), (short)0, SEQ * RT_V * 2, 0x00020000);
        const int vrow = tid >> 3, vch = tid & 7;
        const unsigned voq = (unsigned)((tid >> 5) * RT_IN + (tid & 31) * 8) * 2u, vov = (unsigned)(vrow * RT_IN + vch * 8) * 2u;
        const unsigned soq = (unsigned)(h * 256) * 2u, sok = (unsigned)(2048 + h * 256) * 2u, sov = (unsigned)(4096 + h * 512 + vsl * 64) * 2u;
#define RS_PREFETCH(chn) do { const unsigned cb_ = (unsigned)(chn) * 64u * RT_IN * 2u; _Pragma("unroll") for (int i = 0; i < 4; ++i) { \
            pq[i] = __builtin_amdgcn_raw_buffer_load_b128(rsP, voq, cb_ + (unsigned)i * 16u * RT_IN * 2u + soq, 0); pk[i] = __builtin_amdgcn_raw_buffer_load_b128(rsP, voq, cb_ + (unsigned)i * 16u * RT_IN * 2u + sok, 0); } \
            pv = __builtin_amdgcn_raw_buffer_load_b128(rsP, vov, cb_ + sov, 0); } while (0)
        RS_PREFETCH(0);
        float dec[16];
        { const int a31 = lane & 31, a5 = lane >> 5, w4 = wave & 3, t_i = w4 >> 1, x_i = w4 & 1;
#pragma unroll
          for (int r = 0; r < 16; ++r) {
              if (wave < 4) { const int t = 32 * x_i + a31, s = 32 * t_i + 8 * (r >> 2) + 4 * a5 + (r & 3); dec[r] = (s <= t) ? __builtin_amdgcn_exp2f((float)(t - s) * lg) : 0.f; }
              else { const int t = 32 * t_i + (r & 3) + 8 * (r >> 2) + 4 * a5; dec[r] = __builtin_amdgcn_exp2f((float)(t + 1) * lg); } } }
        for (int ch = 0; ch < SEQ / 64; ++ch) {
#pragma unroll
            for (int i = 0; i < 4; ++i) { const int cid = tid + 512 * i, row = cid >> 5, chq = cid & 31;
                *(LAS v4u*)(lds + QN + row * QRS + chq * 16) = pq[i];
                *(LAS v4u*)(lds + KN + (chq >> 4) * 16384 + off_b(row, chq & 15)) = pk[i]; }
            *(LAS v4u*)(lds + VV + off_b(vrow, vch)) = pv;
            *(LAS v4u*)(lds + VV + off_b(vrow, 8 + vch)) = scale_bf8(pv, __builtin_amdgcn_exp2f((float)(63 - vrow) * lg));
            __syncthreads();
#define RS_STORE_O(chs) do { if (wave >= 4) { const int w4s = wave & 3, tis = w4s >> 1, vis = w4s & 1; int lnS = lane; asm volatile("" : "+v"(lnS)); \
                  \
                const LAS unsigned char* sg_ = lds + RING_BYTES + 4096 + w4s * 2048; \
                const unsigned voo = (unsigned)((lnS >> 2) * RT_V + h * 512 + vsl * 64 + 32 * vis + 8 * (lnS & 3)) * 2u; \
                _Pragma("unroll") for (int q = 0; q < 2; ++q) { const v4u ov_ = *(const LAS v4u*)(sg_ + (16 * q + (lnS >> 2)) * 64 + (lnS & 3) * 16); \
                    __builtin_amdgcn_raw_buffer_store_b128(ov_, rsO, voo, (unsigned)((chs) * 64 + 32 * tis + 16 * q) * RT_V * 2u, 0); } } } while (0)
            if (ch > 0) RS_STORE_O(ch - 1);
            if (ch + 1 < SEQ / 64) RS_PREFETCH(ch + 1);
            f32x16 acc = zero16();
            int lnA = lane; asm volatile("" : "+v"(lnA));
            const int a31 = lnA & 31, a5 = lnA >> 5;
            const int w4 = wave & 3, t_i = w4 >> 1, x_i = w4 & 1;
            s16x8 fa0[4], fb0[4], fa1[4], fb1[4];
            if (wave < 4) {
                const int si = t_i, ti = x_i;
#define RS_LD1A(fa, fb, g4) do { _Pragma("unroll") for (int j = 0; j < 2; ++j) { const int ks = 2 * (g4) + j; \
                    fa[j] = *(const LAS s16x8*)(lds + KN + (ks >> 3) * 16384 + off_b(32 * si + a31, 2 * (ks & 7) + a5)); \
                    fb[j] = *(const LAS s16x8*)(lds + QN + (32 * ti + a31) * QRS + (16 * ks + 8 * a5) * 2); } } while (0)
#define RS_MMA4(fa, fb) do { _Pragma("unroll") for (int j = 0; j < 4; ++j) acc = mfma32(fa[j], fb[j], acc); } while (0)
#define RS_MMA2(fa, fb) do { _Pragma("unroll") for (int j = 0; j < 2; ++j) acc = mfma32(fa[j], fb[j], acc); } while (0)
                RS_LD1A(fa0, fb0, 0); RS_LD1A(fa1, fb1, 1);
#pragma unroll
                for (int g2 = 0; g2 < 3; ++g2) { RS_MMA2(fa0, fb0); RS_LD1A(fa0, fb0, 2 * g2 + 2); RS_MMA2(fa1, fb1); RS_LD1A(fa1, fb1, 2 * g2 + 3); }
                RS_MMA2(fa0, fb0); RS_MMA2(fa1, fb1);
#undef RS_LD1A
                const int t = 32 * ti + a31;
#pragma unroll
                for (int g = 0; g < 4; ++g) { float pvv[4];
#pragma unroll
                    for (int e = 0; e < 4; ++e) pvv[e] = acc[4 * g + e] * dec[4 * g + e];
                    v2u w; w.x = pk2(pvv[0], pvv[1]); w.y = pk2(pvv[2], pvv[3]);
                    *(LAS v2u*)(lds + PI + t * PRS + (32 * si + 8 * g + 4 * a5) * 2) = w; }
            } else {
                const int ti = t_i, vi = x_i;
#define RS_LD1B(fa, fb, g4) do { _Pragma("unroll") for (int j = 0; j < 2; ++j) { const int ks = 2 * (g4) + j; \
                    fa[j] = *(const LAS s16x8*)(lds + QN + (32 * ti + a31) * QRS + (16 * ks + 8 * a5) * 2); \
                    fb[j] = *(const LAS s16x8*)(lds + ST + (32 * vi + a31) * SRS + (16 * ks + 8 * a5) * 2); } } while (0)
                RS_LD1B(fa0, fb0, 0); RS_LD1B(fa1, fb1, 1);
#pragma unroll
                for (int g2 = 0; g2 < 3; ++g2) { RS_MMA2(fa0, fb0); RS_LD1B(fa0, fb0, 2 * g2 + 2); RS_MMA2(fa1, fb1); RS_LD1B(fa1, fb1, 2 * g2 + 3); }
                RS_MMA2(fa0, fb0); RS_MMA2(fa1, fb1);
#undef RS_LD1B
#pragma unroll
                for (int r = 0; r < 16; ++r) acc[r] *= dec[r];
            }
            __syncthreads();
            if (wave < 4) {
                LAS unsigned char* kimg0 = lds + KN + ((2 * wave) >> 2) * 16384; LAS unsigned char* kimg1 = lds + KN + ((2 * wave + 1) >> 2) * 16384;
                const unsigned ka0 = trb_base(lnA, (2 * wave) & 3, 0), ka1 = trb_base(lnA, (2 * wave) & 3, 1), kb0 = trb_base(lnA, (2 * wave + 1) & 3, 0), kb1 = trb_base(lnA, (2 * wave + 1) & 3, 1);
                const unsigned va0 = trb_base(lnA, 2, 0), va1 = trb_base(lnA, 2, 1), vb0 = trb_base(lnA, 3, 0), vb1 = trb_base(lnA, 3, 1);
#define RS_LD2A(g2) do { _Pragma("unroll") for (int j = 0; j < 2; ++j) { const int ks = 2 * (g2) + j; fa0[j] = tr_frag_b2(kimg0, ka0, ka1, ks); fa1[j] = tr_frag_b2(kimg1, kb0, kb1, ks); fb0[j] = tr_frag_b2(lds + VV, va0, va1, ks); fb1[j] = tr_frag_b2(lds + VV, vb0, vb1, ks); } } while (0)
#define RS_MMA2A() do { _Pragma("unroll") for (int j = 0; j < 2; ++j) { S[0][0] = mfma32(fa0[j], fb0[j], S[0][0]); S[0][1] = mfma32(fa0[j], fb1[j], S[0][1]); S[1][0] = mfma32(fa1[j], fb0[j], S[1][0]); S[1][1] = mfma32(fa1[j], fb1[j], S[1][1]); } } while (0)
                RS_LD2A(0);
#pragma unroll
                for (int a = 0; a < 2; ++a)
#pragma unroll
                    for (int c = 0; c < 2; ++c)
#pragma unroll
                        for (int r = 0; r < 16; ++r) S[a][c][r] *= g64;
                RS_MMA2A(); RS_LD2A(1); RS_MMA2A();
#undef RS_LD2A
#undef RS_MMA2A
#pragma unroll
                for (int a = 0; a < 2; ++a)
#pragma unroll
                    for (int c = 0; c < 2; ++c)
#pragma unroll
                        for (int g = 0; g < 4; ++g) { const int d = 32 * (2 * wave + a) + 8 * g + 4 * a5, v = 32 * c + a31;
                            v2u w; w.x = pk2(S[a][c][4 * g], S[a][c][4 * g + 1]); w.y = pk2(S[a][c][4 * g + 2], S[a][c][4 * g + 3]);
                            *(LAS v2u*)(lds + ST + v * SRS + d * 2) = w; }
            } else {
                const int ti = t_i, vi = x_i;
#pragma unroll
                for (int ks = 0; ks < 4; ++ks) { fa0[ks] = *(const LAS s16x8*)(lds + PI + (32 * ti + a31) * PRS + (16 * ks + 8 * a5) * 2); fb0[ks] = tr_frag_b2(lds + VV, trb_base(lnA, vi, 0), trb_base(lnA, vi, 1), ks); }
                RS_MMA4(fa0, fb0);
#pragma unroll
                for (int i = 0; i < 8; ++i) { const float o0_ = acc[2 * i], o1_ = acc[2 * i + 1]; const unsigned pr_ = pk2(o0_, o1_);
                    LAS unsigned char* sp_ = lds + RING_BYTES + 4096 + w4 * 2048 + (2 * (i & 1) + 8 * (i >> 1) + 4 * a5) * 64 + a31 * 2;
                    *(LAS unsigned short*)sp_ = (unsigned short)(pr_ & 0xffffu); *(LAS unsigned short*)(sp_ + 64) = (unsigned short)(pr_ >> 16); }
            }
#undef RS_MMA4
#undef RS_PREFETCH_DUMMY
#undef RS_MMA2
            __syncthreads();
        }
        RS_STORE_O(SEQ / 64 - 1);
#undef RS_STORE_O
#undef RS_PREFETCH
    }
}

__device__ __forceinline__ void phase_hgrn_pre(const bf16* PROJ, const float* lbv, bf16* QD, bf16* KI, bf16* KE, float* DEC, int gt, int NGT) {
    for (int it = gt; it < (M / 32) * 256; it += NGT) {
        const int chunk = it >> 8, col = (it & 255) * 8; const size_t m0 = (size_t)chunk * 32;
        float lb[8], tot[8], cum[8];
        { const f32x4 l0 = *(const GAS f32x4*)(lbv + col), l1 = *(const GAS f32x4*)(lbv + col + 4);
#pragma unroll
          for (int e = 0; e < 4; ++e) { lb[e] = l0[e]; lb[4 + e] = l1[e]; } }
#pragma unroll
        for (int e = 0; e < 8; ++e) { tot[e] = 1.f; cum[e] = 1.f; }
#pragma unroll 4
        for (int t = 0; t < 32; ++t) { const v4u zz = *(const GAS v4u*)(PROJ + (m0 + t) * HG_IN + 2048 + col);
            const float z[8] = {bflo(zz.x), bfhi(zz.x), bflo(zz.y), bfhi(zz.y), bflo(zz.z), bfhi(zz.z), bflo(zz.w), bfhi(zz.w)};
#pragma unroll
            for (int e = 0; e < 8; ++e) tot[e] *= lb[e] + (1.0f - lb[e]) * sigmoid_f(z[e]); }
#pragma unroll 2
        for (int t = 0; t < 32; ++t) { const size_t m = m0 + t;
            const v4u zz = *(const GAS v4u*)(PROJ + m * HG_IN + 2048 + col), qq = *(const GAS v4u*)(PROJ + m * HG_IN + col);
            const float z[8] = {bflo(zz.x), bfhi(zz.x), bflo(zz.y), bfhi(zz.y), bflo(zz.z), bfhi(zz.z), bflo(zz.w), bfhi(zz.w)};
            const float q[8] = {bflo(qq.x), bfhi(qq.x), bflo(qq.y), bfhi(qq.y), bflo(qq.z), bfhi(qq.z), bflo(qq.w), bfhi(qq.w)};
            float qd[8], ki[8], ke[8];
#pragma unroll
            for (int e = 0; e < 8; ++e) { const float sg = sigmoid_f(z[e]); cum[e] *= lb[e] + (1.0f - lb[e]) * sg; const float kk = (1.0f - lb[e]) * (1.0f - sg);
                qd[e] = q[e] * cum[e]; ki[e] = kk * __builtin_amdgcn_rcpf(cum[e]); ke[e] = ki[e] * tot[e]; }
            v4u o; o.x = pk2(qd[0], qd[1]); o.y = pk2(qd[2], qd[3]); o.z = pk2(qd[4], qd[5]); o.w = pk2(qd[6], qd[7]); *(GAS v4u*)(QD + m * DM + col) = o;
            o.x = pk2(ki[0], ki[1]); o.y = pk2(ki[2], ki[3]); o.z = pk2(ki[4], ki[5]); o.w = pk2(ki[6], ki[7]); *(GAS v4u*)(KI + m * DM + col) = o;
            o.x = pk2(ke[0], ke[1]); o.y = pk2(ke[2], ke[3]); o.z = pk2(ke[4], ke[5]); o.w = pk2(ke[6], ke[7]); *(GAS v4u*)(KE + m * DM + col) = o; }
        f32x4 d0, d1;
#pragma unroll
        for (int e = 0; e < 4; ++e) { d0[e] = tot[e]; d1[e] = tot[4 + e]; }
        *(GAS f32x4*)(DEC + (size_t)chunk * DM + col) = d0; *(GAS f32x4*)(DEC + (size_t)chunk * DM + col + 4) = d1;
    }
}
__device__ __forceinline__ void phase_hgrn_scan(const bf16* HV, const bf16* QD, const bf16* KI, const bf16* KE, const float* DEC, bf16* Ob, LAS unsigned char* lds, int tid, int u0, int ustride) {
    constexpr int RS = 272, PRS = 80, VRS = 128, SET = 30208;
    constexpr int QI = 0, KII = 8704, KEI = 17408, VI = 25600, DCI = 29696, PI = 2 * SET, ST = PI + 2560, LDS_END = ST + 2 * 8704;
    static_assert(LDS_END + 4096 <= RING_BYTES, "hgrn scan LDS map (+ 2 x 2 KiB output staging)");
    const int lane = tid & 63, wave = __builtin_amdgcn_readfirstlane(tid >> 6), l31 = lane & 31, h5 = lane >> 5;
    const int vt = (wave >> 1) & 1;
    for (int unit = u0; unit < NB * HG_H * 2; unit += ustride) {
        const int b = unit >> 5, h = (unit >> 1) & 15, vp = unit & 1;
        f32x16 S0 = zero16(), S1 = zero16();
        for (int i = tid; i < 2 * 8704 / 16; i += 512) *(LAS v4u*)(lds + ST + i * 16) = (v4u){0u, 0u, 0u, 0u};
        const int row = tid >> 4, c16 = tid & 15;
        const size_t mb = (size_t)b * SEQ;
        v4u q0, ki0, ke0, x0 = (v4u){0u, 0u, 0u, 0u}, q1, ki1, ke1, x1 = (v4u){0u, 0u, 0u, 0u};
#define HS_CLAMP(c_) ((c_) < SEQ / 32 ? (c_) : SEQ / 32 - 1)
#define HS_LOAD(pq_, pki_, pke_, px_, chn) do { const size_t hb_ = (size_t)(b * 16 + h) * SEQ + (size_t)(chn) * 32; \
            pq_ = *(const GAS v4u*)(QD + (hb_ + row) * 128 + c16 * 8); pki_ = *(const GAS v4u*)(KI + (hb_ + row) * 128 + c16 * 8); pke_ = *(const GAS v4u*)(KE + (hb_ + row) * 128 + c16 * 8); \
            if (tid < 256) px_ = *(const GAS v4u*)(HV + (hb_ + (tid >> 3)) * 128 + vp * 64 + (tid & 7) * 8); \
            else if (tid < 288) px_ = *(const GAS v4u*)(DEC + ((size_t)(b * 16 + h) * (SEQ / 32) + (chn)) * 128 + (tid - 256) * 4); } while (0)
#define HS_WRITE(IB, pq_, pki_, pke_, px_) do { \
            *(LAS v4u*)(lds + (IB) + QI + row * RS + c16 * 16) = pq_; *(LAS v4u*)(lds + (IB) + KII + row * RS + c16 * 16) = pki_; *(LAS v4u*)(lds + (IB) + KEI + off_b(row, c16)) = pke_; \
            if (tid < 256) *(LAS v4u*)(lds + (IB) + VI + (tid >> 3) * VRS + (tid & 7) * 16) = px_; \
            else if (tid < 288) *(LAS v4u*)(lds + (IB) + DCI + (tid - 256) * 16) = px_; } while (0)
#define HS_STORE_O(chs) do { if (wave == 4 || wave == 6) {   \
            const LAS unsigned char* sg_ = lds + LDS_END + vt * 2048; bf16* op = Ob + (mb + (size_t)(chs) * 32 + (lane >> 2)) * DM + h * 128 + vp * 64 + vt * 32 + 8 * (lane & 3); \
            _Pragma("unroll") for (int q = 0; q < 2; ++q) { const v4u ov_ = *(const LAS v4u*)(sg_ + (16 * q + (lane >> 2)) * 64 + (lane & 3) * 16); *(GAS v4u*)(op + (size_t)(16 * q) * DM) = ov_; } } } while (0)
#define HS_CHUNK(IB, NIB, nq_, nki_, nke_, nx_) do { \
            f32x16 acc = zero16(); \
            if (wave == 5) { \
                s16x8 fa[8], fb[8]; \
                _Pragma("unroll") for (int ks = 0; ks < 8; ++ks) { fa[ks] = *(const LAS s16x8*)(lds + (IB) + KII + l31 * RS + (16 * ks + 8 * h5) * 2); fb[ks] = *(const LAS s16x8*)(lds + (IB) + QI + l31 * RS + (16 * ks + 8 * h5) * 2); } \
                _Pragma("unroll") for (int ks = 0; ks < 8; ++ks) acc = mfma32(fa[ks], fb[ks], acc); \
                const int t = l31; \
                _Pragma("unroll") for (int g = 0; g < 4; ++g) { float pvv[4]; \
                    _Pragma("unroll") for (int e = 0; e < 4; ++e) { const int s = 8 * g + 4 * h5 + e; pvv[e] = (s <= t) ? acc[4 * g + e] : 0.f; } \
                    v2u w; w.x = pk2(pvv[0], pvv[1]); w.y = pk2(pvv[2], pvv[3]); \
                    *(LAS v2u*)(lds + PI + t * PRS + (8 * g + 4 * h5) * 2) = w; } \
            } else if (wave == 4 || wave == 6) { \
                s16x8 fa[8], fb[8]; \
                _Pragma("unroll") for (int ks = 0; ks < 8; ++ks) { fa[ks] = *(const LAS s16x8*)(lds + (IB) + QI + l31 * RS + (16 * ks + 8 * h5) * 2); fb[ks] = *(const LAS s16x8*)(lds + ST + vt * 8704 + l31 * RS + (16 * ks + 8 * h5) * 2); } \
                _Pragma("unroll") for (int ks = 0; ks < 8; ++ks) acc = mfma32(fa[ks], fb[ks], acc); \
            } \
            __syncthreads(); \
            if (wave < 4) { \
                _Pragma("unroll") for (int g = 0; g < 4; ++g) { const f32x4 dv = *(const LAS f32x4*)(lds + (IB) + DCI + (32 * wave + 8 * g + 4 * h5) * 4); \
                    _Pragma("unroll") for (int e = 0; e < 4; ++e) { S0[4 * g + e] *= dv[e]; S1[4 * g + e] *= dv[e]; } } \
                _Pragma("unroll") for (int ks = 0; ks < 2; ++ks) { const s16x8 af = tr_frag_b(lds + (IB) + KEI, lane, wave, ks); \
                    const s16x8 b0 = tr_frag_plain(lds + (IB) + VI, VRS, lane, 0, ks), b1 = tr_frag_plain(lds + (IB) + VI, VRS, lane, 1, ks); S0 = mfma32(af, b0, S0); S1 = mfma32(af, b1, S1); } \
                _Pragma("unroll") for (int g = 0; g < 4; ++g) { const int d = 32 * wave + 8 * g + 4 * h5; \
                    v2u w; w.x = pk2(S0[4 * g], S0[4 * g + 1]); w.y = pk2(S0[4 * g + 2], S0[4 * g + 3]); \
                    *(LAS v2u*)(lds + ST + l31 * RS + d * 2) = w; \
                    w.x = pk2(S1[4 * g], S1[4 * g + 1]); w.y = pk2(S1[4 * g + 2], S1[4 * g + 3]); \
                    *(LAS v2u*)(lds + ST + 8704 + l31 * RS + d * 2) = w; } \
            } else if (wave == 4 || wave == 6) { \
                _Pragma("unroll") for (int ks = 0; ks < 2; ++ks) { const s16x8 af = *(const LAS s16x8*)(lds + PI + l31 * PRS + (16 * ks + 8 * h5) * 2); const s16x8 bfr = tr_frag_plain(lds + (IB) + VI, VRS, lane, vt, ks); acc = mfma32(af, bfr, acc); } \
                _Pragma("unroll") for (int i = 0; i < 8; ++i) { const float o0_ = acc[2 * i], o1_ = acc[2 * i + 1]; const unsigned pr_ = pk2(o0_, o1_); \
                    LAS unsigned char* sp_ = lds + LDS_END + vt * 2048 + (2 * (i & 1) + 8 * (i >> 1) + 4 * h5) * 64 + l31 * 2; \
                    *(LAS unsigned short*)sp_ = (unsigned short)(pr_ & 0xffffu); *(LAS unsigned short*)(sp_ + 64) = (unsigned short)(pr_ >> 16); } \
            } \
            HS_WRITE(NIB, nq_, nki_, nke_, nx_); \
            __syncthreads(); } while (0)
        HS_LOAD(q0, ki0, ke0, x0, 0); HS_LOAD(q1, ki1, ke1, x1, 1);
        HS_WRITE(0, q0, ki0, ke0, x0); HS_LOAD(q0, ki0, ke0, x0, 2);
        __syncthreads();
        for (int ch = 0; ch < SEQ / 32; ch += 2) {
            HS_CHUNK(0, SET, q1, ki1, ke1, x1);     HS_LOAD(q1, ki1, ke1, x1, HS_CLAMP(ch + 3)); HS_STORE_O(ch);
            HS_CHUNK(SET, 0, q0, ki0, ke0, x0);     HS_LOAD(q0, ki0, ke0, x0, HS_CLAMP(ch + 4)); HS_STORE_O(ch + 1);
        }
#undef HS_CLAMP
#undef HS_LOAD
#undef HS_WRITE
#undef HS_STORE_O
#undef HS_CHUNK
    }
}

template <bool XF32>
__device__ __forceinline__ void phase_poolmix(const void* hsrc  , const float* rsrow  , bf16* hout, const float* gnorm, const float* ada_l  ,
                                              const float* pscale, const bf16* Wt  ,
                                              const float* g2, const float* shift2, const float* scale2  , bf16* U2,
                                              LAS unsigned char* lds, int tid, int vcu, int G) {
    constexpr int PA = 0, WB = 65536, RSTD = RING_BYTES, ES = XF32 ? 4 : 2;
    const int lane = tid & 63, wave = __builtin_amdgcn_readfirstlane(tid >> 6), l31 = lane & 31, h5 = lane >> 5;
    LAS float* rstdL = (LAS float*)(lds + RSTD);
    LAS float* rowss = (LAS float*)(lds + RING_BYTES + 4096);
    const __amdgpu_buffer_rsrc_t rsH = __builtin_amdgcn_make_buffer_rsrc((void*)hsrc, (short)0, M * DM * ES, 0x00020000);
    const __amdgpu_buffer_rsrc_t rsO = __builtin_amdgcn_make_buffer_rsrc((void*)hout, (short)0, M * DM * 2, 0x00020000);
    const __amdgpu_buffer_rsrc_t rsW = __builtin_amdgcn_make_buffer_rsrc((void*)Wt, (short)0, 4 * 512 * 512 * 2, 0x00020000);
#define PM_OFFP(row, ch) ((row) * 1024 + 16 * ((ch) ^ ((row) & 15)))
#define PM_OFFW(n, ch) ((n) * 64 + 16 * ((ch) ^ (((n) >> 2) & 3)))
#define PM_LDH(voff, soff) __builtin_amdgcn_raw_buffer_load_b128(rsH, (voff), (soff), 0)
#define PM_UNPK(q_, f_) do { f_[0] = bflo(q_.x); f_[1] = bfhi(q_.x); f_[2] = bflo(q_.y); f_[3] = bfhi(q_.y); f_[4] = bflo(q_.z); f_[5] = bfhi(q_.z); f_[6] = bflo(q_.w); f_[7] = bfhi(q_.w); } while (0)
    for (int unit = vcu; unit < M / 64; unit += G) {
        const int r0 = unit * 64, b = r0 >> 12, tpos0 = r0 & (SEQ - 1), halo = tpos0 < 15 ? tpos0 : 15;
        const float* shp = ada_l + (size_t)b * ADA_W; const float* scp = shp + DM; const float* gtp = shp + 2 * DM;
        if (rsrow) { if (tid < 64 + halo) rstdL[tid + 15 - halo] = rsrow[r0 - halo + tid]; }
        else for (int rp = wave; 2 * rp < 64 + halo; rp += 2 * NWAVES) {
            int rrq[2]; float ssq[2]; v4u qq[2][XF32 ? 16 : 8];
#pragma unroll
            for (int z = 0; z < 2; ++z) { const int rr = 2 * (rp + NWAVES * z) + h5, rrc = rr < 64 + halo ? rr : 63 + halo, row = r0 - halo + rrc; rrq[z] = rr;
                const unsigned vo = (unsigned)row * (DM * ES) + (unsigned)l31 * 16u;
#pragma unroll
                for (int j = 0; j < (XF32 ? 16 : 8); ++j) qq[z][j] = PM_LDH(vo, (unsigned)j * 512u); }
#pragma unroll
            for (int z = 0; z < 2; ++z) { float ss = 0.f;
#pragma unroll
                for (int j = 0; j < (XF32 ? 16 : 8); ++j) { const v4u q = qq[z][j];
                    if constexpr (XF32) { const f32x4 v = __builtin_bit_cast(f32x4, q); ss += (v.x * v.x + v.y * v.y) + (v.z * v.z + v.w * v.w); }
                    else { float f[8]; PM_UNPK(q, f); ss += ((f[0] * f[0] + f[1] * f[1]) + (f[2] * f[2] + f[3] * f[3])) + ((f[4] * f[4] + f[5] * f[5]) + (f[6] * f[6] + f[7] * f[7])); } }
                ssq[z] = ss; }
#pragma unroll
            for (int z = 0; z < 2; ++z) { float ss = ssq[z];
                ss = half_sum(ss);
                const float rstd = 1.0f / sqrtf(ss * (1.0f / DM) + EPS);
                if (l31 == 0 && rrq[z] < 64 + halo) rstdL[rrq[z] + 15 - halo] = rstd; }
        }
        __syncthreads();
#pragma unroll 1
        for (int g = 0; g < 4; ++g) {
            const int w = 2 << g;
            const unsigned wvo = (unsigned)lane * 16u, wso = ((unsigned)g * 16u + 2u * (unsigned)wave) * (32u * 1024u);
            v4u wA[4], wB[4], wC[4];
            v4u hk[8];
#define PM_WLD(dst, kc_) do { _Pragma("unroll") for (int nt = 0; nt < 2; ++nt) _Pragma("unroll") for (int ks = 0; ks < 2; ++ks) \
                dst[nt * 2 + ks] = __builtin_amdgcn_raw_buffer_load_b128(rsW, wvo, wso + (unsigned)(nt * 32 + 2 * (kc_) + ks) * 1024u, 0); } while (0)
            PM_WLD(wA, 0); PM_WLD(wB, 1); PM_WLD(wC, 2);
            { const int oct = tid & 63, col = g * 512 + oct * 8; const unsigned hvo = (unsigned)col * ES;
              float gm[8], sh[8];
              { const f32x4 g0 = *(const GAS f32x4*)(gnorm + col), g1 = *(const GAS f32x4*)(gnorm + col + 4), s0 = *(const GAS f32x4*)(scp + col), s1 = *(const GAS f32x4*)(scp + col + 4);
                const f32x4 a0 = *(const GAS f32x4*)(shp + col), a1 = *(const GAS f32x4*)(shp + col + 4);
#pragma unroll
                for (int e = 0; e < 4; ++e) { gm[e] = g0[e] * (1.0f + s0[e]); gm[4 + e] = g1[e] * (1.0f + s1[e]); sh[e] = a0[e]; sh[4 + e] = a1[e]; } }
              LAS unsigned char* UT = lds + WB;
#pragma unroll
              for (int hf = 0; hf < 2; ++hf) {
                  const int rb = r0 - 15 + 32 * hf;
                  { v4u ha[6], hb2[6]; float rsv[6];
#pragma unroll
                      for (int k = 0; k < 6; ++k) { const int j = wave - 1 + 8 * k, row = rb + j, rowc = (j >= 0 && row >= r0 - halo) ? row : r0;
                          const unsigned so = (unsigned)rowc * (DM * ES);
                          ha[k] = PM_LDH(hvo, so); if constexpr (XF32) hb2[k] = PM_LDH(hvo, so + 16u); rsv[k] = rstdL[rowc - r0 + 15]; }
#pragma unroll
                      for (int k = 0; k < 6; ++k) { const int j = wave - 1 + 8 * k; const float rs_ = rsv[k]; float f[8];
                          if constexpr (XF32) { const f32x4 x0 = __builtin_bit_cast(f32x4, ha[k]), x1 = __builtin_bit_cast(f32x4, hb2[k]); f[0] = x0.x; f[1] = x0.y; f[2] = x0.z; f[3] = x0.w; f[4] = x1.x; f[5] = x1.y; f[6] = x1.z; f[7] = x1.w; }
                          else { PM_UNPK(ha[k], f); if (k >= 2) hk[4 * hf + k - 2] = ha[k]; }
                          v4u uq; uq.x = pk2(f[0] * rs_ * gm[0] + sh[0], f[1] * rs_ * gm[1] + sh[1]); uq.y = pk2(f[2] * rs_ * gm[2] + sh[2], f[3] * rs_ * gm[3] + sh[3]);
                          uq.z = pk2(f[4] * rs_ * gm[4] + sh[4], f[5] * rs_ * gm[5] + sh[5]); uq.w = pk2(f[6] * rs_ * gm[6] + sh[6], f[7] * rs_ * gm[7] + sh[7]);
                          if (j >= 0) *(LAS v4u*)(UT + j * 1024 + oct * 16) = uq; }
                  }
                  __syncthreads();
                  { const int il0 = 4 * wave, sl0 = il0 + 15, tp0 = tpos0 + 32 * hf + il0;
                    float S[8], uc[8];
#pragma unroll
                    for (int e = 0; e < 8; ++e) S[e] = 0.f;
                    { const int cnt = tp0 + 1 < w ? tp0 + 1 : w;
#define PM_WIN(J0, NJ) do { v4u qw[NJ]; \
                          _Pragma("unroll") for (int jj = 0; jj < NJ; ++jj) { const int sj = sl0 - (J0) - jj; qw[jj] = *(const LAS v4u*)(UT + (sj > 0 ? sj : 0) * 1024 + oct * 16); } \
                          _Pragma("unroll") for (int jj = 0; jj < NJ; ++jj) { float f[8]; PM_UNPK(qw[jj], f); const float m_ = (J0) + jj < cnt ? 1.0f : 0.0f; \
                              if ((J0) + jj == 0) { _Pragma("unroll") for (int e = 0; e < 8; ++e) uc[e] = f[e]; } \
                              _Pragma("unroll") for (int e = 0; e < 8; ++e) S[e] += m_ * f[e]; } } while (0)
                      PM_WIN(0, 4);
                      if (w > 4) { PM_WIN(4, 4); if (w > 8) PM_WIN(8, 8); }
#undef PM_WIN
                      const float inv = 1.0f / (float)cnt;
                      v4u o; o.x = pk2(S[0] * inv - uc[0], S[1] * inv - uc[1]); o.y = pk2(S[2] * inv - uc[2], S[3] * inv - uc[3]); o.z = pk2(S[4] * inv - uc[4], S[5] * inv - uc[5]); o.w = pk2(S[6] * inv - uc[6], S[7] * inv - uc[7]);
                      *(LAS v4u*)(lds + PA + PM_OFFP(32 * hf + il0, oct)) = o; }
#pragma unroll
                    for (int r = 1; r < 4; ++r) { const int tpr = tp0 + r, cnt = tpr + 1 < w ? tpr + 1 : w;
                        const v4u qn = *(const LAS v4u*)(UT + (sl0 + r) * 1024 + oct * 16), qo = *(const LAS v4u*)(UT + (sl0 + r - w) * 1024 + oct * 16);
                        float fn[8], fo[8]; PM_UNPK(qn, fn); PM_UNPK(qo, fo); const float m_ = tpr + 1 > w ? 1.0f : 0.0f;
#pragma unroll
                        for (int e = 0; e < 8; ++e) S[e] += fn[e] - m_ * fo[e];
                        const float inv = 1.0f / (float)cnt;
                        v4u o; o.x = pk2(S[0] * inv - fn[0], S[1] * inv - fn[1]); o.y = pk2(S[2] * inv - fn[2], S[3] * inv - fn[3]); o.z = pk2(S[4] * inv - fn[4], S[5] * inv - fn[5]); o.w = pk2(S[6] * inv - fn[6], S[7] * inv - fn[7]);
                        *(LAS v4u*)(lds + PA + PM_OFFP(32 * hf + il0 + r, oct)) = o; }
                  }
                  __syncthreads();
              }
            }
            f32x16 acc[2][2];
#pragma unroll
            for (int a = 0; a < 2; ++a)
#pragma unroll
                for (int c = 0; c < 2; ++c) acc[a][c] = zero16();
#define PM_CHUNK(kc, SET) do { \
                int la_ = lane; asm volatile("" : "+v"(la_)); const int l31_ = la_ & 31, h5_ = la_ >> 5; \
                s16x8 fb[2][2]; \
                _Pragma("unroll") for (int ks = 0; ks < 2; ++ks) _Pragma("unroll") for (int mt = 0; mt < 2; ++mt) fb[mt][ks] = *(const LAS s16x8*)(lds + PA + PM_OFFP(32 * mt + l31_, 4 * (kc) + 2 * ks + h5_)); \
                _Pragma("unroll") for (int ks = 0; ks < 2; ++ks) _Pragma("unroll") for (int nt = 0; nt < 2; ++nt) _Pragma("unroll") for (int mt = 0; mt < 2; ++mt) \
                    acc[nt][mt] = mfma32(__builtin_bit_cast(s16x8, SET[nt * 2 + ks]), fb[mt][ks], acc[nt][mt]); \
                if ((kc) + 3 < 16) PM_WLD(SET, (kc) + 3); } while (0)
            PM_CHUNK(0, wA); PM_CHUNK(1, wB); PM_CHUNK(2, wC); PM_CHUNK(3, wA); PM_CHUNK(4, wB); PM_CHUNK(5, wC); PM_CHUNK(6, wA); PM_CHUNK(7, wB);
            PM_CHUNK(8, wC); PM_CHUNK(9, wA); PM_CHUNK(10, wB); PM_CHUNK(11, wC); PM_CHUNK(12, wA); PM_CHUNK(13, wB); PM_CHUNK(14, wC); PM_CHUNK(15, wA);
#undef PM_CHUNK
#undef PM_WLD
            __syncthreads();
#pragma unroll
            for (int nt = 0; nt < 2; ++nt)
#pragma unroll
                for (int q = 0; q < 4; ++q)
#pragma unroll
                    for (int mt = 0; mt < 2; ++mt) { const int n = 32 * (2 * wave + nt) + 8 * q + 4 * h5, m = 32 * mt + l31;
                        const float y0 = acc[nt][mt][4 * q], y1 = acc[nt][mt][4 * q + 1], y2 = acc[nt][mt][4 * q + 2], y3 = acc[nt][mt][4 * q + 3];
                        v2u o; o.x = pk2(y0, y1); o.y = pk2(y2, y3);
                        *(LAS v2u*)(lds + PA + m * 1040 + n * 2) = o; }
            __syncthreads();
            { const int ch = tid & 63, col = g * 512 + ch * 8; const unsigned hvo = (unsigned)col * ES, ovo = (unsigned)col * 2u;
              const f32x4 gv0 = *(const GAS f32x4*)(gtp + col) * *(const GAS f32x4*)(pscale + col), gv1 = *(const GAS f32x4*)(gtp + col + 4) * *(const GAS f32x4*)(pscale + col + 4);
              if constexpr (XF32) {
#pragma unroll
                  for (int kb = 0; kb < 8; kb += 4) {
                      v4u ha[4], hb2[4];
#pragma unroll
                      for (int k = 0; k < 4; ++k) { const unsigned so = (unsigned)(r0 + wave + 8 * (kb + k)) * (DM * ES); ha[k] = PM_LDH(hvo, so); hb2[k] = PM_LDH(hvo, so + 16u); }
#pragma unroll
                      for (int k = 0; k < 4; ++k) { const int m = wave + 8 * (kb + k); float f[8], y[8];
                          const f32x4 x0 = __builtin_bit_cast(f32x4, ha[k]), x1 = __builtin_bit_cast(f32x4, hb2[k]); f[0] = x0.x; f[1] = x0.y; f[2] = x0.z; f[3] = x0.w; f[4] = x1.x; f[5] = x1.y; f[6] = x1.z; f[7] = x1.w;
                          const v4u yq = *(const LAS v4u*)(lds + PA + m * 1040 + ch * 16); PM_UNPK(yq, y);
                          v4u o; o.x = pk2(f[0] + gv0.x * y[0], f[1] + gv0.y * y[1]); o.y = pk2(f[2] + gv0.z * y[2], f[3] + gv0.w * y[3]); o.z = pk2(f[4] + gv1.x * y[4], f[5] + gv1.y * y[5]); o.w = pk2(f[6] + gv1.z * y[6], f[7] + gv1.w * y[7]);
                          __builtin_amdgcn_raw_buffer_store_b128(o, rsO, ovo, (unsigned)(r0 + m) * (DM * 2u), 0); }
                  }
              } else {
                  (void)hvo;
#pragma unroll
                  for (int kk = 0; kk < 8; ++kk) { const int m = wave + 8 * kk; float f[8], y[8]; PM_UNPK(hk[kk], f);
                      const v4u yq = *(const LAS v4u*)(lds + PA + m * 1040 + ch * 16); PM_UNPK(yq, y);
                      v4u o; o.x = pk2(f[0] + gv0.x * y[0], f[1] + gv0.y * y[1]); o.y = pk2(f[2] + gv0.z * y[2], f[3] + gv0.w * y[3]); o.z = pk2(f[4] + gv1.x * y[4], f[5] + gv1.y * y[5]); o.w = pk2(f[6] + gv1.z * y[6], f[7] + gv1.w * y[7]);
                      __builtin_amdgcn_raw_buffer_store_b128(o, rsO, ovo, (unsigned)(r0 + m) * (DM * 2u), 0);
                      if (U2) { float e[8]; PM_UNPK(o, e);
                          const float s2 = wave_sum(((e[0] * e[0] + e[1] * e[1]) + (e[2] * e[2] + e[3] * e[3])) + ((e[4] * e[4] + e[5] * e[5]) + (e[6] * e[6] + e[7] * e[7])));
                          if (lane == 0) rowss[m] = (g ? rowss[m] : 0.f) + s2; } }
              }
            }
            __syncthreads();
        }
        if (U2) {
            const __amdgpu_buffer_rsrc_t rsU = __builtin_amdgcn_make_buffer_rsrc((void*)U2, (short)0, M * DM * 2, 0x00020000);
            const float* sh2 = shift2 + (size_t)b * ADA_W; const float* sc2 = scale2 + (size_t)b * ADA_W;
            f32x4 mul[8], add[8];
#pragma unroll
            for (int j = 0; j < 8; ++j) { const int col = 8 * lane + 512 * (j >> 1) + 4 * (j & 1); const f32x4 gv = *(const GAS f32x4*)(g2 + col), s = *(const GAS f32x4*)(sc2 + col); mul[j] = gv * (s + 1.0f); add[j] = *(const GAS f32x4*)(sh2 + col); }
#pragma unroll 1
            for (int kb = 0; kb < 8; kb += 2) {
                v4u q[2][4]; float rs2[2];
#pragma unroll
                for (int z = 0; z < 2; ++z) { const int m = wave + 8 * (kb + z); rs2[z] = 1.0f / sqrtf(rowss[m] * (1.0f / DM) + EPS);
#pragma unroll
                    for (int j = 0; j < 4; ++j) q[z][j] = __builtin_amdgcn_raw_buffer_load_b128(rsO, (unsigned)lane * 16u + (unsigned)j * 1024u, (unsigned)(r0 + m) * (DM * 2u), 0); }
#pragma unroll
                for (int z = 0; z < 2; ++z) { const int m = wave + 8 * (kb + z); const float rstd = rs2[z];
#pragma unroll
                    for (int j = 0; j < 4; ++j) { float e[8]; PM_UNPK(q[z][j], e);
                        const f32x4 v0 = {e[0], e[1], e[2], e[3]}, v1 = {e[4], e[5], e[6], e[7]};
                        const f32x4 y0 = v0 * rstd * mul[2 * j] + add[2 * j], y1 = v1 * rstd * mul[2 * j + 1] + add[2 * j + 1];
                        v4u w; w.x = pk2(y0.x, y0.y); w.y = pk2(y0.z, y0.w); w.z = pk2(y1.x, y1.y); w.w = pk2(y1.z, y1.w);
                        __builtin_amdgcn_raw_buffer_store_b128(w, rsU, (unsigned)lane * 16u + (unsigned)j * 1024u, (unsigned)(r0 + m) * (DM * 2u), 0); } }
            }
        }
    }
#undef PM_OFFP
#undef PM_OFFW
#undef PM_LDH
#undef PM_UNPK
}

constexpr int NSUB = 6, PH_FINAL = 1 + NSUB * 2 * DEPTH, PH_END = PH_FINAL + 1;
__host__ __device__ constexpr bool phase_exists(int ph) {
    if (ph == 0 || ph == PH_FINAL) return true;
    const int hl = (ph - 1) / NSUB, s = (ph - 1) % NSUB, layer = hl >> 1;
    if (!(hl & 1) && layer % 3 == 0) return s == 1;
    if ((hl & 1) && layer % 3 == 0 && s == 0) return false;
    if (s == 2) return false;
    if (s == 3 || s == 4) return !(hl & 1) && (layer == 1 || layer == 2);
    return true;
}
__global__ void __launch_bounds__(NWAVES * 64, 2) trunk_fwd(Args a) {
    extern __shared__ __attribute__((aligned(16))) unsigned char lds_raw[];
    LAS unsigned char* lds = (LAS unsigned char*)lds_raw;
    volatile LAS unsigned* MISC = (volatile LAS unsigned*)(lds + MISC_OFF);
    const int G = gridDim.x; const int bx = blockIdx.x; const int vcu = (G % 8 == 0) ? (bx % 8) * (G / 8) + bx / 8 : bx;
    const int NGW = G * NWAVES;
    gu32* ctl = (gu32*)(a.ws + WS_CTL);
    const int wave0 = __builtin_amdgcn_readfirstlane((int)threadIdx.x >> 6);
    for (int u = (int)__builtin_amdgcn_mbcnt_hi(~0u, __builtin_amdgcn_mbcnt_lo(~0u, 0u)) + 64 * wave0; u < (LDS_BYTES - LDSCTL_OFF) / 4; u += NWAVES * 64) ((LAS unsigned*)(lds + LDSCTL_OFF))[u] = 0u;
    __syncthreads();
#define PHASE_IDS() const CAS Args* ap = (const CAS Args*)__builtin_amdgcn_kernarg_segment_ptr(); asm volatile("" : "+s"(ap)); unsigned char* ws = ap->ws; int lane = (int)__builtin_amdgcn_mbcnt_hi(~0u, __builtin_amdgcn_mbcnt_lo(~0u, 0u)); asm volatile("" : "+v"(lane)); const int wave = wave0, tid = wave * 64 + lane, gw = vcu * NWAVES + wave; (void)tid; (void)gw
#if MK_ONE_LAUNCH
    XcdBarrier bar = xcd_barrier_post((unsigned*)(ctl + CW_BAR), MISC + 8, wave0);
#define GRID_BAR() xcd_barrier(bar, wave0)
#else
#define GRID_BAR() do { } while (0)
#endif
    const int lo = a.ph_lo, hi = a.ph_hi;
#define IN(k) (lo <= (k) && (k) < hi)
#define ada ((float*)(ws + WS_ADA))
#define U ((bf16*)(ws + WS_U))
#define Pb ((bf16*)(ws + WS_P))
#define PROJ ((bf16*)(ws + WS_PROJ))
#define O ((bf16*)(ws + WS_O))
#define HQD ((bf16*)(ws + WS_PROJ + 256 * MiB))
#define HKI ((bf16*)(ws + WS_PROJ + 320 * MiB))
#define HKE ((bf16*)(ws + WS_P + 64 * MiB))
#define HDEC ((float*)(ws + WS_O + 128 * MiB))
#define HVV ((bf16*)(ws + WS_O + 136 * MiB))
#define H ((bf16*)(ws + (hl >= 7 ? WS_H2 : WS_H)))
#define HPOOL_OUT ((bf16*)(ws + (hl >= 6 ? WS_H2 : WS_H)))

    if (IN(0)) for (int rep = 0; rep < REP_P0; ++rep) { PHASE_IDS(); phase_prologue(ap, lds, tid, lane, wave, vcu, G); GRID_BAR(); }

    for (int hl = 0; hl < 2 * DEPTH; ++hl) {
        const int layer = hl >> 1, isffn = hl & 1, pb = 1 + NSUB * hl;
        const int kind = layer % 3, jj = layer / 3;
#define ada_l (ada + (size_t)layer * NB * ADA_W)
#define hin_is_x (hl == 0)
        if ((kind != 0) && IN(pb + 0)) for (int rep = 0; rep < REP_S0; ++rep) {
            PHASE_IDS();
            if (hin_is_x) phase_normmod(ap->x, ap->norm_mix_g, ada_l, ada_l + DM, U, gw, NGW, lane);
            else phase_normmod_bf(H, (isffn ? ap->norm_ffn_g : ap->norm_mix_g) + (size_t)layer * DM, ada_l + (isffn ? 3 : 0) * DM, ada_l + (isffn ? 4 : 1) * DM, U, gw, NGW, lane);
            GRID_BAR();
        }
        if (IN(pb + 1)) for (int rep = 0; rep < REP_S1; ++rep) {
            PHASE_IDS();
            if (isffn) {
                pg8::Gemm g{U, (const bf16*)(ws + WS_FFWIN) + (size_t)layer * FF2 * DM, M, FF2, DM, DM, DM, FF2 / 256, 0, 0};
                pg8::StaticOrder S; S.init(M, FF2, G, bx);
                pg8::EpiSwiGLU E{PROJ, FF};
                pg8::gemm_phase<pg8::EpiSwiGLU, pg8::StaticOrder, true>(lds + RING_OFF, g, S, E, tid);
            } else if (kind == 0) {
                phase_poolmix<false>(hin_is_x ? (const void*)(ws + WS_H2) : (const void*)H, hin_is_x ? (const float*)(ws + WS_XRS) : (const float*)nullptr, HPOOL_OUT,
                                     ap->norm_mix_g + (size_t)layer * DM, ada_l, ap->pool_scale + (size_t)jj * DM, (const bf16*)(ws + WS_POOLW) + (size_t)jj * 4 * 512 * 512,
                                     ap->norm_ffn_g + (size_t)layer * DM, ada_l + 3 * DM, ada_l + 4 * DM, U, lds, tid, vcu, G);
            } else {
                const int N = (kind == 1) ? HG_IN : RT_IN;
                pg8::Gemm g{U, (const bf16*)(ws + (kind == 1 ? WS_HGWIN : WS_RTWIN)), M, N, DM, DM, DM, N / 256, 0, 0};
                pg8::StaticOrder S; S.init(M, N, G, bx);
                const float* rot = (const float*)(ws + WS_ROT);
                pg8::EpiBf16Rot E{PROJ, N, rot, rot + (size_t)M * 128, kind == 2 ? 16 : 0, kind == 1 ? 16 : 0, (const float*)(ws + WS_LB), HQD, HKI, HKE, HDEC, HVV};
                pg8::gemm_phase<pg8::EpiBf16Rot, pg8::StaticOrder, true>(lds + RING_OFF, g, S, E, tid);
            }
            GRID_BAR();
        }
        if (0) for (int rep = 0; rep < REP_S2; ++rep) {
            PHASE_IDS();
            phase_hgrn_pre(PROJ, (const float*)(ws + WS_LB), HQD, HKI, HKE, HDEC, gw * 64 + lane, NGW * 64);
            GRID_BAR();
        }
        if (!isffn && kind != 0 && IN(pb + 3)) for (int rep = 0; rep < REP_S2; ++rep) {
            PHASE_IDS();
#if NAIVE_SCANS
            if (kind == 1) phase_hgrn_scan_naive(PROJ, (const float*)(ws + WS_LB), O, lds, tid, vcu, G);
            else phase_ret_scan_naive(PROJ, (const float*)(ws + WS_ROT), O, lds, tid, vcu, G);
#else
            if (kind == 1) { if ((vcu & 1) && G >= 2) phase_convert_late_tiles(ap, lds, lane, wave, vcu >> 1, G >> 1);
                             else phase_hgrn_scan(HVV, HQD, HKI, HKE, HDEC, O, lds, tid, G >= 2 ? (vcu >> 1) : vcu, G >= 2 ? ((G + 1) >> 1) : 1); }
            else phase_ret_scan(PROJ, O, lds, tid, vcu, G);
#endif
            GRID_BAR();
        }
        if (!isffn && kind != 0 && IN(pb + 4)) for (int rep = 0; rep < REP_S3; ++rep) {
            PHASE_IDS();
            if (kind == 1) phase_hgrn_post(O, PROJ, ap->hgrn_norm_g, Pb, gw, NGW, lane);
            else phase_ret_post(O, PROJ, ap->ret_norm_g, Pb, gw, NGW, lane);
            GRID_BAR();
        }
        if ((isffn || kind != 0) && IN(pb + 5)) {
            PHASE_IDS();
            pg8::Gemm g;
            const float* cs = nullptr;
            if (isffn) g = pg8::Gemm{PROJ, (const bf16*)(ws + WS_FFWOUT) + (size_t)layer * DM * FF, M, DM, FF, FF, FF, DM / 256, 0, 0};
            else if (kind == 0) { g = pg8::Gemm{Pb, (const bf16*)(ws + WS_POOLW) + (size_t)jj * 4 * 512 * 512, M, DM, 512, DM, 512, 2, 512, 512 * 512}; cs = ap->pool_scale + (size_t)jj * DM; }
            else if (kind == 1) g = pg8::Gemm{Pb, (const bf16*)(ws + WS_HGWOUT), M, DM, DM, DM, DM, DM / 256, 0, 0};
            else g = pg8::Gemm{Pb, (const bf16*)(ws + WS_RTWOUT), M, DM, RT_V, RT_V, RT_V, DM / 256, 0, 0};
            pg8::StaticOrder S; S.init(M, DM, G, bx);
            pg8::EpiResid E{hin_is_x ? ap->x : (const float*)nullptr, H, H, ada_l + (isffn ? 5 : 2) * DM, ADA_W, cs};
            pg8::gemm_phase<pg8::EpiResid, pg8::StaticOrder, true>(lds + RING_OFF, g, S, E, tid);
            GRID_BAR();
        }
    }
    if (IN(PH_FINAL)) { PHASE_IDS(); phase_finalnorm_bf((const bf16*)(ws + WS_H2), ap->final_g, ap->out, gw, NGW, lane); }
#undef IN
#undef ada
#undef U
#undef Pb
#undef PROJ
#undef O
#undef HQD
#undef HKI
#undef HKE
#undef HDEC
#undef HVV
#undef H
#undef HPOOL_OUT
#undef ada_l
#undef hin_is_x
}

extern "C" void kernel_launch(void* const* d_in, const int* in_sizes, int n_in, void* d_out, int out_size, void* d_ws, size_t ws_size, hipStream_t stream) {
    static int grid = 0;
    if (grid == 0) {
        if (n_in != 19 || in_sizes[0] != M * DM || out_size != M * DM || ws_size < WS_END) { fprintf(stderr, "kernel_launch: unexpected shapes (n_in %d, in0 %d, out %d, ws %zu < %zu); nothing launched\n", n_in, n_in > 0 ? in_sizes[0] : -1, out_size, ws_size, (size_t)WS_END); grid = -1; return; }
        int dev = 0, cus = 0, per_cu = 0;
        if (hipGetDevice(&dev) != hipSuccess || hipDeviceGetAttribute(&cus, hipDeviceAttributeMultiprocessorCount, dev) != hipSuccess) { grid = -1; return; }
        if (hipFuncSetAttribute((const void*)trunk_fwd, hipFuncAttributeMaxDynamicSharedMemorySize, LDS_BYTES) != hipSuccess) { fprintf(stderr, "kernel_launch: hipFuncSetAttribute failed\n"); grid = -1; return; }
        if (hipOccupancyMaxActiveBlocksPerMultiprocessor(&per_cu, (const void*)trunk_fwd, NWAVES * 64, LDS_BYTES) != hipSuccess || per_cu < 1)
            fprintf(stderr, "kernel_launch: note: occupancy query reports %d workgroups per CU\n", per_cu);
        (void)hipGetLastError();
        grid = cus;
    }
    if (grid < 0) return;
    if (hipMemsetAsync((char*)d_ws + WS_CTL, 0, CTL_ZERO_BYTES, stream) != hipSuccess) { fprintf(stderr, "kernel_launch: memset failed\n"); return; }
    Args a{};
    a.x = (const float*)d_in[0]; a.c = (const float*)d_in[1]; a.pos = (const int*)d_in[2]; a.w_ada = (const float*)d_in[3]; a.b_ada = (const float*)d_in[4];
    a.norm_mix_g = (const float*)d_in[5]; a.norm_ffn_g = (const float*)d_in[6]; a.pool_w = (const float*)d_in[7]; a.pool_scale = (const float*)d_in[8];
    a.hgrn_w_in = (const float*)d_in[9]; a.hgrn_lb = (const float*)d_in[10]; a.hgrn_norm_g = (const float*)d_in[11]; a.hgrn_w_out = (const float*)d_in[12];
    a.ret_w_in = (const float*)d_in[13]; a.ret_norm_g = (const float*)d_in[14]; a.ret_w_out = (const float*)d_in[15]; a.ffn_w_in = (const float*)d_in[16];
    a.ffn_w_out = (const float*)d_in[17]; a.final_g = (const float*)d_in[18];
    a.out = (float*)d_out; a.ws = (unsigned char*)d_ws;
#if MK_ONE_LAUNCH
    a.ph_lo = 0; a.ph_hi = PH_END;
    hipLaunchKernelGGL(trunk_fwd, dim3(grid), dim3(NWAVES * 64), LDS_BYTES, stream, a);
    { const hipError_t le = hipPeekAtLastError(); if (le != hipSuccess) fprintf(stderr, "kernel_launch: launch failed: %s\n", hipGetErrorName(le)); }
#else
    for (int ph = 0; ph < PH_END; ++ph) {
        if (!phase_exists(ph)) continue;
        a.ph_lo = ph; a.ph_hi = ph + 1;
        hipLaunchKernelGGL(trunk_fwd, dim3(grid), dim3(NWAVES * 64), LDS_BYTES, stream, a);
        const hipError_t le = hipPeekAtLastError();
        if (le != hipSuccess) { fprintf(stderr, "kernel_launch: launch %d failed: %s\n", ph, hipGetErrorName(le)); break; }
    }
#endif
}
```

```cpp
#include <hip/hip_runtime.h>
#include <cstdio>
#include <cstdint>

#ifndef MK_ONE_LAUNCH
#define MK_ONE_LAUNCH 1
#endif
#define REP_S0 1
#define REP_S1 1
#define REP_S2 1
#define REP_S3 1
#define REP_P0 1
#define NAIVE_SCANS 0

constexpr int DM = 2048, NB = 4, SEQ = 4096, DEPTH = 4, M = NB * SEQ;
constexpr int ADA_W = 6 * DM;
constexpr int HG_IN = 8192, HG_H = 16, HG_DK = 128;
constexpr int RT_IN = 12288, RT_H = 8, RT_DK = 256, RT_DV = 512, RT_V = 4096;
constexpr int FF = 5632, FF2 = 2 * FF;
constexpr float EPS = 1e-6f;

namespace pg8 {
#define PG8_LAS __attribute__((address_space(3)))
typedef unsigned short bf16_t;
typedef short bf16x8 __attribute__((ext_vector_type(8)));
typedef float f32x4 __attribute__((ext_vector_type(4)));
typedef unsigned u32x4 __attribute__((ext_vector_type(4)));
constexpr int BM = 256, BK = 64, HALF = 128, HTB = HALF * BK * 2  , STAGE_BYTES = 8 * HTB, NXCD = 8, WGM = 4;

__host__ __device__ __forceinline__ int lds_byte(int r, int c) { const int st = (r >> 4) * 2 + (c >> 5), rr = r & 15, cc = c & 31, ob = rr * 64 + cc * 2; return st * 1024 + (ob ^ (((ob >> 9) & 1) << 5)); }
__host__ __device__ __forceinline__ void stage_rc(int b, int& R, int& C) { const int st = b / 1024, sb = b % 1024, swz = sb ^ (((sb >> 9) & 1) << 5); R = (st >> 1) * 16 + swz / 64; C = (st & 1) * 32 + (swz % 64) / 2; }
__host__ __device__ __forceinline__ int perm32(int rho) { const int n = rho >> 4, i = rho & 15; return 8 * (i >> 2) + 4 * n + (i & 3); }

struct Unit { int pm, pn; };
struct Gemm { const bf16_t* A; const bf16_t* Bt; int M, N, K, lda, ldb, gpn; long a_gs, b_gs; };

struct StaticOrder {
    int nM, nN, nwg, G, c;
    __host__ __device__ void init(int M_, int N_, int G_, int c_) { nM = M_ / BM; nN = N_ / BM; nwg = nM * nN; G = G_; c = c_; }
    __host__ __device__ bool next(int i, Unit& u) const {
        const long L = (long)i * G + c; if (L >= nwg) return false;
        int wgid = (int)L; { const int q = nwg / NXCD, r = nwg % NXCD, xcd = wgid % NXCD, off = wgid / NXCD; wgid = (xcd < r ? xcd * (q + 1) : r * (q + 1) + (xcd - r) * q) + off; }
        const int nig = WGM * nN, gid = wgid / nig, fm = gid * WGM, gsz = (nM - fm) < WGM ? (nM - fm) : WGM;
        u.pm = fm + ((wgid % nig) % gsz); u.pn = (wgid % nig) / gsz; return true;
    }
    __device__ __forceinline__ void a_ready(const Unit&) const {}
    __device__ __forceinline__ void done(const Unit&) const {}
};

__device__ __forceinline__ unsigned cvt_pk_bf16(float lo, float hi) { unsigned r; asm volatile("v_cvt_pk_bf16_f32 %0, %1, %2" : "=v"(r) : "v"(lo), "v"(hi)); return r; }

struct EpiBf16 {
    static constexpr bool PERM = true, AFTER_DRAIN = false;
    bf16_t* O; int ldc;
    __device__ __forceinline__ void operator()(const f32x4 (&acc)[2][2][4][2], const Unit& u, int wr, int wc, int fr, int fq) const {
        const int row0 = u.pm * BM + wr * 64 + fr, col0 = u.pn * BM + wc * 32 + 8 * fq;
#pragma unroll
        for (int ai = 0; ai < 2; ++ai)
#pragma unroll
            for (int m = 0; m < 4; ++m) { bf16_t* rowp = O + (size_t)(row0 + ai * HALF + m * 16) * ldc + col0;
#pragma unroll
                for (int bj = 0; bj < 2; ++bj) { const f32x4 v0 = acc[ai][bj][m][0], v1 = acc[ai][bj][m][1];
                    u32x4 w; w.x = cvt_pk_bf16(v0[0], v0[1]); w.y = cvt_pk_bf16(v0[2], v0[3]); w.z = cvt_pk_bf16(v1[0], v1[1]); w.w = cvt_pk_bf16(v1[2], v1[3]);
                    *(u32x4*)(rowp + bj * HALF) = w; } }
    }
};
__device__ __forceinline__ float scan16_mul(float x) {
#define PG8_DPP_SHR(v, n) __builtin_bit_cast(float, __builtin_amdgcn_update_dpp(0x3f800000, __builtin_bit_cast(int, v), 0x110 + (n), 0xf, 0xf, false))
    x *= PG8_DPP_SHR(x, 1); x *= PG8_DPP_SHR(x, 2); x *= PG8_DPP_SHR(x, 4); x *= PG8_DPP_SHR(x, 8);
#undef PG8_DPP_SHR
    return x;
}
__device__ __forceinline__ float bcast15(float x, int lane) { (void)lane; return __builtin_bit_cast(float, __builtin_amdgcn_update_dpp(0, __builtin_bit_cast(int, x), 0x15F, 0xf, 0xf, false)); }
__device__ __forceinline__ float sigm_f(float x) { return __builtin_amdgcn_rcpf(1.0f + __builtin_amdgcn_exp2f(-1.4426950408889634f * x)); }
struct EpiBf16Rot {
    static constexpr bool PERM = true, AFTER_DRAIN = false;
    bf16_t* O; int ldc; const float* ct; const float* st; int rot_tiles;
    int hg_tiles; const float* lbv; bf16_t* QD; bf16_t* KI; bf16_t* KE; float* DEC; bf16_t* HV;
    __device__ __forceinline__ void operator()(const f32x4 (&acc)[2][2][4][2], const Unit& u, int wr, int wc, int fr, int fq) const {
        const int row0 = u.pm * BM + wr * 64 + fr, col0 = u.pn * BM + wc * 32 + 8 * fq;
        if (u.pn < hg_tiles) {
            const int lane = fq * 16 + fr, cg = u.pn * HALF + wc * 32 + 8 * fq;
            float lb[8];
            { const f32x4 l0 = *(const f32x4*)(lbv + cg), l1 = *(const f32x4*)(lbv + cg + 4);
#pragma unroll
              for (int e = 0; e < 4; ++e) { lb[e] = l0[e]; lb[4 + e] = l1[e]; } }
#pragma unroll
            for (int ai = 0; ai < 2; ++ai)
#pragma unroll
                for (int mp = 0; mp < 2; ++mp) {
                    float qd0[8], ki0[8], ke0[8], qd1[8], ki1[8], ke1[8], tot[8];
                    float s0[8], s1[8], e0[8], e1[8];
#pragma unroll
                    for (int c = 0; c < 8; ++c) { s0[c] = acc[ai][1][2 * mp][c >> 2][c & 3] * -1.4426950408889634f; s1[c] = acc[ai][1][2 * mp + 1][c >> 2][c & 3] * -1.4426950408889634f; }
                    __builtin_amdgcn_sched_barrier(0);
#pragma unroll
                    for (int c = 0; c < 8; ++c) { s0[c] = __builtin_amdgcn_exp2f(s0[c]); s1[c] = __builtin_amdgcn_exp2f(s1[c]); }
                    __builtin_amdgcn_sched_barrier(0);
#pragma unroll
                    for (int c = 0; c < 8; ++c) { s0[c] += 1.0f; s1[c] += 1.0f; }
                    __builtin_amdgcn_sched_barrier(0);
#pragma unroll
                    for (int c = 0; c < 8; ++c) { s0[c] = __builtin_amdgcn_rcpf(s0[c]); s1[c] = __builtin_amdgcn_rcpf(s1[c]); }
                    __builtin_amdgcn_sched_barrier(0);
#pragma unroll
                    for (int c = 0; c < 8; ++c) { const float om = 1.0f - lb[c]; e0[c] = lb[c] + om * s0[c]; e1[c] = lb[c] + om * s1[c]; }
#define PG8_DPP_SHR(v, n) __builtin_bit_cast(float, __builtin_amdgcn_update_dpp(0x3f800000, __builtin_bit_cast(int, v), 0x110 + (n), 0xf, 0xf, false))
#pragma unroll
                    for (int st = 1; st < 16; st <<= 1) {
                        __builtin_amdgcn_sched_barrier(0);
#pragma unroll
                        for (int c = 0; c < 8; ++c) {
                            if (st == 1) { e0[c] *= PG8_DPP_SHR(e0[c], 1); e1[c] *= PG8_DPP_SHR(e1[c], 1); }
                            else if (st == 2) { e0[c] *= PG8_DPP_SHR(e0[c], 2); e1[c] *= PG8_DPP_SHR(e1[c], 2); }
                            else if (st == 4) { e0[c] *= PG8_DPP_SHR(e0[c], 4); e1[c] *= PG8_DPP_SHR(e1[c], 4); }
                            else { e0[c] *= PG8_DPP_SHR(e0[c], 8); e1[c] *= PG8_DPP_SHR(e1[c], 8); } }
                    }
#undef PG8_DPP_SHR
                    __builtin_amdgcn_sched_barrier(0);
#pragma unroll
                    for (int c = 0; c < 8; ++c) e1[c] *= bcast15(e0[c], lane);
#pragma unroll
                    for (int c = 0; c < 8; ++c) tot[c] = bcast15(e1[c], lane);
                    __builtin_amdgcn_sched_barrier(0);
#pragma unroll
                    for (int c = 0; c < 8; ++c) { const float om = 1.0f - lb[c];
                        const float q0 = acc[ai][0][2 * mp][c >> 2][c & 3], q1 = acc[ai][0][2 * mp + 1][c >> 2][c & 3];
                        const float k0 = om * (1.0f - s0[c]) * __builtin_amdgcn_rcpf(e0[c]), k1 = om * (1.0f - s1[c]) * __builtin_amdgcn_rcpf(e1[c]);
                        qd0[c] = q0 * e0[c]; ki0[c] = k0; ke0[c] = k0 * tot[c]; qd1[c] = q1 * e1[c]; ki1[c] = k1; ke1[c] = k1 * tot[c]; }
                    const int rr0 = row0 + ai * HALF + 32 * mp;
                    const size_t r0 = ((size_t)((rr0 >> 12) * 16 + u.pn) * 4096 + (rr0 & 4095)) * 128 + (wc * 32 + 8 * fq), r1 = r0 + 16 * 128;
                    u32x4 w;
                    w.x = cvt_pk_bf16(qd0[0], qd0[1]); w.y = cvt_pk_bf16(qd0[2], qd0[3]); w.z = cvt_pk_bf16(qd0[4], qd0[5]); w.w = cvt_pk_bf16(qd0[6], qd0[7]); *(u32x4*)(QD + r0) = w;
                    w.x = cvt_pk_bf16(ki0[0], ki0[1]); w.y = cvt_pk_bf16(ki0[2], ki0[3]); w.z = cvt_pk_bf16(ki0[4], ki0[5]); w.w = cvt_pk_bf16(ki0[6], ki0[7]); *(u32x4*)(KI + r0) = w;
                    w.x = cvt_pk_bf16(ke0[0], ke0[1]); w.y = cvt_pk_bf16(ke0[2], ke0[3]); w.z = cvt_pk_bf16(ke0[4], ke0[5]); w.w = cvt_pk_bf16(ke0[6], ke0[7]); *(u32x4*)(KE + r0) = w;
                    w.x = cvt_pk_bf16(qd1[0], qd1[1]); w.y = cvt_pk_bf16(qd1[2], qd1[3]); w.z = cvt_pk_bf16(qd1[4], qd1[5]); w.w = cvt_pk_bf16(qd1[6], qd1[7]); *(u32x4*)(QD + r1) = w;
                    w.x = cvt_pk_bf16(ki1[0], ki1[1]); w.y = cvt_pk_bf16(ki1[2], ki1[3]); w.z = cvt_pk_bf16(ki1[4], ki1[5]); w.w = cvt_pk_bf16(ki1[6], ki1[7]); *(u32x4*)(KI + r1) = w;
                    w.x = cvt_pk_bf16(ke1[0], ke1[1]); w.y = cvt_pk_bf16(ke1[2], ke1[3]); w.z = cvt_pk_bf16(ke1[4], ke1[5]); w.w = cvt_pk_bf16(ke1[6], ke1[7]); *(u32x4*)(KE + r1) = w;
                    if (fr == 15) { const int crow = u.pm * BM + wr * 64 + ai * HALF + 32 * mp; float* dp = DEC + ((size_t)((crow >> 12) * 16 + u.pn) * 128 + ((crow & 4095) >> 5)) * 128 + (wc * 32 + 8 * fq);
                        *(f32x4*)dp = (f32x4){tot[0], tot[1], tot[2], tot[3]}; *(f32x4*)(dp + 4) = (f32x4){tot[4], tot[5], tot[6], tot[7]}; }
                }
        } else if (u.pn < rot_tiles) {
            const float sc = u.pn >= 8 ? 0.0625f : 1.0f; const int j0 = wc * 32 + 8 * fq;
#pragma unroll
            for (int ai = 0; ai < 2; ++ai)
#pragma unroll
                for (int m = 0; m < 4; ++m) { const int row = row0 + ai * HALF + m * 16; bf16_t* rowp = O + (size_t)row * ldc + col0;
                    const u32x4 t0 = *(const u32x4*)((const unsigned*)ct + (size_t)row * 128 + j0), t1 = *(const u32x4*)((const unsigned*)ct + (size_t)row * 128 + j0 + 4);
                    f32x4 c0, c1, s0, s1;
#pragma unroll
                    for (int e = 0; e < 4; ++e) { c0[e] = (float)__builtin_bit_cast(_Float16, (unsigned short)(t0[e] & 0xffffu)); s0[e] = (float)__builtin_bit_cast(_Float16, (unsigned short)(t0[e] >> 16));
                        c1[e] = (float)__builtin_bit_cast(_Float16, (unsigned short)(t1[e] & 0xffffu)); s1[e] = (float)__builtin_bit_cast(_Float16, (unsigned short)(t1[e] >> 16)); }
                    const f32x4 a0 = acc[ai][0][m][0], a1 = acc[ai][0][m][1], b0 = acc[ai][1][m][0], b1 = acc[ai][1][m][1];
                    const f32x4 p0 = (a0 * c0 - b0 * s0) * sc, p1 = (a1 * c1 - b1 * s1) * sc, q0 = (a0 * s0 + b0 * c0) * sc, q1 = (a1 * s1 + b1 * c1) * sc;
                    u32x4 w; w.x = cvt_pk_bf16(p0[0], p0[1]); w.y = cvt_pk_bf16(p0[2], p0[3]); w.z = cvt_pk_bf16(p1[0], p1[1]); w.w = cvt_pk_bf16(p1[2], p1[3]);
                    *(u32x4*)rowp = w;
                    w.x = cvt_pk_bf16(q0[0], q0[1]); w.y = cvt_pk_bf16(q0[2], q0[3]); w.z = cvt_pk_bf16(q1[0], q1[1]); w.w = cvt_pk_bf16(q1[2], q1[3]);
                    *(u32x4*)(rowp + HALF) = w; }
        } else {
            const bool hv = hg_tiles > 0 && u.pn < 24;
#pragma unroll
            for (int ai = 0; ai < 2; ++ai)
#pragma unroll
                for (int m = 0; m < 4; ++m) { const int row = row0 + ai * HALF + m * 16; bf16_t* rowp = O + (size_t)row * ldc + col0;
#pragma unroll
                    for (int bj = 0; bj < 2; ++bj) { const f32x4 v0 = acc[ai][bj][m][0], v1 = acc[ai][bj][m][1];
                        u32x4 w; w.x = cvt_pk_bf16(v0[0], v0[1]); w.y = cvt_pk_bf16(v0[2], v0[3]); w.z = cvt_pk_bf16(v1[0], v1[1]); w.w = cvt_pk_bf16(v1[2], v1[3]);
                        if (hv) *(u32x4*)(HV + ((size_t)((row >> 12) * 16 + 2 * (u.pn - 16) + bj) * 4096 + (row & 4095)) * 128 + wc * 32 + 8 * fq) = w;
                        else *(u32x4*)(rowp + bj * HALF) = w; } }
        }
    }
};
__device__ __forceinline__ float silu_f(float x) { return x * __builtin_amdgcn_rcpf(1.0f + __builtin_amdgcn_exp2f(-1.4426950408889634f * x)); }
struct EpiSwiGLU {
    static constexpr bool PERM = true, AFTER_DRAIN = false;
    bf16_t* O; int ldc;
    __device__ __forceinline__ void operator()(const f32x4 (&acc)[2][2][4][2], const Unit& u, int wr, int wc, int fr, int fq) const {
        const int row0 = u.pm * BM + wr * 64 + fr, col0 = u.pn * HALF + wc * 32 + 8 * fq;
#pragma unroll
        for (int ai = 0; ai < 2; ++ai)
#pragma unroll
            for (int m = 0; m < 4; ++m) { bf16_t* rowp = O + (size_t)(row0 + ai * HALF + m * 16) * ldc + col0;
                const f32x4 g0 = acc[ai][0][m][0], g1 = acc[ai][0][m][1], u0 = acc[ai][1][m][0], u1 = acc[ai][1][m][1];
                f32x4 e0 = g0 * -1.4426950408889634f, e1 = g1 * -1.4426950408889634f;
                const f32x4 p0 = g0 * u0, p1 = g1 * u1;
                __builtin_amdgcn_sched_barrier(0);
#pragma unroll
                for (int i = 0; i < 4; ++i) { e0[i] = __builtin_amdgcn_exp2f(e0[i]); e1[i] = __builtin_amdgcn_exp2f(e1[i]); }
                __builtin_amdgcn_sched_barrier(0);
                e0 = e0 + 1.0f; e1 = e1 + 1.0f;
                __builtin_amdgcn_sched_barrier(0);
#pragma unroll
                for (int i = 0; i < 4; ++i) { e0[i] = __builtin_amdgcn_rcpf(e0[i]); e1[i] = __builtin_amdgcn_rcpf(e1[i]); }
                __builtin_amdgcn_sched_barrier(0);
                const f32x4 o0 = p0 * e0, o1 = p1 * e1;
                u32x4 w; w.x = cvt_pk_bf16(o0[0], o0[1]); w.y = cvt_pk_bf16(o0[2], o0[3]); w.z = cvt_pk_bf16(o1[0], o1[1]); w.w = cvt_pk_bf16(o1[2], o1[3]);
                *(u32x4*)rowp = w; }
    }
};
struct EpiResid {
    static constexpr bool PERM = true, AFTER_DRAIN = false;
    const float* xin; const bf16_t* hin; bf16_t* hout; const float* gate; int gate_bs; const float* cscale;
    __device__ __forceinline__ void operator()(const f32x4 (&acc)[2][2][4][2], const Unit& u, int wr, int wc, int fr, int fq) const {
        const int row0 = u.pm * BM + wr * 64 + fr, col0 = u.pn * BM + wc * 32 + 8 * fq;
        const float* gp = gate + (size_t)(u.pm >> 4) * gate_bs + col0;
        f32x4 gv[2][2];
#pragma unroll
        for (int bj = 0; bj < 2; ++bj)
#pragma unroll
            for (int n = 0; n < 2; ++n) { gv[bj][n] = *(const f32x4*)(gp + bj * HALF + n * 4); if (cscale) gv[bj][n] = gv[bj][n] * *(const f32x4*)(cscale + col0 + bj * HALF + n * 4); }
#pragma unroll
        for (int ai = 0; ai < 2; ++ai)
#pragma unroll
            for (int m = 0; m < 4; ++m) { const size_t ro = (size_t)(row0 + ai * HALF + m * 16) * DM + col0;
#pragma unroll
                for (int bj = 0; bj < 2; ++bj) {
                    f32x4 h0, h1;
                    if (xin) { h0 = *(const f32x4*)(xin + ro + bj * HALF); h1 = *(const f32x4*)(xin + ro + bj * HALF + 4); }
                    else { const u32x4 hb = *(const u32x4*)(hin + ro + bj * HALF);
                        h0 = (f32x4){__builtin_bit_cast(float, hb.x << 16), __builtin_bit_cast(float, hb.x & 0xffff0000u), __builtin_bit_cast(float, hb.y << 16), __builtin_bit_cast(float, hb.y & 0xffff0000u)};
                        h1 = (f32x4){__builtin_bit_cast(float, hb.z << 16), __builtin_bit_cast(float, hb.z & 0xffff0000u), __builtin_bit_cast(float, hb.w << 16), __builtin_bit_cast(float, hb.w & 0xffff0000u)}; }
                    const f32x4 o0 = h0 + gv[bj][0] * acc[ai][bj][m][0], o1 = h1 + gv[bj][1] * acc[ai][bj][m][1];
                    u32x4 w; w.x = cvt_pk_bf16(o0[0], o0[1]); w.y = cvt_pk_bf16(o0[2], o0[3]); w.z = cvt_pk_bf16(o1[0], o1[1]); w.w = cvt_pk_bf16(o1[2], o1[3]);
                    *(u32x4*)(hout + ro + bj * HALF) = w; } }
    }
};

template <class Epi, class Sched, bool ALIGN_EPI = false>
__device__ __forceinline__ void gemm_phase(PG8_LAS unsigned char* lds, const Gemm g, const Sched& S, const Epi& E, const int tid) {
    const int wid = __builtin_amdgcn_readfirstlane(tid >> 6), lane = tid & 63, wr = wid >> 2, wc = wid & 3, fr = lane & 15, fq = lane >> 4;
    const int K = g.K, nt = K / BK, lda = g.lda, ldb = g.ldb;
    unsigned voffA[2], voffB[2];
#pragma unroll
    for (int i = 0; i < 2; ++i) { int R, C; stage_rc(tid * 16 + i * 8192, R, C); const int Rb = Epi::PERM ? ((R & ~31) + perm32(R & 31)) : R;
        voffA[i] = (unsigned)(R * lda + C) * 2u; voffB[i] = (unsigned)(Rb * ldb + C) * 2u; }
    const unsigned kstep = (unsigned)(BK * 2);
    const unsigned hstepA = (unsigned)HALF * lda * 2u, hstepB = (unsigned)HALF * ldb * 2u;
    const __amdgpu_buffer_rsrc_t rsA = __builtin_amdgcn_make_buffer_rsrc((void*)g.A, (short)0, 0x7fffffff, 0x00020000), rsB = __builtin_amdgcn_make_buffer_rsrc((void*)g.Bt, (short)0, 0x7fffffff, 0x00020000);
    const unsigned ldsw = (unsigned)wid * 1024u;
    const int aoff = lds_byte(wr * 64 + fr, fq * 8), boff = lds_byte(wc * 32 + fr, fq * 8);
#define PG8_SA(b, h) (((b) * 2 + (h)) * HTB)
#define PG8_SB(b, h) ((4 + (b) * 2 + (h)) * HTB)
#define PG8_STAGEA(bufoff, soff, voff) do { _Pragma("unroll") for (int _i = 0; _i < 2; ++_i) \
        __builtin_amdgcn_raw_ptr_buffer_load_lds(rsA, (PG8_LAS unsigned*)(lds + (bufoff) + ldsw + _i * 8192), 16, (voff)[_i], (soff), 0, 0); } while (0)
#define PG8_STAGEB(bufoff, soff, voff) do { _Pragma("unroll") for (int _i = 0; _i < 2; ++_i) \
        __builtin_amdgcn_raw_ptr_buffer_load_lds(rsB, (PG8_LAS unsigned*)(lds + (bufoff) + ldsw + _i * 8192), 16, (voff)[_i], (soff), 0, 0); } while (0)
#define PG8_LDA(dst, b, h) do { _Pragma("unroll") for (int m = 0; m < 4; ++m) _Pragma("unroll") for (int k = 0; k < 2; ++k) dst[m][k] = *(const PG8_LAS bf16x8*)(lds + PG8_SA(b, h) + aoff + m * 2048 + k * 1024); } while (0)
#define PG8_LDB(dst, b, h) do { _Pragma("unroll") for (int n = 0; n < 2; ++n) _Pragma("unroll") for (int k = 0; k < 2; ++k) dst[n][k] = *(const PG8_LAS bf16x8*)(lds + PG8_SB(b, h) + boff + n * 2048 + k * 1024); } while (0)
#define PG8_MMA(ai, bj, At, Bt) do { __builtin_amdgcn_s_setprio(1); _Pragma("unroll") for (int m = 0; m < 4; ++m) _Pragma("unroll") for (int n = 0; n < 2; ++n) _Pragma("unroll") for (int k = 0; k < 2; ++k) \
        acc[ai][bj][m][n] = __builtin_amdgcn_mfma_f32_16x16x32_bf16(Bt[n][k], At[m][k], acc[ai][bj][m][n], 0, 0, 0); __builtin_amdgcn_s_setprio(0); } while (0)
#define PG8_WAIT_V(n) asm volatile("s_waitcnt vmcnt(" #n ")" ::: "memory")
#define PG8_WAIT_L(n) asm volatile("s_waitcnt lgkmcnt(" #n ")" ::: "memory")
#define PG8_BAR __builtin_amdgcn_s_barrier()
#define PG8_SCHED __builtin_amdgcn_sched_barrier(0)
#define PG8_ABASE(u) ((unsigned)(((size_t)((u).pn / g.gpn) * (size_t)g.a_gs + (size_t)(u).pm * BM * lda) * 2))
#define PG8_BBASE(u) ((unsigned)(((size_t)((u).pn / g.gpn) * (size_t)g.b_gs + (size_t)((u).pn % g.gpn) * BM * ldb) * 2))
    Unit cur, nxt; int ui = 0;
    if (!S.next(0, cur)) return;
    f32x4 acc[2][2][4][2];
#pragma unroll
    for (int a = 0; a < 2; ++a)
#pragma unroll
        for (int b = 0; b < 2; ++b)
#pragma unroll
            for (int m = 0; m < 4; ++m)
#pragma unroll
                for (int n = 0; n < 2; ++n) acc[a][b][m][n] = (f32x4){0.f, 0.f, 0.f, 0.f};
    bf16x8 At[4][2], B0[2][2], B1[2][2];
    unsigned cA = PG8_ABASE(cur), cB = PG8_BBASE(cur);
    S.a_ready(cur);
    PG8_STAGEB(PG8_SB(0, 0), cB, voffB); PG8_STAGEB(PG8_SB(0, 1), cB + hstepB, voffB); PG8_STAGEA(PG8_SA(0, 0), cA, voffA); PG8_STAGEA(PG8_SA(0, 1), cA + hstepA, voffA);
    PG8_STAGEB(PG8_SB(1, 0), cB + kstep, voffB); PG8_STAGEA(PG8_SA(1, 0), cA + kstep, voffA); PG8_STAGEB(PG8_SB(1, 1), cB + hstepB + kstep, voffB);
    if (wr == 1) PG8_BAR;
    PG8_WAIT_V(8); PG8_BAR;
    PG8_WAIT_V(6); PG8_BAR;
    for (;;) {
        const bool has_next = S.next(ui + 1, nxt);
        const unsigned nA = has_next ? PG8_ABASE(nxt) : cA, nB = has_next ? PG8_BBASE(nxt) : cB;
        for (int t = 0; t < nt; t += 2) {
            const bool last = (t == nt - 2);
            const unsigned a1 = cA + (unsigned)(t + 1) * kstep;
            const unsigned a2 = last ? nA : cA + (unsigned)(t + 2) * kstep, b2 = last ? nB : cB + (unsigned)(t + 2) * kstep;
            const unsigned a3 = a2 + kstep, b3 = b2 + kstep;
            if (last && has_next) S.a_ready(nxt);
            PG8_LDB(B0, 0, 0); PG8_LDB(B1, 0, 1); PG8_SCHED; PG8_LDA(At, 0, 0); PG8_STAGEA(PG8_SA(1, 1), a1 + hstepA, voffA);
            PG8_WAIT_V(8); PG8_WAIT_L(0); PG8_BAR; PG8_MMA(0, 0, At, B0); PG8_MMA(0, 1, At, B1); PG8_BAR; PG8_SCHED;
            PG8_LDA(At, 0, 1); PG8_STAGEB(PG8_SB(0, 0), b2, voffB); PG8_STAGEB(PG8_SB(0, 1), b2 + hstepB, voffB); PG8_STAGEA(PG8_SA(0, 0), a2, voffA);
            PG8_WAIT_V(8); PG8_WAIT_L(0); PG8_BAR; PG8_MMA(1, 0, At, B0); PG8_MMA(1, 1, At, B1); PG8_BAR; PG8_SCHED;
            PG8_LDB(B0, 1, 0); PG8_LDB(B1, 1, 1); PG8_SCHED; PG8_LDA(At, 1, 0); PG8_STAGEA(PG8_SA(0, 1), a2 + hstepA, voffA);
            PG8_WAIT_V(8); PG8_WAIT_L(0); PG8_BAR; PG8_MMA(0, 0, At, B0); PG8_MMA(0, 1, At, B1); PG8_BAR; PG8_SCHED;
            PG8_LDA(At, 1, 1); PG8_STAGEB(PG8_SB(1, 0), b3, voffB); PG8_STAGEB(PG8_SB(1, 1), b3 + hstepB, voffB); PG8_STAGEA(PG8_SA(1, 0), a3, voffA);
            PG8_WAIT_V(8); PG8_WAIT_L(0); PG8_BAR; PG8_MMA(1, 0, At, B0); PG8_MMA(1, 1, At, B1); PG8_BAR; PG8_SCHED;
        }
        if constexpr (ALIGN_EPI) { if (wr == 0) PG8_BAR; }
        E(acc, cur, wr, wc, fr, fq); S.done(cur);
        if (!has_next) break;
#pragma unroll
        for (int a = 0; a < 2; ++a)
#pragma unroll
            for (int b = 0; b < 2; ++b)
#pragma unroll
                for (int m = 0; m < 4; ++m)
#pragma unroll
                    for (int n = 0; n < 2; ++n) acc[a][b][m][n] = (f32x4){0.f, 0.f, 0.f, 0.f};
        cur = nxt; cA = nA; cB = nB; ++ui;
        if constexpr (ALIGN_EPI) { if (wr == 1) PG8_BAR; }
    }
    PG8_WAIT_V(0);
    if constexpr (!ALIGN_EPI) { if (wr == 0) PG8_BAR; }
    PG8_BAR;
#undef PG8_SA
#undef PG8_SB
#undef PG8_STAGEA
#undef PG8_STAGEB
#undef PG8_LDA
#undef PG8_LDB
#undef PG8_MMA
#undef PG8_WAIT_V
#undef PG8_WAIT_L
#undef PG8_BAR
#undef PG8_SCHED
#undef PG8_ABASE
#undef PG8_BBASE
}
}

constexpr size_t MiB = 1u << 20;
constexpr size_t WS_CTL = 0, CTL_ZERO_BYTES = 1 * MiB;
constexpr size_t WS_ADA = 1 * MiB;
constexpr size_t WS_LB = 2 * MiB;
constexpr size_t WS_XRS = 3 * MiB;
constexpr size_t WS_ROT = 4 * MiB;
constexpr size_t WS_POOLW = 20 * MiB;
constexpr size_t WS_HGWIN = 24 * MiB;
constexpr size_t WS_HGWOUT = 56 * MiB;
constexpr size_t WS_RTWIN = 64 * MiB;
constexpr size_t WS_RTWOUT = 112 * MiB;
constexpr size_t WS_FFWIN = 128 * MiB;
constexpr size_t WS_FFWOUT = 304 * MiB;
constexpr size_t WS_U = 392 * MiB;
constexpr size_t WS_P = 456 * MiB;
constexpr size_t WS_PROJ = 584 * MiB;
constexpr size_t WS_O = 968 * MiB;
constexpr size_t WS_H = 1224 * MiB;
constexpr size_t WS_H2 = 1288 * MiB;
constexpr size_t WS_END = 1352 * MiB;
constexpr int CW_TMO = 0, CW_CODE = 1, CW_BAR = 4096;

constexpr int RING_OFF = 0, RING_BYTES = 131072;
constexpr int LDSCTL_OFF = RING_BYTES, MISC_OFF = LDSCTL_OFF + 320;
constexpr int LDS_BYTES = 147456;
constexpr int NWAVES = 8;

#define GAS __attribute__((address_space(1)))
#define LAS __attribute__((address_space(3)))
#define CAS __attribute__((address_space(4)))
typedef unsigned short bf16;
typedef unsigned v4u __attribute__((ext_vector_type(4)));
typedef unsigned v2u __attribute__((ext_vector_type(2)));
typedef float f32x4 __attribute__((ext_vector_type(4)));
typedef GAS unsigned gu32;
#define RLX_AGENT __ATOMIC_RELAXED, __HIP_MEMORY_SCOPE_AGENT
#define LDS_WAIT() asm volatile("s_waitcnt lgkmcnt(0)" ::: "memory")
__device__ __forceinline__ unsigned f2bf(float f) { unsigned u = __builtin_bit_cast(unsigned, f); return (u + 0x7fffu + ((u >> 16) & 1u)) >> 16; }
typedef float pk_f2 __attribute__((ext_vector_type(2)));
typedef __bf16 pk_b2 __attribute__((ext_vector_type(2)));
__device__ __forceinline__ unsigned pk2(float lo, float hi) { const pk_f2 v = {lo, hi}; return __builtin_bit_cast(unsigned, __builtin_convertvector(v, pk_b2)); }
__device__ __forceinline__ float bflo(unsigned w) { return __builtin_bit_cast(float, w << 16); }
__device__ __forceinline__ float bfhi(unsigned w) { return __builtin_bit_cast(float, w & 0xffff0000u); }
__device__ __forceinline__ float bf1(bf16 b) { return __builtin_bit_cast(float, (unsigned)b << 16); }
__device__ __forceinline__ float sigmoid_f(float x) { return __builtin_amdgcn_rcpf(1.0f + __builtin_amdgcn_exp2f(-1.4426950408889634f * x)); }
__device__ __forceinline__ float silu1(float x) { return x * sigmoid_f(x); }

#define XB_TMO      128
#define XB_XCNT(j)  (256  + 64 * (j))
#define XB_XSUB(j)  (1280 + 64 * (j))
#define XB_XGEN(j)  (2304 + 64 * (j))
#define XB_TOP      3328
#define XB_TOPGEN   3392
#define XCD_BAR_WORDS 3456
#define XB_SPIN_CAP (1u << 18)

__device__ __forceinline__ unsigned xb_ld(unsigned* p)              { return __hip_atomic_load(p, __ATOMIC_RELAXED, __HIP_MEMORY_SCOPE_AGENT); }
__device__ __forceinline__ unsigned xb_add(unsigned* p, unsigned v) { return __hip_atomic_fetch_add(p, v, __ATOMIC_RELAXED, __HIP_MEMORY_SCOPE_AGENT); }
__device__ __forceinline__ unsigned xb_xcc_id() { return (unsigned)__builtin_amdgcn_s_getreg((3 << 11) | 20) & 0xFu; }
#define XB_SPIN(cond, bar) do { unsigned _sp = 0; while (cond) { __builtin_amdgcn_s_sleep(1); \
    if ((++_sp & 255u) == 0u) { if (xb_ld(&(bar)[XB_TMO])) break; if (_sp > XB_SPIN_CAP) { atomicAdd(&(bar)[XB_TMO], 1u); break; } } } } while (0)

struct XcdBarrier { unsigned* bar; unsigned x; volatile LAS unsigned* st; };
#define XB_TID() ((int)__builtin_amdgcn_mbcnt_hi(~0u, __builtin_amdgcn_mbcnt_lo(~0u, 0u)) + 64 * xb_wave_id)

__device__ __forceinline__ XcdBarrier xcd_barrier_post(unsigned* bar, volatile LAS unsigned* st, const int xb_wave_id) {
    XcdBarrier b; b.bar = bar; b.x = xb_xcc_id(); b.st = st;
    if (XB_TID() == 0) (void)xb_add(&bar[XB_XCNT(b.x)], 1u);
    return b;
}
__device__ __forceinline__ void xcd_barrier_complete(unsigned* bar, unsigned x, unsigned& nloc, unsigned& nx) {
    const unsigned G = gridDim.x * gridDim.y * gridDim.z;
    unsigned sum, cnt, mine, sp = 0u;
    for (;;) {
        sum = 0u; cnt = 0u; mine = 0u;
#pragma unroll
        for (unsigned j = 0; j < 16; ++j) { const unsigned c = xb_ld(&bar[XB_XCNT(j)]); sum += c; cnt += (c > 0u) ? 1u : 0u; mine = (j == x) ? c : mine; }
        if (sum == G) break;
        __builtin_amdgcn_s_sleep(1);
        if ((++sp & 255u) == 0u) { if (xb_ld(&bar[XB_TMO])) break; if (sp > XB_SPIN_CAP) { atomicAdd(&bar[XB_TMO], 1u); break; } }
    }
    nloc = mine > 0u ? mine : 1u; nx = cnt > 0u ? cnt : 1u;
}
__device__ __forceinline__ void xcd_barrier(const XcdBarrier& b, const int xb_wave_id) {
    asm volatile("s_waitcnt vmcnt(0)" ::: "memory");
    __syncthreads();
    if (XB_TID() == 0) {
        unsigned* bar = b.bar;
        __builtin_amdgcn_s_waitcnt(0);
        unsigned nloc = b.st[0], nx = b.st[1];
        if (nloc == 0u) { xcd_barrier_complete(bar, b.x, nloc, nx); b.st[0] = nloc; b.st[1] = nx; }
        const unsigned old = xb_add(&bar[XB_XSUB(b.x)], 1u);
        const unsigned gen = old / nloc;
        if (old + 1u == (gen + 1u) * nloc) {
            __builtin_amdgcn_fence(__ATOMIC_RELEASE, "agent");
            asm volatile("s_waitcnt vmcnt(0)" ::: "memory");
            const unsigned og = xb_add(&bar[XB_TOP], 1u);
            const unsigned tg = og / nx;
            if (og + 1u == (tg + 1u) * nx) xb_add(&bar[XB_TOPGEN], 1u);
            else XB_SPIN(xb_ld(&bar[XB_TOPGEN]) == tg, bar);
            __builtin_amdgcn_fence(__ATOMIC_ACQUIRE, "agent");
            xb_add(&bar[XB_XGEN(b.x)], 1u);
            asm volatile("s_waitcnt vmcnt(0)" ::: "memory");
        } else {
            XB_SPIN(xb_ld(&bar[XB_XGEN(b.x)]) == gen, bar);
            __builtin_amdgcn_fence(__ATOMIC_ACQUIRE, "agent");
            asm volatile("s_waitcnt vmcnt(0)" ::: "memory");
        }
    }
    __syncthreads();
}

struct Args {
    const float* x; const float* c; const int* pos; const float* w_ada; const float* b_ada; const float* norm_mix_g; const float* norm_ffn_g;
    const float* pool_w; const float* pool_scale; const float* hgrn_w_in; const float* hgrn_lb; const float* hgrn_norm_g; const float* hgrn_w_out;
    const float* ret_w_in; const float* ret_norm_g; const float* ret_w_out; const float* ffn_w_in; const float* ffn_w_out; const float* final_g;
    float* out; unsigned char* ws; int ph_lo, ph_hi;
};

#define WS_DPP(v, ctrl) __builtin_bit_cast(float, __builtin_amdgcn_update_dpp(0, __builtin_bit_cast(int, v), (ctrl), 0xf, 0xf, true))
__device__ __forceinline__ float row16_sum(float v) { v += WS_DPP(v, 0xB1); v += WS_DPP(v, 0x4E); v += WS_DPP(v, 0x141); v += WS_DPP(v, 0x140); return v; }
#define WS_RL(v, l) __builtin_bit_cast(float, __builtin_amdgcn_readlane(__builtin_bit_cast(int, v), (l)))
__device__ __forceinline__ float wave_sum(float v) { v = row16_sum(v); return (WS_RL(v, 0) + WS_RL(v, 16)) + (WS_RL(v, 32) + WS_RL(v, 48)); }
__device__ __forceinline__ float half_sum(float v) {
    v = row16_sum(v); const float lo = WS_RL(v, 0) + WS_RL(v, 16), hi = WS_RL(v, 32) + WS_RL(v, 48);
    return (__builtin_amdgcn_mbcnt_hi(~0u, __builtin_amdgcn_mbcnt_lo(~0u, 0u)) < 32u) ? lo : hi; }

struct TItem { const float* W; bf16* WT; int K, N, mode, item; };
__device__ __forceinline__ void titem_load(const TItem& t, int lane, f32x4 (&wv)[8]) {
    const int nblk = t.N / 32, kb = t.item / nblk, nb = t.item % nblk, k0 = 64 * kb, n0 = 32 * nb;
#pragma unroll
    for (int i = 0; i < 8; ++i) wv[i] = *(const GAS f32x4*)(t.W + (size_t)(k0 + 8 * i + (lane >> 3)) * t.N + n0 + 4 * (lane & 7));
}
__device__ __forceinline__ void titem_finish(const TItem& t, LAS float* scr, int lane, const f32x4 (&wv)[8]) {
    const int nblk = t.N / 32, kb = t.item / nblk, nb = t.item % nblk, k0 = 64 * kb, n0 = 32 * nb;
    int d0 = n0;
    if (t.mode == 1) { const int bj = n0 >= FF ? 1 : 0, j = n0 - bj * FF; d0 = 256 * (j >> 7) + 128 * bj + (j & 127); }
    if (t.mode == 2 && n0 < 4096) { const int bj = n0 >> 11, j = n0 & 2047; d0 = 256 * (j >> 7) + 128 * bj + (j & 127); }
#pragma unroll
    for (int i = 0; i < 8; ++i) { LAS float* d = scr + (8 * i + (lane >> 3)) * 33 + 4 * (lane & 7); d[0] = wv[i].x; d[1] = wv[i].y; d[2] = wv[i].z; d[3] = wv[i].w; }
    LDS_WAIT(); asm volatile("" ::: "memory");
    const int c = lane & 7;
#pragma unroll
    for (int j = 0; j < 4; ++j) { const int n = (lane >> 3) + 8 * j; const LAS float* s = scr + (8 * c) * 33 + n;
        v4u o; o.x = pk2(s[0 * 33], s[1 * 33]); o.y = pk2(s[2 * 33], s[3 * 33]); o.z = pk2(s[4 * 33], s[5 * 33]); o.w = pk2(s[6 * 33], s[7 * 33]);
        if (t.mode == 3) { const int nn = d0 + n, kk = k0 + 8 * c;
            *(GAS v4u*)(t.WT + (size_t)((((nn >> 5) * 32 + (kk >> 4)) * 64) + ((kk >> 3) & 1) * 32 + (nn & 31)) * 8) = o; }
        else *(GAS v4u*)(t.WT + (size_t)(d0 + n) * t.K + k0 + 8 * c) = o; }
    LDS_WAIT(); asm volatile("" ::: "memory");
}
__device__ __forceinline__ void transpose_item(const float* W, int K, int N, bf16* WT, int mode, LAS float* scr, int item, int lane) {
    const TItem t{W, WT, K, N, mode, item}; f32x4 wv[8]; titem_load(t, lane, wv); titem_finish(t, scr, lane, wv);
}
template <class AP> __device__ __forceinline__ void phase_prologue(const AP a, LAS unsigned char* lds, int tid, int lane, int wave, int vcu, int G) {
    unsigned char* ws = a->ws;
    float* ada = (float*)(ws + WS_ADA);
    LAS float* sc = (LAS float*)lds;
    LAS float* red = (LAS float*)(lds + 32768);
    for (int i = tid; i < NB * DM; i += 512) sc[i] = silu1(a->c[i]);
    __syncthreads();
    for (int it = vcu; it < DEPTH * (ADA_W / 256); it += G) {
        const int l = it / (ADA_W / 256), cb = it % (ADA_W / 256), e0 = cb * 256 + 4 * lane;
        const float* wp = a->w_ada + ((size_t)l * DM + (size_t)wave * 256) * ADA_W + e0;
        f32x4 acc[4];
#pragma unroll
        for (int b = 0; b < 4; ++b) acc[b] = (f32x4){0.f, 0.f, 0.f, 0.f};
#pragma unroll 16
        for (int d = 0; d < 256; ++d) {
            const f32x4 wv = *(const GAS f32x4*)(wp + (size_t)d * ADA_W);
#pragma unroll
            for (int b = 0; b < 4; ++b) { const float s = sc[b * DM + wave * 256 + d]; acc[b] = acc[b] + wv * s; }
        }
#pragma unroll
        for (int b = 0; b < 4; ++b) *(LAS f32x4*)(red + (wave * 4 + b) * 256 + 4 * lane) = acc[b];
        __syncthreads();
        for (int o = tid; o < 4 * 256; o += 512) { const int b = o >> 8, e = o & 255; float s = 0.f;
#pragma unroll
            for (int w = 0; w < 8; ++w) s += red[(w * 4 + b) * 256 + e];
            ada[((size_t)l * NB + b) * ADA_W + cb * 256 + e] = s + a->b_ada[(size_t)l * ADA_W + cb * 256 + e]; }
        __syncthreads();
    }
    const int gw = vcu * NWAVES + wave, NGW = G * NWAVES, gt = gw * 64 + lane, NGT = NGW * 64;
    { float* lb = (float*)(ws + WS_LB);
      for (int col = gt; col < DM; col += NGT) { float z[DEPTH], mx = -1e30f;
#pragma unroll
          for (int j = 0; j < DEPTH; ++j) { z[j] = a->hgrn_lb[j * DM + col]; mx = fmaxf(mx, z[j]); }
          float s = 0.f, e1 = 0.f;
#pragma unroll
          for (int j = 0; j < DEPTH; ++j) { const float e = __expf(z[j] - mx); s += e; if (j == 1) e1 = e; }
          lb[col] = e1 / s; } }
    { unsigned* rt = (unsigned*)(ws + WS_ROT);
      for (int i = gt; i < M * 128; i += NGT) { const int m = i >> 7, f = i & 127;
          const float inv = exp2f(-(float)f * (13.287712379549449f / 128.0f));
          const float ang = (float)a->pos[m] * inv;
          const double rev = (double)ang * 0.15915494309189535; const float fr = (float)(rev - floor(rev));
          const _Float16 ch = (_Float16)__builtin_amdgcn_cosf(fr), sh = (_Float16)__builtin_amdgcn_sinf(fr);
          rt[i] = (unsigned)__builtin_bit_cast(unsigned short, ch) | ((unsigned)__builtin_bit_cast(unsigned short, sh) << 16); } }
    LAS float* scr = (LAS float*)(lds + wave * 16384);
    constexpr int I_POOL = 8 * (512 / 64) * (512 / 32), I_HGI = (DM / 64) * (HG_IN / 32), I_FFI1 = (DM / 64) * (FF2 / 32), I_FFO1 = (FF / 64) * (DM / 32);
    constexpr int NITEMS = I_POOL + I_HGI + I_FFI1 + I_FFO1;
#define EARLY_DECODE(t_, it_) do { int r = (it_); \
        if (r < I_POOL) { const int mt = r / 128; t_ = TItem{a->pool_w + (size_t)mt * 512 * 512, (bf16*)(ws + WS_POOLW) + (size_t)mt * 512 * 512, 512, 512, 3, r % 128}; break; } r -= I_POOL; \
        if (r < I_HGI) { t_ = TItem{a->hgrn_w_in, (bf16*)(ws + WS_HGWIN), DM, HG_IN, 2, r}; break; } r -= I_HGI; \
        if (r < I_FFI1) { t_ = TItem{a->ffn_w_in, (bf16*)(ws + WS_FFWIN), DM, FF2, 1, r}; break; } r -= I_FFI1; \
        t_ = TItem{a->ffn_w_out, (bf16*)(ws + WS_FFWOUT), FF, DM, 0, r}; } while (0)
    { const bool balc = (G == 256); const int NGVC = DEPTH * (ADA_W / 256);
      const int lgs = (balc && vcu >= NGVC) ? 2 : 0, NGWV = balc ? NGVC * NWAVES + (G - NGVC) * NWAVES * 4 : NGW;
      const int vb = balc ? (vcu < NGVC ? gw : NGVC * NWAVES + ((vcu - NGVC) * NWAVES + wave) * 4) : gw;
#define QITEM(q) (vb + ((q) & ((1 << lgs) - 1)) + ((q) >> lgs) * NGWV)
      if (QITEM(0) < NITEMS) {
        TItem t0, t1, t2; f32x4 w0[8], w1[8], w2[8];
        EARLY_DECODE(t0, QITEM(0)); titem_load(t0, lane, w0);
        t1 = t0; if (QITEM(1) < NITEMS) { EARLY_DECODE(t1, QITEM(1)); titem_load(t1, lane, w1); }
        for (int q = 0; QITEM(q) < NITEMS; q += 3) {
            if (QITEM(q + 2) < NITEMS) { EARLY_DECODE(t2, QITEM(q + 2)); titem_load(t2, lane, w2); }
            __builtin_amdgcn_sched_barrier(0);
            titem_finish(t0, scr, lane, w0);
            if (QITEM(q + 1) >= NITEMS) break;
            if (QITEM(q + 3) < NITEMS) { EARLY_DECODE(t0, QITEM(q + 3)); titem_load(t0, lane, w0); }
            __builtin_amdgcn_sched_barrier(0);
            titem_finish(t1, scr, lane, w1);
            if (QITEM(q + 2) >= NITEMS) break;
            if (QITEM(q + 4) < NITEMS) { EARLY_DECODE(t1, QITEM(q + 4)); titem_load(t1, lane, w1); }
            __builtin_amdgcn_sched_barrier(0);
            titem_finish(t2, scr, lane, w2);
        }
      }
#undef QITEM
    }
#undef EARLY_DECODE
    { const int l31 = lane & 31, h5 = lane >> 5;
      const __amdgpu_buffer_rsrc_t rsX = __builtin_amdgcn_make_buffer_rsrc((void*)a->x, (short)0, M * DM * 4, 0x00020000);
      const __amdgpu_buffer_rsrc_t rsC = __builtin_amdgcn_make_buffer_rsrc((void*)(ws + WS_H2), (short)0, M * DM * 2, 0x00020000);
      const bool bal = (G == 256); const int NGV = DEPTH * (ADA_W / 256);
      const int rpa = bal ? (vcu < NGV ? gw : NGV * NWAVES + (vcu - NGV) * NWAVES + wave) : gw, rps = bal ? (vcu < NGV ? M : (G - NGV) * NWAVES) : NGW;
      for (int rp = rpa; rp < M / 2; rp += rps) {
          const int row = 2 * rp + h5; const unsigned vo = (unsigned)row * (DM * 4) + (unsigned)l31 * 32u, vob = (unsigned)row * (DM * 2) + (unsigned)l31 * 16u;
          v4u q0[8], q1[8];
#pragma unroll
          for (int j = 0; j < 8; ++j) { q0[j] = __builtin_amdgcn_raw_buffer_load_b128(rsX, vo, (unsigned)j * 1024u, 0); q1[j] = __builtin_amdgcn_raw_buffer_load_b128(rsX, vo, (unsigned)j * 1024u + 16u, 0); }
          float ss = 0.f;
#pragma unroll
          for (int j = 0; j < 8; ++j) { const f32x4 p = __builtin_bit_cast(f32x4, q0[j]), c = __builtin_bit_cast(f32x4, q1[j]);
              ss += ((p.x * p.x + p.y * p.y) + (p.z * p.z + p.w * p.w)) + ((c.x * c.x + c.y * c.y) + (c.z * c.z + c.w * c.w));
              v4u o; o.x = pk2(p.x, p.y); o.y = pk2(p.z, p.w); o.z = pk2(c.x, c.y); o.w = pk2(c.z, c.w);
              __builtin_amdgcn_raw_buffer_store_b128(o, rsC, vob, (unsigned)j * 512u, 0); }
          ss = half_sum(ss);
          if (l31 == 0) ((float*)(ws + WS_XRS))[row] = 1.0f / sqrtf(ss * (1.0f / DM) + EPS);
      }
    }
}
template <class AP> __device__ __forceinline__ void phase_convert_late(const AP a, LAS unsigned char* lds, int lane, int wave, int gwc, int NGWC) {
    unsigned char* ws = a->ws;
    LAS float* scr = (LAS float*)(lds + wave * 16384);
    constexpr int I_HGO = (DM / 64) * (DM / 32), I_RTI = (DM / 64) * (RT_IN / 32), I_RTO = (RT_V / 64) * (DM / 32), I_FFI1 = (DM / 64) * (FF2 / 32), I_FFO1 = (FF / 64) * (DM / 32);
    constexpr int NITEMS = I_HGO + I_RTI + I_RTO + 3 * I_FFI1 + 3 * I_FFO1;
#define LATE_DECODE(t_, it_) do { int r = (it_); \
        if (r < I_HGO) { t_ = TItem{a->hgrn_w_out, (bf16*)(ws + WS_HGWOUT), DM, DM, 0, r}; break; } r -= I_HGO; \
        if (r < I_RTI) { t_ = TItem{a->ret_w_in, (bf16*)(ws + WS_RTWIN), DM, RT_IN, 0, r}; break; } r -= I_RTI; \
        if (r < I_RTO) { t_ = TItem{a->ret_w_out, (bf16*)(ws + WS_RTWOUT), RT_V, DM, 0, r}; break; } r -= I_RTO; \
        if (r < 3 * I_FFI1) { const int l = 1 + r / I_FFI1; t_ = TItem{a->ffn_w_in + (size_t)l * DM * FF2, (bf16*)(ws + WS_FFWIN) + (size_t)l * FF2 * DM, DM, FF2, 1, r % I_FFI1}; break; } r -= 3 * I_FFI1; \
        { const int l = 1 + r / I_FFO1; t_ = TItem{a->ffn_w_out + (size_t)l * FF * DM, (bf16*)(ws + WS_FFWOUT) + (size_t)l * DM * FF, FF, DM, 0, r % I_FFO1}; } } while (0)
    if (gwc >= NITEMS) return;
    TItem t0, t1, t2; f32x4 w0[8], w1[8], w2[8];
    LATE_DECODE(t0, gwc); titem_load(t0, lane, w0);
    t1 = t0; if (gwc + NGWC < NITEMS) { LATE_DECODE(t1, gwc + NGWC); titem_load(t1, lane, w1); }
    for (int it = gwc; it < NITEMS; it += 3 * NGWC) {
        if (it + 2 * NGWC < NITEMS) { LATE_DECODE(t2, it + 2 * NGWC); titem_load(t2, lane, w2); }
        __builtin_amdgcn_sched_barrier(0);
        titem_finish(t0, scr, lane, w0);
        if (it + NGWC >= NITEMS) break;
        if (it + 3 * NGWC < NITEMS) { LATE_DECODE(t0, it + 3 * NGWC); titem_load(t0, lane, w0); }
        __builtin_amdgcn_sched_barrier(0);
        titem_finish(t1, scr, lane, w1);
        if (it + 2 * NGWC >= NITEMS) break;
        if (it + 4 * NGWC < NITEMS) { LATE_DECODE(t1, it + 4 * NGWC); titem_load(t1, lane, w1); }
        __builtin_amdgcn_sched_barrier(0);
        titem_finish(t2, scr, lane, w2);
    }
#undef LATE_DECODE
}

struct WTile { const float* W; bf16* WT; int K, N, mode, idx; };
__device__ __forceinline__ void wtile_load(const WTile& t, int lane, int wave, f32x4 (&wv)[8]) {
    const int nblk = t.N >> 7, k0 = 128 * (t.idx / nblk), n0 = 128 * (t.idx % nblk);
#pragma unroll
    for (int i = 0; i < 8; ++i) wv[i] = *(const GAS f32x4*)(t.W + (size_t)(k0 + 16 * wave + 2 * i + (lane >> 5)) * t.N + n0 + 4 * (lane & 31));
}
__device__ __forceinline__ void wtile_to_lds(LAS unsigned char* T, int lane, int wave, const f32x4 (&wv)[8]) {
#pragma unroll
    for (int i = 0; i < 8; ++i) { const int r = 16 * wave + 2 * i + (lane >> 5); *(LAS f32x4*)(T + r * 512 + (((lane & 31) ^ ((r >> 3) & 7)) << 4)) = wv[i]; }
}
__device__ __forceinline__ void wtile_store(const WTile& t, const LAS unsigned char* T, int lane, int wave) {
    const int nblk = t.N >> 7, k0 = 128 * (t.idx / nblk), n0 = 128 * (t.idx % nblk);
    const int c = (lane & 7) + 8 * (lane >> 5), nl = (lane >> 3) & 3;
#pragma unroll
    for (int p = 0; p < 4; ++p) { const int nloc = 16 * wave + 4 * p + nl, n = n0 + nloc;
        const LAS float* s = (const LAS float*)(T + (8 * c) * 512 + (((nloc >> 2) ^ (lane & 7)) << 4) + (nloc & 3) * 4);
        v4u o; o.x = pk2(s[0 * 128], s[1 * 128]); o.y = pk2(s[2 * 128], s[3 * 128]); o.z = pk2(s[4 * 128], s[5 * 128]); o.w = pk2(s[6 * 128], s[7 * 128]);
        int d = n;
        if (t.mode == 1) { const int nb = n & ~31, bj = nb >= FF ? 1 : 0, j = nb - bj * FF; d = 256 * (j >> 7) + 128 * bj + (j & 127) + (n & 31); }
        *(GAS v4u*)(t.WT + (size_t)d * t.K + k0 + 8 * c) = o; }
}
#define WT_BAR() do { asm volatile("s_waitcnt lgkmcnt(0)" ::: "memory"); __builtin_amdgcn_s_barrier(); asm volatile("" ::: "memory"); } while (0)
template <class AP> __device__ __forceinline__ void phase_convert_late_tiles(const AP a, LAS unsigned char* lds, int lane, int wave, int wgc, int NWGC) {
    unsigned char* ws = a->ws;
    constexpr int T_HGO = (DM / 128) * (DM / 128), T_RTI = (DM / 128) * (RT_IN / 128), T_RTO = (RT_V / 128) * (DM / 128), T_FFI = (DM / 128) * (FF2 / 128), T_FFO = (FF / 128) * (DM / 128);
    constexpr int NT = T_HGO + T_RTI + T_RTO + 3 * T_FFI + 3 * T_FFO;
#define LATE_TDEC(t_, it_) do { int r = (it_); \
        if (r < T_HGO) { t_ = WTile{a->hgrn_w_out, (bf16*)(ws + WS_HGWOUT), DM, DM, 0, r}; break; } r -= T_HGO; \
        if (r < T_RTI) { t_ = WTile{a->ret_w_in, (bf16*)(ws + WS_RTWIN), DM, RT_IN, 0, r}; break; } r -= T_RTI; \
        if (r < T_RTO) { t_ = WTile{a->ret_w_out, (bf16*)(ws + WS_RTWOUT), RT_V, DM, 0, r}; break; } r -= T_RTO; \
        if (r < 3 * T_FFI) { const int l = 1 + r / T_FFI; t_ = WTile{a->ffn_w_in + (size_t)l * DM * FF2, (bf16*)(ws + WS_FFWIN) + (size_t)l * FF2 * DM, DM, FF2, 1, r % T_FFI}; break; } r -= 3 * T_FFI; \
        { const int l = 1 + r / T_FFO; t_ = WTile{a->ffn_w_out + (size_t)l * FF * DM, (bf16*)(ws + WS_FFWOUT) + (size_t)l * DM * FF, FF, DM, 0, r % T_FFO}; } } while (0)
    if (wgc >= NT) return;
    WTile tc, tn; f32x4 wv[8];
    LATE_TDEC(tc, wgc); wtile_load(tc, lane, wave, wv);
    for (int it = wgc; it < NT; it += NWGC) {
        WT_BAR();
        wtile_to_lds(lds, lane, wave, wv);
        const bool more = it + NWGC < NT;
        tn = tc; if (more) { LATE_TDEC(tn, it + NWGC); wtile_load(tn, lane, wave, wv); }
        WT_BAR();
        wtile_store(tc, lds, lane, wave);
        tc = tn;
    }
    WT_BAR();
#undef LATE_TDEC
}

__device__ __forceinline__ void phase_normmod(const float* hin, const float* g, const float* shift, const float* scale  , bf16* U, int gw, int NGW, int lane) {
    for (int r0 = gw * 8; r0 < M; r0 += NGW * 8) {
        const int b = r0 >> 12; const float* sh = shift + (size_t)b * ADA_W; const float* scp = scale + (size_t)b * ADA_W;
        f32x4 mul[8], add[8];
#pragma unroll
        for (int j = 0; j < 8; ++j) { const int col = 4 * lane + 256 * j; const f32x4 gv = *(const GAS f32x4*)(g + col), s = *(const GAS f32x4*)(scp + col); mul[j] = gv * (s + 1.0f); add[j] = *(const GAS f32x4*)(sh + col); }
        for (int rr = 0; rr < 8; ++rr) {
            const GAS f32x4* xr = (const GAS f32x4*)(hin + (size_t)(r0 + rr) * DM) + lane;
            f32x4 v[8]; float ss = 0.f;
#pragma unroll
            for (int j = 0; j < 8; ++j) { v[j] = xr[64 * j]; ss += (v[j].x * v[j].x + v[j].y * v[j].y) + (v[j].z * v[j].z + v[j].w * v[j].w); }
            const float rstd = 1.0f / sqrtf(wave_sum(ss) * (1.0f / DM) + EPS);
            GAS v2u* o8 = (GAS v2u*)(U + (size_t)(r0 + rr) * DM) + lane;
#pragma unroll
            for (int j = 0; j < 8; ++j) { const f32x4 y = v[j] * rstd * mul[j] + add[j]; v2u w; w.x = pk2(y.x, y.y); w.y = pk2(y.z, y.w); o8[64 * j] = w; }
        }
    }
}
__device__ __forceinline__ void phase_normmod_bf(const bf16* hin, const float* g, const float* shift, const float* scale  , bf16* U, int gw, int NGW, int lane) {
    for (int r0 = gw * 8; r0 < M; r0 += NGW * 8) {
        const int b = r0 >> 12; const float* sh = shift + (size_t)b * ADA_W; const float* scp = scale + (size_t)b * ADA_W;
        f32x4 mul[8], add[8];
#pragma unroll
        for (int j = 0; j < 8; ++j) { const int col = 8 * lane + 512 * (j >> 1) + 4 * (j & 1); const f32x4 gv = *(const GAS f32x4*)(g + col), s = *(const GAS f32x4*)(scp + col); mul[j] = gv * (s + 1.0f); add[j] = *(const GAS f32x4*)(sh + col); }
        for (int rr = 0; rr < 8; ++rr) {
            const GAS v4u* xr = (const GAS v4u*)(hin + (size_t)(r0 + rr) * DM) + lane;
            f32x4 v[8]; float ss = 0.f;
#pragma unroll
            for (int j = 0; j < 4; ++j) { const v4u q = xr[64 * j]; v[2 * j] = (f32x4){bflo(q.x), bfhi(q.x), bflo(q.y), bfhi(q.y)}; v[2 * j + 1] = (f32x4){bflo(q.z), bfhi(q.z), bflo(q.w), bfhi(q.w)}; }
#pragma unroll
            for (int j = 0; j < 8; ++j) ss += (v[j].x * v[j].x + v[j].y * v[j].y) + (v[j].z * v[j].z + v[j].w * v[j].w);
            const float rstd = 1.0f / sqrtf(wave_sum(ss) * (1.0f / DM) + EPS);
            GAS v4u* o16 = (GAS v4u*)(U + (size_t)(r0 + rr) * DM) + lane;
#pragma unroll
            for (int j = 0; j < 4; ++j) { const f32x4 y0 = v[2 * j] * rstd * mul[2 * j] + add[2 * j], y1 = v[2 * j + 1] * rstd * mul[2 * j + 1] + add[2 * j + 1];
                v4u w; w.x = pk2(y0.x, y0.y); w.y = pk2(y0.z, y0.w); w.z = pk2(y1.x, y1.y); w.w = pk2(y1.z, y1.w); o16[64 * j] = w; }
        }
    }
}
__device__ __forceinline__ void phase_finalnorm_bf(const bf16* hin, const float* g, float* out, int gw, int NGW, int lane) {
    for (int r0 = gw * 8; r0 < M; r0 += NGW * 8) {
        f32x4 mul[8];
#pragma unroll
        for (int j = 0; j < 8; ++j) mul[j] = *(const GAS f32x4*)(g + 8 * lane + 512 * (j >> 1) + 4 * (j & 1));
        for (int rr = 0; rr < 8; ++rr) {
            const GAS v4u* xr = (const GAS v4u*)(hin + (size_t)(r0 + rr) * DM) + lane;
            f32x4 v[8]; float ss = 0.f;
#pragma unroll
            for (int j = 0; j < 4; ++j) { const v4u q = xr[64 * j]; v[2 * j] = (f32x4){bflo(q.x), bfhi(q.x), bflo(q.y), bfhi(q.y)}; v[2 * j + 1] = (f32x4){bflo(q.z), bfhi(q.z), bflo(q.w), bfhi(q.w)}; }
#pragma unroll
            for (int j = 0; j < 8; ++j) ss += (v[j].x * v[j].x + v[j].y * v[j].y) + (v[j].z * v[j].z + v[j].w * v[j].w);
            const float rstd = 1.0f / sqrtf(wave_sum(ss) * (1.0f / DM) + EPS);
            float* orow = out + (size_t)(r0 + rr) * DM + 8 * lane;
#pragma unroll
            for (int j = 0; j < 8; ++j) *(GAS f32x4*)(orow + 512 * (j >> 1) + 4 * (j & 1)) = v[j] * rstd * mul[j];
        }
    }
}
__device__ __forceinline__ void phase_finalnorm(const float* hin, const float* g, float* out, int gw, int NGW, int lane) {
    for (int r0 = gw * 8; r0 < M; r0 += NGW * 8) {
        f32x4 mul[8];
#pragma unroll
        for (int j = 0; j < 8; ++j) mul[j] = *(const GAS f32x4*)(g + 4 * lane + 256 * j);
        for (int rr = 0; rr < 8; ++rr) {
            const GAS f32x4* xr = (const GAS f32x4*)(hin + (size_t)(r0 + rr) * DM) + lane;
            f32x4 v[8]; float ss = 0.f;
#pragma unroll
            for (int j = 0; j < 8; ++j) { v[j] = xr[64 * j]; ss += (v[j].x * v[j].x + v[j].y * v[j].y) + (v[j].z * v[j].z + v[j].w * v[j].w); }
            const float rstd = 1.0f / sqrtf(wave_sum(ss) * (1.0f / DM) + EPS);
            GAS f32x4* o = (GAS f32x4*)(out + (size_t)(r0 + rr) * DM) + lane;
#pragma unroll
            for (int j = 0; j < 8; ++j) o[64 * j] = v[j] * rstd * mul[j];
        }
    }
}
__device__ __forceinline__ void phase_pool(const bf16* U, bf16* Pb, int gw, int NGW, int lane) {
    for (int it = gw; it < (M / 32) * 4; it += NGW) {
        const int gi = it & 3, rw = it >> 2, w = 2 << gi, col = gi * 512 + lane * 8;
        for (int rr = 0; rr < 32; ++rr) {
            const int m = rw * 32 + rr, tpos = m & (SEQ - 1), cnt = (tpos + 1 < w) ? tpos + 1 : w;
            float acc[8];
#pragma unroll
            for (int e = 0; e < 8; ++e) acc[e] = 0.f;
            float cur[8];
            for (int j = 0; j < cnt; ++j) {
                const v4u q = *(const GAS v4u*)(U + (size_t)(m - j) * DM + col);
                const float f0 = bflo(q.x), f1 = bfhi(q.x), f2 = bflo(q.y), f3 = bfhi(q.y), f4 = bflo(q.z), f5 = bfhi(q.z), f6 = bflo(q.w), f7 = bfhi(q.w);
                if (j == 0) { cur[0] = f0; cur[1] = f1; cur[2] = f2; cur[3] = f3; cur[4] = f4; cur[5] = f5; cur[6] = f6; cur[7] = f7; }
                acc[0] += f0; acc[1] += f1; acc[2] += f2; acc[3] += f3; acc[4] += f4; acc[5] += f5; acc[6] += f6; acc[7] += f7;
            }
            const float inv = 1.0f / (float)cnt;
            v4u o; o.x = pk2(acc[0] * inv - cur[0], acc[1] * inv - cur[1]); o.y = pk2(acc[2] * inv - cur[2], acc[3] * inv - cur[3]);
            o.z = pk2(acc[4] * inv - cur[4], acc[5] * inv - cur[5]); o.w = pk2(acc[6] * inv - cur[6], acc[7] * inv - cur[7]);
            *(GAS v4u*)(Pb + (size_t)m * DM + col) = o;
        }
    }
}

__device__ __forceinline__ void phase_hgrn_scan_naive(const bf16* PROJ, const float* lbv, float* O, LAS unsigned char* lds, int tid, int vcu, int G) {
    LAS float* qs = (LAS float*)lds;
    LAS float* fs = qs + 16 * 128;
    LAS float* ks = fs + 16 * 128;
    LAS float* vs = ks + 16 * 128;
    const int v = tid >> 4, dg = tid & 15;
    for (int unit = vcu; unit < NB * HG_H * 4; unit += G) {
        const int b = unit >> 6, h = (unit >> 2) & 15, vsl = unit & 3;
        float S[8];
#pragma unroll
        for (int e = 0; e < 8; ++e) S[e] = 0.f;
        const int lt = tid >> 5, ld4 = (tid & 31) * 4;
        float lbl[4];
#pragma unroll
        for (int e = 0; e < 4; ++e) lbl[e] = lbv[h * 128 + ld4 + e];
        for (int ch = 0; ch < SEQ / 16; ++ch) {
            const size_t m0 = (size_t)b * SEQ + (size_t)ch * 16;
            { const bf16* row = PROJ + (m0 + lt) * HG_IN + h * 128 + ld4;
              const v2u qv = *(const GAS v2u*)row, zv = *(const GAS v2u*)(row + 2048);
              const float qf[4] = {bflo(qv.x), bfhi(qv.x), bflo(qv.y), bfhi(qv.y)}, zf[4] = {bflo(zv.x), bfhi(zv.x), bflo(zv.y), bfhi(zv.y)};
#pragma unroll
              for (int e = 0; e < 4; ++e) { const float sg = sigmoid_f(zf[e]), l = lbl[e]; qs[lt * 128 + ld4 + e] = qf[e]; fs[lt * 128 + ld4 + e] = l + (1.0f - l) * sg; ks[lt * 128 + ld4 + e] = (1.0f - l) * (1.0f - sg); }
              vs[tid] = bf1(PROJ[(m0 + (tid >> 5)) * HG_IN + 4096 + h * 128 + vsl * 32 + (tid & 31)]); }
            __syncthreads();
            for (int tt = 0; tt < 16; ++tt) {
                const float vv = vs[tt * 32 + v]; float acc = 0.f;
#pragma unroll
                for (int e = 0; e < 8; ++e) { const int d = dg * 8 + e; S[e] = fs[tt * 128 + d] * S[e] + ks[tt * 128 + d] * vv; acc += S[e] * qs[tt * 128 + d]; }
                acc += __shfl_xor(acc, 1); acc += __shfl_xor(acc, 2); acc += __shfl_xor(acc, 4); acc += __shfl_xor(acc, 8);
                if (dg == 0) O[(m0 + tt) * DM + h * 128 + vsl * 32 + v] = acc;
            }
            __syncthreads();
        }
    }
}
__device__ __forceinline__ void phase_hgrn_post(const bf16* O, const bf16* PROJ, const float* ng, bf16* Pb, int gw, int NGW, int lane) {
    f32x4 nv[4][2];
#pragma unroll
    for (int j = 0; j < 4; ++j) { nv[j][0] = *(const GAS f32x4*)(ng + 512 * j + 8 * lane); nv[j][1] = *(const GAS f32x4*)(ng + 512 * j + 8 * lane + 4); }
    for (int m = gw; m < M; m += NGW) {
        const GAS v4u* orow = (const GAS v4u*)(O + (size_t)m * DM) + lane;
        const GAS v4u* grow = (const GAS v4u*)(PROJ + (size_t)m * HG_IN + 6144) + lane;
        GAS v4u* prow = (GAS v4u*)(Pb + (size_t)m * DM) + lane;
        v4u ob[4], gq[4];
#pragma unroll
        for (int j = 0; j < 4; ++j) { ob[j] = orow[64 * j]; gq[j] = grow[64 * j]; }
#pragma unroll
        for (int j = 0; j < 4; ++j) {
            const f32x4 o0 = (f32x4){bflo(ob[j].x), bfhi(ob[j].x), bflo(ob[j].y), bfhi(ob[j].y)}, o1 = (f32x4){bflo(ob[j].z), bfhi(ob[j].z), bflo(ob[j].w), bfhi(ob[j].w)};
            float ss = ((o0.x * o0.x + o0.y * o0.y) + (o0.z * o0.z + o0.w * o0.w)) + ((o1.x * o1.x + o1.y * o1.y) + (o1.z * o1.z + o1.w * o1.w));
            ss = row16_sum(ss);
            const float rstd = 1.0f / sqrtf(ss * (1.0f / 128.0f) + EPS);
            const v4u g = gq[j];
            v4u w; w.x = pk2(o0.x * rstd * nv[j][0].x * silu1(bflo(g.x)), o0.y * rstd * nv[j][0].y * silu1(bfhi(g.x))); w.y = pk2(o0.z * rstd * nv[j][0].z * silu1(bflo(g.y)), o0.w * rstd * nv[j][0].w * silu1(bfhi(g.y)));
            w.z = pk2(o1.x * rstd * nv[j][1].x * silu1(bflo(g.z)), o1.y * rstd * nv[j][1].y * silu1(bfhi(g.z))); w.w = pk2(o1.z * rstd * nv[j][1].z * silu1(bflo(g.w)), o1.w * rstd * nv[j][1].w * silu1(bfhi(g.w)));
            prow[64 * j] = w;
        }
    }
}
__device__ __forceinline__ void phase_ret_scan_naive(const bf16* PROJ, const float* rot, float* O, LAS unsigned char* lds, int tid, int vcu, int G) {
    LAS float* qs = (LAS float*)lds;
    LAS float* ks = qs + 16 * 256;
    LAS float* vs = ks + 16 * 256;
    const float* ct = rot; const float* st = rot + (size_t)M * 128;
    const int v = tid >> 3, dg = tid & 7;
    for (int unit = vcu; unit < NB * RT_H * 8; unit += G) {
        const int b = unit >> 6, h = (unit >> 3) & 7, vsl = unit & 7;
        const float gamma = 1.0f - exp2f(-5.0f - (float)h);
        float S[32];
#pragma unroll
        for (int e = 0; e < 32; ++e) S[e] = 0.f;
        const int lt = tid >> 5, li = (tid & 31) * 4;
        for (int ch = 0; ch < SEQ / 16; ++ch) {
            const size_t m0 = (size_t)b * SEQ + (size_t)ch * 16;
            { const size_t m = m0 + lt; const bf16* row = PROJ + m * RT_IN + h * 256 + li;
              const v2u q1 = *(const GAS v2u*)row, q2 = *(const GAS v2u*)(row + 128), k1 = *(const GAS v2u*)(row + 2048), k2 = *(const GAS v2u*)(row + 2048 + 128);
              const f32x4 cv = *(const GAS f32x4*)(ct + m * 128 + li), sv = *(const GAS f32x4*)(st + m * 128 + li);
              const float a1[4] = {bflo(q1.x), bfhi(q1.x), bflo(q1.y), bfhi(q1.y)}, a2[4] = {bflo(q2.x), bfhi(q2.x), bflo(q2.y), bfhi(q2.y)};
              const float b1[4] = {bflo(k1.x), bfhi(k1.x), bflo(k1.y), bfhi(k1.y)}, b2[4] = {bflo(k2.x), bfhi(k2.x), bflo(k2.y), bfhi(k2.y)};
#pragma unroll
              for (int e = 0; e < 4; ++e) { const float cc = cv[e], sn = sv[e];
                  qs[lt * 256 + li + e] = a1[e] * cc - a2[e] * sn; qs[lt * 256 + 128 + li + e] = a1[e] * sn + a2[e] * cc;
                  ks[lt * 256 + li + e] = (b1[e] * cc - b2[e] * sn) * 0.0625f; ks[lt * 256 + 128 + li + e] = (b1[e] * sn + b2[e] * cc) * 0.0625f; }
#pragma unroll
              for (int r = 0; r < 2; ++r) { const int idx = tid + r * 512, tt = idx >> 6, vv = idx & 63; vs[idx] = bf1(PROJ[(m0 + tt) * RT_IN + 4096 + h * 512 + vsl * 64 + vv]); } }
            __syncthreads();
            for (int tt = 0; tt < 16; ++tt) {
                const float vv = vs[tt * 64 + v]; float acc = 0.f;
#pragma unroll
                for (int e = 0; e < 32; ++e) { const int d = dg * 32 + e; S[e] = gamma * S[e] + ks[tt * 256 + d] * vv; acc += S[e] * qs[tt * 256 + d]; }
                acc += __shfl_xor(acc, 1); acc += __shfl_xor(acc, 2); acc += __shfl_xor(acc, 4);
                if (dg == 0) O[(m0 + tt) * RT_V + h * 512 + vsl * 64 + v] = acc;
            }
            __syncthreads();
        }
    }
}
__device__ __forceinline__ void phase_ret_post(const bf16* O, const bf16* PROJ, const float* ng, bf16* Pb, int gw, int NGW, int lane) {
    f32x4 nv[8][2];
#pragma unroll
    for (int hh = 0; hh < 8; ++hh) { nv[hh][0] = *(const GAS f32x4*)(ng + 512 * hh + 8 * lane); nv[hh][1] = *(const GAS f32x4*)(ng + 512 * hh + 8 * lane + 4); }
    for (int m = gw; m < M; m += NGW) {
        const GAS v4u* orow = (const GAS v4u*)(O + (size_t)m * RT_V) + lane;
        const GAS v4u* grow = (const GAS v4u*)(PROJ + (size_t)m * RT_IN + 8192) + lane;
        GAS v4u* prow = (GAS v4u*)(Pb + (size_t)m * RT_V) + lane;
        v4u ob[8], gq[8];
#pragma unroll
        for (int hh = 0; hh < 8; ++hh) { ob[hh] = orow[64 * hh]; gq[hh] = grow[64 * hh]; }
#pragma unroll
        for (int hh = 0; hh < 8; ++hh) {
            const f32x4 o0 = (f32x4){bflo(ob[hh].x), bfhi(ob[hh].x), bflo(ob[hh].y), bfhi(ob[hh].y)}, o1 = (f32x4){bflo(ob[hh].z), bfhi(ob[hh].z), bflo(ob[hh].w), bfhi(ob[hh].w)};
            const float ss = ((o0.x * o0.x + o0.y * o0.y) + (o0.z * o0.z + o0.w * o0.w)) + ((o1.x * o1.x + o1.y * o1.y) + (o1.z * o1.z + o1.w * o1.w));
            const float rstd = 1.0f / sqrtf(wave_sum(ss) * (1.0f / 512.0f) + EPS);
            const v4u g = gq[hh];
            v4u w; w.x = pk2(o0.x * rstd * nv[hh][0].x * silu1(bflo(g.x)), o0.y * rstd * nv[hh][0].y * silu1(bfhi(g.x))); w.y = pk2(o0.z * rstd * nv[hh][0].z * silu1(bflo(g.y)), o0.w * rstd * nv[hh][0].w * silu1(bfhi(g.y)));
            w.z = pk2(o1.x * rstd * nv[hh][1].x * silu1(bflo(g.z)), o1.y * rstd * nv[hh][1].y * silu1(bfhi(g.z))); w.w = pk2(o1.z * rstd * nv[hh][1].z * silu1(bflo(g.w)), o1.w * rstd * nv[hh][1].w * silu1(bfhi(g.w)));
            prow[64 * hh] = w;
        }
    }
}

typedef float f32x16 __attribute__((ext_vector_type(16)));
typedef short s16x4 __attribute__((ext_vector_type(4)));
typedef short s16x8 __attribute__((ext_vector_type(8)));
__device__ __forceinline__ unsigned off_b(unsigned row, unsigned ch) { return 256u * row + 16u * (ch ^ (((row & 3u) << 2) | ((row >> 2) & 3u))); }
__device__ __forceinline__ s16x8 tr_frag_b(LAS unsigned char* img, int lane, int c, int ks) {
    const unsigned h = lane >> 5, blk = (lane >> 4) & 1, q = (lane & 15) >> 2, p = lane & 3;
    const unsigned a0 = off_b(16 * ks + 8 * h + q, 4 * c + 2 * blk + (p >> 1)) + 8 * (p & 1), a1 = off_b(16 * ks + 8 * h + 4 + q, 4 * c + 2 * blk + (p >> 1)) + 8 * (p & 1);
    const s16x4 x = __builtin_amdgcn_ds_read_tr16_b64_v4i16((LAS s16x4*)(img + a0)), y = __builtin_amdgcn_ds_read_tr16_b64_v4i16((LAS s16x4*)(img + a1));
    return (s16x8){x[0], x[1], x[2], x[3], y[0], y[1], y[2], y[3]};
}
__device__ __forceinline__ unsigned trb_base(int lane, int c, int tt) {
    const unsigned h = lane >> 5, blk = (lane >> 4) & 1, q = (lane & 15) >> 2, p = lane & 3;
    return 256u * (8 * h + 4 * tt + q) + 16u * ((4 * c + 2 * blk + (p >> 1)) ^ ((q << 2) | ((2 * h + tt) & 3))) + 8 * (p & 1);
}
__device__ __forceinline__ s16x8 tr_frag_b2(LAS unsigned char* img, unsigned b0, unsigned b1, int ks) {
    const s16x4 x = __builtin_amdgcn_ds_read_tr16_b64_v4i16((LAS s16x4*)(img + b0 + 4096 * ks)), y = __builtin_amdgcn_ds_read_tr16_b64_v4i16((LAS s16x4*)(img + b1 + 4096 * ks));
    return (s16x8){x[0], x[1], x[2], x[3], y[0], y[1], y[2], y[3]};
}
__device__ __forceinline__ s16x8 tr_frag_plain(LAS unsigned char* img, int rs, int lane, int c, int ks) {
    const unsigned h = lane >> 5, blk = (lane >> 4) & 1, q = (lane & 15) >> 2, p = lane & 3;
    const unsigned a0 = (16 * ks + 8 * h + q) * rs + (32 * c + 16 * blk + 4 * p) * 2, a1 = a0 + 4 * rs;
    const s16x4 x = __builtin_amdgcn_ds_read_tr16_b64_v4i16((LAS s16x4*)(img + a0)), y = __builtin_amdgcn_ds_read_tr16_b64_v4i16((LAS s16x4*)(img + a1));
    return (s16x8){x[0], x[1], x[2], x[3], y[0], y[1], y[2], y[3]};
}
__device__ __forceinline__ f32x16 mfma32(s16x8 a, s16x8 b, f32x16 c) { return __builtin_amdgcn_mfma_f32_32x32x16_bf16(a, b, c, 0, 0, 0); }
__device__ __forceinline__ f32x16 zero16() { f32x16 z;
#pragma unroll
    for (int i = 0; i < 16; ++i) z[i] = 0.f; return z; }
__device__ __forceinline__ v4u scale_bf8(v4u q, float f) { v4u o; o.x = pk2(bflo(q.x) * f, bfhi(q.x) * f); o.y = pk2(bflo(q.y) * f, bfhi(q.y) * f); o.z = pk2(bflo(q.z) * f, bfhi(q.z) * f); o.w = pk2(bflo(q.w) * f, bfhi(q.w) * f); return o; }

__device__ __forceinline__ void phase_ret_scan(const bf16* PROJ, bf16* O, LAS unsigned char* lds, int tid, int vcu, int G) {
    constexpr int QN = 0, QRS = 528, KN = 33792, VV = KN + 32768, PI = VV + 16384, PRS = 144, ST = PI + 9216, SRS = 528, LDS_END = ST + 33792;
    static_assert(LDS_END <= RING_BYTES, "retention scan LDS map");
    const int lane = tid & 63, wave = __builtin_amdgcn_readfirstlane(tid >> 6);
    for (int unit = vcu; unit < NB * RT_H * 8; unit += G) {
        const int b = unit >> 6, h = (unit >> 3) & 7, vsl = unit & 7;
        const float lg = __log2f(1.0f - exp2f(-5.0f - (float)h));
        const float g64 = exp2f(64.0f * lg);
        f32x16 S[2][2];
#pragma unroll
        for (int a = 0; a < 2; ++a)
#pragma unroll
            for (int c = 0; c < 2; ++c) S[a][c] = zero16();
        for (int i = tid; i < 33792 / 16; i += 512) *(LAS v4u*)(lds + ST + i * 16) = (v4u){0u, 0u, 0u, 0u};
        v4u pq[4], pk[4], pv;
        const __amdgpu_buffer_rsrc_t rsP = __builtin_amdgcn_make_buffer_rsrc((void*)(PROJ + (size_t)b * SEQ * RT_IN), (short)0, SEQ * RT_IN * 2, 0x00020000);
        const __amdgpu_buffer_rsrc_t rsO = __builtin_amdgcn_make_buffer_rsrc((void*)(O + (size_t)b * SEQ * RT_V), (short)0, SEQ * RT_V * 2, 0x00020000);
        const int vrow = tid >> 3, vch = tid & 7;
        const unsigned voq = (unsigned)((tid >> 5) * RT_IN + (tid & 31) * 8) * 2u, vov = (unsigned)(vrow * RT_IN + vch * 8) * 2u;
        const unsigned soq = (unsigned)(h * 256) * 2u, sok = (unsigned)(2048 + h * 256) * 2u, sov = (unsigned)(4096 + h * 512 + vsl * 64) * 2u;
#define RS_PREFETCH(chn) do { const unsigned cb_ = (unsigned)(chn) * 64u * RT_IN * 2u; _Pragma("unroll") for (int i = 0; i < 4; ++i) { \
            pq[i] = __builtin_amdgcn_raw_buffer_load_b128(rsP, voq, cb_ + (unsigned)i * 16u * RT_IN * 2u + soq, 0); pk[i] = __builtin_amdgcn_raw_buffer_load_b128(rsP, voq, cb_ + (unsigned)i * 16u * RT_IN * 2u + sok, 0); } \
            pv = __builtin_amdgcn_raw_buffer_load_b128(rsP, vov, cb_ + sov, 0); } while (0)
        RS_PREFETCH(0);
        float dec[16];
        { const int a31 = lane & 31, a5 = lane >> 5, w4 = wave & 3, t_i = w4 >> 1, x_i = w4 & 1;
#pragma unroll
          for (int r = 0; r < 16; ++r) {
              if (wave < 4) { const int t = 32 * x_i + a31, s = 32 * t_i + 8 * (r >> 2) + 4 * a5 + (r & 3); dec[r] = (s <= t) ? __builtin_amdgcn_exp2f((float)(t - s) * lg) : 0.f; }
              else { const int t = 32 * t_i + (r & 3) + 8 * (r >> 2) + 4 * a5; dec[r] = __builtin_amdgcn_exp2f((float)(t + 1) * lg); } } }
        for (int ch = 0; ch < SEQ / 64; ++ch) {
#pragma unroll
            for (int i = 0; i < 4; ++i) { const int cid = tid + 512 * i, row = cid >> 5, chq = cid & 31;
                *(LAS v4u*)(lds + QN + row * QRS + chq * 16) = pq[i];
                *(LAS v4u*)(lds + KN + (chq >> 4) * 16384 + off_b(row, chq & 15)) = pk[i]; }
            *(LAS v4u*)(lds + VV + off_b(vrow, vch)) = pv;
            *(LAS v4u*)(lds + VV + off_b(vrow, 8 + vch)) = scale_bf8(pv, __builtin_amdgcn_exp2f((float)(63 - vrow) * lg));
            __syncthreads();
#define RS_STORE_O(chs) do { if (wave >= 4) { const int w4s = wave & 3, tis = w4s >> 1, vis = w4s & 1; int lnS = lane; asm volatile("" : "+v"(lnS)); \
                  \
                const LAS unsigned char* sg_ = lds + RING_BYTES + 4096 + w4s * 2048; \
                const unsigned voo = (unsigned)((lnS >> 2) * RT_V + h * 512 + vsl * 64 + 32 * vis + 8 * (lnS & 3)) * 2u; \
                _Pragma("unroll") for (int q = 0; q < 2; ++q) { const v4u ov_ = *(const LAS v4u*)(sg_ + (16 * q + (lnS >> 2)) * 64 + (lnS & 3) * 16); \
                    __builtin_amdgcn_raw_buffer_store_b128(ov_, rsO, voo, (unsigned)((chs) * 64 + 32 * tis + 16 * q) * RT_V * 2u, 0); } } } while (0)
            if (ch > 0) RS_STORE_O(ch - 1);
            if (ch + 1 < SEQ / 64) RS_PREFETCH(ch + 1);
            f32x16 acc = zero16();
            int lnA = lane; asm volatile("" : "+v"(lnA));
            const int a31 = lnA & 31, a5 = lnA >> 5;
            const int w4 = wave & 3, t_i = w4 >> 1, x_i = w4 & 1;
            s16x8 fa0[4], fb0[4], fa1[4], fb1[4];
            if (wave < 4) {
                const int si = t_i, ti = x_i;
#define RS_LD1A(fa, fb, g4) do { _Pragma("unroll") for (int j = 0; j < 2; ++j) { const int ks = 2 * (g4) + j; \
                    fa[j] = *(const LAS s16x8*)(lds + KN + (ks >> 3) * 16384 + off_b(32 * si + a31, 2 * (ks & 7) + a5)); \
                    fb[j] = *(const LAS s16x8*)(lds + QN + (32 * ti + a31) * QRS + (16 * ks + 8 * a5) * 2); } } while (0)
#define RS_MMA4(fa, fb) do { _Pragma("unroll") for (int j = 0; j < 4; ++j) acc = mfma32(fa[j], fb[j], acc); } while (0)
#define RS_MMA2(fa, fb) do { _Pragma("unroll") for (int j = 0; j < 2; ++j) acc = mfma32(fa[j], fb[j], acc); } while (0)
                RS_LD1A(fa0, fb0, 0); RS_LD1A(fa1, fb1, 1);
#pragma unroll
                for (int g2 = 0; g2 < 3; ++g2) { RS_MMA2(fa0, fb0); RS_LD1A(fa0, fb0, 2 * g2 + 2); RS_MMA2(fa1, fb1); RS_LD1A(fa1, fb1, 2 * g2 + 3); }
                RS_MMA2(fa0, fb0); RS_MMA2(fa1, fb1);
#undef RS_LD1A
                const int t = 32 * ti + a31;
#pragma unroll
                for (int g = 0; g < 4; ++g) { float pvv[4];
#pragma unroll
                    for (int e = 0; e < 4; ++e) pvv[e] = acc[4 * g + e] * dec[4 * g + e];
                    v2u w; w.x = pk2(pvv[0], pvv[1]); w.y = pk2(pvv[2], pvv[3]);
                    *(LAS v2u*)(lds + PI + t * PRS + (32 * si + 8 * g + 4 * a5) * 2) = w; }
            } else {
                const int ti = t_i, vi = x_i;
#define RS_LD1B(fa, fb, g4) do { _Pragma("unroll") for (int j = 0; j < 2; ++j) { const int ks = 2 * (g4) + j; \
                    fa[j] = *(const LAS s16x8*)(lds + QN + (32 * ti + a31) * QRS + (16 * ks + 8 * a5) * 2); \
                    fb[j] = *(const LAS s16x8*)(lds + ST + (32 * vi + a31) * SRS + (16 * ks + 8 * a5) * 2); } } while (0)
                RS_LD1B(fa0, fb0, 0); RS_LD1B(fa1, fb1, 1);
#pragma unroll
                for (int g2 = 0; g2 < 3; ++g2) { RS_MMA2(fa0, fb0); RS_LD1B(fa0, fb0, 2 * g2 + 2); RS_MMA2(fa1, fb1); RS_LD1B(fa1, fb1, 2 * g2 + 3); }
                RS_MMA2(fa0, fb0); RS_MMA2(fa1, fb1);
#undef RS_LD1B
#pragma unroll
                for (int r = 0; r < 16; ++r) acc[r] *= dec[r];
            }
            __syncthreads();
            if (wave < 4) {
                LAS unsigned char* kimg0 = lds + KN + ((2 * wave) >> 2) * 16384; LAS unsigned char* kimg1 = lds + KN + ((2 * wave + 1) >> 2) * 16384;
                const unsigned ka0 = trb_base(lnA, (2 * wave) & 3, 0), ka1 = trb_base(lnA, (2 * wave) & 3, 1), kb0 = trb_base(lnA, (2 * wave + 1) & 3, 0), kb1 = trb_base(lnA, (2 * wave + 1) & 3, 1);
                const unsigned va0 = trb_base(lnA, 2, 0), va1 = trb_base(lnA, 2, 1), vb0 = trb_base(lnA, 3, 0), vb1 = trb_base(lnA, 3, 1);
#define RS_LD2A(g2) do { _Pragma("unroll") for (int j = 0; j < 2; ++j) { const int ks = 2 * (g2) + j; fa0[j] = tr_frag_b2(kimg0, ka0, ka1, ks); fa1[j] = tr_frag_b2(kimg1, kb0, kb1, ks); fb0[j] = tr_frag_b2(lds + VV, va0, va1, ks); fb1[j] = tr_frag_b2(lds + VV, vb0, vb1, ks); } } while (0)
#define RS_MMA2A() do { _Pragma("unroll") for (int j = 0; j < 2; ++j) { S[0][0] = mfma32(fa0[j], fb0[j], S[0][0]); S[0][1] = mfma32(fa0[j], fb1[j], S[0][1]); S[1][0] = mfma32(fa1[j], fb0[j], S[1][0]); S[1][1] = mfma32(fa1[j], fb1[j], S[1][1]); } } while (0)
                RS_LD2A(0);
#pragma unroll
                for (int a = 0; a < 2; ++a)
#pragma unroll
                    for (int c = 0; c < 2; ++c)
#pragma unroll
                        for (int r = 0; r < 16; ++r) S[a][c][r] *= g64;
                RS_MMA2A(); RS_LD2A(1); RS_MMA2A();
#undef RS_LD2A
#undef RS_MMA2A
#pragma unroll
                for (int a = 0; a < 2; ++a)
#pragma unroll
                    for (int c = 0; c < 2; ++c)
#pragma unroll
                        for (int g = 0; g < 4; ++g) { const int d = 32 * (2 * wave + a) + 8 * g + 4 * a5, v = 32 * c + a31;
                            v2u w; w.x = pk2(S[a][c][4 * g], S[a][c][4 * g + 1]); w.y = pk2(S[a][c][4 * g + 2], S[a][c][4 * g + 3]);
                            *(LAS v2u*)(lds + ST + v * SRS + d * 2) = w; }
            } else {
                const int ti = t_i, vi = x_i;
#pragma unroll
                for (int ks = 0; ks < 4; ++ks) { fa0[ks] = *(const LAS s16x8*)(lds + PI + (32 * ti + a31) * PRS + (16 * ks + 8 * a5) * 2); fb0[ks] = tr_frag_b2(lds + VV, trb_base(lnA, vi, 0), trb_base(lnA, vi, 1), ks); }
                RS_MMA4(fa0, fb0);
#pragma unroll
                for (int i = 0; i < 8; ++i) { const float o0_ = acc[2 * i], o1_ = acc[2 * i + 1]; const unsigned pr_ = pk2(o0_, o1_);
                    LAS unsigned char* sp_ = lds + RING_BYTES + 4096 + w4 * 2048 + (2 * (i & 1) + 8 * (i >> 1) + 4 * a5) * 64 + a31 * 2;
                    *(LAS unsigned short*)sp_ = (unsigned short)(pr_ & 0xffffu); *(LAS unsigned short*)(sp_ + 64) = (unsigned short)(pr_ >> 16); }
            }
#undef RS_MMA4
#undef RS_PREFETCH_DUMMY
#undef RS_MMA2
            __syncthreads();
        }
        RS_STORE_O(SEQ / 64 - 1);
#undef RS_STORE_O
#undef RS_PREFETCH
    }
}

__device__ __forceinline__ void phase_hgrn_pre(const bf16* PROJ, const float* lbv, bf16* QD, bf16* KI, bf16* KE, float* DEC, int gt, int NGT) {
    for (int it = gt; it < (M / 32) * 256; it += NGT) {
        const int chunk = it >> 8, col = (it & 255) * 8; const size_t m0 = (size_t)chunk * 32;
        float lb[8], tot[8], cum[8];
        { const f32x4 l0 = *(const GAS f32x4*)(lbv + col), l1 = *(const GAS f32x4*)(lbv + col + 4);
#pragma unroll
          for (int e = 0; e < 4; ++e) { lb[e] = l0[e]; lb[4 + e] = l1[e]; } }
#pragma unroll
        for (int e = 0; e < 8; ++e) { tot[e] = 1.f; cum[e] = 1.f; }
#pragma unroll 4
        for (int t = 0; t < 32; ++t) { const v4u zz = *(const GAS v4u*)(PROJ + (m0 + t) * HG_IN + 2048 + col);
            const float z[8] = {bflo(zz.x), bfhi(zz.x), bflo(zz.y), bfhi(zz.y), bflo(zz.z), bfhi(zz.z), bflo(zz.w), bfhi(zz.w)};
#pragma unroll
            for (int e = 0; e < 8; ++e) tot[e] *= lb[e] + (1.0f - lb[e]) * sigmoid_f(z[e]); }
#pragma unroll 2
        for (int t = 0; t < 32; ++t) { const size_t m = m0 + t;
            const v4u zz = *(const GAS v4u*)(PROJ + m * HG_IN + 2048 + col), qq = *(const GAS v4u*)(PROJ + m * HG_IN + col);
            const float z[8] = {bflo(zz.x), bfhi(zz.x), bflo(zz.y), bfhi(zz.y), bflo(zz.z), bfhi(zz.z), bflo(zz.w), bfhi(zz.w)};
            const float q[8] = {bflo(qq.x), bfhi(qq.x), bflo(qq.y), bfhi(qq.y), bflo(qq.z), bfhi(qq.z), bflo(qq.w), bfhi(qq.w)};
            float qd[8], ki[8], ke[8];
#pragma unroll
            for (int e = 0; e < 8; ++e) { const float sg = sigmoid_f(z[e]); cum[e] *= lb[e] + (1.0f - lb[e]) * sg; const float kk = (1.0f - lb[e]) * (1.0f - sg);
                qd[e] = q[e] * cum[e]; ki[e] = kk * __builtin_amdgcn_rcpf(cum[e]); ke[e] = ki[e] * tot[e]; }
            v4u o; o.x = pk2(qd[0], qd[1]); o.y = pk2(qd[2], qd[3]); o.z = pk2(qd[4], qd[5]); o.w = pk2(qd[6], qd[7]); *(GAS v4u*)(QD + m * DM + col) = o;
            o.x = pk2(ki[0], ki[1]); o.y = pk2(ki[2], ki[3]); o.z = pk2(ki[4], ki[5]); o.w = pk2(ki[6], ki[7]); *(GAS v4u*)(KI + m * DM + col) = o;
            o.x = pk2(ke[0], ke[1]); o.y = pk2(ke[2], ke[3]); o.z = pk2(ke[4], ke[5]); o.w = pk2(ke[6], ke[7]); *(GAS v4u*)(KE + m * DM + col) = o; }
        f32x4 d0, d1;
#pragma unroll
        for (int e = 0; e < 4; ++e) { d0[e] = tot[e]; d1[e] = tot[4 + e]; }
        *(GAS f32x4*)(DEC + (size_t)chunk * DM + col) = d0; *(GAS f32x4*)(DEC + (size_t)chunk * DM + col + 4) = d1;
    }
}
__device__ __forceinline__ void phase_hgrn_scan(const bf16* HV, const bf16* QD, const bf16* KI, const bf16* KE, const float* DEC, bf16* Ob, LAS unsigned char* lds, int tid, int u0, int ustride) {
    constexpr int RS = 272, PRS = 80, VRS = 128, SET = 30208;
    constexpr int QI = 0, KII = 8704, KEI = 17408, VI = 25600, DCI = 29696, PI = 2 * SET, ST = PI + 2560, LDS_END = ST + 2 * 8704;
    static_assert(LDS_END + 4096 <= RING_BYTES, "hgrn scan LDS map (+ 2 x 2 KiB output staging)");
    const int lane = tid & 63, wave = __builtin_amdgcn_readfirstlane(tid >> 6), l31 = lane & 31, h5 = lane >> 5;
    const int vt = (wave >> 1) & 1;
    for (int unit = u0; unit < NB * HG_H * 2; unit += ustride) {
        const int b = unit >> 5, h = (unit >> 1) & 15, vp = unit & 1;
        f32x16 S0 = zero16(), S1 = zero16();
        for (int i = tid; i < 2 * 8704 / 16; i += 512) *(LAS v4u*)(lds + ST + i * 16) = (v4u){0u, 0u, 0u, 0u};
        const int row = tid >> 4, c16 = tid & 15;
        const size_t mb = (size_t)b * SEQ;
        v4u q0, ki0, ke0, x0 = (v4u){0u, 0u, 0u, 0u}, q1, ki1, ke1, x1 = (v4u){0u, 0u, 0u, 0u};
#define HS_CLAMP(c_) ((c_) < SEQ / 32 ? (c_) : SEQ / 32 - 1)
#define HS_LOAD(pq_, pki_, pke_, px_, chn) do { const size_t hb_ = (size_t)(b * 16 + h) * SEQ + (size_t)(chn) * 32; \
            pq_ = *(const GAS v4u*)(QD + (hb_ + row) * 128 + c16 * 8); pki_ = *(const GAS v4u*)(KI + (hb_ + row) * 128 + c16 * 8); pke_ = *(const GAS v4u*)(KE + (hb_ + row) * 128 + c16 * 8); \
            if (tid < 256) px_ = *(const GAS v4u*)(HV + (hb_ + (tid >> 3)) * 128 + vp * 64 + (tid & 7) * 8); \
            else if (tid < 288) px_ = *(const GAS v4u*)(DEC + ((size_t)(b * 16 + h) * (SEQ / 32) + (chn)) * 128 + (tid - 256) * 4); } while (0)
#define HS_WRITE(IB, pq_, pki_, pke_, px_) do { \
            *(LAS v4u*)(lds + (IB) + QI + row * RS + c16 * 16) = pq_; *(LAS v4u*)(lds + (IB) + KII + row * RS + c16 * 16) = pki_; *(LAS v4u*)(lds + (IB) + KEI + off_b(row, c16)) = pke_; \
            if (tid < 256) *(LAS v4u*)(lds + (IB) + VI + (tid >> 3) * VRS + (tid & 7) * 16) = px_; \
            else if (tid < 288) *(LAS v4u*)(lds + (IB) + DCI + (tid - 256) * 16) = px_; } while (0)
#define HS_STORE_O(chs) do { if (wave == 4 || wave == 6) {   \
            const LAS unsigned char* sg_ = lds + LDS_END + vt * 2048; bf16* op = Ob + (mb + (size_t)(chs) * 32 + (lane >> 2)) * DM + h * 128 + vp * 64 + vt * 32 + 8 * (lane & 3); \
            _Pragma("unroll") for (int q = 0; q < 2; ++q) { const v4u ov_ = *(const LAS v4u*)(sg_ + (16 * q + (lane >> 2)) * 64 + (lane & 3) * 16); *(GAS v4u*)(op + (size_t)(16 * q) * DM) = ov_; } } } while (0)
#define HS_CHUNK(IB, NIB, nq_, nki_, nke_, nx_) do { \
            f32x16 acc = zero16(); \
            if (wave == 5) { \
                s16x8 fa[8], fb[8]; \
                _Pragma("unroll") for (int ks = 0; ks < 8; ++ks) { fa[ks] = *(const LAS s16x8*)(lds + (IB) + KII + l31 * RS + (16 * ks + 8 * h5) * 2); fb[ks] = *(const LAS s16x8*)(lds + (IB) + QI + l31 * RS + (16 * ks + 8 * h5) * 2); } \
                _Pragma("unroll") for (int ks = 0; ks < 8; ++ks) acc = mfma32(fa[ks], fb[ks], acc); \
                const int t = l31; \
                _Pragma("unroll") for (int g = 0; g < 4; ++g) { float pvv[4]; \
                    _Pragma("unroll") for (int e = 0; e < 4; ++e) { const int s = 8 * g + 4 * h5 + e; pvv[e] = (s <= t) ? acc[4 * g + e] : 0.f; } \
                    v2u w; w.x = pk2(pvv[0], pvv[1]); w.y = pk2(pvv[2], pvv[3]); \
                    *(LAS v2u*)(lds + PI + t * PRS + (8 * g + 4 * h5) * 2) = w; } \
            } else if (wave == 4 || wave == 6) { \
                s16x8 fa[8], fb[8]; \
                _Pragma("unroll") for (int ks = 0; ks < 8; ++ks) { fa[ks] = *(const LAS s16x8*)(lds + (IB) + QI + l31 * RS + (16 * ks + 8 * h5) * 2); fb[ks] = *(const LAS s16x8*)(lds + ST + vt * 8704 + l31 * RS + (16 * ks + 8 * h5) * 2); } \
                _Pragma("unroll") for (int ks = 0; ks < 8; ++ks) acc = mfma32(fa[ks], fb[ks], acc); \
            } \
            __syncthreads(); \
            if (wave < 4) { \
                _Pragma("unroll") for (int g = 0; g < 4; ++g) { const f32x4 dv = *(const LAS f32x4*)(lds + (IB) + DCI + (32 * wave + 8 * g + 4 * h5) * 4); \
                    _Pragma("unroll") for (int e = 0; e < 4; ++e) { S0[4 * g + e] *= dv[e]; S1[4 * g + e] *= dv[e]; } } \
                _Pragma("unroll") for (int ks = 0; ks < 2; ++ks) { const s16x8 af = tr_frag_b(lds + (IB) + KEI, lane, wave, ks); \
                    const s16x8 b0 = tr_frag_plain(lds + (IB) + VI, VRS, lane, 0, ks), b1 = tr_frag_plain(lds + (IB) + VI, VRS, lane, 1, ks); S0 = mfma32(af, b0, S0); S1 = mfma32(af, b1, S1); } \
                _Pragma("unroll") for (int g = 0; g < 4; ++g) { const int d = 32 * wave + 8 * g + 4 * h5; \
                    v2u w; w.x = pk2(S0[4 * g], S0[4 * g + 1]); w.y = pk2(S0[4 * g + 2], S0[4 * g + 3]); \
                    *(LAS v2u*)(lds + ST + l31 * RS + d * 2) = w; \
                    w.x = pk2(S1[4 * g], S1[4 * g + 1]); w.y = pk2(S1[4 * g + 2], S1[4 * g + 3]); \
                    *(LAS v2u*)(lds + ST + 8704 + l31 * RS + d * 2) = w; } \
            } else if (wave == 4 || wave == 6) { \
                _Pragma("unroll") for (int ks = 0; ks < 2; ++ks) { const s16x8 af = *(const LAS s16x8*)(lds + PI + l31 * PRS + (16 * ks + 8 * h5) * 2); const s16x8 bfr = tr_frag_plain(lds + (IB) + VI, VRS, lane, vt, ks); acc = mfma32(af, bfr, acc); } \
                _Pragma("unroll") for (int i = 0; i < 8; ++i) { const float o0_ = acc[2 * i], o1_ = acc[2 * i + 1]; const unsigned pr_ = pk2(o0_, o1_); \
                    LAS unsigned char* sp_ = lds + LDS_END + vt * 2048 + (2 * (i & 1) + 8 * (i >> 1) + 4 * h5) * 64 + l31 * 2; \
                    *(LAS unsigned short*)sp_ = (unsigned short)(pr_ & 0xffffu); *(LAS unsigned short*)(sp_ + 64) = (unsigned short)(pr_ >> 16); } \
            } \
            HS_WRITE(NIB, nq_, nki_, nke_, nx_); \
            __syncthreads(); } while (0)
        HS_LOAD(q0, ki0, ke0, x0, 0); HS_LOAD(q1, ki1, ke1, x1, 1);
        HS_WRITE(0, q0, ki0, ke0, x0); HS_LOAD(q0, ki0, ke0, x0, 2);
        __syncthreads();
        for (int ch = 0; ch < SEQ / 32; ch += 2) {
            HS_CHUNK(0, SET, q1, ki1, ke1, x1);     HS_LOAD(q1, ki1, ke1, x1, HS_CLAMP(ch + 3)); HS_STORE_O(ch);
            HS_CHUNK(SET, 0, q0, ki0, ke0, x0);     HS_LOAD(q0, ki0, ke0, x0, HS_CLAMP(ch + 4)); HS_STORE_O(ch + 1);
        }
#undef HS_CLAMP
#undef HS_LOAD
#undef HS_WRITE
#undef HS_STORE_O
#undef HS_CHUNK
    }
}

template <bool XF32>
__device__ __forceinline__ void phase_poolmix(const void* hsrc  , const float* rsrow  , bf16* hout, const float* gnorm, const float* ada_l  ,
                                              const float* pscale, const bf16* Wt  ,
                                              const float* g2, const float* shift2, const float* scale2  , bf16* U2,
                                              LAS unsigned char* lds, int tid, int vcu, int G) {
    constexpr int PA = 0, WB = 65536, RSTD = RING_BYTES, ES = XF32 ? 4 : 2;
    const int lane = tid & 63, wave = __builtin_amdgcn_readfirstlane(tid >> 6), l31 = lane & 31, h5 = lane >> 5;
    LAS float* rstdL = (LAS float*)(lds + RSTD);
    LAS float* rowss = (LAS float*)(lds + RING_BYTES + 4096);
    const __amdgpu_buffer_rsrc_t rsH = __builtin_amdgcn_make_buffer_rsrc((void*)hsrc, (short)0, M * DM * ES, 0x00020000);
    const __amdgpu_buffer_rsrc_t rsO = __builtin_amdgcn_make_buffer_rsrc((void*)hout, (short)0, M * DM * 2, 0x00020000);
    const __amdgpu_buffer_rsrc_t rsW = __builtin_amdgcn_make_buffer_rsrc((void*)Wt, (short)0, 4 * 512 * 512 * 2, 0x00020000);
#define PM_OFFP(row, ch) ((row) * 1024 + 16 * ((ch) ^ ((row) & 15)))
#define PM_OFFW(n, ch) ((n) * 64 + 16 * ((ch) ^ (((n) >> 2) & 3)))
#define PM_LDH(voff, soff) __builtin_amdgcn_raw_buffer_load_b128(rsH, (voff), (soff), 0)
#define PM_UNPK(q_, f_) do { f_[0] = bflo(q_.x); f_[1] = bfhi(q_.x); f_[2] = bflo(q_.y); f_[3] = bfhi(q_.y); f_[4] = bflo(q_.z); f_[5] = bfhi(q_.z); f_[6] = bflo(q_.w); f_[7] = bfhi(q_.w); } while (0)
    for (int unit = vcu; unit < M / 64; unit += G) {
        const int r0 = unit * 64, b = r0 >> 12, tpos0 = r0 & (SEQ - 1), halo = tpos0 < 15 ? tpos0 : 15;
        const float* shp = ada_l + (size_t)b * ADA_W; const float* scp = shp + DM; const float* gtp = shp + 2 * DM;
        if (rsrow) { if (tid < 64 + halo) rstdL[tid + 15 - halo] = rsrow[r0 - halo + tid]; }
        else for (int rp = wave; 2 * rp < 64 + halo; rp += 2 * NWAVES) {
            int rrq[2]; float ssq[2]; v4u qq[2][XF32 ? 16 : 8];
#pragma unroll
            for (int z = 0; z < 2; ++z) { const int rr = 2 * (rp + NWAVES * z) + h5, rrc = rr < 64 + halo ? rr : 63 + halo, row = r0 - halo + rrc; rrq[z] = rr;
                const unsigned vo = (unsigned)row * (DM * ES) + (unsigned)l31 * 16u;
#pragma unroll
                for (int j = 0; j < (XF32 ? 16 : 8); ++j) qq[z][j] = PM_LDH(vo, (unsigned)j * 512u); }
#pragma unroll
            for (int z = 0; z < 2; ++z) { float ss = 0.f;
#pragma unroll
                for (int j = 0; j < (XF32 ? 16 : 8); ++j) { const v4u q = qq[z][j];
                    if constexpr (XF32) { const f32x4 v = __builtin_bit_cast(f32x4, q); ss += (v.x * v.x + v.y * v.y) + (v.z * v.z + v.w * v.w); }
                    else { float f[8]; PM_UNPK(q, f); ss += ((f[0] * f[0] + f[1] * f[1]) + (f[2] * f[2] + f[3] * f[3])) + ((f[4] * f[4] + f[5] * f[5]) + (f[6] * f[6] + f[7] * f[7])); } }
                ssq[z] = ss; }
#pragma unroll
            for (int z = 0; z < 2; ++z) { float ss = ssq[z];
                ss = half_sum(ss);
                const float rstd = 1.0f / sqrtf(ss * (1.0f / DM) + EPS);
                if (l31 == 0 && rrq[z] < 64 + halo) rstdL[rrq[z] + 15 - halo] = rstd; }
        }
        __syncthreads();
#pragma unroll 1
        for (int g = 0; g < 4; ++g) {
            const int w = 2 << g;
            const unsigned wvo = (unsigned)lane * 16u, wso = ((unsigned)g * 16u + 2u * (unsigned)wave) * (32u * 1024u);
            v4u wA[4], wB[4], wC[4];
            v4u hk[8];
#define PM_WLD(dst, kc_) do { _Pragma("unroll") for (int nt = 0; nt < 2; ++nt) _Pragma("unroll") for (int ks = 0; ks < 2; ++ks) \
                dst[nt * 2 + ks] = __builtin_amdgcn_raw_buffer_load_b128(rsW, wvo, wso + (unsigned)(nt * 32 + 2 * (kc_) + ks) * 1024u, 0); } while (0)
            PM_WLD(wA, 0); PM_WLD(wB, 1); PM_WLD(wC, 2);
            { const int oct = tid & 63, col = g * 512 + oct * 8; const unsigned hvo = (unsigned)col * ES;
              float gm[8], sh[8];
              { const f32x4 g0 = *(const GAS f32x4*)(gnorm + col), g1 = *(const GAS f32x4*)(gnorm + col + 4), s0 = *(const GAS f32x4*)(scp + col), s1 = *(const GAS f32x4*)(scp + col + 4);
                const f32x4 a0 = *(const GAS f32x4*)(shp + col), a1 = *(const GAS f32x4*)(shp + col + 4);
#pragma unroll
                for (int e = 0; e < 4; ++e) { gm[e] = g0[e] * (1.0f + s0[e]); gm[4 + e] = g1[e] * (1.0f + s1[e]); sh[e] = a0[e]; sh[4 + e] = a1[e]; } }
              LAS unsigned char* UT = lds + WB;
#pragma unroll
              for (int hf = 0; hf < 2; ++hf) {
                  const int rb = r0 - 15 + 32 * hf;
                  { v4u ha[6], hb2[6]; float rsv[6];
#pragma unroll
                      for (int k = 0; k < 6; ++k) { const int j = wave - 1 + 8 * k, row = rb + j, rowc = (j >= 0 && row >= r0 - halo) ? row : r0;
                          const unsigned so = (unsigned)rowc * (DM * ES);
                          ha[k] = PM_LDH(hvo, so); if constexpr (XF32) hb2[k] = PM_LDH(hvo, so + 16u); rsv[k] = rstdL[rowc - r0 + 15]; }
#pragma unroll
                      for (int k = 0; k < 6; ++k) { const int j = wave - 1 + 8 * k; const float rs_ = rsv[k]; float f[8];
                          if constexpr (XF32) { const f32x4 x0 = __builtin_bit_cast(f32x4, ha[k]), x1 = __builtin_bit_cast(f32x4, hb2[k]); f[0] = x0.x; f[1] = x0.y; f[2] = x0.z; f[3] = x0.w; f[4] = x1.x; f[5] = x1.y; f[6] = x1.z; f[7] = x1.w; }
                          else { PM_UNPK(ha[k], f); if (k >= 2) hk[4 * hf + k - 2] = ha[k]; }
                          v4u uq; uq.x = pk2(f[0] * rs_ * gm[0] + sh[0], f[1] * rs_ * gm[1] + sh[1]); uq.y = pk2(f[2] * rs_ * gm[2] + sh[2], f[3] * rs_ * gm[3] + sh[3]);
                          uq.z = pk2(f[4] * rs_ * gm[4] + sh[4], f[5] * rs_ * gm[5] + sh[5]); uq.w = pk2(f[6] * rs_ * gm[6] + sh[6], f[7] * rs_ * gm[7] + sh[7]);
                          if (j >= 0) *(LAS v4u*)(UT + j * 1024 + oct * 16) = uq; }
                  }
                  __syncthreads();
                  { const int il0 = 4 * wave, sl0 = il0 + 15, tp0 = tpos0 + 32 * hf + il0;
                    float S[8], uc[8];
#pragma unroll
                    for (int e = 0; e < 8; ++e) S[e] = 0.f;
                    { const int cnt = tp0 + 1 < w ? tp0 + 1 : w;
#define PM_WIN(J0, NJ) do { v4u qw[NJ]; \
                          _Pragma("unroll") for (int jj = 0; jj < NJ; ++jj) { const int sj = sl0 - (J0) - jj; qw[jj] = *(const LAS v4u*)(UT + (sj > 0 ? sj : 0) * 1024 + oct * 16); } \
                          _Pragma("unroll") for (int jj = 0; jj < NJ; ++jj) { float f[8]; PM_UNPK(qw[jj], f); const float m_ = (J0) + jj < cnt ? 1.0f : 0.0f; \
                              if ((J0) + jj == 0) { _Pragma("unroll") for (int e = 0; e < 8; ++e) uc[e] = f[e]; } \
                              _Pragma("unroll") for (int e = 0; e < 8; ++e) S[e] += m_ * f[e]; } } while (0)
                      PM_WIN(0, 4);
                      if (w > 4) { PM_WIN(4, 4); if (w > 8) PM_WIN(8, 8); }
#undef PM_WIN
                      const float inv = 1.0f / (float)cnt;
                      v4u o; o.x = pk2(S[0] * inv - uc[0], S[1] * inv - uc[1]); o.y = pk2(S[2] * inv - uc[2], S[3] * inv - uc[3]); o.z = pk2(S[4] * inv - uc[4], S[5] * inv - uc[5]); o.w = pk2(S[6] * inv - uc[6], S[7] * inv - uc[7]);
                      *(LAS v4u*)(lds + PA + PM_OFFP(32 * hf + il0, oct)) = o; }
#pragma unroll
                    for (int r = 1; r < 4; ++r) { const int tpr = tp0 + r, cnt = tpr + 1 < w ? tpr + 1 : w;
                        const v4u qn = *(const LAS v4u*)(UT + (sl0 + r) * 1024 + oct * 16), qo = *(const LAS v4u*)(UT + (sl0 + r - w) * 1024 + oct * 16);
                        float fn[8], fo[8]; PM_UNPK(qn, fn); PM_UNPK(qo, fo); const float m_ = tpr + 1 > w ? 1.0f : 0.0f;
#pragma unroll
                        for (int e = 0; e < 8; ++e) S[e] += fn[e] - m_ * fo[e];
                        const float inv = 1.0f / (float)cnt;
                        v4u o; o.x = pk2(S[0] * inv - fn[0], S[1] * inv - fn[1]); o.y = pk2(S[2] * inv - fn[2], S[3] * inv - fn[3]); o.z = pk2(S[4] * inv - fn[4], S[5] * inv - fn[5]); o.w = pk2(S[6] * inv - fn[6], S[7] * inv - fn[7]);
                        *(LAS v4u*)(lds + PA + PM_OFFP(32 * hf + il0 + r, oct)) = o; }
                  }
                  __syncthreads();
              }
            }
            f32x16 acc[2][2];
#pragma unroll
            for (int a = 0; a < 2; ++a)
#pragma unroll
                for (int c = 0; c < 2; ++c) acc[a][c] = zero16();
#define PM_CHUNK(kc, SET) do { \
                int la_ = lane; asm volatile("" : "+v"(la_)); const int l31_ = la_ & 31, h5_ = la_ >> 5; \
                s16x8 fb[2][2]; \
                _Pragma("unroll") for (int ks = 0; ks < 2; ++ks) _Pragma("unroll") for (int mt = 0; mt < 2; ++mt) fb[mt][ks] = *(const LAS s16x8*)(lds + PA + PM_OFFP(32 * mt + l31_, 4 * (kc) + 2 * ks + h5_)); \
                _Pragma("unroll") for (int ks = 0; ks < 2; ++ks) _Pragma("unroll") for (int nt = 0; nt < 2; ++nt) _Pragma("unroll") for (int mt = 0; mt < 2; ++mt) \
                    acc[nt][mt] = mfma32(__builtin_bit_cast(s16x8, SET[nt * 2 + ks]), fb[mt][ks], acc[nt][mt]); \
                if ((kc) + 3 < 16) PM_WLD(SET, (kc) + 3); } while (0)
            PM_CHUNK(0, wA); PM_CHUNK(1, wB); PM_CHUNK(2, wC); PM_CHUNK(3, wA); PM_CHUNK(4, wB); PM_CHUNK(5, wC); PM_CHUNK(6, wA); PM_CHUNK(7, wB);
            PM_CHUNK(8, wC); PM_CHUNK(9, wA); PM_CHUNK(10, wB); PM_CHUNK(11, wC); PM_CHUNK(12, wA); PM_CHUNK(13, wB); PM_CHUNK(14, wC); PM_CHUNK(15, wA);
#undef PM_CHUNK
#undef PM_WLD
            __syncthreads();
#pragma unroll
            for (int nt = 0; nt < 2; ++nt)
#pragma unroll
                for (int q = 0; q < 4; ++q)
#pragma unroll
                    for (int mt = 0; mt < 2; ++mt) { const int n = 32 * (2 * wave + nt) + 8 * q + 4 * h5, m = 32 * mt + l31;
                        const float y0 = acc[nt][mt][4 * q], y1 = acc[nt][mt][4 * q + 1], y2 = acc[nt][mt][4 * q + 2], y3 = acc[nt][mt][4 * q + 3];
                        v2u o; o.x = pk2(y0, y1); o.y = pk2(y2, y3);
                        *(LAS v2u*)(lds + PA + m * 1040 + n * 2) = o; }
            __syncthreads();
            { const int ch = tid & 63, col = g * 512 + ch * 8; const unsigned hvo = (unsigned)col * ES, ovo = (unsigned)col * 2u;
              const f32x4 gv0 = *(const GAS f32x4*)(gtp + col) * *(const GAS f32x4*)(pscale + col), gv1 = *(const GAS f32x4*)(gtp + col + 4) * *(const GAS f32x4*)(pscale + col + 4);
              if constexpr (XF32) {
#pragma unroll
                  for (int kb = 0; kb < 8; kb += 4) {
                      v4u ha[4], hb2[4];
#pragma unroll
                      for (int k = 0; k < 4; ++k) { const unsigned so = (unsigned)(r0 + wave + 8 * (kb + k)) * (DM * ES); ha[k] = PM_LDH(hvo, so); hb2[k] = PM_LDH(hvo, so + 16u); }
#pragma unroll
                      for (int k = 0; k < 4; ++k) { const int m = wave + 8 * (kb + k); float f[8], y[8];
                          const f32x4 x0 = __builtin_bit_cast(f32x4, ha[k]), x1 = __builtin_bit_cast(f32x4, hb2[k]); f[0] = x0.x; f[1] = x0.y; f[2] = x0.z; f[3] = x0.w; f[4] = x1.x; f[5] = x1.y; f[6] = x1.z; f[7] = x1.w;
                          const v4u yq = *(const LAS v4u*)(lds + PA + m * 1040 + ch * 16); PM_UNPK(yq, y);
                          v4u o; o.x = pk2(f[0] + gv0.x * y[0], f[1] + gv0.y * y[1]); o.y = pk2(f[2] + gv0.z * y[2], f[3] + gv0.w * y[3]); o.z = pk2(f[4] + gv1.x * y[4], f[5] + gv1.y * y[5]); o.w = pk2(f[6] + gv1.z * y[6], f[7] + gv1.w * y[7]);
                          __builtin_amdgcn_raw_buffer_store_b128(o, rsO, ovo, (unsigned)(r0 + m) * (DM * 2u), 0); }
                  }
              } else {
                  (void)hvo;
#pragma unroll
                  for (int kk = 0; kk < 8; ++kk) { const int m = wave + 8 * kk; float f[8], y[8]; PM_UNPK(hk[kk], f);
                      const v4u yq = *(const LAS v4u*)(lds + PA + m * 1040 + ch * 16); PM_UNPK(yq, y);
                      v4u o; o.x = pk2(f[0] + gv0.x * y[0], f[1] + gv0.y * y[1]); o.y = pk2(f[2] + gv0.z * y[2], f[3] + gv0.w * y[3]); o.z = pk2(f[4] + gv1.x * y[4], f[5] + gv1.y * y[5]); o.w = pk2(f[6] + gv1.z * y[6], f[7] + gv1.w * y[7]);
                      __builtin_amdgcn_raw_buffer_store_b128(o, rsO, ovo, (unsigned)(r0 + m) * (DM * 2u), 0);
                      if (U2) { float e[8]; PM_UNPK(o, e);
                          const float s2 = wave_sum(((e[0] * e[0] + e[1] * e[1]) + (e[2] * e[2] + e[3] * e[3])) + ((e[4] * e[4] + e[5] * e[5]) + (e[6] * e[6] + e[7] * e[7])));
                          if (lane == 0) rowss[m] = (g ? rowss[m] : 0.f) + s2; } }
              }
            }
            __syncthreads();
        }
        if (U2) {
            const __amdgpu_buffer_rsrc_t rsU = __builtin_amdgcn_make_buffer_rsrc((void*)U2, (short)0, M * DM * 2, 0x00020000);
            const float* sh2 = shift2 + (size_t)b * ADA_W; const float* sc2 = scale2 + (size_t)b * ADA_W;
            f32x4 mul[8], add[8];
#pragma unroll
            for (int j = 0; j < 8; ++j) { const int col = 8 * lane + 512 * (j >> 1) + 4 * (j & 1); const f32x4 gv = *(const GAS f32x4*)(g2 + col), s = *(const GAS f32x4*)(sc2 + col); mul[j] = gv * (s + 1.0f); add[j] = *(const GAS f32x4*)(sh2 + col); }
#pragma unroll 1
            for (int kb = 0; kb < 8; kb += 2) {
                v4u q[2][4]; float rs2[2];
#pragma unroll
                for (int z = 0; z < 2; ++z) { const int m = wave + 8 * (kb + z); rs2[z] = 1.0f / sqrtf(rowss[m] * (1.0f / DM) + EPS);
#pragma unroll
                    for (int j = 0; j < 4; ++j) q[z][j] = __builtin_amdgcn_raw_buffer_load_b128(rsO, (unsigned)lane * 16u + (unsigned)j * 1024u, (unsigned)(r0 + m) * (DM * 2u), 0); }
#pragma unroll
                for (int z = 0; z < 2; ++z) { const int m = wave + 8 * (kb + z); const float rstd = rs2[z];
#pragma unroll
                    for (int j = 0; j < 4; ++j) { float e[8]; PM_UNPK(q[z][j], e);
                        const f32x4 v0 = {e[0], e[1], e[2], e[3]}, v1 = {e[4], e[5], e[6], e[7]};
                        const f32x4 y0 = v0 * rstd * mul[2 * j] + add[2 * j], y1 = v1 * rstd * mul[2 * j + 1] + add[2 * j + 1];
                        v4u w; w.x = pk2(y0.x, y0.y); w.y = pk2(y0.z, y0.w); w.z = pk2(y1.x, y1.y); w.w = pk2(y1.z, y1.w);
                        __builtin_amdgcn_raw_buffer_store_b128(w, rsU, (unsigned)lane * 16u + (unsigned)j * 1024u, (unsigned)(r0 + m) * (DM * 2u), 0); } }
            }
        }
    }
#undef PM_OFFP
#undef PM_OFFW
#undef PM_LDH
#undef PM_UNPK
}

constexpr int NSUB = 6, PH_FINAL = 1 + NSUB * 2 * DEPTH, PH_END = PH_FINAL + 1;
__host__ __device__ constexpr bool phase_exists(int ph) {
    if (ph == 0 || ph == PH_FINAL) return true;
    const int hl = (ph - 1) / NSUB, s = (ph - 1) % NSUB, layer = hl >> 1;
    if (!(hl & 1) && layer % 3 == 0) return s == 1;
    if ((hl & 1) && layer % 3 == 0 && s == 0) return false;
    if (s == 2) return false;
    if (s == 3 || s == 4) return !(hl & 1) && (layer == 1 || layer == 2);
    return true;
}
__global__ void __launch_bounds__(NWAVES * 64, 2) trunk_fwd(Args a) {
    extern __shared__ __attribute__((aligned(16))) unsigned char lds_raw[];
    LAS unsigned char* lds = (LAS unsigned char*)lds_raw;
    volatile LAS unsigned* MISC = (volatile LAS unsigned*)(lds + MISC_OFF);
    const int G = gridDim.x; const int bx = blockIdx.x; const int vcu = (G % 8 == 0) ? (bx % 8) * (G / 8) + bx / 8 : bx;
    const int NGW = G * NWAVES;
    gu32* ctl = (gu32*)(a.ws + WS_CTL);
    const int wave0 = __builtin_amdgcn_readfirstlane((int)threadIdx.x >> 6);
    for (int u = (int)__builtin_amdgcn_mbcnt_hi(~0u, __builtin_amdgcn_mbcnt_lo(~0u, 0u)) + 64 * wave0; u < (LDS_BYTES - LDSCTL_OFF) / 4; u += NWAVES * 64) ((LAS unsigned*)(lds + LDSCTL_OFF))[u] = 0u;
    __syncthreads();
#define PHASE_IDS() const CAS Args* ap = (const CAS Args*)__builtin_amdgcn_kernarg_segment_ptr(); asm volatile("" : "+s"(ap)); unsigned char* ws = ap->ws; int lane = (int)__builtin_amdgcn_mbcnt_hi(~0u, __builtin_amdgcn_mbcnt_lo(~0u, 0u)); asm volatile("" : "+v"(lane)); const int wave = wave0, tid = wave * 64 + lane, gw = vcu * NWAVES + wave; (void)tid; (void)gw
#if MK_ONE_LAUNCH
    XcdBarrier bar = xcd_barrier_post((unsigned*)(ctl + CW_BAR), MISC + 8, wave0);
#define GRID_BAR() xcd_barrier(bar, wave0)
#else
#define GRID_BAR() do { } while (0)
#endif
    const int lo = a.ph_lo, hi = a.ph_hi;
#define IN(k) (lo <= (k) && (k) < hi)
#define ada ((float*)(ws + WS_ADA))
#define U ((bf16*)(ws + WS_U))
#define Pb ((bf16*)(ws + WS_P))
#define PROJ ((bf16*)(ws + WS_PROJ))
#define O ((bf16*)(ws + WS_O))
#define HQD ((bf16*)(ws + WS_PROJ + 256 * MiB))
#define HKI ((bf16*)(ws + WS_PROJ + 320 * MiB))
#define HKE ((bf16*)(ws + WS_P + 64 * MiB))
#define HDEC ((float*)(ws + WS_O + 128 * MiB))
#define HVV ((bf16*)(ws + WS_O + 136 * MiB))
#define H ((bf16*)(ws + (hl >= 7 ? WS_H2 : WS_H)))
#define HPOOL_OUT ((bf16*)(ws + (hl >= 6 ? WS_H2 : WS_H)))

    if (IN(0)) for (int rep = 0; rep < REP_P0; ++rep) { PHASE_IDS(); phase_prologue(ap, lds, tid, lane, wave, vcu, G); GRID_BAR(); }

    for (int hl = 0; hl < 2 * DEPTH; ++hl) {
        const int layer = hl >> 1, isffn = hl & 1, pb = 1 + NSUB * hl;
        const int kind = layer % 3, jj = layer / 3;
#define ada_l (ada + (size_t)layer * NB * ADA_W)
#define hin_is_x (hl == 0)
        if ((kind != 0) && IN(pb + 0)) for (int rep = 0; rep < REP_S0; ++rep) {
            PHASE_IDS();
            if (hin_is_x) phase_normmod(ap->x, ap->norm_mix_g, ada_l, ada_l + DM, U, gw, NGW, lane);
            else phase_normmod_bf(H, (isffn ? ap->norm_ffn_g : ap->norm_mix_g) + (size_t)layer * DM, ada_l + (isffn ? 3 : 0) * DM, ada_l + (isffn ? 4 : 1) * DM, U, gw, NGW, lane);
            GRID_BAR();
        }
        if (IN(pb + 1)) for (int rep = 0; rep < REP_S1; ++rep) {
            PHASE_IDS();
            if (isffn) {
                pg8::Gemm g{U, (const bf16*)(ws + WS_FFWIN) + (size_t)layer * FF2 * DM, M, FF2, DM, DM, DM, FF2 / 256, 0, 0};
                pg8::StaticOrder S; S.init(M, FF2, G, bx);
                pg8::EpiSwiGLU E{PROJ, FF};
                pg8::gemm_phase<pg8::EpiSwiGLU, pg8::StaticOrder, true>(lds + RING_OFF, g, S, E, tid);
            } else if (kind == 0) {
                phase_poolmix<false>(hin_is_x ? (const void*)(ws + WS_H2) : (const void*)H, hin_is_x ? (const float*)(ws + WS_XRS) : (const float*)nullptr, HPOOL_OUT,
                                     ap->norm_mix_g + (size_t)layer * DM, ada_l, ap->pool_scale + (size_t)jj * DM, (const bf16*)(ws + WS_POOLW) + (size_t)jj * 4 * 512 * 512,
                                     ap->norm_ffn_g + (size_t)layer * DM, ada_l + 3 * DM, ada_l + 4 * DM, U, lds, tid, vcu, G);
            } else {
                const int N = (kind == 1) ? HG_IN : RT_IN;
                pg8::Gemm g{U, (const bf16*)(ws + (kind == 1 ? WS_HGWIN : WS_RTWIN)), M, N, DM, DM, DM, N / 256, 0, 0};
                pg8::StaticOrder S; S.init(M, N, G, bx);
                const float* rot = (const float*)(ws + WS_ROT);
                pg8::EpiBf16Rot E{PROJ, N, rot, rot + (size_t)M * 128, kind == 2 ? 16 : 0, kind == 1 ? 16 : 0, (const float*)(ws + WS_LB), HQD, HKI, HKE, HDEC, HVV};
                pg8::gemm_phase<pg8::EpiBf16Rot, pg8::StaticOrder, true>(lds + RING_OFF, g, S, E, tid);
            }
            GRID_BAR();
        }
        if (0) for (int rep = 0; rep < REP_S2; ++rep) {
            PHASE_IDS();
            phase_hgrn_pre(PROJ, (const float*)(ws + WS_LB), HQD, HKI, HKE, HDEC, gw * 64 + lane, NGW * 64);
            GRID_BAR();
        }
        if (!isffn && kind != 0 && IN(pb + 3)) for (int rep = 0; rep < REP_S2; ++rep) {
            PHASE_IDS();
#if NAIVE_SCANS
            if (kind == 1) phase_hgrn_scan_naive(PROJ, (const float*)(ws + WS_LB), O, lds, tid, vcu, G);
            else phase_ret_scan_naive(PROJ, (const float*)(ws + WS_ROT), O, lds, tid, vcu, G);
#else
            if (kind == 1) { if ((vcu & 1) && G >= 2) phase_convert_late_tiles(ap, lds, lane, wave, vcu >> 1, G >> 1);
                             else phase_hgrn_scan(HVV, HQD, HKI, HKE, HDEC, O, lds, tid, G >= 2 ? (vcu >> 1) : vcu, G >= 2 ? ((G + 1) >> 1) : 1); }
            else phase_ret_scan(PROJ, O, lds, tid, vcu, G);
#endif
            GRID_BAR();
        }
        if (!isffn && kind != 0 && IN(pb + 4)) for (int rep = 0; rep < REP_S3; ++rep) {
            PHASE_IDS();
            if (kind == 1) phase_hgrn_post(O, PROJ, ap->hgrn_norm_g, Pb, gw, NGW, lane);
            else phase_ret_post(O, PROJ, ap->ret_norm_g, Pb, gw, NGW, lane);
            GRID_BAR();
        }
        if ((isffn || kind != 0) && IN(pb + 5)) {
            PHASE_IDS();
            pg8::Gemm g;
            const float* cs = nullptr;
            if (isffn) g = pg8::Gemm{PROJ, (const bf16*)(ws + WS_FFWOUT) + (size_t)layer * DM * FF, M, DM, FF, FF, FF, DM / 256, 0, 0};
            else if (kind == 0) { g = pg8::Gemm{Pb, (const bf16*)(ws + WS_POOLW) + (size_t)jj * 4 * 512 * 512, M, DM, 512, DM, 512, 2, 512, 512 * 512}; cs = ap->pool_scale + (size_t)jj * DM; }
            else if (kind == 1) g = pg8::Gemm{Pb, (const bf16*)(ws + WS_HGWOUT), M, DM, DM, DM, DM, DM / 256, 0, 0};
            else g = pg8::Gemm{Pb, (const bf16*)(ws + WS_RTWOUT), M, DM, RT_V, RT_V, RT_V, DM / 256, 0, 0};
            pg8::StaticOrder S; S.init(M, DM, G, bx);
            pg8::EpiResid E{hin_is_x ? ap->x : (const float*)nullptr, H, H, ada_l + (isffn ? 5 : 2) * DM, ADA_W, cs};
            pg8::gemm_phase<pg8::EpiResid, pg8::StaticOrder, true>(lds + RING_OFF, g, S, E, tid);
            GRID_BAR();
        }
    }
    if (IN(PH_FINAL)) { PHASE_IDS(); phase_finalnorm_bf((const bf16*)(ws + WS_H2), ap->final_g, ap->out, gw, NGW, lane); }
#undef IN
#undef ada
#undef U
#undef Pb
#undef PROJ
#undef O
#undef HQD
#undef HKI
#undef HKE
#undef HDEC
#undef HVV
#undef H
#undef HPOOL_OUT
#undef ada_l
#undef hin_is_x
}

extern "C" void kernel_launch(void* const* d_in, const int* in_sizes, int n_in, void* d_out, int out_size, void* d_ws, size_t ws_size, hipStream_t stream) {
    static int grid = 0;
    if (grid == 0) {
        if (n_in != 19 || in_sizes[0] != M * DM || out_size != M * DM || ws_size < WS_END) { fprintf(stderr, "kernel_launch: unexpected shapes (n_in %d, in0 %d, out %d, ws %zu < %zu); nothing launched\n", n_in, n_in > 0 ? in_sizes[0] : -1, out_size, ws_size, (size_t)WS_END); grid = -1; return; }
        int dev = 0, cus = 0, per_cu = 0;
        if (hipGetDevice(&dev) != hipSuccess || hipDeviceGetAttribute(&cus, hipDeviceAttributeMultiprocessorCount, dev) != hipSuccess) { grid = -1; return; }
        if (hipFuncSetAttribute((const void*)trunk_fwd, hipFuncAttributeMaxDynamicSharedMemorySize, LDS_BYTES) != hipSuccess) { fprintf(stderr, "kernel_launch: hipFuncSetAttribute failed\n"); grid = -1; return; }
        if (hipOccupancyMaxActiveBlocksPerMultiprocessor(&per_cu, (const void*)trunk_fwd, NWAVES * 64, LDS_BYTES) != hipSuccess || per_cu < 1)
            fprintf(stderr, "kernel_launch: note: occupancy query reports %d workgroups per CU\n", per_cu);
        (void)hipGetLastError();
        grid = cus;
    }
    if (grid < 0) return;
    if (hipMemsetAsync((char*)d_ws + WS_CTL, 0, CTL_ZERO_BYTES, stream) != hipSuccess) { fprintf(stderr, "kernel_launch: memset failed\n"); return; }
    Args a{};
    a.x = (const float*)d_in[0]; a.c = (const float*)d_in[1]; a.pos = (const int*)d_in[2]; a.w_ada = (const float*)d_in[3]; a.b_ada = (const float*)d_in[4];
    a.norm_mix_g = (const float*)d_in[5]; a.norm_ffn_g = (const float*)d_in[6]; a.pool_w = (const float*)d_in[7]; a.pool_scale = (const float*)d_in[8];
    a.hgrn_w_in = (const float*)d_in[9]; a.hgrn_lb = (const float*)d_in[10]; a.hgrn_norm_g = (const float*)d_in[11]; a.hgrn_w_out = (const float*)d_in[12];
    a.ret_w_in = (const float*)d_in[13]; a.ret_norm_g = (const float*)d_in[14]; a.ret_w_out = (const float*)d_in[15]; a.ffn_w_in = (const float*)d_in[16];
    a.ffn_w_out = (const float*)d_in[17]; a.final_g = (const float*)d_in[18];
    a.out = (float*)d_out; a.ws = (unsigned char*)d_ws;
#if MK_ONE_LAUNCH
    a.ph_lo = 0; a.ph_hi = PH_END;
    hipLaunchKernelGGL(trunk_fwd, dim3(grid), dim3(NWAVES * 64), LDS_BYTES, stream, a);
    { const hipError_t le = hipPeekAtLastError(); if (le != hipSuccess) fprintf(stderr, "kernel_launch: launch failed: %s\n", hipGetErrorName(le)); }
#else
    for (int ph = 0; ph < PH_END; ++ph) {
        if (!phase_exists(ph)) continue;
        a.ph_lo = ph; a.ph_hi = ph + 1;
        hipLaunchKernelGGL(trunk_fwd, dim3(grid), dim3(NWAVES * 64), LDS_BYTES, stream, a);
        const hipError_t le = hipPeekAtLastError();
        if (le != hipSuccess) { fprintf(stderr, "kernel_launch: launch %d failed: %s\n", ph, hipGetErrorName(le)); break; }
    }
#endif
}
```
